# Optimizing an MI355X kernel written in HIP

```python
import jax
import jax.numpy as jnp
from jax import lax
import numpy as np

D_MODEL = 1024
BATCH = 8
SEQ = 4096
DEPTH = 4

N_HEADS = 16
HEAD_DIM = D_MODEL // N_HEADS
N_KV_GROUPS = 4
HEADS_PER_GROUP = N_HEADS // N_KV_GROUPS
N_BRANCH = 3
CMP_LEN = 32
CMP_STRIDE = 16
CMP_HIDDEN = 4 * HEAD_DIM
SLC_LEN = 64
SLC_TOP_N = 16
WINDOW = 512
Q_BLOCK = 64
D_FF = 2816
CONV_WIDTH = 3
RMS_EPS = 1e-6
NEG_INF = -1e30
FORCE_SCORE = 1e30

kernel_name = "yoco_shortconv_nsa_macaron_trunk"


def rms_norm(x, g):
    x32 = x.astype(jnp.float32)
    y = x32 * lax.rsqrt(jnp.mean(x32 * x32, axis=-1, keepdims=True) + RMS_EPS)
    return (y * g.astype(jnp.float32)).astype(x.dtype)


def masked_softmax(s, mask):
    s = jnp.where(mask, s, NEG_INF)
    m = jnp.max(s, axis=-1, keepdims=True)
    e = jnp.where(mask, jnp.exp(s - m), 0.0)
    return e / jnp.maximum(jnp.sum(e, axis=-1, keepdims=True), 1e-30)


def alibi_slopes():
    h = jnp.arange(1, N_HEADS + 1, dtype=jnp.float32)
    return jnp.exp2(-8.0 * h / N_HEADS).reshape(N_KV_GROUPS, HEADS_PER_GROUP)


def modulate_pre(x, g_pre, shift, scale):
    return rms_norm(x, g_pre) * (1.0 + scale[:, None, :]) + shift[:, None, :]


def gated_post_add(x, y, g_post, gate, weight):
    return x + weight * gate[:, None, :] * rms_norm(y, g_post)


def swiglu_ffn(h, w_in, w_out):
    g, u = jnp.split(h @ w_in, 2, axis=-1)
    return (jax.nn.silu(g) * u) @ w_out


def causal_shift(v, n):
    if n == 0:
        return v
    return jnp.pad(v[:, :-n], ((0, 0), (n, 0), (0, 0)))


def short_conv_mixer(h, w_in, conv_w, w_out):
    b_gate, c_gate, u = jnp.split(h @ w_in, 3, axis=-1)
    v = c_gate * u
    y = sum(conv_w[k] * causal_shift(v, CONV_WIDTH - 1 - k) for k in range(CONV_WIDTH))
    return (b_gate * y) @ w_out


def build_shared_kv(x, c, kv_norm_g, kv_ada_w, kv_ada_b, kv_w, cmp_pos, cmp_w1, cmp_w2):
    B, S, _ = x.shape
    G, dh = N_KV_GROUPS, HEAD_DIM
    shift, scale = jnp.split(jax.nn.silu(c) @ kv_ada_w + kv_ada_b, 2, axis=-1)
    h = modulate_pre(x, kv_norm_g, shift, scale)
    kv = (h @ kv_w).reshape(B, S, N_BRANCH, 2, G, dh)
    kv = jnp.transpose(kv, (2, 3, 0, 4, 1, 5))
    n_cmp = (S - CMP_LEN) // CMP_STRIDE + 1
    tok = jnp.arange(n_cmp)[:, None] * CMP_STRIDE + jnp.arange(CMP_LEN)[None, :]
    blocks = kv[0][:, :, :, tok] + cmp_pos[:, None, None, None]
    blocks = blocks.reshape(2, B, G, n_cmp, CMP_LEN * dh)
    hid = jax.nn.gelu(jnp.einsum('kbgnf,kfh->kbgnh', blocks, cmp_w1))
    kv_cmp = jnp.einsum('kbgnh,khd->kbgnd', hid, cmp_w2)
    kv_slc = kv[1].reshape(2, B, G, S // SLC_LEN, SLC_LEN, dh)
    kv_win = jnp.pad(kv[2], ((0, 0), (0, 0), (0, 0), (WINDOW, 0), (0, 0)))
    return kv_cmp, kv_slc, kv_win


def nsa_mixer(h, kv_cmp, kv_slc, kv_win, w_in, w_out):
    B, S, _ = h.shape
    G, R, dh = N_KV_GROUPS, HEADS_PER_GROUP, HEAD_DIM
    f32 = jnp.float32
    proj = h @ w_in
    q = proj[..., :N_HEADS * dh].reshape(B, S, G, R, dh) * (dh ** -0.5)
    gates = jax.nn.sigmoid(proj[..., N_HEADS * dh:].astype(f32)).reshape(B, S, N_BRANCH, G, R)
    k_cmp, v_cmp = kv_cmp[0], kv_cmp[1]
    k_slc, v_slc = kv_slc[0], kv_slc[1]
    k_win, v_win = kv_win[0], kv_win[1]
    n_cmp = k_cmp.shape[2]
    n_slc = k_slc.shape[2]
    top_n = min(SLC_TOP_N, n_slc)
    cmp_start = jnp.arange(n_cmp) * CMP_STRIDE
    cmp_end = cmp_start + CMP_LEN - 1
    slc_start = jnp.arange(n_slc) * SLC_LEN
    overlap = ((cmp_start[:, None] < slc_start[None, :] + SLC_LEN)
               & (cmp_end[:, None] >= slc_start[None, :])).astype(f32)
    slopes = alibi_slopes()
    sl5 = slopes[None, :, :, None, None]
    bi = jnp.arange(B)[:, None, None, None]
    gi = jnp.arange(G)[None, :, None, None]
    blk = jnp.arange(n_slc)

    def attend_block(qi):
        q0 = qi * Q_BLOCK
        qb = lax.dynamic_slice_in_dim(q, q0, Q_BLOCK, axis=1)
        t = q0 + jnp.arange(Q_BLOCK)
        d_cmp = t[:, None] - cmp_end[None, :]
        s = jnp.einsum('bqgrd,bgnd->bgrqn', qb, k_cmp, preferred_element_type=f32)
        s = s - sl5 * d_cmp.astype(f32)
        p_cmp = masked_softmax(s, d_cmp >= 0)
        o_cmp = jnp.einsum('bgrqn,bgnd->bqgrd', p_cmp.astype(v_cmp.dtype), v_cmp)
        imp = jnp.einsum('bgrqn,nj->bgqj', p_cmp, overlap)
        cur = t // SLC_LEN
        forced = (blk[None, :] == 0) | (blk[None, :] == cur[:, None]) | (blk[None, :] == cur[:, None] - 1)
        future = slc_start[None, :] > t[:, None]
        imp = jnp.where(forced, FORCE_SCORE, jnp.where(future, NEG_INF, imp))
        _, idx = lax.top_k(imp, top_n)
        k_sel = k_slc[bi, gi, idx]
        v_sel = v_slc[bi, gi, idx]
        d_sel = t[None, None, :, None, None] - (idx[..., None] * SLC_LEN + jnp.arange(SLC_LEN))
        s = jnp.einsum('bqgrd,bgqnld->bgrqnl', qb, k_sel, preferred_element_type=f32)
        s = s - slopes[None, :, :, None, None, None] * d_sel[:, :, None].astype(f32)
        s = s.reshape(B, G, R, Q_BLOCK, top_n * SLC_LEN)
        m_sel = (d_sel >= 0)[:, :, None].reshape(B, G, 1, Q_BLOCK, top_n * SLC_LEN)
        p_sel = masked_softmax(s, m_sel).reshape(B, G, R, Q_BLOCK, top_n, SLC_LEN)
        o_sel = jnp.einsum('bgrqnl,bgqnld->bqgrd', p_sel.astype(v_sel.dtype), v_sel)
        kw = lax.dynamic_slice_in_dim(k_win, q0, WINDOW + Q_BLOCK, axis=2)
        vw = lax.dynamic_slice_in_dim(v_win, q0, WINDOW + Q_BLOCK, axis=2)
        spos = q0 - WINDOW + jnp.arange(WINDOW + Q_BLOCK)
        d_win = t[:, None] - spos[None, :]
        m_win = (d_win >= 0) & (d_win < WINDOW) & (spos[None, :] >= 0)
        s = jnp.einsum('bqgrd,bgkd->bgrqk', qb, kw, preferred_element_type=f32)
        s = s - sl5 * d_win.astype(f32)
        p_win = masked_softmax(s, m_win)
        o_win = jnp.einsum('bgrqk,bgkd->bqgrd', p_win.astype(vw.dtype), vw)
        g = lax.dynamic_slice_in_dim(gates, q0, Q_BLOCK, axis=1)
        o = (g[:, :, 0, :, :, None] * o_cmp.astype(f32)
             + g[:, :, 1, :, :, None] * o_sel.astype(f32)
             + g[:, :, 2, :, :, None] * o_win.astype(f32))
        return o.astype(h.dtype)

    o = lax.map(attend_block, jnp.arange(S // Q_BLOCK))
    o = jnp.moveaxis(o, 0, 1).reshape(B, S, N_HEADS * dh)
    return o @ w_out


def setup_inputs(seed: int = 0) -> dict:
    key = jax.random.key(seed)
    ks = jax.random.split(key, 20)
    f32 = jnp.float32
    D = D_MODEL
    n_a = DEPTH // 2
    n_b = DEPTH - n_a
    kv_cols = N_BRANCH * 2 * N_KV_GROUPS * HEAD_DIM

    def dense(k, shape, fan_in):
        return jax.random.normal(k, shape, f32) * fan_in ** -0.5

    def small(k, shape, s):
        return jax.random.normal(k, shape, f32) * s

    return {
        "x": jax.random.normal(ks[0], (BATCH, SEQ, D), f32),
        "c": jax.random.normal(ks[1], (BATCH, D), f32),
        "ada_w": dense(ks[2], (DEPTH, D, 9 * D), D),
        "ada_b": small(ks[3], (DEPTH, 9 * D), 0.01),
        "norm_g": 1.0 + small(ks[4], (DEPTH, 3, 2, D), 0.05),
        "ffn_w_in": dense(ks[5], (DEPTH, 2, D, 2 * D_FF), D),
        "ffn_w_out": dense(ks[6], (DEPTH, 2, D_FF, D), D_FF),
        "a_w_in": dense(ks[7], (n_a, D, 3 * D), D),
        "a_conv": dense(ks[8], (n_a, CONV_WIDTH, D), CONV_WIDTH),
        "a_w_out": dense(ks[9], (n_a, D, D), D),
        "kv_norm_g": 1.0 + small(ks[10], (D,), 0.05),
        "kv_ada_w": dense(ks[11], (D, 2 * D), D),
        "kv_ada_b": small(ks[12], (2 * D,), 0.01),
        "kv_w": dense(ks[13], (D, kv_cols), D),
        "cmp_pos": small(ks[14], (2, CMP_LEN, HEAD_DIM), 0.1),
        "cmp_w1": dense(ks[15], (2, CMP_LEN * HEAD_DIM, CMP_HIDDEN), CMP_LEN * HEAD_DIM),
        "cmp_w2": dense(ks[16], (2, CMP_HIDDEN, HEAD_DIM), CMP_HIDDEN),
        "b_w_in": dense(ks[17], (n_b, D, N_HEADS * HEAD_DIM + N_BRANCH * N_HEADS), D),
        "b_w_out": dense(ks[18], (n_b, N_HEADS * HEAD_DIM, D), N_HEADS * HEAD_DIM),
    }


def reference(x, c, ada_w, ada_b, norm_g, ffn_w_in, ffn_w_out, a_w_in, a_conv, a_w_out,
              kv_norm_g, kv_ada_w, kv_ada_b, kv_w, cmp_pos, cmp_w1, cmp_w2, b_w_in, b_w_out):
    B = x.shape[0]
    D = x.shape[-1]
    n_a = DEPTH // 2
    kv_cmp = kv_slc = kv_win = None
    for layer in range(DEPTH):
        if layer == n_a:
            kv_cmp, kv_slc, kv_win = build_shared_kv(
                x, c, kv_norm_g, kv_ada_w, kv_ada_b, kv_w, cmp_pos, cmp_w1, cmp_w2)
        mod = (jax.nn.silu(c) @ ada_w[layer] + ada_b[layer]).reshape(B, 3, 3, D)
        g = norm_g[layer]
        h = modulate_pre(x, g[0, 0], mod[:, 0, 0], mod[:, 0, 1])
        y = swiglu_ffn(h, ffn_w_in[layer, 0], ffn_w_out[layer, 0])
        x = gated_post_add(x, y, g[0, 1], mod[:, 0, 2], 0.5)
        h = modulate_pre(x, g[1, 0], mod[:, 1, 0], mod[:, 1, 1])
        if layer < n_a:
            y = short_conv_mixer(h, a_w_in[layer], a_conv[layer], a_w_out[layer])
        else:
            y = nsa_mixer(h, kv_cmp, kv_slc, kv_win, b_w_in[layer - n_a], b_w_out[layer - n_a])
        x = gated_post_add(x, y, g[1, 1], mod[:, 1, 2], 1.0)
        h = modulate_pre(x, g[2, 0], mod[:, 2, 0], mod[:, 2, 1])
        y = swiglu_ffn(h, ffn_w_in[layer, 1], ffn_w_out[layer, 1])
        x = gated_post_add(x, y, g[2, 1], mod[:, 2, 2], 0.5)
    return x
```

```cpp
#include <hip/hip_runtime.h>
#include <hip/hip_cooperative_groups.h>
#include <cstdio>
#include <cstdint>
namespace cg = cooperative_groups;
namespace pg8 {
#define PG8_LAS __attribute__((address_space(3)))
typedef unsigned short bf16_t;
typedef short bf16x8 __attribute__((ext_vector_type(8)));
typedef float f32x4 __attribute__((ext_vector_type(4)));
typedef unsigned u32x4 __attribute__((ext_vector_type(4)));
constexpr int BM = 256, BK = 64, HALF = 128, HTB = HALF * BK * 2  , STAGE_BYTES = 8 * HTB, NXCD = 8, WGM = 8;

__host__ __device__ __forceinline__ int lds_byte(int r, int c) { const int st = (r >> 4) * 2 + (c >> 5), rr = r & 15, cc = c & 31, ob = rr * 64 + cc * 2; return st * 1024 + (ob ^ (((ob >> 9) & 1) << 5)); }
__host__ __device__ __forceinline__ void stage_rc(int b, int& R, int& C) { const int st = b / 1024, sb = b % 1024, swz = sb ^ (((sb >> 9) & 1) << 5); R = (st >> 1) * 16 + swz / 64; C = (st & 1) * 32 + (swz % 64) / 2; }
__host__ __device__ __forceinline__ int perm32(int rho) { const int n = rho >> 4, i = rho & 15; return 8 * (i >> 2) + 4 * n + (i & 3); }

struct Unit { int pm, pn; };
struct Gemm { const bf16_t* A; const bf16_t* Bt; int M, N, K, lda; };

struct StaticOrder {
    int nM, nN, nwg, G, c;
    __host__ __device__ void init(int M, int N, int G_, int c_) { nM = M / BM; nN = N / BM; nwg = nM * nN; G = G_; c = c_; }
    __host__ __device__ bool next(int i, Unit& u) const {
        const long L = (long)i * G + c; if (L >= nwg) return false;
        int wgid = (int)L; { const int q = nwg / NXCD, r = nwg % NXCD, xcd = wgid % NXCD, off = wgid / NXCD; wgid = (xcd < r ? xcd * (q + 1) : r * (q + 1) + (xcd - r) * q) + off; }
        const int nig = WGM * nN, gid = wgid / nig, fm = gid * WGM, gsz = (nM - fm) < WGM ? (nM - fm) : WGM;
        u.pm = fm + ((wgid % nig) % gsz); u.pn = (wgid % nig) / gsz; return true;
    }
    __device__ __forceinline__ void a_ready(const Unit&) const {}
    __device__ __forceinline__ void done(const Unit&) const {}
};

__device__ __forceinline__ unsigned cvt_pk_bf16(float lo, float hi) { unsigned r; asm volatile("v_cvt_pk_bf16_f32 %0, %1, %2" : "=v"(r) : "v"(lo), "v"(hi)); return r; }
typedef float f32x2 __attribute__((ext_vector_type(2)));
__device__ __forceinline__ f32x2 gelu_pk(f32x2 v) {
    const f32x2 av = __builtin_elementwise_abs(v), d = av * 0.2316418882f + 1.0f;
    f32x2 t; t.x = __builtin_amdgcn_rcpf(d.x); t.y = __builtin_amdgcn_rcpf(d.y);
    f32x2 q = t * 0.5307027145f + (-0.7265760135f); q = q * t + 0.7107068705f; q = q * t + (-0.142248368f); q = q * t + 0.127414796f; q = q * t;
    const f32x2 s = (v * v) * (-0.72134752044f);
    f32x2 e; e.x = __builtin_amdgcn_exp2f(s.x); e.y = __builtin_amdgcn_exp2f(s.y);
    const f32x2 m = v * (q * e), r = v - m;
    f32x2 o; o.x = v.x < 0.f ? m.x : r.x; o.y = v.y < 0.f ? m.y : r.y; return o;
}


template <class Epi, class Sched, bool ALIGN_EPI = false, bool SP2 = false>
__device__ __forceinline__ void gemm_phase(PG8_LAS unsigned char* lds, const Gemm g, const Sched& S, const Epi& E, const int tid) {
    const int wid = __builtin_amdgcn_readfirstlane(tid >> 6), lane = tid & 63, wr = wid >> 2, wc = wid & 3, fr = lane & 15, fq = lane >> 4;
    const int K = g.K, nt = K / BK;
    unsigned voffA[2], voffB[2];
#pragma unroll
    for (int i = 0; i < 2; ++i) { int R, C; stage_rc(tid * 16 + i * 8192, R, C); const int Rb = Epi::PERM ? ((R & ~31) + perm32(R & 31)) : R;
        voffA[i] = (unsigned)(R * g.lda + C) * 2u; voffB[i] = (unsigned)(Rb * K + C) * 2u; }
    const size_t kstep = (size_t)(BK * 2);
    const size_t hstepB = (size_t)HALF * K * 2, hstepA = (size_t)HALF * g.lda * 2;
    const size_t tstepB = 2 * hstepB, tstepA = 2 * hstepA;
    const unsigned ldsw = (unsigned)wid * 1024u;
    const int aoff = lds_byte(wr * 64 + fr, fq * 8), boff = lds_byte(wc * 32 + fr, fq * 8);
#define PG8_SA(b, h) (((b) * 2 + (h)) * HTB)
#define PG8_SB(b, h) ((4 + (b) * 2 + (h)) * HTB)
#define PG8_STAGE(bufoff, gbase, voff) do { _Pragma("unroll") for (int _i = 0; _i < 2; ++_i) \
        __builtin_amdgcn_global_load_lds((const unsigned*)((const char*)(gbase) + (voff)[_i]), (PG8_LAS unsigned*)(lds + (bufoff) + ldsw + _i * 8192), 16, 0, 0); } while (0)
#define PG8_LDA(dst, b, h) do { _Pragma("unroll") for (int m = 0; m < 4; ++m) _Pragma("unroll") for (int k = 0; k < 2; ++k) dst[m][k] = *(const PG8_LAS bf16x8*)(lds + PG8_SA(b, h) + aoff + m * 2048 + k * 1024); } while (0)
#define PG8_LDB(dst, b, h) do { _Pragma("unroll") for (int n = 0; n < 2; ++n) _Pragma("unroll") for (int k = 0; k < 2; ++k) dst[n][k] = *(const PG8_LAS bf16x8*)(lds + PG8_SB(b, h) + boff + n * 2048 + k * 1024); } while (0)
#define PG8_MMA(ai, bj, At, Bt) do { __builtin_amdgcn_s_setprio(1); _Pragma("unroll") for (int m = 0; m < 4; ++m) _Pragma("unroll") for (int n = 0; n < 2; ++n) _Pragma("unroll") for (int k = 0; k < 2; ++k) \
        acc[ai][bj][m][n] = __builtin_amdgcn_mfma_f32_16x16x32_bf16(Bt[n][k], At[m][k], acc[ai][bj][m][n], 0, 0, 0); __builtin_amdgcn_s_setprio(0); } while (0)
#define PG8_WAIT_V(n) asm volatile("s_waitcnt vmcnt(" #n ")" ::: "memory")
#define PG8_WAIT_L(n) asm volatile("s_waitcnt lgkmcnt(" #n ")" ::: "memory")
#define PG8_BAR __builtin_amdgcn_s_barrier()
#define PG8_SCHED __builtin_amdgcn_sched_barrier(0)
    Unit cur, nxt; int ui = 0;
    if (!S.next(0, cur)) return;
    f32x4 acc[2][2][4][2];
#pragma unroll
    for (int a = 0; a < 2; ++a)
#pragma unroll
        for (int b = 0; b < 2; ++b)
#pragma unroll
            for (int m = 0; m < 4; ++m)
#pragma unroll
                for (int n = 0; n < 2; ++n) acc[a][b][m][n] = (f32x4){0.f, 0.f, 0.f, 0.f};
    bf16x8 At[4][2], B0[2][2], B1[2][2];
    const char* cA = (const char*)g.A + (size_t)cur.pm * tstepA; const char* cB = (const char*)g.Bt + (size_t)cur.pn * tstepB;
    S.a_ready(cur);
    if constexpr (SP2) {
        PG8_STAGE(PG8_SB(0, 0), cB, voffB); PG8_STAGE(PG8_SB(0, 1), cB + hstepB, voffB); PG8_STAGE(PG8_SA(0, 0), cA, voffA); PG8_STAGE(PG8_SA(0, 1), cA + hstepA, voffA);
        if (wr == 1) PG8_BAR;
        PG8_WAIT_V(2); PG8_BAR;
        PG8_STAGE(PG8_SB(1, 0), cB + kstep, voffB); PG8_STAGE(PG8_SA(1, 0), cA + kstep, voffA); PG8_STAGE(PG8_SB(1, 1), cB + hstepB + kstep, voffB);
        PG8_WAIT_V(6); PG8_BAR;
    } else {
        PG8_STAGE(PG8_SB(0, 0), cB, voffB); PG8_STAGE(PG8_SA(0, 0), cA, voffA); PG8_STAGE(PG8_SB(0, 1), cB + hstepB, voffB); PG8_STAGE(PG8_SA(0, 1), cA + hstepA, voffA);
        if (wr == 1) PG8_BAR;
        PG8_WAIT_V(4); PG8_BAR;
        PG8_STAGE(PG8_SB(1, 0), cB + kstep, voffB); PG8_STAGE(PG8_SA(1, 0), cA + kstep, voffA); PG8_STAGE(PG8_SB(1, 1), cB + hstepB + kstep, voffB);
        PG8_WAIT_V(6); PG8_BAR;
    }
    for (;;) {
        const bool has_next = S.next(ui + 1, nxt);
        const char* nA = has_next ? (const char*)g.A + (size_t)nxt.pm * tstepA : cA; const char* nB = has_next ? (const char*)g.Bt + (size_t)nxt.pn * tstepB : cB;
        for (int t = 0; t < nt; t += 2) {
            const bool last = (t == nt - 2);
            const char* a1 = cA + (size_t)(t + 1) * kstep;
            const char* a2 = last ? nA : cA + (size_t)(t + 2) * kstep; const char* b2 = last ? nB : cB + (size_t)(t + 2) * kstep;
            const char* a3 = a2 + kstep; const char* b3 = b2 + kstep;
            if (last && has_next) S.a_ready(nxt);
            if constexpr (SP2) {
            PG8_LDB(B0, 0, 0); PG8_LDB(B1, 0, 1); PG8_SCHED; PG8_LDA(At, 0, 0); PG8_STAGE(PG8_SA(1, 1), a1 + hstepA, voffA);
            PG8_WAIT_V(8); PG8_WAIT_L(0); PG8_BAR; PG8_MMA(0, 0, At, B0); PG8_MMA(0, 1, At, B1); PG8_BAR; PG8_SCHED;
            PG8_LDA(At, 0, 1); PG8_STAGE(PG8_SB(0, 0), b2, voffB); PG8_STAGE(PG8_SB(0, 1), b2 + hstepB, voffB); PG8_STAGE(PG8_SA(0, 0), a2, voffA);
            PG8_WAIT_V(8); PG8_WAIT_L(0); PG8_BAR; PG8_MMA(1, 0, At, B0); PG8_MMA(1, 1, At, B1); PG8_BAR; PG8_SCHED;
            PG8_LDB(B0, 1, 0); PG8_LDB(B1, 1, 1); PG8_SCHED; PG8_LDA(At, 1, 0); PG8_STAGE(PG8_SA(0, 1), a2 + hstepA, voffA);
            PG8_WAIT_V(8); PG8_WAIT_L(0); PG8_BAR; PG8_MMA(0, 0, At, B0); PG8_MMA(0, 1, At, B1); PG8_BAR; PG8_SCHED;
            PG8_LDA(At, 1, 1); PG8_STAGE(PG8_SB(1, 0), b3, voffB); PG8_STAGE(PG8_SB(1, 1), b3 + hstepB, voffB); PG8_STAGE(PG8_SA(1, 0), a3, voffA);
            PG8_WAIT_V(8); PG8_WAIT_L(0); PG8_BAR; PG8_MMA(1, 0, At, B0); PG8_MMA(1, 1, At, B1); PG8_BAR; PG8_SCHED;
            } else {
            PG8_LDB(B0, 0, 0); PG8_SCHED; PG8_LDA(At, 0, 0); PG8_STAGE(PG8_SA(1, 1), a1 + hstepA, voffA);
            PG8_WAIT_L(8); PG8_BAR; PG8_WAIT_L(0); PG8_MMA(0, 0, At, B0); PG8_BAR; PG8_SCHED;
            PG8_LDB(B1, 0, 1); PG8_STAGE(PG8_SB(0, 0), b2, voffB);
            PG8_BAR; PG8_WAIT_L(0); PG8_MMA(0, 1, At, B1); PG8_BAR;
            PG8_LDA(At, 0, 1); PG8_STAGE(PG8_SA(0, 0), a2, voffA);
            PG8_BAR; PG8_WAIT_L(0); PG8_MMA(1, 0, At, B0); PG8_BAR; PG8_SCHED;
            PG8_STAGE(PG8_SB(0, 1), b2 + hstepB, voffB);
            PG8_WAIT_V(6); PG8_BAR; PG8_MMA(1, 1, At, B1); PG8_BAR;
            PG8_LDB(B0, 1, 0); PG8_SCHED; PG8_LDA(At, 1, 0); PG8_STAGE(PG8_SA(0, 1), a2 + hstepA, voffA);
            PG8_WAIT_L(8); PG8_BAR; PG8_WAIT_L(0); PG8_MMA(0, 0, At, B0); PG8_BAR; PG8_SCHED;
            PG8_LDB(B1, 1, 1); PG8_STAGE(PG8_SB(1, 0), b3, voffB);
            PG8_BAR; PG8_WAIT_L(0); PG8_MMA(0, 1, At, B1); PG8_BAR;
            PG8_LDA(At, 1, 1); PG8_STAGE(PG8_SA(1, 0), a3, voffA);
            PG8_BAR; PG8_WAIT_L(0); PG8_MMA(1, 0, At, B0); PG8_BAR; PG8_SCHED;
            PG8_STAGE(PG8_SB(1, 1), b3 + hstepB, voffB);
            PG8_WAIT_V(6); PG8_BAR; PG8_MMA(1, 1, At, B1); PG8_BAR;
            }
        }
        if constexpr (ALIGN_EPI) { if (wr == 0) PG8_BAR; }
        if constexpr (!Epi::AFTER_DRAIN) { E(acc, cur, wr, wc, fr, fq); S.done(cur); }
        if (!has_next) break;
#pragma unroll
        for (int a = 0; a < 2; ++a)
#pragma unroll
            for (int b = 0; b < 2; ++b)
#pragma unroll
                for (int m = 0; m < 4; ++m)
#pragma unroll
                    for (int n = 0; n < 2; ++n) acc[a][b][m][n] = (f32x4){0.f, 0.f, 0.f, 0.f};
        cur = nxt; cA = nA; cB = nB; ++ui;
        if constexpr (ALIGN_EPI) { if (wr == 1) PG8_BAR; }
    }
    PG8_WAIT_V(0);
    if constexpr (!ALIGN_EPI) { if (wr == 0) PG8_BAR; }
    PG8_BAR;
    if constexpr (Epi::AFTER_DRAIN) { E.fused(acc, cur, wr, wc, fr, fq, lds, wid, lane); S.done(cur); }
#undef PG8_SA
#undef PG8_SB
#undef PG8_STAGE
#undef PG8_LDA
#undef PG8_LDB
#undef PG8_MMA
#undef PG8_WAIT_V
#undef PG8_WAIT_L
#undef PG8_BAR
#undef PG8_SCHED
}
}
#define LAS __attribute__((address_space(3)))
using pg8::bf16_t; using pg8::bf16x8; using pg8::f32x4; using pg8::u32x4; using pg8::cvt_pk_bf16;
typedef float f32x16 __attribute__((ext_vector_type(16)));
typedef unsigned u32x2 __attribute__((ext_vector_type(2)));
typedef float f32x2 __attribute__((ext_vector_type(2)));

constexpr int T = 32768, D = 1024, FF = 2816, SEQ = 4096, NBATCH = 8;
constexpr int NPH = 45;
constexpr float EPS = 1e-6f, LOG2E = 1.4426950408889634f;
constexpr size_t MiB = 1u << 20;
constexpr size_t WS_FIN = 0;
constexpr size_t WS_FOUT = WS_FIN + 88 * MiB;
constexpr size_t WS_AIN = WS_FOUT + 44 * MiB;
constexpr size_t WS_AOUT = WS_AIN + 12 * MiB;
constexpr size_t WS_KVW = WS_AOUT + 4 * MiB;
constexpr size_t WS_CW1 = WS_KVW + 3 * MiB;
constexpr size_t WS_BIN = WS_CW1 + 2 * MiB;
constexpr size_t WS_BOUT = WS_BIN + 5 * MiB;
constexpr size_t WS_MOD = WS_BOUT + 4 * MiB;
constexpr size_t WS_KVMOD = WS_MOD + 4ull * 8 * 9216 * 4;
constexpr size_t WS_CBIAS = WS_KVMOD + 8ull * 2048 * 4;
constexpr size_t WS_H = WS_MOD + 2 * MiB;
constexpr size_t WS_HID = WS_H + 64 * MiB;
constexpr size_t WS_Y = WS_HID + 176 * MiB;
constexpr size_t WS_PART = WS_Y + 64 * MiB;
constexpr size_t WS_GATES = WS_PART + 2 * MiB;
constexpr size_t WS_KC = WS_GATES + 6 * MiB;
constexpr size_t WS_KS = WS_KC + 33 * MiB;
constexpr size_t WS_KW = WS_KS + 16 * MiB;
constexpr size_t WS_VST = WS_KW + 16 * MiB;
constexpr size_t WS_VWT = WS_VST + 16 * MiB;
constexpr size_t WS_HIDC = WS_VWT + 16 * MiB;
constexpr size_t WS_KCMP = WS_HIDC + 8 * MiB;
constexpr size_t WS_VCMPT = WS_KCMP + 1 * MiB;
constexpr size_t WS_END = WS_VCMPT + 1 * MiB;
constexpr int LDS_BYTES = 135168;

struct Params { const float* in[19]; float* out; unsigned char* ws; int ph_lo, ph_hi; };
enum { I_X = 0, I_C, I_ADAW, I_ADAB, I_NORMG, I_FIN, I_FOUT, I_AIN, I_ACONV, I_AOUT, I_KVNG, I_KVADAW, I_KVADAB, I_KVW, I_CPOS, I_CW1, I_CW2, I_BIN, I_BOUT };

__device__ __forceinline__ float bf2f(unsigned short b) { return __uint_as_float((unsigned)b << 16); }
__device__ __forceinline__ float fexp2(float x) { return __builtin_amdgcn_exp2f(x); }
__device__ __forceinline__ float frcp(float x) { return __builtin_amdgcn_rcpf(x); }
__device__ __forceinline__ float silu_f(float g) { return g * frcp(1.f + fexp2(-g * LOG2E)); }
__device__ __forceinline__ float wave_sum(float v) {
#pragma unroll
    for (int o = 1; o < 64; o <<= 1) v += __shfl_xor(v, o);
    return v;
}
template <class Tp> __device__ __forceinline__ Tp* uptr(Tp* p) { const unsigned long long v = (unsigned long long)p; const unsigned lo = __builtin_amdgcn_readfirstlane((unsigned)v), hi = __builtin_amdgcn_readfirstlane((unsigned)(v >> 32)); typedef __attribute__((address_space(1))) Tp* gptr_t; gptr_t gp = (gptr_t)(((unsigned long long)hi << 32) | lo); return (Tp*)gp; }
#define LDS_WAIT() asm volatile("s_waitcnt lgkmcnt(0)" ::: "memory")

namespace pg8 {
__device__ __forceinline__ u32x4 pack8(const f32x4 a, const f32x4 b) { u32x4 w; w.x = cvt_pk_bf16(a[0], a[1]); w.y = cvt_pk_bf16(a[2], a[3]); w.z = cvt_pk_bf16(b[0], b[1]); w.w = cvt_pk_bf16(b[2], b[3]); return w; }
struct EpiSwiglu {
    static constexpr bool PERM = true, AFTER_DRAIN = false;
    bf16_t* O;
    __device__ __forceinline__ void operator()(const f32x4 (&acc)[2][2][4][2], const Unit& u, int wr, int wc, int fr, int fq) const {
        const int row0 = u.pm * BM + wr * 64 + fr, col0 = u.pn * 128 + wc * 32 + 8 * fq;
#pragma unroll
        for (int ai = 0; ai < 2; ++ai)
#pragma unroll
            for (int m = 0; m < 4; ++m) {
                f32x4 h0, h1;
#pragma unroll
                for (int e = 0; e < 4; ++e) { h0[e] = silu_f(acc[ai][0][m][0][e]) * acc[ai][1][m][0][e]; h1[e] = silu_f(acc[ai][0][m][1][e]) * acc[ai][1][m][1][e]; }
                *(u32x4*)(O + (size_t)(row0 + ai * HALF + m * 16) * FF + col0) = pack8(h0, h1);
            }
    }
};
struct EpiY {
    static constexpr bool PERM = true, AFTER_DRAIN = false;
    bf16_t* Y; float* part;
    __device__ __forceinline__ void operator()(const f32x4 (&acc)[2][2][4][2], const Unit& u, int wr, int wc, int fr, int fq) const {
        const int row0 = u.pm * BM + wr * 64 + fr, col0 = u.pn * BM + wc * 32 + 8 * fq;
#pragma unroll
        for (int ai = 0; ai < 2; ++ai)
#pragma unroll
            for (int m = 0; m < 4; ++m) {
                const int row = row0 + ai * HALF + m * 16; float ss = 0.f;
#pragma unroll
                for (int bj = 0; bj < 2; ++bj) {
                    const f32x4 a = acc[ai][bj][m][0], b = acc[ai][bj][m][1];
                    ss += (a[0] * a[0] + a[1] * a[1]) + (a[2] * a[2] + a[3] * a[3]) + (b[0] * b[0] + b[1] * b[1]) + (b[2] * b[2] + b[3] * b[3]);
                    *(u32x4*)(Y + (size_t)row * D + col0 + bj * HALF) = pack8(a, b);
                }
                ss += __shfl_xor(ss, 16); ss += __shfl_xor(ss, 32);
                if (fq == 0) part[(size_t)row * 16 + u.pn * 4 + wc] = ss;
            }
    }
};
struct EpiConvIn {
    static constexpr bool PERM = true, AFTER_DRAIN = false;
    bf16_t* V; bf16_t* Bg;
    __device__ __forceinline__ void operator()(const f32x4 (&acc)[2][2][4][2], const Unit& u, int wr, int wc, int fr, int fq) const {
        const int row0 = u.pm * BM + wr * 64 + fr;
        if (u.pn < 8) {
            const int col0 = u.pn * 128 + wc * 32 + 8 * fq;
#pragma unroll
            for (int ai = 0; ai < 2; ++ai)
#pragma unroll
                for (int m = 0; m < 4; ++m)
                    *(u32x4*)(V + (size_t)(row0 + ai * HALF + m * 16) * D + col0) = pack8(acc[ai][0][m][0] * acc[ai][1][m][0], acc[ai][0][m][1] * acc[ai][1][m][1]);
        } else {
            const int col0 = (u.pn - 8) * BM + wc * 32 + 8 * fq;
#pragma unroll
            for (int ai = 0; ai < 2; ++ai)
#pragma unroll
                for (int m = 0; m < 4; ++m)
#pragma unroll
                    for (int bj = 0; bj < 2; ++bj)
                        *(u32x4*)(Bg + (size_t)(row0 + ai * HALF + m * 16) * D + col0 + bj * HALF) = pack8(acc[ai][bj][m][0], acc[ai][bj][m][1]);
        }
    }
};
struct EpiQG {
    static constexpr bool PERM = true, AFTER_DRAIN = false;
    bf16_t* Q; float* G;
    __device__ __forceinline__ void operator()(const f32x4 (&acc)[2][2][4][2], const Unit& u, int wr, int wc, int fr, int fq) const {
        const int row0 = u.pm * BM + wr * 64 + fr;
        if (u.pn < 4) {
            const int col0 = u.pn * BM + wc * 32 + 8 * fq; const float sc = 0.125f * LOG2E;
#pragma unroll
            for (int ai = 0; ai < 2; ++ai)
#pragma unroll
                for (int m = 0; m < 4; ++m)
#pragma unroll
                    for (int bj = 0; bj < 2; ++bj)
                        *(u32x4*)(Q + (size_t)(row0 + ai * HALF + m * 16) * D + col0 + bj * HALF) = pack8(acc[ai][bj][m][0] * sc, acc[ai][bj][m][1] * sc);
        } else {
            const int col0 = wc * 32 + 8 * fq;
            if (col0 < 48) {
#pragma unroll
                for (int ai = 0; ai < 2; ++ai)
#pragma unroll
                    for (int m = 0; m < 4; ++m) {
                        float* gp = G + (size_t)(row0 + ai * HALF + m * 16) * 48 + col0;
#pragma unroll
                        for (int n = 0; n < 2; ++n) { f32x4 s;
#pragma unroll
                            for (int e = 0; e < 4; ++e) s[e] = frcp(1.f + fexp2(-acc[ai][0][m][n][e] * LOG2E));
                            *(f32x4*)(gp + 4 * n) = s; }
                    }
            }
        }
    }
};
struct EpiKV {
    static constexpr bool PERM = true, AFTER_DRAIN = false;
    bf16_t *KC, *KS, *KW, *VSt, *VWt;
    __device__ __forceinline__ void operator()(const f32x4 (&acc)[2][2][4][2], const Unit& u, int wr, int wc, int fr, int fq) const {
        const int br = u.pn >> 1, kv = u.pn & 1;
        const int row0 = u.pm * BM + wr * 64 + fr, b = row0 >> 12;
        const int d0 = (wc & 1) * 32 + 8 * fq;
        if (br == 0 || kv == 0) {
            bf16_t* base = br == 0 ? KC + (size_t)kv * 32 * 4096 * 64 : (br == 1 ? KS : KW);
#pragma unroll
            for (int ai = 0; ai < 2; ++ai)
#pragma unroll
                for (int m = 0; m < 4; ++m)
#pragma unroll
                    for (int bj = 0; bj < 2; ++bj) {
                        const int s = (row0 + ai * HALF + m * 16) & 4095, g = 2 * bj + (wc >> 1);
                        *(u32x4*)(base + ((size_t)(b * 4 + g) * 4096 + s) * 64 + d0) = pack8(acc[ai][bj][m][0], acc[ai][bj][m][1]);
                    }
        } else {
            bf16_t* base = br == 1 ? VSt : VWt;
#pragma unroll
            for (int ai = 0; ai < 2; ++ai)
#pragma unroll
                for (int m = 0; m < 4; ++m)
#pragma unroll
                    for (int bj = 0; bj < 2; ++bj) {
                        const int s = (row0 + ai * HALF + m * 16) & 4095, g = 2 * bj + (wc >> 1);
                        bf16_t* p = base + ((size_t)(b * 4 + g) * 64 + d0) * 4096 + s;
                        const u32x4 w = pack8(acc[ai][bj][m][0], acc[ai][bj][m][1]);
                        p[0 * 4096] = (bf16_t)(w.x & 0xffffu); p[1 * 4096] = (bf16_t)(w.x >> 16); p[2 * 4096] = (bf16_t)(w.y & 0xffffu); p[3 * 4096] = (bf16_t)(w.y >> 16);
                        p[4 * 4096] = (bf16_t)(w.z & 0xffffu); p[5 * 4096] = (bf16_t)(w.z >> 16); p[6 * 4096] = (bf16_t)(w.w & 0xffffu); p[7 * 4096] = (bf16_t)(w.w >> 16);
                    }
        }
    }
};
struct EpiCmp1 {
    static constexpr bool PERM = true, AFTER_DRAIN = false;
    bf16_t* O; const float* cbias;
    __device__ __forceinline__ void operator()(const f32x4 (&acc)[2][2][4][2], const Unit& u, int wr, int wc, int fr, int fq) const {
        const int row0 = u.pm * BM + wr * 64 + fr, col0 = wc * 32 + 8 * fq;
#pragma unroll
        for (int bj = 0; bj < 2; ++bj) {
            const f32x4 b0 = *(const f32x4*)(cbias + u.pn * 256 + col0 + bj * HALF), b1 = *(const f32x4*)(cbias + u.pn * 256 + col0 + bj * HALF + 4);
#pragma unroll
            for (int ai = 0; ai < 2; ++ai)
#pragma unroll
                for (int m = 0; m < 4; ++m) {
                    f32x4 x0 = acc[ai][bj][m][0] + b0, x1 = acc[ai][bj][m][1] + b1;
#pragma unroll
                    for (int e = 0; e < 4; ++e) {
                        { const float x = x0[e], z = 1.5957691216f * (x + 0.044715f * x * x * x); x0[e] = x * frcp(1.f + fexp2(-z * LOG2E)); }
                        { const float x = x1[e], z = 1.5957691216f * (x + 0.044715f * x * x * x); x1[e] = x * frcp(1.f + fexp2(-z * LOG2E)); }
                    }
                    *(u32x4*)(O + (size_t)(row0 + ai * HALF + m * 16) * 256 + col0 + bj * HALF) = pack8(x0, x1);
                }
        }
    }
};
struct DiagOrder {
    int G, c;
    __device__ bool next(int i, Unit& u) const { const int L = i * G + c; if (L >= 64) return false; u.pm = L; u.pn = L >> 5; return true; }
    __device__ __forceinline__ void a_ready(const Unit&) const {}
    __device__ __forceinline__ void done(const Unit&) const {}
};
}
struct Ctx { LAS unsigned char* lds; int tid, lane, wave, G, bid; };

__device__ __forceinline__ void conv_item(const float* W, int ldw, int ncv, int src_col0, int K, bf16_t* WT, int dst_row0, int kb, LAS float* scr, int lane) {
    const int k0 = 64 * kb, col = src_col0 + (lane & 31); const bool ok = col < ncv;
#pragma unroll 8
    for (int i = 0; i < 32; ++i) { const int kk = 2 * i + (lane >> 5); scr[kk * 33 + (lane & 31)] = ok ? W[(size_t)(k0 + kk) * ldw + col] : 0.f; }
    LDS_WAIT(); asm volatile("" ::: "memory");
    const int c = lane & 7;
#pragma unroll
    for (int j = 0; j < 4; ++j) { const int n = (lane >> 3) + 8 * j; const LAS float* s = scr + (8 * c) * 33 + n;
        u32x4 o; o.x = cvt_pk_bf16(s[0 * 33], s[1 * 33]); o.y = cvt_pk_bf16(s[2 * 33], s[3 * 33]); o.z = cvt_pk_bf16(s[4 * 33], s[5 * 33]); o.w = cvt_pk_bf16(s[6 * 33], s[7 * 33]);
        *(u32x4*)(WT + (size_t)(dst_row0 + n) * K + k0 + 8 * c) = o; }
    LDS_WAIT(); asm volatile("" ::: "memory");
}
#define PIN(k) uptr(LP->in[k])
__device__ __forceinline__ void p0_phase(const Ctx& X, const LAS Params* LP) {
    unsigned char* ws = uptr(LP->ws);
    LAS float* sc = (LAS float*)X.lds;
    LAS float* red = (LAS float*)(X.lds + 32768);
    for (int i = X.tid; i < 8192; i += 512) { const int b = i >> 10, k = i & 1023; sc[k * 8 + b] = silu_f(PIN(I_C)[i]); }
    __syncthreads();
    for (int it = X.bid; it < 608; it += X.G) {
        const float* W; const float* bias; float* out; int N, cb;
        if (it < 576) { const int l = it / 144; cb = it % 144; N = 9216; W = PIN(I_ADAW) + (size_t)l * 1024 * 9216; bias = PIN(I_ADAB) + l * 9216; out = (float*)(ws + WS_MOD) + (size_t)l * 8 * 9216; }
        else { cb = it - 576; N = 2048; W = PIN(I_KVADAW); bias = PIN(I_KVADAB); out = (float*)(ws + WS_KVMOD); }
        float a[8];
#pragma unroll
        for (int b = 0; b < 8; ++b) a[b] = 0.f;
        const float* wp = W + (size_t)(128 * X.wave) * N + 64 * cb + X.lane;
#pragma unroll 4
        for (int k = 0; k < 128; ++k) { const float w = wp[(size_t)k * N]; const f32x4 s0 = *(const LAS f32x4*)(sc + (128 * X.wave + k) * 8), s1 = *(const LAS f32x4*)(sc + (128 * X.wave + k) * 8 + 4);
            a[0] += s0[0] * w; a[1] += s0[1] * w; a[2] += s0[2] * w; a[3] += s0[3] * w; a[4] += s1[0] * w; a[5] += s1[1] * w; a[6] += s1[2] * w; a[7] += s1[3] * w; }
#pragma unroll
        for (int b = 0; b < 8; ++b) red[(X.wave * 8 + b) * 64 + X.lane] = a[b];
        __syncthreads();
        { const int b = X.tid >> 6, col = X.tid & 63; float s = bias[64 * cb + col];
#pragma unroll
          for (int w = 0; w < 8; ++w) s += red[(w * 8 + b) * 64 + col];
          out[(size_t)b * N + 64 * cb + col] = s; }
        __syncthreads();
    }
    for (int kv = 0; kv < 2; ++kv) if (X.bid == X.G - 1 - kv) {
        const int col = X.tid & 255, half = X.tid >> 8; const float* pos = PIN(I_CPOS) + kv * 2048 + half * 1024; const float* w1 = PIN(I_CW1) + ((size_t)kv * 2048 + half * 1024) * 256 + col;
        float s = 0.f;
        for (int f = 0; f < 1024; ++f) s += pos[f] * w1[(size_t)f * 256];
        red[X.tid] = s; __syncthreads();
        if (X.tid < 256) ((float*)(ws + WS_CBIAS))[kv * 256 + X.tid] = red[X.tid] + red[X.tid + 256];
        __syncthreads();
    }
    __syncthreads();
    LAS float* scr = (LAS float*)(X.lds + X.wave * 8448);
    const int gw = X.bid * 8 + X.wave, NGW = X.G * 8;
    for (int it = gw; it < 41472; it += NGW) {
        int r = it;
        if (r < 22528) { const int id = r / 2816, q = r % 2816, nb = q >> 4, kb = q & 15, pn = nb >> 3, jb = nb & 7;
            conv_item(PIN(I_FIN) + (size_t)id * 1024 * 5632, 5632, 5632, (jb >> 2) * 2816 + 128 * pn + 32 * (jb & 3), 1024, (bf16_t*)(ws + WS_FIN) + (size_t)id * 5632 * 1024, 32 * nb, kb, scr, X.lane); continue; } r -= 22528;
        if (r < 11264) { const int id = r / 1408, q = r % 1408, nb = q / 44, kb = q % 44;
            conv_item(PIN(I_FOUT) + (size_t)id * 2816 * 1024, 1024, 1024, 32 * nb, 2816, (bf16_t*)(ws + WS_FOUT) + (size_t)id * 1024 * 2816, 32 * nb, kb, scr, X.lane); continue; } r -= 11264;
        if (r < 3072) { const int id = r / 1536, q = r % 1536, nb = q >> 4, kb = q & 15, pn = nb >> 3, jb = nb & 7;
            const int src = pn < 8 ? ((jb >> 2) ? 2048 : 1024) + 128 * pn + 32 * (jb & 3) : 256 * (pn - 8) + 32 * jb;
            conv_item(PIN(I_AIN) + (size_t)id * 1024 * 3072, 3072, 3072, src, 1024, (bf16_t*)(ws + WS_AIN) + (size_t)id * 3072 * 1024, 32 * nb, kb, scr, X.lane); continue; } r -= 3072;
        if (r < 1024) { const int id = r / 512, q = r % 512, nb = q >> 4, kb = q & 15;
            conv_item(PIN(I_AOUT) + (size_t)id * 1024 * 1024, 1024, 1024, 32 * nb, 1024, (bf16_t*)(ws + WS_AOUT) + (size_t)id * 1024 * 1024, 32 * nb, kb, scr, X.lane); continue; } r -= 1024;
        if (r < 768) { const int nb = r >> 4, kb = r & 15;
            conv_item(PIN(I_KVW), 1536, 1536, 32 * nb, 1024, (bf16_t*)(ws + WS_KVW), 32 * nb, kb, scr, X.lane); continue; } r -= 768;
        if (r < 512) { const int id = r / 256, q = r % 256, nb = q >> 5, kb = q & 31;
            conv_item(PIN(I_CW1) + (size_t)id * 2048 * 256, 256, 256, 32 * nb, 2048, (bf16_t*)(ws + WS_CW1) + (size_t)id * 256 * 2048, 32 * nb, kb, scr, X.lane); continue; } r -= 512;
        if (r < 1280) { const int id = r / 640, q = r % 640, nb = q >> 4, kb = q & 15;
            conv_item(PIN(I_BIN) + (size_t)id * 1024 * 1072, 1072, 1072, 32 * nb, 1024, (bf16_t*)(ws + WS_BIN) + (size_t)id * 1280 * 1024, 32 * nb, kb, scr, X.lane); continue; } r -= 1280;
        { const int id = r / 512, q = r % 512, nb = q >> 4, kb = q & 15;
            conv_item(PIN(I_BOUT) + (size_t)id * 1024 * 1024, 1024, 1024, 32 * nb, 1024, (bf16_t*)(ws + WS_BOUT) + (size_t)id * 1024 * 1024, 32 * nb, kb, scr, X.lane); }
    }
}

struct UpdArgs { const float* xin; float* xout; const bf16_t* y; const float* part; const float* gate; const float* gpost; float w; int bstride;
                 const float* gpre; const float* shift; const float* scale; bf16_t* h; const float* gpre2; const float* shift2; const float* scale2; bf16_t* h2; };
__device__ __forceinline__ void update_phase(const Ctx& X, const UpdArgs& A) {
    const int gw = X.bid * 8 + X.wave, NGW = X.G * 8, c0 = 4 * X.lane;
    for (int row = gw; row < T; row += NGW) {
        const int b = row >> 12;
        f32x4 xv[4];
#pragma unroll
        for (int j = 0; j < 4; ++j) xv[j] = *(const f32x4*)(A.xin + (size_t)row * D + c0 + 256 * j);
        if (A.y) {
            const f32x4* pp = (const f32x4*)(A.part + (size_t)row * 16); const f32x4 p0 = pp[0], p1 = pp[1], p2 = pp[2], p3 = pp[3];
            const float ssq = ((p0[0] + p0[1]) + (p0[2] + p0[3])) + ((p1[0] + p1[1]) + (p1[2] + p1[3])) + ((p2[0] + p2[1]) + (p2[2] + p2[3])) + ((p3[0] + p3[1]) + (p3[2] + p3[3]));
            const float rs = A.w * __builtin_amdgcn_rsqf(ssq * (1.f / D) + EPS);
#pragma unroll
            for (int j = 0; j < 4; ++j) { const int c = c0 + 256 * j; const u32x2 yy = *(const u32x2*)(A.y + (size_t)row * D + c);
                const f32x4 gt = *(const f32x4*)(A.gate + (size_t)b * A.bstride + c), gp = *(const f32x4*)(A.gpost + c);
                const f32x4 yv = {__uint_as_float(yy.x << 16), __uint_as_float(yy.x & 0xffff0000u), __uint_as_float(yy.y << 16), __uint_as_float(yy.y & 0xffff0000u)};
                xv[j] = xv[j] + gt * gp * yv * rs; }
        }
        if (A.xout) {
#pragma unroll
            for (int j = 0; j < 4; ++j) *(f32x4*)(A.xout + (size_t)row * D + c0 + 256 * j) = xv[j];
        }
        if (A.h) {
            float s = 0.f;
#pragma unroll
            for (int j = 0; j < 4; ++j) s += (xv[j][0] * xv[j][0] + xv[j][1] * xv[j][1]) + (xv[j][2] * xv[j][2] + xv[j][3] * xv[j][3]);
            const float r = __builtin_amdgcn_rsqf(wave_sum(s) * (1.f / D) + EPS);
#pragma unroll
            for (int j = 0; j < 4; ++j) { const int c = c0 + 256 * j;
                const f32x4 g = *(const f32x4*)(A.gpre + c), sh = *(const f32x4*)(A.shift + (size_t)b * A.bstride + c), scl = *(const f32x4*)(A.scale + (size_t)b * A.bstride + c);
                const f32x4 hv = xv[j] * r * g * (scl + 1.f) + sh; u32x2 o; o.x = cvt_pk_bf16(hv[0], hv[1]); o.y = cvt_pk_bf16(hv[2], hv[3]);
                *(u32x2*)(A.h + (size_t)row * D + c) = o; }
            if (A.h2) {
#pragma unroll
                for (int j = 0; j < 4; ++j) { const int c = c0 + 256 * j;
                    const f32x4 g = *(const f32x4*)(A.gpre2 + c), sh = *(const f32x4*)(A.shift2 + (size_t)b * 2048 + c), scl = *(const f32x4*)(A.scale2 + (size_t)b * 2048 + c);
                    const f32x4 hv = xv[j] * r * g * (scl + 1.f) + sh; u32x2 o; o.x = cvt_pk_bf16(hv[0], hv[1]); o.y = cvt_pk_bf16(hv[2], hv[3]);
                    *(u32x2*)(A.h2 + (size_t)row * D + c) = o; }
            }
        }
    }
}

__device__ __forceinline__ void unpack8(const u32x4 w, float (&f)[8]) {
    f[0] = __uint_as_float(w.x << 16); f[1] = __uint_as_float(w.x & 0xffff0000u); f[2] = __uint_as_float(w.y << 16); f[3] = __uint_as_float(w.y & 0xffff0000u);
    f[4] = __uint_as_float(w.z << 16); f[5] = __uint_as_float(w.z & 0xffff0000u); f[6] = __uint_as_float(w.w << 16); f[7] = __uint_as_float(w.w & 0xffff0000u);
}
__device__ __forceinline__ void conv_phase(const Ctx& X, const bf16_t* V, const bf16_t* Bg, const float* cw, bf16_t* Z) {
    const int gt = X.bid * 512 + X.tid, NT = X.G * 512;
    for (int i = gt; i < T * 128; i += NT) {
        const int row = i >> 7, c = (i & 127) * 8, s = row & 4095;
        const u32x4 z0 = {0u, 0u, 0u, 0u};
        const u32x4 v2 = *(const u32x4*)(V + (size_t)row * D + c), v1 = s >= 1 ? *(const u32x4*)(V + (size_t)(row - 1) * D + c) : z0, v0 = s >= 2 ? *(const u32x4*)(V + (size_t)(row - 2) * D + c) : z0;
        const u32x4 bb = *(const u32x4*)(Bg + (size_t)row * D + c);
        float a0[8], a1[8], a2[8], bf[8], o[8]; unpack8(v0, a0); unpack8(v1, a1); unpack8(v2, a2); unpack8(bb, bf);
#pragma unroll
        for (int e = 0; e < 8; ++e) o[e] = bf[e] * (cw[c + e] * a0[e] + cw[D + c + e] * a1[e] + cw[2 * D + c + e] * a2[e]);
        u32x4 w; w.x = cvt_pk_bf16(o[0], o[1]); w.y = cvt_pk_bf16(o[2], o[3]); w.z = cvt_pk_bf16(o[4], o[5]); w.w = cvt_pk_bf16(o[6], o[7]);
        *(u32x4*)(Z + (size_t)row * D + c) = w;
    }
}

__device__ __forceinline__ void cmp2_phase(const Ctx& X, const bf16_t* hidc, const float* w2, bf16_t* kcmp, bf16_t* vcmpT) {
    const int gt = X.bid * 512 + X.tid, NT = X.G * 512;
    for (int i = gt; i < 16384 * 16; i += NT) {
        const int row = i >> 4, c = (i & 15) * 4, kv = row >> 13, rr = row & 8191;
        const float* w = w2 + (size_t)kv * 256 * 64 + c; const bf16_t* hp = hidc + (size_t)row * 256;
        f32x4 a = {0.f, 0.f, 0.f, 0.f};
        for (int k = 0; k < 256; k += 8) { float hf[8]; unpack8(*(const u32x4*)(hp + k), hf);
#pragma unroll
            for (int e = 0; e < 8; ++e) a += *(const f32x4*)(w + (size_t)(k + e) * 64) * hf[e]; }
        if (kv == 0) { u32x2 o; o.x = cvt_pk_bf16(a[0], a[1]); o.y = cvt_pk_bf16(a[2], a[3]); *(u32x2*)(kcmp + (size_t)rr * 64 + c) = o; }
        else { const int bg = rr >> 8, n = rr & 255; bf16_t* p = vcmpT + ((size_t)bg * 64 + c) * 256 + n; const unsigned w0 = cvt_pk_bf16(a[0], a[1]), w1 = cvt_pk_bf16(a[2], a[3]);
            p[0] = (bf16_t)(w0 & 0xffffu); p[256] = (bf16_t)(w0 >> 16); p[512] = (bf16_t)(w1 & 0xffffu); p[768] = (bf16_t)(w1 >> 16); }
    }
}
struct AttnArgs { const bf16_t* Q; const float* gates; const bf16_t *kcmp, *vcmpT, *KS, *VSt, *KW, *VWt; bf16_t* O; };

__device__ __forceinline__ f32x16 qk_tile(const bf16_t* Kb, int key0, const bf16x8 (&qf)[4], int jr, int h) {
    const bf16x8* p = (const bf16x8*)(Kb + (size_t)(key0 + jr) * 64 + h * 8);
    f32x16 acc;
#pragma unroll
    for (int v = 0; v < 16; ++v) acc[v] = 0.f;
#pragma unroll
    for (int ks = 0; ks < 4; ++ks) acc = __builtin_amdgcn_mfma_f32_32x32x16_bf16(p[2 * ks], qf[ks], acc, 0, 0, 0);
    return acc;
}
__device__ __forceinline__ void pv_tile(f32x16 (&o)[2], const bf16_t* Vt, int ldv, int key0, const f32x16& p, int j, int h) {
#pragma unroll
    for (int s = 0; s < 2; ++s) {
        u32x4 w; w.x = cvt_pk_bf16(p[8 * s + 0], p[8 * s + 1]); w.y = cvt_pk_bf16(p[8 * s + 2], p[8 * s + 3]); w.z = cvt_pk_bf16(p[8 * s + 4], p[8 * s + 5]); w.w = cvt_pk_bf16(p[8 * s + 6], p[8 * s + 7]);
        const bf16x8 pb = __builtin_bit_cast(bf16x8, w);
#pragma unroll
        for (int dt = 0; dt < 2; ++dt) {
            const bf16x8 vf = *(const bf16x8*)(Vt + (size_t)(dt * 32 + j) * ldv + key0 + 16 * s + 8 * h);
            o[dt] = __builtin_amdgcn_mfma_f32_32x32x16_bf16(vf, pb, o[dt], 0, 0, 0);
        }
    }
}
__device__ __forceinline__ unsigned run_mask(int kstart, int lo, int hi) {
    const int a = max(lo - kstart, 0), b = min(hi - kstart, 7);
    return a <= b ? ((1u << (b + 1)) - 1u) & ~((1u << a) - 1u) : 0u;
}
__device__ __forceinline__ void softmax_step(f32x16& s, unsigned vm, float& m, float& l, f32x16 (&o)[2]) {
    float tm = -1e30f;
#pragma unroll
    for (int v = 0; v < 16; ++v) { const float sv = ((vm >> v) & 1u) ? s[v] : -1e30f; s[v] = sv; tm = fmaxf(tm, sv); }
    tm = fmaxf(tm, __shfl_xor(tm, 32));
    const float mn = fmaxf(m, tm), al = fexp2(m - mn);
    l *= al; o[0] = o[0] * al; o[1] = o[1] * al;
    float ps = 0.f;
#pragma unroll
    for (int v = 0; v < 16; ++v) { const float p = ((vm >> v) & 1u) ? fexp2(s[v] - mn) : 0.f; s[v] = p; ps += p; }
    l += ps; m = mn;
}
__device__ __forceinline__ void add_bias(f32x16& s, float sl, float base) {
#pragma unroll
    for (int v = 0; v < 16; ++v) s[v] += sl * (base + (float)(16 * (v >> 3) + (v & 7)));
}

__device__ __forceinline__ void attn_item(const Ctx& X, const AttnArgs& A, int b, int g, int qt) {
    const int lane = X.lane, h = lane >> 5, j = lane & 31, ql = j >> 2, r = j & 3;
    const int t0 = qt * 64 + X.wave * 8, t = t0 + ql, head = g * 4 + r, bg = b * 4 + g, cur = qt;
    const size_t row = (size_t)b * SEQ + t;
    bf16x8 qf[4];
#pragma unroll
    for (int ks = 0; ks < 4; ++ks) qf[ks] = *(const bf16x8*)(A.Q + row * D + head * 64 + ks * 16 + h * 8);
    const float sl2 = fexp2(-0.5f * (float)(head + 1)) * LOG2E;
    const int jr = (j & ~12) | ((j & 4) << 1) | ((j & 8) >> 1);
    const float g0 = A.gates[row * 48 + head], g1 = A.gates[row * 48 + 16 + head], g2 = A.gates[row * 48 + 32 + head];
    f32x16 om[2], o[2];
#pragma unroll
    for (int v = 0; v < 16; ++v) { om[0][v] = 0.f; om[1][v] = 0.f; o[0][v] = 0.f; o[1][v] = 0.f; }
    LAS float* cm = (LAS float*)(X.lds + X.wave * 8192);
    float m, l;

    {
        const int nmax_w = (t0 + 7 - 31) >> 4, nmax_t = (t - 31) >> 4;
        const int ntile = nmax_w >= 0 ? (nmax_w >> 5) + 1 : 0;
        const bf16_t* Kc = A.kcmp + (size_t)bg * 256 * 64; const bf16_t* Vc = A.vcmpT + (size_t)bg * 64 * 256;
        m = -1e30f; l = 0.f;
        for (int tile = 0; tile < ntile; ++tile) {
            f32x16 s = qk_tile(Kc, tile * 32, qf, jr, h);
            add_bias(s, 16.f * sl2, (float)(tile * 32 + 8 * h) + (float)(31 - t) * (1.f / 16.f));
            const unsigned vm = run_mask(tile * 32 + 8 * h, 0, nmax_t) | (run_mask(tile * 32 + 16 + 8 * h, 0, nmax_t) << 8);
            softmax_step(s, vm, m, l, o);
        }
        l += __shfl_xor(l, 32);
        const float inv = 1.f / fmaxf(l, 1e-30f);
        for (int tile = 0; tile < ntile; ++tile) {
            f32x16 s = qk_tile(Kc, tile * 32, qf, jr, h);
            add_bias(s, 16.f * sl2, (float)(tile * 32 + 8 * h) + (float)(31 - t) * (1.f / 16.f));
            const unsigned vm = run_mask(tile * 32 + 8 * h, 0, nmax_t) | (run_mask(tile * 32 + 16 + 8 * h, 0, nmax_t) << 8);
#pragma unroll
            for (int v = 0; v < 16; ++v) {
                const float p = ((vm >> v) & 1u) ? fexp2(s[v] - m) * inv : 0.f; s[v] = p;
                float x = p; x += __shfl_xor(x, 1); x += __shfl_xor(x, 2);
                if ((v & 3) == r) cm[ql * 256 + tile * 32 + 16 * (v >> 3) + 8 * h + (v & 7)] = x;
            }
            pv_tile(o, Vc, 256, tile * 32, s, j, h);
        }
#pragma unroll
        for (int v = 0; v < 16; ++v) { om[0][v] = g0 * o[0][v]; om[1][v] = g0 * o[1][v]; o[0][v] = 0.f; o[1][v] = 0.f; }
    }
    LDS_WAIT(); asm volatile("" ::: "memory");
    unsigned long long mq = 0ull, uni = 0ull;
    {
        const unsigned long long causal = cur >= 63 ? ~0ull : ((1ull << (cur + 1)) - 1ull);
#pragma unroll 1
        for (int q = 0; q < 8; ++q) {
            float iv;
            if (lane == 0 || lane == cur || lane == cur - 1) iv = 1e30f;
            else if (lane > cur) iv = -1e30f;
            else { const LAS float* c = cm + q * 256 + 4 * lane; iv = (((c[-1] + c[0]) + c[1]) + c[2]) + c[3]; }
            int rank = 0;
#pragma unroll 1
            for (int i0 = 0; i0 < 64; i0 += 8) {
#pragma unroll
                for (int i1 = 0; i1 < 8; ++i1) { const int i = i0 + i1; const float ov = __uint_as_float(__builtin_amdgcn_readlane(__float_as_uint(iv), i)); rank += ((ov > iv) || (ov == iv && i < lane)) ? 1 : 0; }
            }
            const unsigned long long mk = __ballot(rank < 16) & causal;
            uni |= mk; if (ql == q) mq = mk;
        }
    }
    {
        const bf16_t* Ks = A.KS + (size_t)bg * 4096 * 64; const bf16_t* Vs = A.VSt + (size_t)bg * 64 * 4096;
        m = -1e30f; l = 0.f;
        for (unsigned long long um = uni; um; um &= um - 1ull) {
            const int jb = __builtin_ctzll(um); const bool mine = (mq >> jb) & 1ull;
#pragma unroll 1
            for (int hf = 0; hf < 2; ++hf) {
                const int key0 = jb * 64 + hf * 32;
                f32x16 s = qk_tile(Ks, key0, qf, jr, h);
                add_bias(s, sl2, (float)(key0 + 8 * h - t));
                const unsigned vm = mine ? (run_mask(key0 + 8 * h, 0, t) | (run_mask(key0 + 16 + 8 * h, 0, t) << 8)) : 0u;
                softmax_step(s, vm, m, l, o);
                pv_tile(o, Vs, 4096, key0, s, j, h);
            }
        }
        l += __shfl_xor(l, 32);
        const float sc = g1 / fmaxf(l, 1e-30f);
#pragma unroll
        for (int v = 0; v < 16; ++v) { om[0][v] += sc * o[0][v]; om[1][v] += sc * o[1][v]; o[0][v] = 0.f; o[1][v] = 0.f; }
    }
    {
        const bf16_t* Kw = A.KW + (size_t)bg * 4096 * 64; const bf16_t* Vw = A.VWt + (size_t)bg * 64 * 4096;
        m = -1e30f; l = 0.f;
        const int kt0 = max(t0 - 511, 0) >> 5, kt1 = (t0 + 7) >> 5;
#pragma unroll 1
        for (int kt = kt0; kt <= kt1; ++kt) {
            const int key0 = kt * 32;
            f32x16 s = qk_tile(Kw, key0, qf, jr, h);
            add_bias(s, sl2, (float)(key0 + 8 * h - t));
            const unsigned vm = run_mask(key0 + 8 * h, t - 511, t) | (run_mask(key0 + 16 + 8 * h, t - 511, t) << 8);
            softmax_step(s, vm, m, l, o);
            pv_tile(o, Vw, 4096, key0, s, j, h);
        }
        l += __shfl_xor(l, 32);
        const float sc = g2 / fmaxf(l, 1e-30f);
#pragma unroll
        for (int v = 0; v < 16; ++v) { om[0][v] += sc * o[0][v]; om[1][v] += sc * o[1][v]; }
    }
    bf16_t* op = A.O + row * D + head * 64 + 4 * h;
#pragma unroll
    for (int dt = 0; dt < 2; ++dt)
#pragma unroll
        for (int v4 = 0; v4 < 4; ++v4) { u32x2 w; w.x = cvt_pk_bf16(om[dt][4 * v4], om[dt][4 * v4 + 1]); w.y = cvt_pk_bf16(om[dt][4 * v4 + 2], om[dt][4 * v4 + 3]); *(u32x2*)(op + 32 * dt + 8 * v4) = w; }
}
__device__ __forceinline__ void attn_phase(const Ctx& X, const AttnArgs& A) {
    for (int i = 0;; ++i) {
        const int k = i * X.G + ((i & 1) ? X.G - 1 - X.bid : X.bid);
        if (i * X.G >= 2048) break;
        if (k < 2048) { const int qt = 63 - (k >> 5), bg = k & 31; attn_item(X, A, bg >> 2, bg & 3, qt); }
    }
}
__global__ void __launch_bounds__(512, 2) yoco_fwd(Params Pk) {
    extern __shared__ __attribute__((aligned(16))) unsigned char lds_raw[];
    cg::grid_group grid = cg::this_grid();
    { LAS Params* LP = (LAS Params*)((LAS unsigned char*)lds_raw + 131072); if (threadIdx.x == 0) {
#pragma unroll
        for (int i = 0; i < 19; ++i) LP->in[i] = Pk.in[i];
        LP->out = Pk.out; LP->ws = Pk.ws; LP->ph_lo = Pk.ph_lo; LP->ph_hi = Pk.ph_hi; } }
    __syncthreads();
    const int ph_lo = Pk.ph_lo, ph_hi = Pk.ph_hi;
    if (ph_lo == 0) {
        int tid_ = threadIdx.x, g_ = gridDim.x, b_ = blockIdx.x; asm volatile("" : "+v"(tid_), "+s"(g_), "+s"(b_));
        Ctx X; X.lds = (LAS unsigned char*)lds_raw; X.tid = tid_; X.lane = X.tid & 63; X.wave = __builtin_amdgcn_readfirstlane(X.tid >> 6); X.G = g_; X.bid = b_;
#ifndef SKIP_P0
        p0_phase(X, (const LAS Params*)(X.lds + 131072));
#endif
        if (1 < ph_hi) grid.sync();
    }
    for (int ph = ph_lo < 1 ? 1 : ph_lo; ph < ph_hi; ++ph) {
        asm volatile("" ::: "memory");
        int tid_ = threadIdx.x, g_ = gridDim.x, b_ = blockIdx.x; asm volatile("" : "+v"(tid_), "+s"(g_), "+s"(b_));
        Ctx X; X.lds = (LAS unsigned char*)lds_raw; X.tid = tid_; X.lane = X.tid & 63; X.wave = __builtin_amdgcn_readfirstlane(X.tid >> 6); X.G = g_; X.bid = b_;
        Params P;
        { const LAS Params* LP = (const LAS Params*)(X.lds + 131072);
          P.in[I_X] = uptr(LP->in[I_X]); P.in[I_NORMG] = uptr(LP->in[I_NORMG]); P.in[I_ACONV] = uptr(LP->in[I_ACONV]); P.in[I_KVNG] = uptr(LP->in[I_KVNG]); P.in[I_CW2] = uptr(LP->in[I_CW2]);
          P.out = uptr(LP->out); P.ws = uptr(LP->ws); }
        unsigned char* ws = P.ws;
        bf16_t* const H = (bf16_t*)(ws + WS_H); bf16_t* const HID = (bf16_t*)(ws + WS_HID); bf16_t* const HID2 = (bf16_t*)(ws + WS_HID + 64 * MiB); bf16_t* const Y = (bf16_t*)(ws + WS_Y);
        float* const PART = (float*)(ws + WS_PART); float* const GATES = (float*)(ws + WS_GATES);
        const float* const MOD = (const float*)(ws + WS_MOD); const float* const KVMOD = (const float*)(ws + WS_KVMOD);
        const float* const NG = P.in[I_NORMG];
        if (ph == 1) {
            UpdArgs U{}; U.xin = P.in[I_X]; U.xout = P.out; U.bstride = 9216; U.gpre = NG; U.shift = MOD; U.scale = MOD + 1024; U.h = H;

#ifndef SKIP_UPD
update_phase(X, U);
#endif

        } else {
            int p = ph - 2, l, st;
            if (p < 20) { l = p / 10; st = p % 10; } else if (p < 23) { l = 2; st = 10 + (p - 20); } else { p -= 23; l = 2 + p / 10; st = p % 10; }
            const float* modl = MOD + (size_t)l * 8 * 9216; const float* ngl = NG + (size_t)l * 6 * 1024;
            if (st == 0 || st == 7) {
                const int s = st == 0 ? 0 : 1;
                pg8::Gemm g{H, (const bf16_t*)(ws + WS_FIN) + (size_t)(l * 2 + s) * 5632 * 1024, T, 5632, 1024, 1024}; pg8::StaticOrder S; S.init(T, 5632, X.G, X.bid);
                pg8::EpiSwiglu E{HID};

#ifndef SKIP_G1
pg8::gemm_phase<pg8::EpiSwiglu, pg8::StaticOrder, true, true>(X.lds, g, S, E, X.tid);
#endif

            } else if (st == 1 || st == 8 || st == 5) {
                pg8::Gemm g;
                if (st == 5) { g = pg8::Gemm{l < 2 ? H : HID2, l < 2 ? (const bf16_t*)(ws + WS_AOUT) + (size_t)l * 1024 * 1024 : (const bf16_t*)(ws + WS_BOUT) + (size_t)(l - 2) * 1024 * 1024, T, 1024, 1024, 1024}; }
                else { g = pg8::Gemm{HID, (const bf16_t*)(ws + WS_FOUT) + (size_t)(l * 2 + (st == 8 ? 1 : 0)) * 1024 * 2816, T, 1024, 2816, 2816}; }
                pg8::StaticOrder S; S.init(T, 1024, X.G, X.bid);
                pg8::EpiY E{Y, PART};

#ifndef SKIP_G2
pg8::gemm_phase<pg8::EpiY, pg8::StaticOrder, true, true>(X.lds, g, S, E, X.tid);
#endif

            } else if (st == 2 || st == 6 || st == 9) {
                const int sub = st == 2 ? 0 : (st == 6 ? 1 : 2);
                UpdArgs U{}; U.xin = P.out; U.xout = P.out; U.y = Y; U.part = PART; U.gate = modl + (sub * 3 + 2) * 1024; U.gpost = ngl + (sub * 2 + 1) * 1024; U.w = sub == 1 ? 1.0f : 0.5f; U.bstride = 9216;
                if (sub < 2) { U.gpre = ngl + ((sub + 1) * 2) * 1024; U.shift = modl + ((sub + 1) * 3) * 1024; U.scale = modl + ((sub + 1) * 3 + 1) * 1024; U.h = H; }
                else if (l < 3) { U.gpre = ngl + 6 * 1024; U.shift = modl + 8 * 9216; U.scale = modl + 8 * 9216 + 1024; U.h = H;
                    if (l == 1) { U.gpre2 = P.in[I_KVNG]; U.shift2 = KVMOD; U.scale2 = KVMOD + 1024; U.h2 = HID; } }

#ifndef SKIP_UPD
update_phase(X, U);
#endif

            } else if (st == 3) {
                if (l < 2) {
                    pg8::Gemm g{H, (const bf16_t*)(ws + WS_AIN) + (size_t)l * 3072 * 1024, T, 3072, 1024, 1024}; pg8::StaticOrder S; S.init(T, 3072, X.G, X.bid);
                    pg8::EpiConvIn E{HID, HID2};

#ifndef SKIP_G3
pg8::gemm_phase<pg8::EpiConvIn, pg8::StaticOrder, true, true>(X.lds, g, S, E, X.tid);
#endif

                } else {
                    pg8::Gemm g{H, (const bf16_t*)(ws + WS_BIN) + (size_t)(l - 2) * 1280 * 1024, T, 1280, 1024, 1024}; pg8::StaticOrder S; S.init(T, 1280, X.G, X.bid);
                    pg8::EpiQG E{HID, GATES};

#ifndef SKIP_G3B
pg8::gemm_phase<pg8::EpiQG, pg8::StaticOrder, true, true>(X.lds, g, S, E, X.tid);
#endif

                }
            } else if (st == 4) {
                if (l < 2) {
#ifndef SKIP_CONV
conv_phase(X, HID, HID2, P.in[I_ACONV] + (size_t)l * 3 * 1024, H);
#endif
}
                else { AttnArgs A{HID, GATES, (const bf16_t*)(ws + WS_KCMP), (const bf16_t*)(ws + WS_VCMPT), (const bf16_t*)(ws + WS_KS), (const bf16_t*)(ws + WS_VST), (const bf16_t*)(ws + WS_KW), (const bf16_t*)(ws + WS_VWT), HID2};

#ifndef SKIP_ATTN
attn_phase(X, A);
#endif
 }
            } else if (st == 10) {
                pg8::Gemm g{HID, (const bf16_t*)(ws + WS_KVW), T, 1536, 1024, 1024}; pg8::StaticOrder S; S.init(T, 1536, X.G, X.bid);
                pg8::EpiKV E{(bf16_t*)(ws + WS_KC), (bf16_t*)(ws + WS_KS), (bf16_t*)(ws + WS_KW), (bf16_t*)(ws + WS_VST), (bf16_t*)(ws + WS_VWT)};

#ifndef SKIP_GK
pg8::gemm_phase<pg8::EpiKV, pg8::StaticOrder, true, true>(X.lds, g, S, E, X.tid);
#endif

            } else if (st == 11) {
                pg8::Gemm g{(const bf16_t*)(ws + WS_KC), (const bf16_t*)(ws + WS_CW1), 16384, 512, 2048, 1024}; pg8::DiagOrder S{X.G, X.bid};
                pg8::EpiCmp1 E{(bf16_t*)(ws + WS_HIDC), (const float*)(ws + WS_CBIAS)};

#ifndef SKIP_CM1
pg8::gemm_phase<pg8::EpiCmp1, pg8::DiagOrder, true, true>(X.lds, g, S, E, X.tid);
#endif

            } else if (st == 12) {

#ifndef SKIP_CM2
cmp2_phase(X, (const bf16_t*)(ws + WS_HIDC), P.in[I_CW2], (bf16_t*)(ws + WS_KCMP), (bf16_t*)(ws + WS_VCMPT));
#endif

            }
        }
        if (ph + 1 < ph_hi) grid.sync();
    }
}

extern "C" void kernel_launch(void* const* d_in, const int* in_sizes, int n_in, void* d_out, int out_size, void* d_ws, size_t ws_size, hipStream_t stream) {
    static int grid = 0;
    if (grid == 0) {
        if (n_in != 19 || out_size != T * D || ws_size < WS_END) { fprintf(stderr, "kernel_launch: unexpected shapes (n_in %d, out %d, ws %zu < %zu)\n", n_in, out_size, ws_size, (size_t)WS_END); grid = -1; return; }
        int dev = 0, cus = 0, per_cu = 0;
        (void)hipGetDevice(&dev); (void)hipDeviceGetAttribute(&cus, hipDeviceAttributeMultiprocessorCount, dev);
        if (hipFuncSetAttribute((const void*)yoco_fwd, hipFuncAttributeMaxDynamicSharedMemorySize, LDS_BYTES) != hipSuccess) { fprintf(stderr, "kernel_launch: hipFuncSetAttribute failed\n"); grid = -1; return; }
        if (hipOccupancyMaxActiveBlocksPerMultiprocessor(&per_cu, (const void*)yoco_fwd, 512, LDS_BYTES) != hipSuccess || per_cu < 1) { fprintf(stderr, "kernel_launch: occupancy query says %d\n", per_cu); per_cu = 1; }
        (void)hipGetLastError();
        grid = cus * per_cu;
    }
    if (grid < 0) return;
    Params p{};
    for (int i = 0; i < 19; ++i) p.in[i] = (const float*)d_in[i];
    p.out = (float*)d_out; p.ws = (unsigned char*)d_ws;
#ifdef MULTI_LAUNCH
    for (int ph = 0; ph < NPH; ++ph) { p.ph_lo = ph; p.ph_hi = ph + 1; hipLaunchKernelGGL(yoco_fwd, dim3(grid), dim3(512), LDS_BYTES, stream, p); }
#else
    p.ph_lo = 0; p.ph_hi = NPH;
    void* args[] = {&p};
    hipError_t e = hipLaunchCooperativeKernel((const void*)yoco_fwd, dim3(grid), dim3(512), args, LDS_BYTES, stream);
    if (e != hipSuccess) fprintf(stderr, "kernel_launch: cooperative launch failed: %s (grid %d)\n", hipGetErrorString(e), grid);
#endif
}
```

```cpp
#include <hip/hip_runtime.h>
#include <hip/hip_cooperative_groups.h>
#include <cstdio>
#include <cstdint>
namespace cg = cooperative_groups;
namespace pg8 {
#define PG8_LAS __attribute__((address_space(3)))
typedef unsigned short bf16_t;
typedef short bf16x8 __attribute__((ext_vector_type(8)));
typedef float f32x4 __attribute__((ext_vector_type(4)));
typedef unsigned u32x4 __attribute__((ext_vector_type(4)));
constexpr int BM = 256, BK = 64, HALF = 128, HTB = HALF * BK * 2  , STAGE_BYTES = 8 * HTB, NXCD = 8, WGM = 8;

__host__ __device__ __forceinline__ int lds_byte(int r, int c) { const int st = (r >> 4) * 2 + (c >> 5), rr = r & 15, cc = c & 31, ob = rr * 64 + cc * 2; return st * 1024 + (ob ^ (((ob >> 9) & 1) << 5)); }
__host__ __device__ __forceinline__ void stage_rc(int b, int& R, int& C) { const int st = b / 1024, sb = b % 1024, swz = sb ^ (((sb >> 9) & 1) << 5); R = (st >> 1) * 16 + swz / 64; C = (st & 1) * 32 + (swz % 64) / 2; }
__host__ __device__ __forceinline__ int perm32(int rho) { const int n = rho >> 4, i = rho & 15; return 8 * (i >> 2) + 4 * n + (i & 3); }

struct Unit { int pm, pn; };
struct Gemm { const bf16_t* A; const bf16_t* Bt; int M, N, K, lda; };

struct StaticOrder {
    int nM, nN, nwg, G, c;
    __host__ __device__ void init(int M, int N, int G_, int c_) { nM = M / BM; nN = N / BM; nwg = nM * nN; G = G_; c = c_; }
    __host__ __device__ bool next(int i, Unit& u) const {
        const long L = (long)i * G + c; if (L >= nwg) return false;
        int wgid = (int)L; { const int q = nwg / NXCD, r = nwg % NXCD, xcd = wgid % NXCD, off = wgid / NXCD; wgid = (xcd < r ? xcd * (q + 1) : r * (q + 1) + (xcd - r) * q) + off; }
        const int nig = WGM * nN, gid = wgid / nig, fm = gid * WGM, gsz = (nM - fm) < WGM ? (nM - fm) : WGM;
        u.pm = fm + ((wgid % nig) % gsz); u.pn = (wgid % nig) / gsz; return true;
    }
    __device__ __forceinline__ void a_ready(const Unit&) const {}
    __device__ __forceinline__ void done(const Unit&) const {}
};

__device__ __forceinline__ unsigned cvt_pk_bf16(float lo, float hi) { unsigned r; asm volatile("v_cvt_pk_bf16_f32 %0, %1, %2" : "=v"(r) : "v"(lo), "v"(hi)); return r; }
typedef float f32x2 __attribute__((ext_vector_type(2)));
__device__ __forceinline__ f32x2 gelu_pk(f32x2 v) {
    const f32x2 av = __builtin_elementwise_abs(v), d = av * 0.2316418882f + 1.0f;
    f32x2 t; t.x = __builtin_amdgcn_rcpf(d.x); t.y = __builtin_amdgcn_rcpf(d.y);
    f32x2 q = t * 0.5307027145f + (-0.7265760135f); q = q * t + 0.7107068705f; q = q * t + (-0.142248368f); q = q * t + 0.127414796f; q = q * t;
    const f32x2 s = (v * v) * (-0.72134752044f);
    f32x2 e; e.x = __builtin_amdgcn_exp2f(s.x); e.y = __builtin_amdgcn_exp2f(s.y);
    const f32x2 m = v * (q * e), r = v - m;
    f32x2 o; o.x = v.x < 0.f ? m.x : r.x; o.y = v.y < 0.f ? m.y : r.y; return o;
}


template <class Epi, class Sched, bool ALIGN_EPI = false, bool SP2 = false>
__device__ __forceinline__ void gemm_phase(PG8_LAS unsigned char* lds, const Gemm g, const Sched& S, const Epi& E, const int tid) {
    const int wid = __builtin_amdgcn_readfirstlane(tid >> 6), lane = tid & 63, wr = wid >> 2, wc = wid & 3, fr = lane & 15, fq = lane >> 4;
    const int K = g.K, nt = K / BK;
    unsigned voffA[2], voffB[2];
#pragma unroll
    for (int i = 0; i < 2; ++i) { int R, C; stage_rc(tid * 16 + i * 8192, R, C); const int Rb = Epi::PERM ? ((R & ~31) + perm32(R & 31)) : R;
        voffA[i] = (unsigned)(R * g.lda + C) * 2u; voffB[i] = (unsigned)(Rb * K + C) * 2u; }
    const size_t kstep = (size_t)(BK * 2);
    const size_t hstepB = (size_t)HALF * K * 2, hstepA = (size_t)HALF * g.lda * 2;
    const size_t tstepB = 2 * hstepB, tstepA = 2 * hstepA;
    const unsigned ldsw = (unsigned)wid * 1024u;
    const int aoff = lds_byte(wr * 64 + fr, fq * 8), boff = lds_byte(wc * 32 + fr, fq * 8);
#define PG8_SA(b, h) (((b) * 2 + (h)) * HTB)
#define PG8_SB(b, h) ((4 + (b) * 2 + (h)) * HTB)
#define PG8_STAGE(bufoff, gbase, voff) do { _Pragma("unroll") for (int _i = 0; _i < 2; ++_i) \
        __builtin_amdgcn_global_load_lds((const unsigned*)((const char*)(gbase) + (voff)[_i]), (PG8_LAS unsigned*)(lds + (bufoff) + ldsw + _i * 8192), 16, 0, 0); } while (0)
#define PG8_LDA(dst, b, h) do { _Pragma("unroll") for (int m = 0; m < 4; ++m) _Pragma("unroll") for (int k = 0; k < 2; ++k) dst[m][k] = *(const PG8_LAS bf16x8*)(lds + PG8_SA(b, h) + aoff + m * 2048 + k * 1024); } while (0)
#define PG8_LDB(dst, b, h) do { _Pragma("unroll") for (int n = 0; n < 2; ++n) _Pragma("unroll") for (int k = 0; k < 2; ++k) dst[n][k] = *(const PG8_LAS bf16x8*)(lds + PG8_SB(b, h) + boff + n * 2048 + k * 1024); } while (0)
#define PG8_MMA(ai, bj, At, Bt) do { __builtin_amdgcn_s_setprio(1); _Pragma("unroll") for (int m = 0; m < 4; ++m) _Pragma("unroll") for (int n = 0; n < 2; ++n) _Pragma("unroll") for (int k = 0; k < 2; ++k) \
        acc[ai][bj][m][n] = __builtin_amdgcn_mfma_f32_16x16x32_bf16(Bt[n][k], At[m][k], acc[ai][bj][m][n], 0, 0, 0); __builtin_amdgcn_s_setprio(0); } while (0)
#define PG8_WAIT_V(n) asm volatile("s_waitcnt vmcnt(" #n ")" ::: "memory")
#define PG8_WAIT_L(n) asm volatile("s_waitcnt lgkmcnt(" #n ")" ::: "memory")
#define PG8_BAR __builtin_amdgcn_s_barrier()
#define PG8_SCHED __builtin_amdgcn_sched_barrier(0)
    Unit cur, nxt; int ui = 0;
    if (!S.next(0, cur)) return;
    f32x4 acc[2][2][4][2];
#pragma unroll
    for (int a = 0; a < 2; ++a)
#pragma unroll
        for (int b = 0; b < 2; ++b)
#pragma unroll
            for (int m = 0; m < 4; ++m)
#pragma unroll
                for (int n = 0; n < 2; ++n) acc[a][b][m][n] = (f32x4){0.f, 0.f, 0.f, 0.f};
    bf16x8 At[4][2], B0[2][2], B1[2][2];
    const char* cA = (const char*)g.A + (size_t)cur.pm * tstepA; const char* cB = (const char*)g.Bt + (size_t)cur.pn * tstepB;
    S.a_ready(cur);
    if constexpr (SP2) {
        PG8_STAGE(PG8_SB(0, 0), cB, voffB); PG8_STAGE(PG8_SB(0, 1), cB + hstepB, voffB); PG8_STAGE(PG8_SA(0, 0), cA, voffA); PG8_STAGE(PG8_SA(0, 1), cA + hstepA, voffA);
        if (wr == 1) PG8_BAR;
        PG8_WAIT_V(2); PG8_BAR;
        PG8_STAGE(PG8_SB(1, 0), cB + kstep, voffB); PG8_STAGE(PG8_SA(1, 0), cA + kstep, voffA); PG8_STAGE(PG8_SB(1, 1), cB + hstepB + kstep, voffB);
        PG8_WAIT_V(6); PG8_BAR;
    } else {
        PG8_STAGE(PG8_SB(0, 0), cB, voffB); PG8_STAGE(PG8_SA(0, 0), cA, voffA); PG8_STAGE(PG8_SB(0, 1), cB + hstepB, voffB); PG8_STAGE(PG8_SA(0, 1), cA + hstepA, voffA);
        if (wr == 1) PG8_BAR;
        PG8_WAIT_V(4); PG8_BAR;
        PG8_STAGE(PG8_SB(1, 0), cB + kstep, voffB); PG8_STAGE(PG8_SA(1, 0), cA + kstep, voffA); PG8_STAGE(PG8_SB(1, 1), cB + hstepB + kstep, voffB);
        PG8_WAIT_V(6); PG8_BAR;
    }
    for (;;) {
        const bool has_next = S.next(ui + 1, nxt);
        const char* nA = has_next ? (const char*)g.A + (size_t)nxt.pm * tstepA : cA; const char* nB = has_next ? (const char*)g.Bt + (size_t)nxt.pn * tstepB : cB;
        for (int t = 0; t < nt; t += 2) {
            const bool last = (t == nt - 2);
            const char* a1 = cA + (size_t)(t + 1) * kstep;
            const char* a2 = last ? nA : cA + (size_t)(t + 2) * kstep; const char* b2 = last ? nB : cB + (size_t)(t + 2) * kstep;
            const char* a3 = a2 + kstep; const char* b3 = b2 + kstep;
            if (last && has_next) S.a_ready(nxt);
            if constexpr (SP2) {
            PG8_LDB(B0, 0, 0); PG8_LDB(B1, 0, 1); PG8_SCHED; PG8_LDA(At, 0, 0); PG8_STAGE(PG8_SA(1, 1), a1 + hstepA, voffA);
            PG8_WAIT_V(8); PG8_WAIT_L(0); PG8_BAR; PG8_MMA(0, 0, At, B0); PG8_MMA(0, 1, At, B1); PG8_BAR; PG8_SCHED;
            PG8_LDA(At, 0, 1); PG8_STAGE(PG8_SB(0, 0), b2, voffB); PG8_STAGE(PG8_SB(0, 1), b2 + hstepB, voffB); PG8_STAGE(PG8_SA(0, 0), a2, voffA);
            PG8_WAIT_V(8); PG8_WAIT_L(0); PG8_BAR; PG8_MMA(1, 0, At, B0); PG8_MMA(1, 1, At, B1); PG8_BAR; PG8_SCHED;
            PG8_LDB(B0, 1, 0); PG8_LDB(B1, 1, 1); PG8_SCHED; PG8_LDA(At, 1, 0); PG8_STAGE(PG8_SA(0, 1), a2 + hstepA, voffA);
            PG8_WAIT_V(8); PG8_WAIT_L(0); PG8_BAR; PG8_MMA(0, 0, At, B0); PG8_MMA(0, 1, At, B1); PG8_BAR; PG8_SCHED;
            PG8_LDA(At, 1, 1); PG8_STAGE(PG8_SB(1, 0), b3, voffB); PG8_STAGE(PG8_SB(1, 1), b3 + hstepB, voffB); PG8_STAGE(PG8_SA(1, 0), a3, voffA);
            PG8_WAIT_V(8); PG8_WAIT_L(0); PG8_BAR; PG8_MMA(1, 0, At, B0); PG8_MMA(1, 1, At, B1); PG8_BAR; PG8_SCHED;
            } else {
            PG8_LDB(B0, 0, 0); PG8_SCHED; PG8_LDA(At, 0, 0); PG8_STAGE(PG8_SA(1, 1), a1 + hstepA, voffA);
            PG8_WAIT_L(8); PG8_BAR; PG8_WAIT_L(0); PG8_MMA(0, 0, At, B0); PG8_BAR; PG8_SCHED;
            PG8_LDB(B1, 0, 1); PG8_STAGE(PG8_SB(0, 0), b2, voffB);
            PG8_BAR; PG8_WAIT_L(0); PG8_MMA(0, 1, At, B1); PG8_BAR;
            PG8_LDA(At, 0, 1); PG8_STAGE(PG8_SA(0, 0), a2, voffA);
            PG8_BAR; PG8_WAIT_L(0); PG8_MMA(1, 0, At, B0); PG8_BAR; PG8_SCHED;
            PG8_STAGE(PG8_SB(0, 1), b2 + hstepB, voffB);
            PG8_WAIT_V(6); PG8_BAR; PG8_MMA(1, 1, At, B1); PG8_BAR;
            PG8_LDB(B0, 1, 0); PG8_SCHED; PG8_LDA(At, 1, 0); PG8_STAGE(PG8_SA(0, 1), a2 + hstepA, voffA);
            PG8_WAIT_L(8); PG8_BAR; PG8_WAIT_L(0); PG8_MMA(0, 0, At, B0); PG8_BAR; PG8_SCHED;
            PG8_LDB(B1, 1, 1); PG8_STAGE(PG8_SB(1, 0), b3, voffB);
            PG8_BAR; PG8_WAIT_L(0); PG8_MMA(0, 1, At, B1); PG8_BAR;
            PG8_LDA(At, 1, 1); PG8_STAGE(PG8_SA(1, 0), a3, voffA);
            PG8_BAR; PG8_WAIT_L(0); PG8_MMA(1, 0, At, B0); PG8_BAR; PG8_SCHED;
            PG8_STAGE(PG8_SB(1, 1), b3 + hstepB, voffB);
            PG8_WAIT_V(6); PG8_BAR; PG8_MMA(1, 1, At, B1); PG8_BAR;
            }
        }
        if constexpr (ALIGN_EPI) { if (wr == 0) PG8_BAR; }
        if constexpr (!Epi::AFTER_DRAIN) { E(acc, cur, wr, wc, fr, fq); S.done(cur); }
        if (!has_next) break;
#pragma unroll
        for (int a = 0; a < 2; ++a)
#pragma unroll
            for (int b = 0; b < 2; ++b)
#pragma unroll
                for (int m = 0; m < 4; ++m)
#pragma unroll
                    for (int n = 0; n < 2; ++n) acc[a][b][m][n] = (f32x4){0.f, 0.f, 0.f, 0.f};
        cur = nxt; cA = nA; cB = nB; ++ui;
        if constexpr (ALIGN_EPI) { if (wr == 1) PG8_BAR; }
    }
    PG8_WAIT_V(0);
    if constexpr (!ALIGN_EPI) { if (wr == 0) PG8_BAR; }
    PG8_BAR;
    if constexpr (Epi::AFTER_DRAIN) { E.fused(acc, cur, wr, wc, fr, fq, lds, wid, lane); S.done(cur); }
#undef PG8_SA
#undef PG8_SB
#undef PG8_STAGE
#undef PG8_LDA
#undef PG8_LDB
#undef PG8_MMA
#undef PG8_WAIT_V
#undef PG8_WAIT_L
#undef PG8_BAR
#undef PG8_SCHED
}
}
#define LAS __attribute__((address_space(3)))
using pg8::bf16_t; using pg8::bf16x8; using pg8::f32x4; using pg8::u32x4; using pg8::cvt_pk_bf16;
typedef float f32x16 __attribute__((ext_vector_type(16)));
typedef unsigned u32x2 __attribute__((ext_vector_type(2)));
typedef float f32x2 __attribute__((ext_vector_type(2)));

constexpr int T = 32768, D = 1024, FF = 2816, SEQ = 4096, NBATCH = 8;
constexpr int NPH = 45;
constexpr float EPS = 1e-6f, LOG2E = 1.4426950408889634f;
constexpr size_t MiB = 1u << 20;
constexpr size_t WS_FIN = 0;
constexpr size_t WS_FOUT = WS_FIN + 88 * MiB;
constexpr size_t WS_AIN = WS_FOUT + 44 * MiB;
constexpr size_t WS_AOUT = WS_AIN + 12 * MiB;
constexpr size_t WS_KVW = WS_AOUT + 4 * MiB;
constexpr size_t WS_CW1 = WS_KVW + 3 * MiB;
constexpr size_t WS_BIN = WS_CW1 + 2 * MiB;
constexpr size_t WS_BOUT = WS_BIN + 5 * MiB;
constexpr size_t WS_MOD = WS_BOUT + 4 * MiB;
constexpr size_t WS_KVMOD = WS_MOD + 4ull * 8 * 9216 * 4;
constexpr size_t WS_CBIAS = WS_KVMOD + 8ull * 2048 * 4;
constexpr size_t WS_H = WS_MOD + 2 * MiB;
constexpr size_t WS_HID = WS_H + 64 * MiB;
constexpr size_t WS_Y = WS_HID + 176 * MiB;
constexpr size_t WS_PART = WS_Y + 64 * MiB;
constexpr size_t WS_GATES = WS_PART + 2 * MiB;
constexpr size_t WS_KC = WS_GATES + 6 * MiB;
constexpr size_t WS_KS = WS_KC + 33 * MiB;
constexpr size_t WS_KW = WS_KS + 16 * MiB;
constexpr size_t WS_VST = WS_KW + 16 * MiB;
constexpr size_t WS_VWT = WS_VST + 16 * MiB;
constexpr size_t WS_HIDC = WS_VWT + 16 * MiB;
constexpr size_t WS_KCMP = WS_HIDC + 8 * MiB;
constexpr size_t WS_VCMPT = WS_KCMP + 1 * MiB;
constexpr size_t WS_END = WS_VCMPT + 1 * MiB;
constexpr int LDS_BYTES = 135168;

struct Params { const float* in[19]; float* out; unsigned char* ws; int ph_lo, ph_hi; };
enum { I_X = 0, I_C, I_ADAW, I_ADAB, I_NORMG, I_FIN, I_FOUT, I_AIN, I_ACONV, I_AOUT, I_KVNG, I_KVADAW, I_KVADAB, I_KVW, I_CPOS, I_CW1, I_CW2, I_BIN, I_BOUT };

__device__ __forceinline__ float bf2f(unsigned short b) { return __uint_as_float((unsigned)b << 16); }
__device__ __forceinline__ float fexp2(float x) { return __builtin_amdgcn_exp2f(x); }
__device__ __forceinline__ float frcp(float x) { return __builtin_amdgcn_rcpf(x); }
__device__ __forceinline__ float silu_f(float g) { return g * frcp(1.f + fexp2(-g * LOG2E)); }
__device__ __forceinline__ float wave_sum(float v) {
#pragma unroll
    for (int o = 1; o < 64; o <<= 1) v += __shfl_xor(v, o);
    return v;
}
template <class Tp> __device__ __forceinline__ Tp* uptr(Tp* p) { const unsigned long long v = (unsigned long long)p; const unsigned lo = __builtin_amdgcn_readfirstlane((unsigned)v), hi = __builtin_amdgcn_readfirstlane((unsigned)(v >> 32)); typedef __attribute__((address_space(1))) Tp* gptr_t; gptr_t gp = (gptr_t)(((unsigned long long)hi << 32) | lo); return (Tp*)gp; }
#define LDS_WAIT() asm volatile("s_waitcnt lgkmcnt(0)" ::: "memory")

namespace pg8 {
__device__ __forceinline__ u32x4 pack8(const f32x4 a, const f32x4 b) { u32x4 w; w.x = cvt_pk_bf16(a[0], a[1]); w.y = cvt_pk_bf16(a[2], a[3]); w.z = cvt_pk_bf16(b[0], b[1]); w.w = cvt_pk_bf16(b[2], b[3]); return w; }
struct EpiSwiglu {
    static constexpr bool PERM = true, AFTER_DRAIN = false;
    bf16_t* O;
    __device__ __forceinline__ void operator()(const f32x4 (&acc)[2][2][4][2], const Unit& u, int wr, int wc, int fr, int fq) const {
        const int row0 = u.pm * BM + wr * 64 + fr, col0 = u.pn * 128 + wc * 32 + 8 * fq;
#pragma unroll
        for (int ai = 0; ai < 2; ++ai)
#pragma unroll
            for (int m = 0; m < 4; ++m) {
                f32x4 h0, h1;
#pragma unroll
                for (int e = 0; e < 4; ++e) { h0[e] = silu_f(acc[ai][0][m][0][e]) * acc[ai][1][m][0][e]; h1[e] = silu_f(acc[ai][0][m][1][e]) * acc[ai][1][m][1][e]; }
                *(u32x4*)(O + (size_t)(row0 + ai * HALF + m * 16) * FF + col0) = pack8(h0, h1);
            }
    }
};
struct EpiY {
    static constexpr bool PERM = true, AFTER_DRAIN = false;
    bf16_t* Y; float* part;
    __device__ __forceinline__ void operator()(const f32x4 (&acc)[2][2][4][2], const Unit& u, int wr, int wc, int fr, int fq) const {
        const int row0 = u.pm * BM + wr * 64 + fr, col0 = u.pn * BM + wc * 32 + 8 * fq;
#pragma unroll
        for (int ai = 0; ai < 2; ++ai)
#pragma unroll
            for (int m = 0; m < 4; ++m) {
                const int row = row0 + ai * HALF + m * 16; float ss = 0.f;
#pragma unroll
                for (int bj = 0; bj < 2; ++bj) {
                    const f32x4 a = acc[ai][bj][m][0], b = acc[ai][bj][m][1];
                    ss += (a[0] * a[0] + a[1] * a[1]) + (a[2] * a[2] + a[3] * a[3]) + (b[0] * b[0] + b[1] * b[1]) + (b[2] * b[2] + b[3] * b[3]);
                    *(u32x4*)(Y + (size_t)row * D + col0 + bj * HALF) = pack8(a, b);
                }
                ss += __shfl_xor(ss, 16); ss += __shfl_xor(ss, 32);
                if (fq == 0) part[(size_t)row * 16 + u.pn * 4 + wc] = ss;
            }
    }
};
struct EpiConvIn {
    static constexpr bool PERM = true, AFTER_DRAIN = false;
    bf16_t* V; bf16_t* Bg;
    __device__ __forceinline__ void operator()(const f32x4 (&acc)[2][2][4][2], const Unit& u, int wr, int wc, int fr, int fq) const {
        const int row0 = u.pm * BM + wr * 64 + fr;
        if (u.pn < 8) {
            const int col0 = u.pn * 128 + wc * 32 + 8 * fq;
#pragma unroll
            for (int ai = 0; ai < 2; ++ai)
#pragma unroll
                for (int m = 0; m < 4; ++m)
                    *(u32x4*)(V + (size_t)(row0 + ai * HALF + m * 16) * D + col0) = pack8(acc[ai][0][m][0] * acc[ai][1][m][0], acc[ai][0][m][1] * acc[ai][1][m][1]);
        } else {
            const int col0 = (u.pn - 8) * BM + wc * 32 + 8 * fq;
#pragma unroll
            for (int ai = 0; ai < 2; ++ai)
#pragma unroll
                for (int m = 0; m < 4; ++m)
#pragma unroll
                    for (int bj = 0; bj < 2; ++bj)
                        *(u32x4*)(Bg + (size_t)(row0 + ai * HALF + m * 16) * D + col0 + bj * HALF) = pack8(acc[ai][bj][m][0], acc[ai][bj][m][1]);
        }
    }
};
struct EpiQG {
    static constexpr bool PERM = true, AFTER_DRAIN = false;
    bf16_t* Q; float* G;
    __device__ __forceinline__ void operator()(const f32x4 (&acc)[2][2][4][2], const Unit& u, int wr, int wc, int fr, int fq) const {
        const int row0 = u.pm * BM + wr * 64 + fr;
        if (u.pn < 4) {
            const int col0 = u.pn * BM + wc * 32 + 8 * fq; const float sc = 0.125f * LOG2E;
#pragma unroll
            for (int ai = 0; ai < 2; ++ai)
#pragma unroll
                for (int m = 0; m < 4; ++m)
#pragma unroll
                    for (int bj = 0; bj < 2; ++bj)
                        *(u32x4*)(Q + (size_t)(row0 + ai * HALF + m * 16) * D + col0 + bj * HALF) = pack8(acc[ai][bj][m][0] * sc, acc[ai][bj][m][1] * sc);
        } else {
            const int col0 = wc * 32 + 8 * fq;
            if (col0 < 48) {
#pragma unroll
                for (int ai = 0; ai < 2; ++ai)
#pragma unroll
                    for (int m = 0; m < 4; ++m) {
                        float* gp = G + (size_t)(row0 + ai * HALF + m * 16) * 48 + col0;
#pragma unroll
                        for (int n = 0; n < 2; ++n) { f32x4 s;
#pragma unroll
                            for (int e = 0; e < 4; ++e) s[e] = frcp(1.f + fexp2(-acc[ai][0][m][n][e] * LOG2E));
                            *(f32x4*)(gp + 4 * n) = s; }
                    }
            }
        }
    }
};
struct EpiKV {
    static constexpr bool PERM = true, AFTER_DRAIN = false;
    bf16_t *KC, *KS, *KW, *VSt, *VWt;
    __device__ __forceinline__ void operator()(const f32x4 (&acc)[2][2][4][2], const Unit& u, int wr, int wc, int fr, int fq) const {
        const int br = u.pn >> 1, kv = u.pn & 1;
        const int row0 = u.pm * BM + wr * 64 + fr, b = row0 >> 12;
        const int d0 = (wc & 1) * 32 + 8 * fq;
        if (br == 0 || kv == 0) {
            bf16_t* base = br == 0 ? KC + (size_t)kv * 32 * 4096 * 64 : (br == 1 ? KS : KW);
#pragma unroll
            for (int ai = 0; ai < 2; ++ai)
#pragma unroll
                for (int m = 0; m < 4; ++m)
#pragma unroll
                    for (int bj = 0; bj < 2; ++bj) {
                        const int s = (row0 + ai * HALF + m * 16) & 4095, g = 2 * bj + (wc >> 1);
                        *(u32x4*)(base + ((size_t)(b * 4 + g) * 4096 + s) * 64 + d0) = pack8(acc[ai][bj][m][0], acc[ai][bj][m][1]);
                    }
        } else {
            bf16_t* base = br == 1 ? VSt : VWt;
#pragma unroll
            for (int ai = 0; ai < 2; ++ai)
#pragma unroll
                for (int m = 0; m < 4; ++m)
#pragma unroll
                    for (int bj = 0; bj < 2; ++bj) {
                        const int s = (row0 + ai * HALF + m * 16) & 4095, g = 2 * bj + (wc >> 1);
                        bf16_t* p = base + ((size_t)(b * 4 + g) * 64 + d0) * 4096 + s;
                        const u32x4 w = pack8(acc[ai][bj][m][0], acc[ai][bj][m][1]);
                        p[0 * 4096] = (bf16_t)(w.x & 0xffffu); p[1 * 4096] = (bf16_t)(w.x >> 16); p[2 * 4096] = (bf16_t)(w.y & 0xffffu); p[3 * 4096] = (bf16_t)(w.y >> 16);
                        p[4 * 4096] = (bf16_t)(w.z & 0xffffu); p[5 * 4096] = (bf16_t)(w.z >> 16); p[6 * 4096] = (bf16_t)(w.w & 0xffffu); p[7 * 4096] = (bf16_t)(w.w >> 16);
                    }
        }
    }
};
struct EpiCmp1 {
    static constexpr bool PERM = true, AFTER_DRAIN = false;
    bf16_t* O; const float* cbias;
    __device__ __forceinline__ void operator()(const f32x4 (&acc)[2][2][4][2], const Unit& u, int wr, int wc, int fr, int fq) const {
        const int row0 = u.pm * BM + wr * 64 + fr, col0 = wc * 32 + 8 * fq;
#pragma unroll
        for (int bj = 0; bj < 2; ++bj) {
            const f32x4 b0 = *(const f32x4*)(cbias + u.pn * 256 + col0 + bj * HALF), b1 = *(const f32x4*)(cbias + u.pn * 256 + col0 + bj * HALF + 4);
#pragma unroll
            for (int ai = 0; ai < 2; ++ai)
#pragma unroll
                for (int m = 0; m < 4; ++m) {
                    f32x4 x0 = acc[ai][bj][m][0] + b0, x1 = acc[ai][bj][m][1] + b1;
#pragma unroll
                    for (int e = 0; e < 4; ++e) {
                        { const float x = x0[e], z = 1.5957691216f * (x + 0.044715f * x * x * x); x0[e] = x * frcp(1.f + fexp2(-z * LOG2E)); }
                        { const float x = x1[e], z = 1.5957691216f * (x + 0.044715f * x * x * x); x1[e] = x * frcp(1.f + fexp2(-z * LOG2E)); }
                    }
                    *(u32x4*)(O + (size_t)(row0 + ai * HALF + m * 16) * 256 + col0 + bj * HALF) = pack8(x0, x1);
                }
        }
    }
};
struct DiagOrder {
    int G, c;
    __device__ bool next(int i, Unit& u) const { const int L = i * G + c; if (L >= 64) return false; u.pm = L; u.pn = L >> 5; return true; }
    __device__ __forceinline__ void a_ready(const Unit&) const {}
    __device__ __forceinline__ void done(const Unit&) const {}
};
}
struct Ctx { LAS unsigned char* lds; int tid, lane, wave, G, bid; };

__device__ __forceinline__ void conv_item(const float* W, int ldw, int ncv, int src_col0, int K, bf16_t* WT, int dst_row0, int kb, LAS float* scr, int lane) {
    const int k0 = 64 * kb, col = src_col0 + (lane & 31); const bool ok = col < ncv;
#pragma unroll 8
    for (int i = 0; i < 32; ++i) { const int kk = 2 * i + (lane >> 5); scr[kk * 33 + (lane & 31)] = ok ? W[(size_t)(k0 + kk) * ldw + col] : 0.f; }
    LDS_WAIT(); asm volatile("" ::: "memory");
    const int c = lane & 7;
#pragma unroll
    for (int j = 0; j < 4; ++j) { const int n = (lane >> 3) + 8 * j; const LAS float* s = scr + (8 * c) * 33 + n;
        u32x4 o; o.x = cvt_pk_bf16(s[0 * 33], s[1 * 33]); o.y = cvt_pk_bf16(s[2 * 33], s[3 * 33]); o.z = cvt_pk_bf16(s[4 * 33], s[5 * 33]); o.w = cvt_pk_bf16(s[6 * 33], s[7 * 33]);
        *(u32x4*)(WT + (size_t)(dst_row0 + n) * K + k0 + 8 * c) = o; }
    LDS_WAIT(); asm volatile("" ::: "memory");
}
#define PIN(k) uptr(LP->in[k])
__device__ __forceinline__ void p0_phase(const Ctx& X, const LAS Params* LP) {
    unsigned char* ws = uptr(LP->ws);
    LAS float* sc = (LAS float*)X.lds;
    LAS float* red = (LAS float*)(X.lds + 32768);
    for (int i = X.tid; i < 8192; i += 512) { const int b = i >> 10, k = i & 1023; sc[k * 8 + b] = silu_f(PIN(I_C)[i]); }
    __syncthreads();
    for (int it = X.bid; it < 608; it += X.G) {
        const float* W; const float* bias; float* out; int N, cb;
        if (it < 576) { const int l = it / 144; cb = it % 144; N = 9216; W = PIN(I_ADAW) + (size_t)l * 1024 * 9216; bias = PIN(I_ADAB) + l * 9216; out = (float*)(ws + WS_MOD) + (size_t)l * 8 * 9216; }
        else { cb = it - 576; N = 2048; W = PIN(I_KVADAW); bias = PIN(I_KVADAB); out = (float*)(ws + WS_KVMOD); }
        float a[8];
#pragma unroll
        for (int b = 0; b < 8; ++b) a[b] = 0.f;
        const float* wp = W + (size_t)(128 * X.wave) * N + 64 * cb + X.lane;
#pragma unroll 4
        for (int k = 0; k < 128; ++k) { const float w = wp[(size_t)k * N]; const f32x4 s0 = *(const LAS f32x4*)(sc + (128 * X.wave + k) * 8), s1 = *(const LAS f32x4*)(sc + (128 * X.wave + k) * 8 + 4);
            a[0] += s0[0] * w; a[1] += s0[1] * w; a[2] += s0[2] * w; a[3] += s0[3] * w; a[4] += s1[0] * w; a[5] += s1[1] * w; a[6] += s1[2] * w; a[7] += s1[3] * w; }
#pragma unroll
        for (int b = 0; b < 8; ++b) red[(X.wave * 8 + b) * 64 + X.lane] = a[b];
        __syncthreads();
        { const int b = X.tid >> 6, col = X.tid & 63; float s = bias[64 * cb + col];
#pragma unroll
          for (int w = 0; w < 8; ++w) s += red[(w * 8 + b) * 64 + col];
          out[(size_t)b * N + 64 * cb + col] = s; }
        __syncthreads();
    }
    for (int kv = 0; kv < 2; ++kv) if (X.bid == X.G - 1 - kv) {
        const int col = X.tid & 255, half = X.tid >> 8; const float* pos = PIN(I_CPOS) + kv * 2048 + half * 1024; const float* w1 = PIN(I_CW1) + ((size_t)kv * 2048 + half * 1024) * 256 + col;
        float s = 0.f;
        for (int f = 0; f < 1024; ++f) s += pos[f] * w1[(size_t)f * 256];
        red[X.tid] = s; __syncthreads();
        if (X.tid < 256) ((float*)(ws + WS_CBIAS))[kv * 256 + X.tid] = red[X.tid] + red[X.tid + 256];
        __syncthreads();
    }
    __syncthreads();
    LAS float* scr = (LAS float*)(X.lds + X.wave * 8448);
    const int gw = X.bid * 8 + X.wave, NGW = X.G * 8;
    for (int it = gw; it < 41472; it += NGW) {
        int r = it;
        if (r < 22528) { const int id = r / 2816, q = r % 2816, nb = q >> 4, kb = q & 15, pn = nb >> 3, jb = nb & 7;
            conv_item(PIN(I_FIN) + (size_t)id * 1024 * 5632, 5632, 5632, (jb >> 2) * 2816 + 128 * pn + 32 * (jb & 3), 1024, (bf16_t*)(ws + WS_FIN) + (size_t)id * 5632 * 1024, 32 * nb, kb, scr, X.lane); continue; } r -= 22528;
        if (r < 11264) { const int id = r / 1408, q = r % 1408, nb = q / 44, kb = q % 44;
            conv_item(PIN(I_FOUT) + (size_t)id * 2816 * 1024, 1024, 1024, 32 * nb, 2816, (bf16_t*)(ws + WS_FOUT) + (size_t)id * 1024 * 2816, 32 * nb, kb, scr, X.lane); continue; } r -= 11264;
        if (r < 3072) { const int id = r / 1536, q = r % 1536, nb = q >> 4, kb = q & 15, pn = nb >> 3, jb = nb & 7;
            const int src = pn < 8 ? ((jb >> 2) ? 2048 : 1024) + 128 * pn + 32 * (jb & 3) : 256 * (pn - 8) + 32 * jb;
            conv_item(PIN(I_AIN) + (size_t)id * 1024 * 3072, 3072, 3072, src, 1024, (bf16_t*)(ws + WS_AIN) + (size_t)id * 3072 * 1024, 32 * nb, kb, scr, X.lane); continue; } r -= 3072;
        if (r < 1024) { const int id = r / 512, q = r % 512, nb = q >> 4, kb = q & 15;
            conv_item(PIN(I_AOUT) + (size_t)id * 1024 * 1024, 1024, 1024, 32 * nb, 1024, (bf16_t*)(ws + WS_AOUT) + (size_t)id * 1024 * 1024, 32 * nb, kb, scr, X.lane); continue; } r -= 1024;
        if (r < 768) { const int nb = r >> 4, kb = r & 15;
            conv_item(PIN(I_KVW), 1536, 1536, 32 * nb, 1024, (bf16_t*)(ws + WS_KVW), 32 * nb, kb, scr, X.lane); continue; } r -= 768;
        if (r < 512) { const int id = r / 256, q = r % 256, nb = q >> 5, kb = q & 31;
            conv_item(PIN(I_CW1) + (size_t)id * 2048 * 256, 256, 256, 32 * nb, 2048, (bf16_t*)(ws + WS_CW1) + (size_t)id * 256 * 2048, 32 * nb, kb, scr, X.lane); continue; } r -= 512;
        if (r < 1280) { const int id = r / 640, q = r % 640, nb = q >> 4, kb = q & 15;
            conv_item(PIN(I_BIN) + (size_t)id * 1024 * 1072, 1072, 1072, 32 * nb, 1024, (bf16_t*)(ws + WS_BIN) + (size_t)id * 1280 * 1024, 32 * nb, kb, scr, X.lane); continue; } r -= 1280;
        { const int id = r / 512, q = r % 512, nb = q >> 4, kb = q & 15;
            conv_item(PIN(I_BOUT) + (size_t)id * 1024 * 1024, 1024, 1024, 32 * nb, 1024, (bf16_t*)(ws + WS_BOUT) + (size_t)id * 1024 * 1024, 32 * nb, kb, scr, X.lane); }
    }
}

struct UpdArgs { const float* xin; float* xout; const bf16_t* y; const float* part; const float* gate; const float* gpost; float w; int bstride;
                 const float* gpre; const float* shift; const float* scale; bf16_t* h; const float* gpre2; const float* shift2; const float* scale2; bf16_t* h2; };
__device__ __forceinline__ void update_phase(const Ctx& X, const UpdArgs& A) {
    const int gw = X.bid * 8 + X.wave, NGW = X.G * 8, c0 = 4 * X.lane;
    for (int row = gw; row < T; row += NGW) {
        const int b = row >> 12;
        f32x4 xv[4];
#pragma unroll
        for (int j = 0; j < 4; ++j) xv[j] = *(const f32x4*)(A.xin + (size_t)row * D + c0 + 256 * j);
        if (A.y) {
            const f32x4* pp = (const f32x4*)(A.part + (size_t)row * 16); const f32x4 p0 = pp[0], p1 = pp[1], p2 = pp[2], p3 = pp[3];
            const float ssq = ((p0[0] + p0[1]) + (p0[2] + p0[3])) + ((p1[0] + p1[1]) + (p1[2] + p1[3])) + ((p2[0] + p2[1]) + (p2[2] + p2[3])) + ((p3[0] + p3[1]) + (p3[2] + p3[3]));
            const float rs = A.w * __builtin_amdgcn_rsqf(ssq * (1.f / D) + EPS);
#pragma unroll
            for (int j = 0; j < 4; ++j) { const int c = c0 + 256 * j; const u32x2 yy = *(const u32x2*)(A.y + (size_t)row * D + c);
                const f32x4 gt = *(const f32x4*)(A.gate + (size_t)b * A.bstride + c), gp = *(const f32x4*)(A.gpost + c);
                const f32x4 yv = {__uint_as_float(yy.x << 16), __uint_as_float(yy.x & 0xffff0000u), __uint_as_float(yy.y << 16), __uint_as_float(yy.y & 0xffff0000u)};
                xv[j] = xv[j] + gt * gp * yv * rs; }
        }
        if (A.xout) {
#pragma unroll
            for (int j = 0; j < 4; ++j) *(f32x4*)(A.xout + (size_t)row * D + c0 + 256 * j) = xv[j];
        }
        if (A.h) {
            float s = 0.f;
#pragma unroll
            for (int j = 0; j < 4; ++j) s += (xv[j][0] * xv[j][0] + xv[j][1] * xv[j][1]) + (xv[j][2] * xv[j][2] + xv[j][3] * xv[j][3]);
            const float r = __builtin_amdgcn_rsqf(wave_sum(s) * (1.f / D) + EPS);
#pragma unroll
            for (int j = 0; j < 4; ++j) { const int c = c0 + 256 * j;
                const f32x4 g = *(const f32x4*)(A.gpre + c), sh = *(const f32x4*)(A.shift + (size_t)b * A.bstride + c), scl = *(const f32x4*)(A.scale + (size_t)b * A.bstride + c);
                const f32x4 hv = xv[j] * r * g * (scl + 1.f) + sh; u32x2 o; o.x = cvt_pk_bf16(hv[0], hv[1]); o.y = cvt_pk_bf16(hv[2], hv[3]);
                *(u32x2*)(A.h + (size_t)row * D + c) = o; }
            if (A.h2) {
#pragma unroll
                for (int j = 0; j < 4; ++j) { const int c = c0 + 256 * j;
                    const f32x4 g = *(const f32x4*)(A.gpre2 + c), sh = *(const f32x4*)(A.shift2 + (size_t)b * 2048 + c), scl = *(const f32x4*)(A.scale2 + (size_t)b * 2048 + c);
                    const f32x4 hv = xv[j] * r * g * (scl + 1.f) + sh; u32x2 o; o.x = cvt_pk_bf16(hv[0], hv[1]); o.y = cvt_pk_bf16(hv[2], hv[3]);
                    *(u32x2*)(A.h2 + (size_t)row * D + c) = o; }
            }
        }
    }
}

__device__ __forceinline__ void unpack8(const u32x4 w, float (&f)[8]) {
    f[0] = __uint_as_float(w.x << 16); f[1] = __uint_as_float(w.x & 0xffff0000u); f[2] = __uint_as_float(w.y << 16); f[3] = __uint_as_float(w.y & 0xffff0000u);
    f[4] = __uint_as_float(w.z << 16); f[5] = __uint_as_float(w.z & 0xffff0000u); f[6] = __uint_as_float(w.w << 16); f[7] = __uint_as_float(w.w & 0xffff0000u);
}
__device__ __forceinline__ void conv_phase(const Ctx& X, const bf16_t* V, const bf16_t* Bg, const float* cw, bf16_t* Z) {
    const int gt = X.bid * 512 + X.tid, NT = X.G * 512;
    for (int i = gt; i < T * 128; i += NT) {
        const int row = i >> 7, c = (i & 127) * 8, s = row & 4095;
        const u32x4 z0 = {0u, 0u, 0u, 0u};
        const u32x4 v2 = *(const u32x4*)(V + (size_t)row * D + c), v1 = s >= 1 ? *(const u32x4*)(V + (size_t)(row - 1) * D + c) : z0, v0 = s >= 2 ? *(const u32x4*)(V + (size_t)(row - 2) * D + c) : z0;
        const u32x4 bb = *(const u32x4*)(Bg + (size_t)row * D + c);
        float a0[8], a1[8], a2[8], bf[8], o[8]; unpack8(v0, a0); unpack8(v1, a1); unpack8(v2, a2); unpack8(bb, bf);
#pragma unroll
        for (int e = 0; e < 8; ++e) o[e] = bf[e] * (cw[c + e] * a0[e] + cw[D + c + e] * a1[e] + cw[2 * D + c + e] * a2[e]);
        u32x4 w; w.x = cvt_pk_bf16(o[0], o[1]); w.y = cvt_pk_bf16(o[2], o[3]); w.z = cvt_pk_bf16(o[4], o[5]); w.w = cvt_pk_bf16(o[6], o[7]);
        *(u32x4*)(Z + (size_t)row * D + c) = w;
    }
}

__device__ __forceinline__ void cmp2_phase(const Ctx& X, const bf16_t* hidc, const float* w2, bf16_t* kcmp, bf16_t* vcmpT) {
    const int gt = X.bid * 512 + X.tid, NT = X.G * 512;
    for (int i = gt; i < 16384 * 16; i += NT) {
        const int row = i >> 4, c = (i & 15) * 4, kv = row >> 13, rr = row & 8191;
        const float* w = w2 + (size_t)kv * 256 * 64 + c; const bf16_t* hp = hidc + (size_t)row * 256;
        f32x4 a = {0.f, 0.f, 0.f, 0.f};
        for (int k = 0; k < 256; k += 8) { float hf[8]; unpack8(*(const u32x4*)(hp + k), hf);
#pragma unroll
            for (int e = 0; e < 8; ++e) a += *(const f32x4*)(w + (size_t)(k + e) * 64) * hf[e]; }
        if (kv == 0) { u32x2 o; o.x = cvt_pk_bf16(a[0], a[1]); o.y = cvt_pk_bf16(a[2], a[3]); *(u32x2*)(kcmp + (size_t)rr * 64 + c) = o; }
        else { const int bg = rr >> 8, n = rr & 255; bf16_t* p = vcmpT + ((size_t)bg * 64 + c) * 256 + n; const unsigned w0 = cvt_pk_bf16(a[0], a[1]), w1 = cvt_pk_bf16(a[2], a[3]);
            p[0] = (bf16_t)(w0 & 0xffffu); p[256] = (bf16_t)(w0 >> 16); p[512] = (bf16_t)(w1 & 0xffffu); p[768] = (bf16_t)(w1 >> 16); }
    }
}
struct AttnArgs { const bf16_t* Q; const float* gates; const bf16_t *kcmp, *vcmpT, *KS, *VSt, *KW, *VWt; bf16_t* O; };

__device__ __forceinline__ void load_k(bf16x8 (&kf)[4], const bf16_t* Kb, int key0, int jr, int h) {
    const bf16x8* p = (const bf16x8*)(Kb + (size_t)(key0 + jr) * 64 + h * 8);
#pragma unroll
    for (int ks = 0; ks < 4; ++ks) kf[ks] = p[2 * ks];
}
__device__ __forceinline__ void load_v(bf16x8 (&vf)[4], const bf16_t* Vt, int ldv, int key0, int j, int h) {
#pragma unroll
    for (int s = 0; s < 2; ++s)
#pragma unroll
        for (int dt = 0; dt < 2; ++dt) vf[s * 2 + dt] = *(const bf16x8*)(Vt + (size_t)(dt * 32 + j) * ldv + key0 + 16 * s + 8 * h);
}
__device__ __forceinline__ f32x16 qk_mma(const bf16x8 (&kf)[4], const bf16x8 (&qf)[4], const f32x16& bc) {
    f32x16 acc = __builtin_amdgcn_mfma_f32_32x32x16_bf16(kf[0], qf[0], bc, 0, 0, 0);
#pragma unroll
    for (int ks = 1; ks < 4; ++ks) acc = __builtin_amdgcn_mfma_f32_32x32x16_bf16(kf[ks], qf[ks], acc, 0, 0, 0);
    return acc;
}
__device__ __forceinline__ void pv_mma(f32x16 (&o)[2], const bf16x8 (&vf)[4], const f32x16& p) {
#pragma unroll
    for (int s = 0; s < 2; ++s) {
        u32x4 w; w.x = cvt_pk_bf16(p[8 * s + 0], p[8 * s + 1]); w.y = cvt_pk_bf16(p[8 * s + 2], p[8 * s + 3]); w.z = cvt_pk_bf16(p[8 * s + 4], p[8 * s + 5]); w.w = cvt_pk_bf16(p[8 * s + 6], p[8 * s + 7]);
        const bf16x8 pb = __builtin_bit_cast(bf16x8, w);
#pragma unroll
        for (int dt = 0; dt < 2; ++dt) o[dt] = __builtin_amdgcn_mfma_f32_32x32x16_bf16(vf[s * 2 + dt], pb, o[dt], 0, 0, 0);
    }
}
__device__ __forceinline__ void pf_block(const bf16_t* Kb, const bf16_t* Vt, int ldv, int key0, int lane, LAS unsigned* junk) {
    __builtin_amdgcn_global_load_lds((const unsigned*)(Kb + (size_t)(key0 + lane) * 64), junk, 4, 0, 0);
    __builtin_amdgcn_global_load_lds((const unsigned*)(Vt + (size_t)lane * ldv + key0), junk, 4, 0, 0);
}
__device__ __forceinline__ unsigned run_mask(int kstart, int lo, int hi) {
    const int a = max(lo - kstart, 0), b = min(hi - kstart, 7);
    return a <= b ? ((1u << (b + 1)) - 1u) & ~((1u << a) - 1u) : 0u;
}
__device__ __forceinline__ float max16(const f32x16& s) {
    float a = fmaxf(fmaxf(s[0], s[1]), s[2]), b = fmaxf(fmaxf(s[3], s[4]), s[5]), c = fmaxf(fmaxf(s[6], s[7]), s[8]), d = fmaxf(fmaxf(s[9], s[10]), s[11]), e = fmaxf(fmaxf(s[12], s[13]), s[14]);
    return fmaxf(fmaxf(fmaxf(a, b), fmaxf(c, d)), fmaxf(e, s[15]));
}
__device__ __forceinline__ void softmax_step(f32x16& s, bool full, unsigned vm, float off, float& m, float& l, f32x16 (&o)[2]) {
    if (!full) {
#pragma unroll
        for (int v = 0; v < 16; ++v) s[v] = ((vm >> v) & 1u) ? s[v] : -1e30f;
    }
    float tm = max16(s);
    tm = fmaxf(tm, __shfl_xor(tm, 32)) + off;
    const float mn = fmaxf(m, tm);
    if (__any(mn > m)) { const float al = fexp2(m - mn); l *= al; o[0] = o[0] * al; o[1] = o[1] * al; }
    m = mn; const float ml = mn - off;
    float ps = 0.f;
    if (full) {
#pragma unroll
        for (int v = 0; v < 16; ++v) { const float p = fexp2(s[v] - ml); s[v] = p; ps += p; }
    } else {
#pragma unroll
        for (int v = 0; v < 16; ++v) { const float p = ((vm >> v) & 1u) ? fexp2(s[v] - ml) : 0.f; s[v] = p; ps += p; }
    }
    l += ps;
}

__device__ __forceinline__ void glds16(const void* gsrc, unsigned lds_dst) { unsigned keep;
    asm volatile("s_mov_b32 %0, m0\n\ts_mov_b32 m0, %2\n\ts_nop 0\n\tglobal_load_lds_dwordx4 %1, off\n\ts_mov_b32 m0, %0" : "=&s"(keep) : "v"(gsrc), "s"(lds_dst) : "memory"); }
struct AttnSrc { const bf16_t *Kc, *Vc, *Kw, *Vw, *Ks, *Vs; };
__device__ __forceinline__ void ring_load(const AttnSrc& S, int type, int key0, unsigned slot_addr, int wave, int j, int h, int jr) {
    const bf16_t* src;
    if (wave < 4) { const bf16_t* kb = type == 0 ? S.Kc : (type == 1 ? S.Kw : S.Ks); src = kb + (size_t)(key0 + jr) * 64 + 16 * wave + 8 * h; }
    else { const int idx = wave - 4, s = idx >> 1, dt = idx & 1; const bf16_t* vb = type == 0 ? S.Vc : (type == 1 ? S.Vw : S.Vs); const int ldv = type == 0 ? 256 : 4096;
           src = vb + (size_t)(dt * 32 + j) * ldv + key0 + 16 * s + 8 * h; }
    glds16(src, slot_addr + (unsigned)wave * 1024u);
}
#define RING_WAIT_BAR() do { asm volatile("s_waitcnt vmcnt(6)" ::: "memory"); __builtin_amdgcn_s_barrier(); asm volatile("" ::: "memory"); } while (0)
#define RING_DRAIN_BAR() do { asm volatile("s_waitcnt vmcnt(0) lgkmcnt(0)" ::: "memory"); __builtin_amdgcn_s_barrier(); asm volatile("" ::: "memory"); } while (0)
__device__ __forceinline__ void ring_read_k(bf16x8 (&kf)[4], const LAS unsigned char* slot, int lane) {
#pragma unroll
    for (int ks = 0; ks < 4; ++ks) kf[ks] = *(const LAS bf16x8*)(slot + ks * 1024 + lane * 16);
}
__device__ __forceinline__ void ring_read_v(bf16x8 (&vf)[4], const LAS unsigned char* slot, int lane) {
#pragma unroll
    for (int i = 0; i < 4; ++i) vf[i] = *(const LAS bf16x8*)(slot + 4096 + i * 1024 + lane * 16);
}

__device__ __forceinline__ void attn_item(const Ctx& X, const AttnArgs& A, int b, int g, int qt, const int mode = 3) {
    int lane_ = X.lane; asm volatile("" : "+v"(lane_));
    const int lane = lane_, h = lane >> 5, j = lane & 31, ql = j >> 2, r = j & 3, wave = X.wave;
    const int tb = qt * 64, t0 = tb + wave * 8, t = t0 + ql, head = g * 4 + r, bg = b * 4 + g, cur = qt;
    const size_t row = (size_t)b * SEQ + t;
    RING_DRAIN_BAR();
    bf16x8 qf[4];
#pragma unroll
    for (int ks = 0; ks < 4; ++ks) qf[ks] = *(const bf16x8*)(A.Q + row * D + head * 64 + ks * 16 + h * 8);
    const float sl2 = fexp2(-0.5f * (float)(head + 1)) * LOG2E;
    const int jr = (j & ~12) | ((j & 4) << 1) | ((j & 8) >> 1);
    const float g0 = A.gates[row * 48 + head], g1 = A.gates[row * 48 + 16 + head], g2 = A.gates[row * 48 + 32 + head];
    f32x16 o[2], bc;
#pragma unroll
    for (int v = 0; v < 16; ++v) { o[0][v] = 0.f; o[1][v] = 0.f; }
    LAS float* cm = (LAS float*)(X.lds + wave * 8192);
    LAS float* ob = cm + lane;
    const LAS unsigned char* ring = X.lds + 65536;
    const unsigned ring_a = (unsigned)(unsigned long long)ring;
    LAS unsigned long long* ux = (LAS unsigned long long*)(X.lds + 131072);
    AttnSrc S; S.Kc = A.kcmp + (size_t)bg * 256 * 64; S.Vc = A.vcmpT + (size_t)bg * 64 * 256; S.Kw = A.KW + (size_t)bg * 4096 * 64; S.Vw = A.VWt + (size_t)bg * 64 * 4096;
    S.Ks = A.KS + (size_t)bg * 4096 * 64; S.Vs = A.VSt + (size_t)bg * 64 * 4096;
    float m, l;
    bf16x8 kc[4], vf[4];

    const int ntb = (((tb + 63 - 31) >> 4) >> 5) + 1;
    const int nmax_w = (t0 + 7 - 31) >> 4, nmax_t = (t - 31) >> 4, nmin_w = (t0 - 31) >> 4;
    const int ntile = nmax_w >= 0 ? (nmax_w >> 5) + 1 : 0;
#pragma unroll
    for (int v = 0; v < 16; ++v) bc[v] = 16.f * sl2 * (float)(8 * h + 16 * (v >> 3) + (v & 7)) + sl2 * (float)(31 - ql);
    m = -1e30f; l = 0.f;
    {
        const int n1 = 2 * ntb;
#define CMP_TILE(i) ((i) < ntb ? ntb - 1 - (i) : 2 * ntb - 1 - min((i), n1 - 1))
        for (int i = 0; i < 7; ++i) ring_load(S, 0, CMP_TILE(i) * 32, ring_a + (unsigned)(i & 7) * 8192u, wave, j, h, jr);
        float inv = 0.f;
#pragma unroll 1
        for (int i = 0; i < n1; ++i) {
            RING_WAIT_BAR();
            ring_load(S, 0, CMP_TILE(i + 7) * 32, ring_a + (unsigned)((i + 7) & 7) * 8192u, wave, j, h, jr);
            const int tile = CMP_TILE(i); const LAS unsigned char* slot = ring + (i & 7) * 8192;
            if (i == ntb) { l += __shfl_xor(l, 32); inv = 1.f / fmaxf(l, 1e-30f); }
            if (tile < ntile) {
                ring_read_k(kc, slot, lane);
                const unsigned vm = run_mask(tile * 32 + 8 * h, 0, nmax_t) | (run_mask(tile * 32 + 16 + 8 * h, 0, nmax_t) << 8);
                const float off = sl2 * (float)(512 * tile - t0);
                if (i < ntb) {
                    f32x16 s = qk_mma(kc, qf, bc);
                    softmax_step(s, tile * 32 + 31 <= nmin_w, vm, off, m, l, o);
                } else {
                    ring_read_v(vf, slot, lane);
                    f32x16 s = qk_mma(kc, qf, bc);
                    const float ml = m - off;
#pragma unroll
                    for (int v = 0; v < 16; ++v) {
                        const float p = ((vm >> v) & 1u) ? fexp2(s[v] - ml) * inv : 0.f; s[v] = p;
                        float x = p; x += __shfl_xor(x, 1); x += __shfl_xor(x, 2);
                        if ((v & 3) == r) cm[ql * 256 + tile * 32 + 16 * (v >> 3) + 8 * h + (v & 7)] = x;
                    }
                    pv_mma(o, vf, s);
                }
            }
        }
#undef CMP_TILE
    }
    RING_DRAIN_BAR();
    const int kt1b = (tb + 63) >> 5, kt0b = max(tb - 511, 0) >> 5, nW = kt1b - kt0b + 1;
    const int kt0 = max(t0 - 511, 0) >> 5, kt1 = (t0 + 7) >> 5;
    int li = 0;
    for (; li < 7 && li < nW; ++li) ring_load(S, 1, (kt1b - li) * 32, ring_a + (unsigned)(li & 7) * 8192u, wave, j, h, jr);
    unsigned long long mq = 0ull, uni = 0ull, alln = ~0ull;
    {
        const unsigned long long causal = cur >= 63 ? ~0ull : ((1ull << (cur + 1)) - 1ull);
        if (cur + 1 <= 16) { mq = causal; uni = causal; alln = causal; }
        else {
#pragma unroll 1
            for (int q = 0; q < 8; ++q) {
                float iv;
                if (lane == 0 || lane == cur || lane == cur - 1) iv = 1e30f;
                else if (lane > cur) iv = -1.f;
                else { const LAS float* c = cm + q * 256 + 4 * lane; iv = (((c[-1] + c[0]) + c[1]) + c[2]) + c[3]; }
                const int ib = __float_as_int(iv);
                int Tb = 0; unsigned long long ge = causal;
#pragma unroll 1
                for (int bit = 30; bit >= 0; --bit) {
                    const int cand = Tb | (1 << bit); const unsigned long long bm = __ballot(ib >= cand); const int c = __popcll(bm);
                    if (c >= 16) { Tb = cand; ge = bm; if (c == 16) break; }
                }
                unsigned long long mk = ge;
                if (__popcll(ge) > 16) {
                    const unsigned long long gt = __ballot(ib > Tb); unsigned long long eq = ge & ~gt; int need = 16 - __popcll(gt); mk = gt;
                    for (; need > 0; --need) { const unsigned long long low = eq & (0ull - eq); mk |= low; eq ^= low; }
                }
                mk &= causal;
                uni |= mk; alln &= mk; if (ql == q) mq = mk;
            }
        }
    }
    if (lane == 0) ux[wave] = uni;
    asm volatile("s_waitcnt lgkmcnt(0)" ::: "memory"); __builtin_amdgcn_s_barrier(); asm volatile("" ::: "memory");
    unsigned long long bun = 0ull;
#pragma unroll
    for (int w = 0; w < 8; ++w) bun |= ux[w];
    { const unsigned lo = __builtin_amdgcn_readfirstlane((unsigned)bun), hi = __builtin_amdgcn_readfirstlane((unsigned)(bun >> 32)); bun = ((unsigned long long)hi << 32) | lo; }
    const int n2 = nW + 2 * __popcll(bun);
    unsigned long long lmask = bun; int ljb = 0;
#define LOAD_STEP2() do { int ty_, k0_; \
        if (li < nW) { ty_ = 1; k0_ = (kt1b - li) * 32; } \
        else { ty_ = 2; if (li < n2) { if (((li - nW) & 1) == 0) { ljb = 63 - __builtin_clzll(lmask); lmask &= ~(1ull << ljb); k0_ = ljb * 64 + 32; } else k0_ = ljb * 64; } else k0_ = ljb * 64; } \
        ring_load(S, ty_, k0_, ring_a + (unsigned)(li & 7) * 8192u, wave, j, h, jr); ++li; } while (0)
    while (li < 7) LOAD_STEP2();
#pragma unroll
    for (int v = 0; v < 16; ++v) { ob[v * 64] = g0 * o[0][v]; ob[(16 + v) * 64] = g0 * o[1][v]; o[0][v] = 0.f; o[1][v] = 0.f; }
#pragma unroll
    for (int v = 0; v < 16; ++v) bc[v] = sl2 * (float)(8 * h + 16 * (v >> 3) + (v & 7) - ql);
    m = -1e30f; l = 0.f;
    int ci = 0;
#pragma unroll 1
    for (; ci < nW; ++ci) {
        RING_WAIT_BAR();
        LOAD_STEP2();
        const int kt = kt1b - ci, key0 = kt * 32; const LAS unsigned char* slot = ring + (ci & 7) * 8192;
        if (kt >= kt0 && kt <= kt1 && (mode & 2)) {
            ring_read_k(kc, slot, lane); ring_read_v(vf, slot, lane);
            f32x16 s = qk_mma(kc, qf, bc);
            const bool full = (key0 + 31 <= t0) && (key0 >= t0 + 7 - 511);
            const unsigned vm = run_mask(key0 + 8 * h, t - 511, t) | (run_mask(key0 + 16 + 8 * h, t - 511, t) << 8);
            softmax_step(s, full, vm, sl2 * (float)(key0 - t0), m, l, o);
            pv_mma(o, vf, s);
        }
    }
    {
        l += __shfl_xor(l, 32);
        const float sc = g2 / fmaxf(l, 1e-30f);
#pragma unroll
        for (int v = 0; v < 16; ++v) { ob[v * 64] += sc * o[0][v]; ob[(16 + v) * 64] += sc * o[1][v]; o[0][v] = 0.f; o[1][v] = 0.f; }
    }
    m = -1e30f; l = 0.f;
    {
        unsigned long long cmask = bun; int jb = 0;
#pragma unroll 1
        for (; ci < n2; ++ci) {
            RING_WAIT_BAR();
            LOAD_STEP2();
            int hf;
            if (((ci - nW) & 1) == 0) { jb = 63 - __builtin_clzll(cmask); cmask &= ~(1ull << jb); hf = 1; } else hf = 0;
            const int key0 = jb * 64 + hf * 32; const LAS unsigned char* slot = ring + (ci & 7) * 8192;
            if (((uni >> jb) & 1ull) && (mode & 1)) {
                ring_read_k(kc, slot, lane); ring_read_v(vf, slot, lane);
                f32x16 s = qk_mma(kc, qf, bc);
                const bool mine = (mq >> jb) & 1ull;
                const bool full = ((alln >> jb) & 1ull) && (key0 + 31 <= t0);
                const unsigned vm = mine ? (run_mask(key0 + 8 * h, 0, t) | (run_mask(key0 + 16 + 8 * h, 0, t) << 8)) : 0u;
                softmax_step(s, full, vm, sl2 * (float)(key0 - t0), m, l, o);
                pv_mma(o, vf, s);
            }
        }
    }
#undef LOAD_STEP2
    {
        l += __shfl_xor(l, 32);
        const float sc = g1 / fmaxf(l, 1e-30f);
#pragma unroll
        for (int v = 0; v < 16; ++v) { o[0][v] = ob[v * 64] + sc * o[0][v]; o[1][v] = ob[(16 + v) * 64] + sc * o[1][v]; }
    }
    bf16_t* op = A.O + row * D + head * 64 + 4 * h;
#pragma unroll
    for (int dt = 0; dt < 2; ++dt)
#pragma unroll
        for (int v4 = 0; v4 < 4; ++v4) { u32x2 w; w.x = cvt_pk_bf16(o[dt][4 * v4], o[dt][4 * v4 + 1]); w.y = cvt_pk_bf16(o[dt][4 * v4 + 2], o[dt][4 * v4 + 3]); *(u32x2*)(op + 32 * dt + 8 * v4) = w; }
}
__device__ __forceinline__ void attn_phase(const Ctx& X, const AttnArgs& A, const int mode = 3) {
    for (int i = 0;; ++i) {
        const int k = i * X.G + ((i & 1) ? X.G - 1 - X.bid : X.bid);
        if (i * X.G >= 2048) break;
        if (k < 2048) { const int qt = 63 - (k >> 5), bg = k & 31; attn_item(X, A, bg >> 2, bg & 3, qt, mode); }
    }
    RING_DRAIN_BAR();
}
__global__ void __launch_bounds__(512, 2) yoco_fwd(Params Pk) {
    extern __shared__ __attribute__((aligned(16))) unsigned char lds_raw[];
    cg::grid_group grid = cg::this_grid();
    { LAS Params* LP = (LAS Params*)((LAS unsigned char*)lds_raw); if (threadIdx.x == 0) {
#pragma unroll
        for (int i = 0; i < 19; ++i) LP->in[i] = Pk.in[i];
        LP->out = Pk.out; LP->ws = Pk.ws; LP->ph_lo = Pk.ph_lo; LP->ph_hi = Pk.ph_hi; } }
    __syncthreads();
    const int ph_lo = Pk.ph_lo, ph_hi = Pk.ph_hi;
    if (ph_lo == 0) {
        int tid_ = threadIdx.x, g_ = gridDim.x, b_ = blockIdx.x; asm volatile("" : "+v"(tid_), "+s"(g_), "+s"(b_));
        Ctx X; X.lds = (LAS unsigned char*)lds_raw + 256; X.tid = tid_; X.lane = X.tid & 63; X.wave = __builtin_amdgcn_readfirstlane(X.tid >> 6); X.G = g_; X.bid = b_;
#ifndef REP_P0
#define REP_P0 1
#endif
        for (int rep_ = 0; rep_ < REP_P0; ++rep_) { p0_phase(X, (const LAS Params*)(X.lds - 256)); __syncthreads(); }
        if (1 < ph_hi) grid.sync();
    }
    for (int ph = ph_lo < 1 ? 1 : ph_lo; ph < ph_hi; ++ph) {
        asm volatile("" ::: "memory");
        int tid_ = threadIdx.x, g_ = gridDim.x, b_ = blockIdx.x; asm volatile("" : "+v"(tid_), "+s"(g_), "+s"(b_));
        Ctx X; X.lds = (LAS unsigned char*)lds_raw + 256; X.tid = tid_; X.lane = X.tid & 63; X.wave = __builtin_amdgcn_readfirstlane(X.tid >> 6); X.G = g_; X.bid = b_;
        Params P;
        { const LAS Params* LP = (const LAS Params*)(X.lds - 256);
          P.in[I_X] = uptr(LP->in[I_X]); P.in[I_NORMG] = uptr(LP->in[I_NORMG]); P.in[I_ACONV] = uptr(LP->in[I_ACONV]); P.in[I_KVNG] = uptr(LP->in[I_KVNG]); P.in[I_CW2] = uptr(LP->in[I_CW2]);
          P.out = uptr(LP->out); P.ws = uptr(LP->ws); }
        unsigned char* ws = P.ws;
        bf16_t* const H = (bf16_t*)(ws + WS_H); bf16_t* const HID = (bf16_t*)(ws + WS_HID); bf16_t* const HID2 = (bf16_t*)(ws + WS_HID + 64 * MiB); bf16_t* const Y = (bf16_t*)(ws + WS_Y);
        float* const PART = (float*)(ws + WS_PART); float* const GATES = (float*)(ws + WS_GATES);
        const float* const MOD = (const float*)(ws + WS_MOD); const float* const KVMOD = (const float*)(ws + WS_KVMOD);
        const float* const NG = P.in[I_NORMG];
        if (ph == 1) {
            UpdArgs U{}; U.xin = P.in[I_X]; U.xout = P.out; U.bstride = 9216; U.gpre = NG; U.shift = MOD; U.scale = MOD + 1024; U.h = H;

#ifndef SKIP_UPD
update_phase(X, U);
#endif

        } else {
            int p = ph - 2, l, st;
            if (p < 20) { l = p / 10; st = p % 10; } else if (p < 23) { l = 2; st = 10 + (p - 20); } else { p -= 23; l = 2 + p / 10; st = p % 10; }
            const float* modl = MOD + (size_t)l * 8 * 9216; const float* ngl = NG + (size_t)l * 6 * 1024;
            if (st == 0 || st == 7) {
                const int s = st == 0 ? 0 : 1;
                pg8::Gemm g{H, (const bf16_t*)(ws + WS_FIN) + (size_t)(l * 2 + s) * 5632 * 1024, T, 5632, 1024, 1024}; pg8::StaticOrder S; S.init(T, 5632, X.G, X.bid);
                pg8::EpiSwiglu E{HID};

#ifndef REP_G1
#define REP_G1 1
#endif
for (int rep_ = 0; rep_ < REP_G1; ++rep_) pg8::gemm_phase<pg8::EpiSwiglu, pg8::StaticOrder, true, true>(X.lds, g, S, E, X.tid);

            } else if (st == 1 || st == 8 || st == 5) {
                pg8::Gemm g;
                if (st == 5) { g = pg8::Gemm{l < 2 ? H : HID2, l < 2 ? (const bf16_t*)(ws + WS_AOUT) + (size_t)l * 1024 * 1024 : (const bf16_t*)(ws + WS_BOUT) + (size_t)(l - 2) * 1024 * 1024, T, 1024, 1024, 1024}; }
                else { g = pg8::Gemm{HID, (const bf16_t*)(ws + WS_FOUT) + (size_t)(l * 2 + (st == 8 ? 1 : 0)) * 1024 * 2816, T, 1024, 2816, 2816}; }
                pg8::StaticOrder S; S.init(T, 1024, X.G, X.bid);
                pg8::EpiY E{Y, PART};

#ifndef SKIP_G2
pg8::gemm_phase<pg8::EpiY, pg8::StaticOrder, true, true>(X.lds, g, S, E, X.tid);
#endif

            } else if (st == 2 || st == 6 || st == 9) {
                const int sub = st == 2 ? 0 : (st == 6 ? 1 : 2);
                UpdArgs U{}; U.xin = P.out; U.xout = P.out; U.y = Y; U.part = PART; U.gate = modl + (sub * 3 + 2) * 1024; U.gpost = ngl + (sub * 2 + 1) * 1024; U.w = sub == 1 ? 1.0f : 0.5f; U.bstride = 9216;
                if (sub < 2) { U.gpre = ngl + ((sub + 1) * 2) * 1024; U.shift = modl + ((sub + 1) * 3) * 1024; U.scale = modl + ((sub + 1) * 3 + 1) * 1024; U.h = H; }
                else if (l < 3) { U.gpre = ngl + 6 * 1024; U.shift = modl + 8 * 9216; U.scale = modl + 8 * 9216 + 1024; U.h = H;
                    if (l == 1) { U.gpre2 = P.in[I_KVNG]; U.shift2 = KVMOD; U.scale2 = KVMOD + 1024; U.h2 = HID; } }

#ifndef SKIP_UPD
update_phase(X, U);
#endif

            } else if (st == 3) {
                if (l < 2) {
                    pg8::Gemm g{H, (const bf16_t*)(ws + WS_AIN) + (size_t)l * 3072 * 1024, T, 3072, 1024, 1024}; pg8::StaticOrder S; S.init(T, 3072, X.G, X.bid);
                    pg8::EpiConvIn E{HID, HID2};

#ifndef SKIP_G3
pg8::gemm_phase<pg8::EpiConvIn, pg8::StaticOrder, true, true>(X.lds, g, S, E, X.tid);
#endif

                } else {
                    pg8::Gemm g{H, (const bf16_t*)(ws + WS_BIN) + (size_t)(l - 2) * 1280 * 1024, T, 1280, 1024, 1024}; pg8::StaticOrder S; S.init(T, 1280, X.G, X.bid);
                    pg8::EpiQG E{HID, GATES};

#ifndef SKIP_G3B
pg8::gemm_phase<pg8::EpiQG, pg8::StaticOrder, true, true>(X.lds, g, S, E, X.tid);
#endif

                }
            } else if (st == 4) {
                if (l < 2) {
#ifndef SKIP_CONV
conv_phase(X, HID, HID2, P.in[I_ACONV] + (size_t)l * 3 * 1024, H);
#endif
}
                else { AttnArgs A{HID, GATES, (const bf16_t*)(ws + WS_KCMP), (const bf16_t*)(ws + WS_VCMPT), (const bf16_t*)(ws + WS_KS), (const bf16_t*)(ws + WS_VST), (const bf16_t*)(ws + WS_KW), (const bf16_t*)(ws + WS_VWT), HID2};

#ifndef REP_ATTN
#define REP_ATTN 1
#endif
attn_phase(X, A);
#ifdef PROBE_ATTN_MODE
{ AttnArgs A2 = A; A2.O = Y; attn_phase(X, A2, PROBE_ATTN_MODE); }
#endif
 }
            } else if (st == 10) {
                pg8::Gemm g{HID, (const bf16_t*)(ws + WS_KVW), T, 1536, 1024, 1024}; pg8::StaticOrder S; S.init(T, 1536, X.G, X.bid);
                pg8::EpiKV E{(bf16_t*)(ws + WS_KC), (bf16_t*)(ws + WS_KS), (bf16_t*)(ws + WS_KW), (bf16_t*)(ws + WS_VST), (bf16_t*)(ws + WS_VWT)};

#ifndef SKIP_GK
pg8::gemm_phase<pg8::EpiKV, pg8::StaticOrder, true, true>(X.lds, g, S, E, X.tid);
#endif

            } else if (st == 11) {
                pg8::Gemm g{(const bf16_t*)(ws + WS_KC), (const bf16_t*)(ws + WS_CW1), 16384, 512, 2048, 1024}; pg8::DiagOrder S{X.G, X.bid};
                pg8::EpiCmp1 E{(bf16_t*)(ws + WS_HIDC), (const float*)(ws + WS_CBIAS)};

#ifndef SKIP_CM1
pg8::gemm_phase<pg8::EpiCmp1, pg8::DiagOrder, true, true>(X.lds, g, S, E, X.tid);
#endif

            } else if (st == 12) {

#ifndef SKIP_CM2
cmp2_phase(X, (const bf16_t*)(ws + WS_HIDC), P.in[I_CW2], (bf16_t*)(ws + WS_KCMP), (bf16_t*)(ws + WS_VCMPT));
#endif

            }
        }
        if (ph + 1 < ph_hi) grid.sync();
    }
}

extern "C" void kernel_launch(void* const* d_in, const int* in_sizes, int n_in, void* d_out, int out_size, void* d_ws, size_t ws_size, hipStream_t stream) {
    static int grid = 0;
    if (grid == 0) {
        if (n_in != 19 || out_size != T * D || ws_size < WS_END) { fprintf(stderr, "kernel_launch: unexpected shapes (n_in %d, out %d, ws %zu < %zu)\n", n_in, out_size, ws_size, (size_t)WS_END); grid = -1; return; }
        int dev = 0, cus = 0, per_cu = 0;
        (void)hipGetDevice(&dev); (void)hipDeviceGetAttribute(&cus, hipDeviceAttributeMultiprocessorCount, dev);
        if (hipFuncSetAttribute((const void*)yoco_fwd, hipFuncAttributeMaxDynamicSharedMemorySize, LDS_BYTES) != hipSuccess) { fprintf(stderr, "kernel_launch: hipFuncSetAttribute failed\n"); grid = -1; return; }
        if (hipOccupancyMaxActiveBlocksPerMultiprocessor(&per_cu, (const void*)yoco_fwd, 512, LDS_BYTES) != hipSuccess || per_cu < 1) { fprintf(stderr, "kernel_launch: occupancy query says %d\n", per_cu); per_cu = 1; }
        (void)hipGetLastError();
        grid = cus * per_cu;
    }
    if (grid < 0) return;
    Params p{};
    for (int i = 0; i < 19; ++i) p.in[i] = (const float*)d_in[i];
    p.out = (float*)d_out; p.ws = (unsigned char*)d_ws;
#ifdef MULTI_LAUNCH
    for (int ph = 0; ph < NPH; ++ph) { p.ph_lo = ph; p.ph_hi = ph + 1; hipLaunchKernelGGL(yoco_fwd, dim3(grid), dim3(512), LDS_BYTES, stream, p); }
#else
    p.ph_lo = 0; p.ph_hi = NPH;
    void* args[] = {&p};
    hipError_t e = hipLaunchCooperativeKernel((const void*)yoco_fwd, dim3(grid), dim3(512), args, LDS_BYTES, stream);
    if (e != hipSuccess) fprintf(stderr, "kernel_launch: cooperative launch failed: %s (grid %d)\n", hipGetErrorString(e), grid);
#endif
}
```

```cpp
#include <hip/hip_runtime.h>
#include <hip/hip_cooperative_groups.h>
#include <cstdio>
#include <cstdint>
namespace cg = cooperative_groups;
namespace pg8 {
#define PG8_LAS __attribute__((address_space(3)))
typedef unsigned short bf16_t;
typedef short bf16x8 __attribute__((ext_vector_type(8)));
typedef float f32x4 __attribute__((ext_vector_type(4)));
typedef unsigned u32x4 __attribute__((ext_vector_type(4)));
constexpr int BM = 256, BK = 64, HALF = 128, HTB = HALF * BK * 2  , STAGE_BYTES = 8 * HTB, NXCD = 8, WGM = 8;

__host__ __device__ __forceinline__ int lds_byte(int r, int c) { const int st = (r >> 4) * 2 + (c >> 5), rr = r & 15, cc = c & 31, ob = rr * 64 + cc * 2; return st * 1024 + (ob ^ (((ob >> 9) & 1) << 5)); }
__host__ __device__ __forceinline__ void stage_rc(int b, int& R, int& C) { const int st = b / 1024, sb = b % 1024, swz = sb ^ (((sb >> 9) & 1) << 5); R = (st >> 1) * 16 + swz / 64; C = (st & 1) * 32 + (swz % 64) / 2; }
__host__ __device__ __forceinline__ int perm32(int rho) { const int n = rho >> 4, i = rho & 15; return 8 * (i >> 2) + 4 * n + (i & 3); }

struct Unit { int pm, pn; };
struct Gemm { const bf16_t* A; const bf16_t* Bt; int M, N, K, lda; };

struct StaticOrder {
    int nM, nN, nwg, G, c;
    __host__ __device__ void init(int M, int N, int G_, int c_) { nM = M / BM; nN = N / BM; nwg = nM * nN; G = G_; c = c_; }
    __host__ __device__ bool next(int i, Unit& u) const {
        const long L = (long)i * G + c; if (L >= nwg) return false;
        int wgid = (int)L; { const int q = nwg / NXCD, r = nwg % NXCD, xcd = wgid % NXCD, off = wgid / NXCD; wgid = (xcd < r ? xcd * (q + 1) : r * (q + 1) + (xcd - r) * q) + off; }
        const int nig = WGM * nN, gid = wgid / nig, fm = gid * WGM, gsz = (nM - fm) < WGM ? (nM - fm) : WGM;
        u.pm = fm + ((wgid % nig) % gsz); u.pn = (wgid % nig) / gsz; return true;
    }
    __device__ __forceinline__ void a_ready(const Unit&) const {}
    __device__ __forceinline__ void done(const Unit&) const {}
};

__device__ __forceinline__ unsigned cvt_pk_bf16(float lo, float hi) { unsigned r; asm volatile("v_cvt_pk_bf16_f32 %0, %1, %2" : "=v"(r) : "v"(lo), "v"(hi)); return r; }
typedef float f32x2 __attribute__((ext_vector_type(2)));
__device__ __forceinline__ f32x2 gelu_pk(f32x2 v) {
    const f32x2 av = __builtin_elementwise_abs(v), d = av * 0.2316418882f + 1.0f;
    f32x2 t; t.x = __builtin_amdgcn_rcpf(d.x); t.y = __builtin_amdgcn_rcpf(d.y);
    f32x2 q = t * 0.5307027145f + (-0.7265760135f); q = q * t + 0.7107068705f; q = q * t + (-0.142248368f); q = q * t + 0.127414796f; q = q * t;
    const f32x2 s = (v * v) * (-0.72134752044f);
    f32x2 e; e.x = __builtin_amdgcn_exp2f(s.x); e.y = __builtin_amdgcn_exp2f(s.y);
    const f32x2 m = v * (q * e), r = v - m;
    f32x2 o; o.x = v.x < 0.f ? m.x : r.x; o.y = v.y < 0.f ? m.y : r.y; return o;
}


template <class Epi, class Sched, bool ALIGN_EPI = false, bool SP2 = false>
__device__ __forceinline__ void gemm_phase(PG8_LAS unsigned char* lds, const Gemm g, const Sched& S, const Epi& E, const int tid) {
    const int wid = __builtin_amdgcn_readfirstlane(tid >> 6), lane = tid & 63, wr = wid >> 2, wc = wid & 3, fr = lane & 15, fq = lane >> 4;
    const int K = g.K, nt = K / BK;
    unsigned voffA[2], voffB[2];
#pragma unroll
    for (int i = 0; i < 2; ++i) { int R, C; stage_rc(tid * 16 + i * 8192, R, C); const int Rb = Epi::PERM ? ((R & ~31) + perm32(R & 31)) : R;
        voffA[i] = (unsigned)(R * g.lda + C) * 2u; voffB[i] = (unsigned)(Rb * K + C) * 2u; }
    const size_t kstep = (size_t)(BK * 2);
    const size_t hstepB = (size_t)HALF * K * 2, hstepA = (size_t)HALF * g.lda * 2;
    const size_t tstepB = 2 * hstepB, tstepA = 2 * hstepA;
    const unsigned ldsw = (unsigned)wid * 1024u;
    const int aoff = lds_byte(wr * 64 + fr, fq * 8), boff = lds_byte(wc * 32 + fr, fq * 8);
#define PG8_SA(b, h) (((b) * 2 + (h)) * HTB)
#define PG8_SB(b, h) ((4 + (b) * 2 + (h)) * HTB)
#define PG8_STAGE(bufoff, gbase, voff) do { _Pragma("unroll") for (int _i = 0; _i < 2; ++_i) \
        __builtin_amdgcn_global_load_lds((const unsigned*)((const char*)(gbase) + (voff)[_i]), (PG8_LAS unsigned*)(lds + (bufoff) + ldsw + _i * 8192), 16, 0, 0); } while (0)
#define PG8_LDA(dst, b, h) do { _Pragma("unroll") for (int m = 0; m < 4; ++m) _Pragma("unroll") for (int k = 0; k < 2; ++k) dst[m][k] = *(const PG8_LAS bf16x8*)(lds + PG8_SA(b, h) + aoff + m * 2048 + k * 1024); } while (0)
#define PG8_LDB(dst, b, h) do { _Pragma("unroll") for (int n = 0; n < 2; ++n) _Pragma("unroll") for (int k = 0; k < 2; ++k) dst[n][k] = *(const PG8_LAS bf16x8*)(lds + PG8_SB(b, h) + boff + n * 2048 + k * 1024); } while (0)
#define PG8_MMA(ai, bj, At, Bt) do { __builtin_amdgcn_s_setprio(1); _Pragma("unroll") for (int m = 0; m < 4; ++m) _Pragma("unroll") for (int n = 0; n < 2; ++n) _Pragma("unroll") for (int k = 0; k < 2; ++k) \
        acc[ai][bj][m][n] = __builtin_amdgcn_mfma_f32_16x16x32_bf16(Bt[n][k], At[m][k], acc[ai][bj][m][n], 0, 0, 0); __builtin_amdgcn_s_setprio(0); } while (0)
#define PG8_WAIT_V(n) asm volatile("s_waitcnt vmcnt(" #n ")" ::: "memory")
#define PG8_WAIT_L(n) asm volatile("s_waitcnt lgkmcnt(" #n ")" ::: "memory")
#define PG8_BAR __builtin_amdgcn_s_barrier()
#define PG8_SCHED __builtin_amdgcn_sched_barrier(0)
    Unit cur, nxt; int ui = 0;
    if (!S.next(0, cur)) return;
    f32x4 acc[2][2][4][2];
#pragma unroll
    for (int a = 0; a < 2; ++a)
#pragma unroll
        for (int b = 0; b < 2; ++b)
#pragma unroll
            for (int m = 0; m < 4; ++m)
#pragma unroll
                for (int n = 0; n < 2; ++n) acc[a][b][m][n] = (f32x4){0.f, 0.f, 0.f, 0.f};
    bf16x8 At[4][2], B0[2][2], B1[2][2];
    const char* cA = (const char*)g.A + (size_t)cur.pm * tstepA; const char* cB = (const char*)g.Bt + (size_t)cur.pn * tstepB;
    S.a_ready(cur);
    if constexpr (SP2) {
        PG8_STAGE(PG8_SB(0, 0), cB, voffB); PG8_STAGE(PG8_SB(0, 1), cB + hstepB, voffB); PG8_STAGE(PG8_SA(0, 0), cA, voffA); PG8_STAGE(PG8_SA(0, 1), cA + hstepA, voffA);
        if (wr == 1) PG8_BAR;
        PG8_WAIT_V(2); PG8_BAR;
        PG8_STAGE(PG8_SB(1, 0), cB + kstep, voffB); PG8_STAGE(PG8_SA(1, 0), cA + kstep, voffA); PG8_STAGE(PG8_SB(1, 1), cB + hstepB + kstep, voffB);
        PG8_WAIT_V(6); PG8_BAR;
    } else {
        PG8_STAGE(PG8_SB(0, 0), cB, voffB); PG8_STAGE(PG8_SA(0, 0), cA, voffA); PG8_STAGE(PG8_SB(0, 1), cB + hstepB, voffB); PG8_STAGE(PG8_SA(0, 1), cA + hstepA, voffA);
        if (wr == 1) PG8_BAR;
        PG8_WAIT_V(4); PG8_BAR;
        PG8_STAGE(PG8_SB(1, 0), cB + kstep, voffB); PG8_STAGE(PG8_SA(1, 0), cA + kstep, voffA); PG8_STAGE(PG8_SB(1, 1), cB + hstepB + kstep, voffB);
        PG8_WAIT_V(6); PG8_BAR;
    }
    for (;;) {
        const bool has_next = S.next(ui + 1, nxt);
        const char* nA = has_next ? (const char*)g.A + (size_t)nxt.pm * tstepA : cA; const char* nB = has_next ? (const char*)g.Bt + (size_t)nxt.pn * tstepB : cB;
        for (int t = 0; t < nt; t += 2) {
            const bool last = (t == nt - 2);
            const char* a1 = cA + (size_t)(t + 1) * kstep;
            const char* a2 = last ? nA : cA + (size_t)(t + 2) * kstep; const char* b2 = last ? nB : cB + (size_t)(t + 2) * kstep;
            const char* a3 = a2 + kstep; const char* b3 = b2 + kstep;
            if (last && has_next) S.a_ready(nxt);
            if constexpr (SP2) {
            PG8_LDB(B0, 0, 0); PG8_LDB(B1, 0, 1); PG8_SCHED; PG8_LDA(At, 0, 0); PG8_STAGE(PG8_SA(1, 1), a1 + hstepA, voffA);
            PG8_WAIT_V(8); PG8_WAIT_L(0); PG8_BAR; PG8_MMA(0, 0, At, B0); PG8_MMA(0, 1, At, B1); PG8_BAR; PG8_SCHED;
            PG8_LDA(At, 0, 1); PG8_STAGE(PG8_SB(0, 0), b2, voffB); PG8_STAGE(PG8_SB(0, 1), b2 + hstepB, voffB); PG8_STAGE(PG8_SA(0, 0), a2, voffA);
            PG8_WAIT_V(8); PG8_WAIT_L(0); PG8_BAR; PG8_MMA(1, 0, At, B0); PG8_MMA(1, 1, At, B1); PG8_BAR; PG8_SCHED;
            PG8_LDB(B0, 1, 0); PG8_LDB(B1, 1, 1); PG8_SCHED; PG8_LDA(At, 1, 0); PG8_STAGE(PG8_SA(0, 1), a2 + hstepA, voffA);
            PG8_WAIT_V(8); PG8_WAIT_L(0); PG8_BAR; PG8_MMA(0, 0, At, B0); PG8_MMA(0, 1, At, B1); PG8_BAR; PG8_SCHED;
            PG8_LDA(At, 1, 1); PG8_STAGE(PG8_SB(1, 0), b3, voffB); PG8_STAGE(PG8_SB(1, 1), b3 + hstepB, voffB); PG8_STAGE(PG8_SA(1, 0), a3, voffA);
            PG8_WAIT_V(8); PG8_WAIT_L(0); PG8_BAR; PG8_MMA(1, 0, At, B0); PG8_MMA(1, 1, At, B1); PG8_BAR; PG8_SCHED;
            } else {
            PG8_LDB(B0, 0, 0); PG8_SCHED; PG8_LDA(At, 0, 0); PG8_STAGE(PG8_SA(1, 1), a1 + hstepA, voffA);
            PG8_WAIT_L(8); PG8_BAR; PG8_WAIT_L(0); PG8_MMA(0, 0, At, B0); PG8_BAR; PG8_SCHED;
            PG8_LDB(B1, 0, 1); PG8_STAGE(PG8_SB(0, 0), b2, voffB);
            PG8_BAR; PG8_WAIT_L(0); PG8_MMA(0, 1, At, B1); PG8_BAR;
            PG8_LDA(At, 0, 1); PG8_STAGE(PG8_SA(0, 0), a2, voffA);
            PG8_BAR; PG8_WAIT_L(0); PG8_MMA(1, 0, At, B0); PG8_BAR; PG8_SCHED;
            PG8_STAGE(PG8_SB(0, 1), b2 + hstepB, voffB);
            PG8_WAIT_V(6); PG8_BAR; PG8_MMA(1, 1, At, B1); PG8_BAR;
            PG8_LDB(B0, 1, 0); PG8_SCHED; PG8_LDA(At, 1, 0); PG8_STAGE(PG8_SA(0, 1), a2 + hstepA, voffA);
            PG8_WAIT_L(8); PG8_BAR; PG8_WAIT_L(0); PG8_MMA(0, 0, At, B0); PG8_BAR; PG8_SCHED;
            PG8_LDB(B1, 1, 1); PG8_STAGE(PG8_SB(1, 0), b3, voffB);
            PG8_BAR; PG8_WAIT_L(0); PG8_MMA(0, 1, At, B1); PG8_BAR;
            PG8_LDA(At, 1, 1); PG8_STAGE(PG8_SA(1, 0), a3, voffA);
            PG8_BAR; PG8_WAIT_L(0); PG8_MMA(1, 0, At, B0); PG8_BAR; PG8_SCHED;
            PG8_STAGE(PG8_SB(1, 1), b3 + hstepB, voffB);
            PG8_WAIT_V(6); PG8_BAR; PG8_MMA(1, 1, At, B1); PG8_BAR;
            }
        }
        if constexpr (ALIGN_EPI) { if (wr == 0) PG8_BAR; }
        if constexpr (!Epi::AFTER_DRAIN) { E(acc, cur, wr, wc, fr, fq); S.done(cur); }
        if (!has_next) break;
#pragma unroll
        for (int a = 0; a < 2; ++a)
#pragma unroll
            for (int b = 0; b < 2; ++b)
#pragma unroll
                for (int m = 0; m < 4; ++m)
#pragma unroll
                    for (int n = 0; n < 2; ++n) acc[a][b][m][n] = (f32x4){0.f, 0.f, 0.f, 0.f};
        cur = nxt; cA = nA; cB = nB; ++ui;
        if constexpr (ALIGN_EPI) { if (wr == 1) PG8_BAR; }
    }
    PG8_WAIT_V(0);
    if constexpr (!ALIGN_EPI) { if (wr == 0) PG8_BAR; }
    PG8_BAR;
    if constexpr (Epi::AFTER_DRAIN) { E.fused(acc, cur, wr, wc, fr, fq, lds, wid, lane); S.done(cur); }
#undef PG8_SA
#undef PG8_SB
#undef PG8_STAGE
#undef PG8_LDA
#undef PG8_LDB
#undef PG8_MMA
#undef PG8_WAIT_V
#undef PG8_WAIT_L
#undef PG8_BAR
#undef PG8_SCHED
}
}
#define LAS __attribute__((address_space(3)))
using pg8::bf16_t; using pg8::bf16x8; using pg8::f32x4; using pg8::u32x4; using pg8::cvt_pk_bf16;
typedef float f32x16 __attribute__((ext_vector_type(16)));
typedef unsigned u32x2 __attribute__((ext_vector_type(2)));
typedef float f32x2 __attribute__((ext_vector_type(2)));

constexpr int T = 32768, D = 1024, FF = 2816, SEQ = 4096, NBATCH = 8;
constexpr int NPH = 45;
constexpr float EPS = 1e-6f, LOG2E = 1.4426950408889634f;
constexpr size_t MiB = 1u << 20;
constexpr size_t WS_FIN = 0;
constexpr size_t WS_FOUT = WS_FIN + 88 * MiB;
constexpr size_t WS_AIN = WS_FOUT + 44 * MiB;
constexpr size_t WS_AOUT = WS_AIN + 12 * MiB;
constexpr size_t WS_KVW = WS_AOUT + 4 * MiB;
constexpr size_t WS_CW1 = WS_KVW + 3 * MiB;
constexpr size_t WS_BIN = WS_CW1 + 2 * MiB;
constexpr size_t WS_BOUT = WS_BIN + 5 * MiB;
constexpr size_t WS_MOD = WS_BOUT + 4 * MiB;
constexpr size_t WS_KVMOD = WS_MOD + 4ull * 8 * 9216 * 4;
constexpr size_t WS_CBIAS = WS_KVMOD + 8ull * 2048 * 4;
constexpr size_t WS_H = WS_MOD + 2 * MiB;
constexpr size_t WS_HID = WS_H + 64 * MiB;
constexpr size_t WS_Y = WS_HID + 176 * MiB;
constexpr size_t WS_PART = WS_Y + 64 * MiB;
constexpr size_t WS_GATES = WS_PART + 2 * MiB;
constexpr size_t WS_KC = WS_GATES + 6 * MiB;
constexpr size_t WS_KS = WS_KC + 33 * MiB;
constexpr size_t WS_KW = WS_KS + 16 * MiB;
constexpr size_t WS_VST = WS_KW + 16 * MiB;
constexpr size_t WS_VWT = WS_VST + 16 * MiB;
constexpr size_t WS_HIDC = WS_VWT + 16 * MiB;
constexpr size_t WS_KCMP = WS_HIDC + 8 * MiB;
constexpr size_t WS_VCMPT = WS_KCMP + 1 * MiB;
constexpr size_t WS_BAR = WS_VCMPT + 1 * MiB;
constexpr size_t WS_END = WS_BAR + 1 * MiB;
constexpr int LDS_BYTES = 135168;

struct Params { const float* in[19]; float* out; unsigned char* ws; int ph_lo, ph_hi; };
enum { I_X = 0, I_C, I_ADAW, I_ADAB, I_NORMG, I_FIN, I_FOUT, I_AIN, I_ACONV, I_AOUT, I_KVNG, I_KVADAW, I_KVADAB, I_KVW, I_CPOS, I_CW1, I_CW2, I_BIN, I_BOUT };

__device__ __forceinline__ float bf2f(unsigned short b) { return __uint_as_float((unsigned)b << 16); }
__device__ __forceinline__ float fexp2(float x) { return __builtin_amdgcn_exp2f(x); }
__device__ __forceinline__ float frcp(float x) { return __builtin_amdgcn_rcpf(x); }
__device__ __forceinline__ float silu_f(float g) { return g * frcp(1.f + fexp2(-g * LOG2E)); }
__device__ __forceinline__ float wave_sum(float v) {
#pragma unroll
    for (int o = 1; o < 64; o <<= 1) v += __shfl_xor(v, o);
    return v;
}
template <class Tp> __device__ __forceinline__ Tp* uptr(Tp* p) { const unsigned long long v = (unsigned long long)p; const unsigned lo = __builtin_amdgcn_readfirstlane((unsigned)v), hi = __builtin_amdgcn_readfirstlane((unsigned)(v >> 32)); typedef __attribute__((address_space(1))) Tp* gptr_t; gptr_t gp = (gptr_t)(((unsigned long long)hi << 32) | lo); return (Tp*)gp; }
#define LDS_WAIT() asm volatile("s_waitcnt lgkmcnt(0)" ::: "memory")

namespace pg8 {
__device__ __forceinline__ u32x4 pack8(const f32x4 a, const f32x4 b) { u32x4 w; w.x = cvt_pk_bf16(a[0], a[1]); w.y = cvt_pk_bf16(a[2], a[3]); w.z = cvt_pk_bf16(b[0], b[1]); w.w = cvt_pk_bf16(b[2], b[3]); return w; }
struct EpiSwiglu {
    static constexpr bool PERM = true, AFTER_DRAIN = false;
    bf16_t* O;
    __device__ __forceinline__ void operator()(const f32x4 (&acc)[2][2][4][2], const Unit& u, int wr, int wc, int fr, int fq) const {
        const int row0 = u.pm * BM + wr * 64 + fr, col0 = u.pn * 128 + wc * 32 + 8 * fq;
#pragma unroll
        for (int ai = 0; ai < 2; ++ai)
#pragma unroll
            for (int m = 0; m < 4; ++m) {
                f32x4 h0, h1;
#pragma unroll
                for (int e = 0; e < 4; ++e) { h0[e] = silu_f(acc[ai][0][m][0][e]) * acc[ai][1][m][0][e]; h1[e] = silu_f(acc[ai][0][m][1][e]) * acc[ai][1][m][1][e]; }
                *(u32x4*)(O + (size_t)(row0 + ai * HALF + m * 16) * FF + col0) = pack8(h0, h1);
            }
    }
};
struct EpiY {
    static constexpr bool PERM = true, AFTER_DRAIN = false;
    bf16_t* Y; float* part;
    __device__ __forceinline__ void operator()(const f32x4 (&acc)[2][2][4][2], const Unit& u, int wr, int wc, int fr, int fq) const {
        const int row0 = u.pm * BM + wr * 64 + fr, col0 = u.pn * BM + wc * 32 + 8 * fq;
#pragma unroll
        for (int ai = 0; ai < 2; ++ai)
#pragma unroll
            for (int m = 0; m < 4; ++m) {
                const int row = row0 + ai * HALF + m * 16; float ss = 0.f;
#pragma unroll
                for (int bj = 0; bj < 2; ++bj) {
                    const f32x4 a = acc[ai][bj][m][0], b = acc[ai][bj][m][1];
                    ss += (a[0] * a[0] + a[1] * a[1]) + (a[2] * a[2] + a[3] * a[3]) + (b[0] * b[0] + b[1] * b[1]) + (b[2] * b[2] + b[3] * b[3]);
                    *(u32x4*)(Y + (size_t)row * D + col0 + bj * HALF) = pack8(a, b);
                }
                ss += __shfl_xor(ss, 16); ss += __shfl_xor(ss, 32);
                if (fq == 0) part[(size_t)row * 16 + u.pn * 4 + wc] = ss;
            }
    }
};
struct EpiConvIn {
    static constexpr bool PERM = true, AFTER_DRAIN = false;
    bf16_t* V; bf16_t* Bg;
    __device__ __forceinline__ void operator()(const f32x4 (&acc)[2][2][4][2], const Unit& u, int wr, int wc, int fr, int fq) const {
        const int row0 = u.pm * BM + wr * 64 + fr;
        if (u.pn < 8) {
            const int col0 = u.pn * 128 + wc * 32 + 8 * fq;
#pragma unroll
            for (int ai = 0; ai < 2; ++ai)
#pragma unroll
                for (int m = 0; m < 4; ++m)
                    *(u32x4*)(V + (size_t)(row0 + ai * HALF + m * 16) * D + col0) = pack8(acc[ai][0][m][0] * acc[ai][1][m][0], acc[ai][0][m][1] * acc[ai][1][m][1]);
        } else {
            const int col0 = (u.pn - 8) * BM + wc * 32 + 8 * fq;
#pragma unroll
            for (int ai = 0; ai < 2; ++ai)
#pragma unroll
                for (int m = 0; m < 4; ++m)
#pragma unroll
                    for (int bj = 0; bj < 2; ++bj)
                        *(u32x4*)(Bg + (size_t)(row0 + ai * HALF + m * 16) * D + col0 + bj * HALF) = pack8(acc[ai][bj][m][0], acc[ai][bj][m][1]);
        }
    }
};
struct EpiQG {
    static constexpr bool PERM = true, AFTER_DRAIN = false;
    bf16_t* Q; float* G;
    __device__ __forceinline__ void operator()(const f32x4 (&acc)[2][2][4][2], const Unit& u, int wr, int wc, int fr, int fq) const {
        const int row0 = u.pm * BM + wr * 64 + fr;
        if (u.pn < 4) {
            const int col0 = u.pn * BM + wc * 32 + 8 * fq; const float sc = 0.125f * LOG2E;
#pragma unroll
            for (int ai = 0; ai < 2; ++ai)
#pragma unroll
                for (int m = 0; m < 4; ++m)
#pragma unroll
                    for (int bj = 0; bj < 2; ++bj)
                        *(u32x4*)(Q + (size_t)(row0 + ai * HALF + m * 16) * D + col0 + bj * HALF) = pack8(acc[ai][bj][m][0] * sc, acc[ai][bj][m][1] * sc);
        } else {
            const int col0 = wc * 32 + 8 * fq;
            if (col0 < 48) {
#pragma unroll
                for (int ai = 0; ai < 2; ++ai)
#pragma unroll
                    for (int m = 0; m < 4; ++m) {
                        float* gp = G + (size_t)(row0 + ai * HALF + m * 16) * 48 + col0;
#pragma unroll
                        for (int n = 0; n < 2; ++n) { f32x4 s;
#pragma unroll
                            for (int e = 0; e < 4; ++e) s[e] = frcp(1.f + fexp2(-acc[ai][0][m][n][e] * LOG2E));
                            *(f32x4*)(gp + 4 * n) = s; }
                    }
            }
        }
    }
};
struct EpiKV {
    static constexpr bool PERM = true, AFTER_DRAIN = false;
    bf16_t *KC, *KS, *KW, *VSt, *VWt;
    __device__ __forceinline__ void operator()(const f32x4 (&acc)[2][2][4][2], const Unit& u, int wr, int wc, int fr, int fq) const {
        const int br = u.pn >> 1, kv = u.pn & 1;
        const int row0 = u.pm * BM + wr * 64 + fr, b = row0 >> 12;
        const int d0 = (wc & 1) * 32 + 8 * fq;
        if (br == 0 || kv == 0) {
            bf16_t* base = br == 0 ? KC + (size_t)kv * 32 * 4096 * 64 : (br == 1 ? KS : KW);
#pragma unroll
            for (int ai = 0; ai < 2; ++ai)
#pragma unroll
                for (int m = 0; m < 4; ++m)
#pragma unroll
                    for (int bj = 0; bj < 2; ++bj) {
                        const int s = (row0 + ai * HALF + m * 16) & 4095, g = 2 * bj + (wc >> 1);
                        *(u32x4*)(base + ((size_t)(b * 4 + g) * 4096 + s) * 64 + d0) = pack8(acc[ai][bj][m][0], acc[ai][bj][m][1]);
                    }
        } else {
            bf16_t* base = br == 1 ? VSt : VWt;
#pragma unroll
            for (int ai = 0; ai < 2; ++ai)
#pragma unroll
                for (int m = 0; m < 4; ++m)
#pragma unroll
                    for (int bj = 0; bj < 2; ++bj) {
                        const int s = (row0 + ai * HALF + m * 16) & 4095, g = 2 * bj + (wc >> 1);
                        bf16_t* p = base + ((size_t)(b * 4 + g) * 64 + d0) * 4096 + s;
                        const u32x4 w = pack8(acc[ai][bj][m][0], acc[ai][bj][m][1]);
                        p[0 * 4096] = (bf16_t)(w.x & 0xffffu); p[1 * 4096] = (bf16_t)(w.x >> 16); p[2 * 4096] = (bf16_t)(w.y & 0xffffu); p[3 * 4096] = (bf16_t)(w.y >> 16);
                        p[4 * 4096] = (bf16_t)(w.z & 0xffffu); p[5 * 4096] = (bf16_t)(w.z >> 16); p[6 * 4096] = (bf16_t)(w.w & 0xffffu); p[7 * 4096] = (bf16_t)(w.w >> 16);
                    }
        }
    }
};
struct EpiCmp1 {
    static constexpr bool PERM = true, AFTER_DRAIN = false;
    bf16_t* O; const float* cbias;
    __device__ __forceinline__ void operator()(const f32x4 (&acc)[2][2][4][2], const Unit& u, int wr, int wc, int fr, int fq) const {
        const int row0 = u.pm * BM + wr * 64 + fr, col0 = wc * 32 + 8 * fq;
#pragma unroll
        for (int bj = 0; bj < 2; ++bj) {
            const f32x4 b0 = *(const f32x4*)(cbias + u.pn * 256 + col0 + bj * HALF), b1 = *(const f32x4*)(cbias + u.pn * 256 + col0 + bj * HALF + 4);
#pragma unroll
            for (int ai = 0; ai < 2; ++ai)
#pragma unroll
                for (int m = 0; m < 4; ++m) {
                    f32x4 x0 = acc[ai][bj][m][0] + b0, x1 = acc[ai][bj][m][1] + b1;
#pragma unroll
                    for (int e = 0; e < 4; ++e) {
                        { const float x = x0[e], z = 1.5957691216f * (x + 0.044715f * x * x * x); x0[e] = x * frcp(1.f + fexp2(-z * LOG2E)); }
                        { const float x = x1[e], z = 1.5957691216f * (x + 0.044715f * x * x * x); x1[e] = x * frcp(1.f + fexp2(-z * LOG2E)); }
                    }
                    *(u32x4*)(O + (size_t)(row0 + ai * HALF + m * 16) * 256 + col0 + bj * HALF) = pack8(x0, x1);
                }
        }
    }
};
struct DiagOrder {
    int G, c;
    __device__ bool next(int i, Unit& u) const { const int L = i * G + c; if (L >= 64) return false; u.pm = L; u.pn = L >> 5; return true; }
    __device__ __forceinline__ void a_ready(const Unit&) const {}
    __device__ __forceinline__ void done(const Unit&) const {}
};
}
struct Ctx { LAS unsigned char* lds; int tid, lane, wave, G, bid; };

__device__ __forceinline__ void conv_item(const float* W, int ldw, int ncv, int src_col0, int K, bf16_t* WT, int dst_row0, int kb, LAS float* scr, int lane) {
    const int k0 = 64 * kb, col = src_col0 + (lane & 31); const bool ok = col < ncv;
#pragma unroll 8
    for (int i = 0; i < 32; ++i) { const int kk = 2 * i + (lane >> 5); scr[kk * 33 + (lane & 31)] = ok ? W[(size_t)(k0 + kk) * ldw + col] : 0.f; }
    LDS_WAIT(); asm volatile("" ::: "memory");
    const int c = lane & 7;
#pragma unroll
    for (int j = 0; j < 4; ++j) { const int n = (lane >> 3) + 8 * j; const LAS float* s = scr + (8 * c) * 33 + n;
        u32x4 o; o.x = cvt_pk_bf16(s[0 * 33], s[1 * 33]); o.y = cvt_pk_bf16(s[2 * 33], s[3 * 33]); o.z = cvt_pk_bf16(s[4 * 33], s[5 * 33]); o.w = cvt_pk_bf16(s[6 * 33], s[7 * 33]);
        *(u32x4*)(WT + (size_t)(dst_row0 + n) * K + k0 + 8 * c) = o; }
    LDS_WAIT(); asm volatile("" ::: "memory");
}
#define PIN(k) uptr(LP->in[k])
__device__ __forceinline__ void p0_phase(const Ctx& X, const LAS Params* LP) {
    unsigned char* ws = uptr(LP->ws);
    LAS float* sc = (LAS float*)X.lds;
    LAS float* red = (LAS float*)(X.lds + 32768);
    for (int i = X.tid; i < 8192; i += 512) { const int b = i >> 10, k = i & 1023; sc[k * 8 + b] = silu_f(PIN(I_C)[i]); }
    __syncthreads();
    for (int it = X.bid; it < 608; it += X.G) {
        const float* W; const float* bias; float* out; int N, cb;
        if (it < 576) { const int l = it / 144; cb = it % 144; N = 9216; W = PIN(I_ADAW) + (size_t)l * 1024 * 9216; bias = PIN(I_ADAB) + l * 9216; out = (float*)(ws + WS_MOD) + (size_t)l * 8 * 9216; }
        else { cb = it - 576; N = 2048; W = PIN(I_KVADAW); bias = PIN(I_KVADAB); out = (float*)(ws + WS_KVMOD); }
        float a[8];
#pragma unroll
        for (int b = 0; b < 8; ++b) a[b] = 0.f;
        const float* wp = W + (size_t)(128 * X.wave) * N + 64 * cb + X.lane;
#pragma unroll 4
        for (int k = 0; k < 128; ++k) { const float w = wp[(size_t)k * N]; const f32x4 s0 = *(const LAS f32x4*)(sc + (128 * X.wave + k) * 8), s1 = *(const LAS f32x4*)(sc + (128 * X.wave + k) * 8 + 4);
            a[0] += s0[0] * w; a[1] += s0[1] * w; a[2] += s0[2] * w; a[3] += s0[3] * w; a[4] += s1[0] * w; a[5] += s1[1] * w; a[6] += s1[2] * w; a[7] += s1[3] * w; }
#pragma unroll
        for (int b = 0; b < 8; ++b) red[(X.wave * 8 + b) * 64 + X.lane] = a[b];
        __syncthreads();
        { const int b = X.tid >> 6, col = X.tid & 63; float s = bias[64 * cb + col];
#pragma unroll
          for (int w = 0; w < 8; ++w) s += red[(w * 8 + b) * 64 + col];
          out[(size_t)b * N + 64 * cb + col] = s; }
        __syncthreads();
    }
    for (int kv = 0; kv < 2; ++kv) if (X.bid == X.G - 1 - kv) {
        const int col = X.tid & 255, half = X.tid >> 8; const float* pos = PIN(I_CPOS) + kv * 2048 + half * 1024; const float* w1 = PIN(I_CW1) + ((size_t)kv * 2048 + half * 1024) * 256 + col;
        float s = 0.f;
        for (int f = 0; f < 1024; ++f) s += pos[f] * w1[(size_t)f * 256];
        red[X.tid] = s; __syncthreads();
        if (X.tid < 256) ((float*)(ws + WS_CBIAS))[kv * 256 + X.tid] = red[X.tid] + red[X.tid + 256];
        __syncthreads();
    }
    __syncthreads();
    LAS float* scr = (LAS float*)(X.lds + X.wave * 8448);
    const int gw = X.bid * 8 + X.wave, NGW = X.G * 8;
    for (int it = gw; it < 41472; it += NGW) {
        int r = it;
        if (r < 22528) { const int id = r / 2816, q = r % 2816, nb = q >> 4, kb = q & 15, pn = nb >> 3, jb = nb & 7;
            conv_item(PIN(I_FIN) + (size_t)id * 1024 * 5632, 5632, 5632, (jb >> 2) * 2816 + 128 * pn + 32 * (jb & 3), 1024, (bf16_t*)(ws + WS_FIN) + (size_t)id * 5632 * 1024, 32 * nb, kb, scr, X.lane); continue; } r -= 22528;
        if (r < 11264) { const int id = r / 1408, q = r % 1408, nb = q / 44, kb = q % 44;
            conv_item(PIN(I_FOUT) + (size_t)id * 2816 * 1024, 1024, 1024, 32 * nb, 2816, (bf16_t*)(ws + WS_FOUT) + (size_t)id * 1024 * 2816, 32 * nb, kb, scr, X.lane); continue; } r -= 11264;
        if (r < 3072) { const int id = r / 1536, q = r % 1536, nb = q >> 4, kb = q & 15, pn = nb >> 3, jb = nb & 7;
            const int src = pn < 8 ? ((jb >> 2) ? 2048 : 1024) + 128 * pn + 32 * (jb & 3) : 256 * (pn - 8) + 32 * jb;
            conv_item(PIN(I_AIN) + (size_t)id * 1024 * 3072, 3072, 3072, src, 1024, (bf16_t*)(ws + WS_AIN) + (size_t)id * 3072 * 1024, 32 * nb, kb, scr, X.lane); continue; } r -= 3072;
        if (r < 1024) { const int id = r / 512, q = r % 512, nb = q >> 4, kb = q & 15;
            conv_item(PIN(I_AOUT) + (size_t)id * 1024 * 1024, 1024, 1024, 32 * nb, 1024, (bf16_t*)(ws + WS_AOUT) + (size_t)id * 1024 * 1024, 32 * nb, kb, scr, X.lane); continue; } r -= 1024;
        if (r < 768) { const int nb = r >> 4, kb = r & 15;
            conv_item(PIN(I_KVW), 1536, 1536, 32 * nb, 1024, (bf16_t*)(ws + WS_KVW), 32 * nb, kb, scr, X.lane); continue; } r -= 768;
        if (r < 512) { const int id = r / 256, q = r % 256, nb = q >> 5, kb = q & 31;
            conv_item(PIN(I_CW1) + (size_t)id * 2048 * 256, 256, 256, 32 * nb, 2048, (bf16_t*)(ws + WS_CW1) + (size_t)id * 256 * 2048, 32 * nb, kb, scr, X.lane); continue; } r -= 512;
        if (r < 1280) { const int id = r / 640, q = r % 640, nb = q >> 4, kb = q & 15;
            conv_item(PIN(I_BIN) + (size_t)id * 1024 * 1072, 1072, 1072, 32 * nb, 1024, (bf16_t*)(ws + WS_BIN) + (size_t)id * 1280 * 1024, 32 * nb, kb, scr, X.lane); continue; } r -= 1280;
        { const int id = r / 512, q = r % 512, nb = q >> 4, kb = q & 15;
            conv_item(PIN(I_BOUT) + (size_t)id * 1024 * 1024, 1024, 1024, 32 * nb, 1024, (bf16_t*)(ws + WS_BOUT) + (size_t)id * 1024 * 1024, 32 * nb, kb, scr, X.lane); }
    }
}

struct UpdArgs { const float* xin; float* xout; const bf16_t* y; const float* part; const float* gate; const float* gpost; float w; int bstride;
                 const float* gpre; const float* shift; const float* scale; bf16_t* h; const float* gpre2; const float* shift2; const float* scale2; bf16_t* h2; };
__device__ __forceinline__ void update_phase(const Ctx& X, const UpdArgs& A) {
    const int gw = X.bid * 8 + X.wave, NGW = X.G * 8, c0 = 4 * X.lane;
    for (int row = gw; row < T; row += NGW) {
        const int b = row >> 12;
        f32x4 xv[4];
#pragma unroll
        for (int j = 0; j < 4; ++j) xv[j] = *(const f32x4*)(A.xin + (size_t)row * D + c0 + 256 * j);
        if (A.y) {
            const f32x4* pp = (const f32x4*)(A.part + (size_t)row * 16); const f32x4 p0 = pp[0], p1 = pp[1], p2 = pp[2], p3 = pp[3];
            const float ssq = ((p0[0] + p0[1]) + (p0[2] + p0[3])) + ((p1[0] + p1[1]) + (p1[2] + p1[3])) + ((p2[0] + p2[1]) + (p2[2] + p2[3])) + ((p3[0] + p3[1]) + (p3[2] + p3[3]));
            const float rs = A.w * __builtin_amdgcn_rsqf(ssq * (1.f / D) + EPS);
#pragma unroll
            for (int j = 0; j < 4; ++j) { const int c = c0 + 256 * j; const u32x2 yy = *(const u32x2*)(A.y + (size_t)row * D + c);
                const f32x4 gt = *(const f32x4*)(A.gate + (size_t)b * A.bstride + c), gp = *(const f32x4*)(A.gpost + c);
                const f32x4 yv = {__uint_as_float(yy.x << 16), __uint_as_float(yy.x & 0xffff0000u), __uint_as_float(yy.y << 16), __uint_as_float(yy.y & 0xffff0000u)};
                xv[j] = xv[j] + gt * gp * yv * rs; }
        }
        if (A.xout) {
#pragma unroll
            for (int j = 0; j < 4; ++j) *(f32x4*)(A.xout + (size_t)row * D + c0 + 256 * j) = xv[j];
        }
        if (A.h) {
            float s = 0.f;
#pragma unroll
            for (int j = 0; j < 4; ++j) s += (xv[j][0] * xv[j][0] + xv[j][1] * xv[j][1]) + (xv[j][2] * xv[j][2] + xv[j][3] * xv[j][3]);
            const float r = __builtin_amdgcn_rsqf(wave_sum(s) * (1.f / D) + EPS);
#pragma unroll
            for (int j = 0; j < 4; ++j) { const int c = c0 + 256 * j;
                const f32x4 g = *(const f32x4*)(A.gpre + c), sh = *(const f32x4*)(A.shift + (size_t)b * A.bstride + c), scl = *(const f32x4*)(A.scale + (size_t)b * A.bstride + c);
                const f32x4 hv = xv[j] * r * g * (scl + 1.f) + sh; u32x2 o; o.x = cvt_pk_bf16(hv[0], hv[1]); o.y = cvt_pk_bf16(hv[2], hv[3]);
                *(u32x2*)(A.h + (size_t)row * D + c) = o; }
            if (A.h2) {
#pragma unroll
                for (int j = 0; j < 4; ++j) { const int c = c0 + 256 * j;
                    const f32x4 g = *(const f32x4*)(A.gpre2 + c), sh = *(const f32x4*)(A.shift2 + (size_t)b * 2048 + c), scl = *(const f32x4*)(A.scale2 + (size_t)b * 2048 + c);
                    const f32x4 hv = xv[j] * r * g * (scl + 1.f) + sh; u32x2 o; o.x = cvt_pk_bf16(hv[0], hv[1]); o.y = cvt_pk_bf16(hv[2], hv[3]);
                    *(u32x2*)(A.h2 + (size_t)row * D + c) = o; }
            }
        }
    }
}

__device__ __forceinline__ void unpack8(const u32x4 w, float (&f)[8]) {
    f[0] = __uint_as_float(w.x << 16); f[1] = __uint_as_float(w.x & 0xffff0000u); f[2] = __uint_as_float(w.y << 16); f[3] = __uint_as_float(w.y & 0xffff0000u);
    f[4] = __uint_as_float(w.z << 16); f[5] = __uint_as_float(w.z & 0xffff0000u); f[6] = __uint_as_float(w.w << 16); f[7] = __uint_as_float(w.w & 0xffff0000u);
}
__device__ __forceinline__ void conv_phase(const Ctx& X, const bf16_t* V, const bf16_t* Bg, const float* cw, bf16_t* Z) {
    const int gt = X.bid * 512 + X.tid, NT = X.G * 512;
    for (int i = gt; i < T * 128; i += NT) {
        const int row = i >> 7, c = (i & 127) * 8, s = row & 4095;
        const u32x4 z0 = {0u, 0u, 0u, 0u};
        const u32x4 v2 = *(const u32x4*)(V + (size_t)row * D + c), v1 = s >= 1 ? *(const u32x4*)(V + (size_t)(row - 1) * D + c) : z0, v0 = s >= 2 ? *(const u32x4*)(V + (size_t)(row - 2) * D + c) : z0;
        const u32x4 bb = *(const u32x4*)(Bg + (size_t)row * D + c);
        float a0[8], a1[8], a2[8], bf[8], o[8]; unpack8(v0, a0); unpack8(v1, a1); unpack8(v2, a2); unpack8(bb, bf);
#pragma unroll
        for (int e = 0; e < 8; ++e) o[e] = bf[e] * (cw[c + e] * a0[e] + cw[D + c + e] * a1[e] + cw[2 * D + c + e] * a2[e]);
        u32x4 w; w.x = cvt_pk_bf16(o[0], o[1]); w.y = cvt_pk_bf16(o[2], o[3]); w.z = cvt_pk_bf16(o[4], o[5]); w.w = cvt_pk_bf16(o[6], o[7]);
        *(u32x4*)(Z + (size_t)row * D + c) = w;
    }
}

__device__ __forceinline__ void cmp2_phase(const Ctx& X, const bf16_t* hidc, const float* w2, bf16_t* kcmp, bf16_t* vcmpT) {
    const int gt = X.bid * 512 + X.tid, NT = X.G * 512;
    for (int i = gt; i < 16384 * 16; i += NT) {
        const int row = i >> 4, c = (i & 15) * 4, kv = row >> 13, rr = row & 8191;
        const float* w = w2 + (size_t)kv * 256 * 64 + c; const bf16_t* hp = hidc + (size_t)row * 256;
        f32x4 a = {0.f, 0.f, 0.f, 0.f};
        for (int k = 0; k < 256; k += 8) { float hf[8]; unpack8(*(const u32x4*)(hp + k), hf);
#pragma unroll
            for (int e = 0; e < 8; ++e) a += *(const f32x4*)(w + (size_t)(k + e) * 64) * hf[e]; }
        if (kv == 0) { u32x2 o; o.x = cvt_pk_bf16(a[0], a[1]); o.y = cvt_pk_bf16(a[2], a[3]); *(u32x2*)(kcmp + (size_t)rr * 64 + c) = o; }
        else { const int bg = rr >> 8, n = rr & 255; bf16_t* p = vcmpT + ((size_t)bg * 64 + c) * 256 + n; const unsigned w0 = cvt_pk_bf16(a[0], a[1]), w1 = cvt_pk_bf16(a[2], a[3]);
            p[0] = (bf16_t)(w0 & 0xffffu); p[256] = (bf16_t)(w0 >> 16); p[512] = (bf16_t)(w1 & 0xffffu); p[768] = (bf16_t)(w1 >> 16); }
    }
}
struct AttnArgs { const bf16_t* Q; const float* gates; const bf16_t *kcmp, *vcmpT, *KS, *VSt, *KW, *VWt; bf16_t* O; };

__device__ __forceinline__ void load_k(bf16x8 (&kf)[4], const bf16_t* Kb, int key0, int jr, int h) {
    const bf16x8* p = (const bf16x8*)(Kb + (size_t)(key0 + jr) * 64 + h * 8);
#pragma unroll
    for (int ks = 0; ks < 4; ++ks) kf[ks] = p[2 * ks];
}
__device__ __forceinline__ void load_v(bf16x8 (&vf)[4], const bf16_t* Vt, int ldv, int key0, int j, int h) {
#pragma unroll
    for (int s = 0; s < 2; ++s)
#pragma unroll
        for (int dt = 0; dt < 2; ++dt) vf[s * 2 + dt] = *(const bf16x8*)(Vt + (size_t)(dt * 32 + j) * ldv + key0 + 16 * s + 8 * h);
}
__device__ __forceinline__ f32x16 qk_mma(const bf16x8 (&kf)[4], const bf16x8 (&qf)[4], const f32x16& bc) {
    f32x16 acc = __builtin_amdgcn_mfma_f32_32x32x16_bf16(kf[0], qf[0], bc, 0, 0, 0);
#pragma unroll
    for (int ks = 1; ks < 4; ++ks) acc = __builtin_amdgcn_mfma_f32_32x32x16_bf16(kf[ks], qf[ks], acc, 0, 0, 0);
    return acc;
}
__device__ __forceinline__ void pv_mma(f32x16 (&o)[2], const bf16x8 (&vf)[4], const f32x16& p) {
#pragma unroll
    for (int s = 0; s < 2; ++s) {
        u32x4 w; w.x = cvt_pk_bf16(p[8 * s + 0], p[8 * s + 1]); w.y = cvt_pk_bf16(p[8 * s + 2], p[8 * s + 3]); w.z = cvt_pk_bf16(p[8 * s + 4], p[8 * s + 5]); w.w = cvt_pk_bf16(p[8 * s + 6], p[8 * s + 7]);
        const bf16x8 pb = __builtin_bit_cast(bf16x8, w);
#pragma unroll
        for (int dt = 0; dt < 2; ++dt) o[dt] = __builtin_amdgcn_mfma_f32_32x32x16_bf16(vf[s * 2 + dt], pb, o[dt], 0, 0, 0);
    }
}
__device__ __forceinline__ void pf_block(const bf16_t* Kb, const bf16_t* Vt, int ldv, int key0, int lane, LAS unsigned* junk) {
    __builtin_amdgcn_global_load_lds((const unsigned*)(Kb + (size_t)(key0 + lane) * 64), junk, 4, 0, 0);
    __builtin_amdgcn_global_load_lds((const unsigned*)(Vt + (size_t)lane * ldv + key0), junk, 4, 0, 0);
}
__device__ __forceinline__ unsigned run_mask(int kstart, int lo, int hi) {
    const int a = max(lo - kstart, 0), b = min(hi - kstart, 7);
    return a <= b ? ((1u << (b + 1)) - 1u) & ~((1u << a) - 1u) : 0u;
}
__device__ __forceinline__ float max16(const f32x16& s) {
    float a = fmaxf(fmaxf(s[0], s[1]), s[2]), b = fmaxf(fmaxf(s[3], s[4]), s[5]), c = fmaxf(fmaxf(s[6], s[7]), s[8]), d = fmaxf(fmaxf(s[9], s[10]), s[11]), e = fmaxf(fmaxf(s[12], s[13]), s[14]);
    return fmaxf(fmaxf(fmaxf(a, b), fmaxf(c, d)), fmaxf(e, s[15]));
}
__device__ __forceinline__ void softmax_step(f32x16& s, bool full, unsigned vm, float off, float& m, float& l, f32x16 (&o)[2]) {
    if (!full) {
#pragma unroll
        for (int v = 0; v < 16; ++v) s[v] = ((vm >> v) & 1u) ? s[v] : -1e30f;
    }
    float tm = max16(s);
    tm = fmaxf(tm, __shfl_xor(tm, 32)) + off;
    const float mn = fmaxf(m, tm);
    if (__any(mn > m)) { const float al = fexp2(m - mn); l *= al; o[0] = o[0] * al; o[1] = o[1] * al; }
    m = mn; const float ml = mn - off;
    float ps = 0.f;
    if (full) {
#pragma unroll
        for (int v = 0; v < 16; ++v) { const float p = fexp2(s[v] - ml); s[v] = p; ps += p; }
    } else {
#pragma unroll
        for (int v = 0; v < 16; ++v) { const float p = ((vm >> v) & 1u) ? fexp2(s[v] - ml) : 0.f; s[v] = p; ps += p; }
    }
    l += ps;
}

__device__ __forceinline__ void glds16(const void* gsrc, unsigned lds_dst) { unsigned keep;
    asm volatile("s_mov_b32 %0, m0\n\ts_mov_b32 m0, %2\n\ts_nop 0\n\tglobal_load_lds_dwordx4 %1, off\n\ts_mov_b32 m0, %0" : "=&s"(keep) : "v"(gsrc), "s"(lds_dst) : "memory"); }
struct AttnSrc { const bf16_t *Kc, *Vc, *Kw, *Vw, *Ks, *Vs; };
__device__ __forceinline__ void ring_load(const AttnSrc& S, int type, int key0, unsigned slot_addr, int wave, int j, int h, int jr) {
    const bf16_t* src;
    if (wave < 4) { const bf16_t* kb = type == 0 ? S.Kc : (type == 1 ? S.Kw : S.Ks); src = kb + (size_t)(key0 + jr) * 64 + 16 * wave + 8 * h; }
    else { const int idx = wave - 4, s = idx >> 1, dt = idx & 1; const bf16_t* vb = type == 0 ? S.Vc : (type == 1 ? S.Vw : S.Vs); const int ldv = type == 0 ? 256 : 4096;
           src = vb + (size_t)(dt * 32 + j) * ldv + key0 + 16 * s + 8 * h; }
    glds16(src, slot_addr + (unsigned)wave * 1024u);
}
#define RING_WAIT_BAR() do { asm volatile("s_waitcnt vmcnt(6)" ::: "memory"); __builtin_amdgcn_s_barrier(); asm volatile("" ::: "memory"); } while (0)
#define RING_DRAIN_BAR() do { asm volatile("s_waitcnt vmcnt(0) lgkmcnt(0)" ::: "memory"); __builtin_amdgcn_s_barrier(); asm volatile("" ::: "memory"); } while (0)
__device__ __forceinline__ void ring_read_k(bf16x8 (&kf)[4], const LAS unsigned char* slot, int lane) {
#pragma unroll
    for (int ks = 0; ks < 4; ++ks) kf[ks] = *(const LAS bf16x8*)(slot + ks * 1024 + lane * 16);
}
__device__ __forceinline__ void ring_read_v(bf16x8 (&vf)[4], const LAS unsigned char* slot, int lane) {
#pragma unroll
    for (int i = 0; i < 4; ++i) vf[i] = *(const LAS bf16x8*)(slot + 4096 + i * 1024 + lane * 16);
}

__device__ __forceinline__ void attn_item(const Ctx& X, const AttnArgs& A, int b, int g, int qt, const int mode = 3) {
    int lane_ = X.lane; asm volatile("" : "+v"(lane_));
    const int lane = lane_, h = lane >> 5, j = lane & 31, ql = j >> 2, r = j & 3, wave = X.wave;
    const int tb = qt * 64, t0 = tb + wave * 8, t = t0 + ql, head = g * 4 + r, bg = b * 4 + g, cur = qt;
    const size_t row = (size_t)b * SEQ + t;
    RING_DRAIN_BAR();
    bf16x8 qf[4];
#pragma unroll
    for (int ks = 0; ks < 4; ++ks) qf[ks] = *(const bf16x8*)(A.Q + row * D + head * 64 + ks * 16 + h * 8);
    const float sl2 = fexp2(-0.5f * (float)(head + 1)) * LOG2E;
    const int jr = (j & ~12) | ((j & 4) << 1) | ((j & 8) >> 1);
    const float g0 = A.gates[row * 48 + head], g1 = A.gates[row * 48 + 16 + head], g2 = A.gates[row * 48 + 32 + head];
    f32x16 o[2], bc;
#pragma unroll
    for (int v = 0; v < 16; ++v) { o[0][v] = 0.f; o[1][v] = 0.f; }
    LAS float* cm = (LAS float*)(X.lds + wave * 8192);
    LAS float* ob = cm + lane;
    const LAS unsigned char* ring = X.lds + 65536;
    const unsigned ring_a = (unsigned)(unsigned long long)ring;
    LAS unsigned long long* ux = (LAS unsigned long long*)(X.lds + 131072);
    AttnSrc S; S.Kc = A.kcmp + (size_t)bg * 256 * 64; S.Vc = A.vcmpT + (size_t)bg * 64 * 256; S.Kw = A.KW + (size_t)bg * 4096 * 64; S.Vw = A.VWt + (size_t)bg * 64 * 4096;
    S.Ks = A.KS + (size_t)bg * 4096 * 64; S.Vs = A.VSt + (size_t)bg * 64 * 4096;
    float m, l;
    bf16x8 kc[4], vf[4];

    const int ntb = (((tb + 63 - 31) >> 4) >> 5) + 1;
    const int nmax_w = (t0 + 7 - 31) >> 4, nmax_t = (t - 31) >> 4, nmin_w = (t0 - 31) >> 4;
    const int ntile = nmax_w >= 0 ? (nmax_w >> 5) + 1 : 0;
#pragma unroll
    for (int v = 0; v < 16; ++v) bc[v] = 16.f * sl2 * (float)(8 * h + 16 * (v >> 3) + (v & 7)) + sl2 * (float)(31 - ql);
    m = -1e30f; l = 0.f;
    {
        const int n1 = 2 * ntb;
#define CMP_TILE(i) ((i) < ntb ? ntb - 1 - (i) : 2 * ntb - 1 - min((i), n1 - 1))
        for (int i = 0; i < 7; ++i) ring_load(S, 0, CMP_TILE(i) * 32, ring_a + (unsigned)(i & 7) * 8192u, wave, j, h, jr);
        float inv = 0.f;
#pragma unroll 1
        for (int i = 0; i < n1; ++i) {
            RING_WAIT_BAR();
            ring_load(S, 0, CMP_TILE(i + 7) * 32, ring_a + (unsigned)((i + 7) & 7) * 8192u, wave, j, h, jr);
            const int tile = CMP_TILE(i); const LAS unsigned char* slot = ring + (i & 7) * 8192;
            if (i == ntb) { l += __shfl_xor(l, 32); inv = 1.f / fmaxf(l, 1e-30f); }
            if (tile < ntile) {
                ring_read_k(kc, slot, lane);
                const unsigned vm = run_mask(tile * 32 + 8 * h, 0, nmax_t) | (run_mask(tile * 32 + 16 + 8 * h, 0, nmax_t) << 8);
                const float off = sl2 * (float)(512 * tile - t0);
                if (i < ntb) {
                    f32x16 s = qk_mma(kc, qf, bc);
                    softmax_step(s, tile * 32 + 31 <= nmin_w, vm, off, m, l, o);
                } else {
                    ring_read_v(vf, slot, lane);
                    f32x16 s = qk_mma(kc, qf, bc);
                    const float ml = m - off;
#pragma unroll
                    for (int v = 0; v < 16; ++v) {
                        const float p = ((vm >> v) & 1u) ? fexp2(s[v] - ml) * inv : 0.f; s[v] = p;
                        float x = p; x += __shfl_xor(x, 1); x += __shfl_xor(x, 2);
                        if ((v & 3) == r) cm[ql * 256 + tile * 32 + 16 * (v >> 3) + 8 * h + (v & 7)] = x;
                    }
                    pv_mma(o, vf, s);
                }
            }
        }
#undef CMP_TILE
    }
    RING_DRAIN_BAR();
    const int kt1b = (tb + 63) >> 5, kt0b = max(tb - 511, 0) >> 5, nW = kt1b - kt0b + 1;
    const int kt0 = max(t0 - 511, 0) >> 5, kt1 = (t0 + 7) >> 5;
    int li = 0;
    for (; li < 7 && li < nW; ++li) ring_load(S, 1, (kt1b - li) * 32, ring_a + (unsigned)(li & 7) * 8192u, wave, j, h, jr);
    unsigned long long mq = 0ull, uni = 0ull, alln = ~0ull;
    {
        const unsigned long long causal = cur >= 63 ? ~0ull : ((1ull << (cur + 1)) - 1ull);
        if (cur + 1 <= 16) { mq = causal; uni = causal; alln = causal; }
        else {
#pragma unroll 1
            for (int q = 0; q < 8; ++q) {
                float iv;
                if (lane == 0 || lane == cur || lane == cur - 1) iv = 1e30f;
                else if (lane > cur) iv = -1.f;
                else { const LAS float* c = cm + q * 256 + 4 * lane; iv = (((c[-1] + c[0]) + c[1]) + c[2]) + c[3]; }
                const int ib = __float_as_int(iv);
                int Tb = 0; unsigned long long ge = causal;
#pragma unroll 1
                for (int bit = 30; bit >= 0; --bit) {
                    const int cand = Tb | (1 << bit); const unsigned long long bm = __ballot(ib >= cand); const int c = __popcll(bm);
                    if (c >= 16) { Tb = cand; ge = bm; if (c == 16) break; }
                }
                unsigned long long mk = ge;
                if (__popcll(ge) > 16) {
                    const unsigned long long gt = __ballot(ib > Tb); unsigned long long eq = ge & ~gt; int need = 16 - __popcll(gt); mk = gt;
                    for (; need > 0; --need) { const unsigned long long low = eq & (0ull - eq); mk |= low; eq ^= low; }
                }
                mk &= causal;
                uni |= mk; alln &= mk; if (ql == q) mq = mk;
            }
        }
    }
    if (lane == 0) ux[wave] = uni;
    asm volatile("s_waitcnt lgkmcnt(0)" ::: "memory"); __builtin_amdgcn_s_barrier(); asm volatile("" ::: "memory");
    unsigned long long bun = 0ull;
#pragma unroll
    for (int w = 0; w < 8; ++w) bun |= ux[w];
    { const unsigned lo = __builtin_amdgcn_readfirstlane((unsigned)bun), hi = __builtin_amdgcn_readfirstlane((unsigned)(bun >> 32)); bun = ((unsigned long long)hi << 32) | lo; }
    const int n2 = nW + 2 * __popcll(bun);
    unsigned long long lmask = bun; int ljb = 0;
#define LOAD_STEP2() do { int ty_, k0_; \
        if (li < nW) { ty_ = 1; k0_ = (kt1b - li) * 32; } \
        else { ty_ = 2; if (li < n2) { if (((li - nW) & 1) == 0) { ljb = 63 - __builtin_clzll(lmask); lmask &= ~(1ull << ljb); k0_ = ljb * 64 + 32; } else k0_ = ljb * 64; } else k0_ = ljb * 64; } \
        ring_load(S, ty_, k0_, ring_a + (unsigned)(li & 7) * 8192u, wave, j, h, jr); ++li; } while (0)
    while (li < 7) LOAD_STEP2();
#pragma unroll
    for (int v = 0; v < 16; ++v) { ob[v * 64] = g0 * o[0][v]; ob[(16 + v) * 64] = g0 * o[1][v]; o[0][v] = 0.f; o[1][v] = 0.f; }
#pragma unroll
    for (int v = 0; v < 16; ++v) bc[v] = sl2 * (float)(8 * h + 16 * (v >> 3) + (v & 7) - ql);
    m = -1e30f; l = 0.f;
    int ci = 0;
#pragma unroll 1
    for (; ci < nW; ++ci) {
        RING_WAIT_BAR();
        LOAD_STEP2();
        const int kt = kt1b - ci, key0 = kt * 32; const LAS unsigned char* slot = ring + (ci & 7) * 8192;
        if (kt >= kt0 && kt <= kt1 && (mode & 2)) {
            ring_read_k(kc, slot, lane); ring_read_v(vf, slot, lane);
            f32x16 s = qk_mma(kc, qf, bc);
            const bool full = (key0 + 31 <= t0) && (key0 >= t0 + 7 - 511);
            const unsigned vm = run_mask(key0 + 8 * h, t - 511, t) | (run_mask(key0 + 16 + 8 * h, t - 511, t) << 8);
            softmax_step(s, full, vm, sl2 * (float)(key0 - t0), m, l, o);
            pv_mma(o, vf, s);
        }
    }
    {
        l += __shfl_xor(l, 32);
        const float sc = g2 / fmaxf(l, 1e-30f);
#pragma unroll
        for (int v = 0; v < 16; ++v) { ob[v * 64] += sc * o[0][v]; ob[(16 + v) * 64] += sc * o[1][v]; o[0][v] = 0.f; o[1][v] = 0.f; }
    }
    m = -1e30f; l = 0.f;
    {
        unsigned long long cmask = bun; int jb = 0;
#pragma unroll 1
        for (; ci < n2; ++ci) {
            RING_WAIT_BAR();
            LOAD_STEP2();
            int hf;
            if (((ci - nW) & 1) == 0) { jb = 63 - __builtin_clzll(cmask); cmask &= ~(1ull << jb); hf = 1; } else hf = 0;
            const int key0 = jb * 64 + hf * 32; const LAS unsigned char* slot = ring + (ci & 7) * 8192;
            if (((uni >> jb) & 1ull) && (mode & 1)) {
                ring_read_k(kc, slot, lane); ring_read_v(vf, slot, lane);
                f32x16 s = qk_mma(kc, qf, bc);
                const bool mine = (mq >> jb) & 1ull;
                const bool full = ((alln >> jb) & 1ull) && (key0 + 31 <= t0);
                const unsigned vm = mine ? (run_mask(key0 + 8 * h, 0, t) | (run_mask(key0 + 16 + 8 * h, 0, t) << 8)) : 0u;
                softmax_step(s, full, vm, sl2 * (float)(key0 - t0), m, l, o);
                pv_mma(o, vf, s);
            }
        }
    }
#undef LOAD_STEP2
    {
        l += __shfl_xor(l, 32);
        const float sc = g1 / fmaxf(l, 1e-30f);
#pragma unroll
        for (int v = 0; v < 16; ++v) { o[0][v] = ob[v * 64] + sc * o[0][v]; o[1][v] = ob[(16 + v) * 64] + sc * o[1][v]; }
    }
    bf16_t* op = A.O + row * D + head * 64 + 4 * h;
#pragma unroll
    for (int dt = 0; dt < 2; ++dt)
#pragma unroll
        for (int v4 = 0; v4 < 4; ++v4) { u32x2 w; w.x = cvt_pk_bf16(o[dt][4 * v4], o[dt][4 * v4 + 1]); w.y = cvt_pk_bf16(o[dt][4 * v4 + 2], o[dt][4 * v4 + 3]); *(u32x2*)(op + 32 * dt + 8 * v4) = w; }
}
__device__ __forceinline__ void attn_phase(const Ctx& X, const AttnArgs& A, const int mode = 3) {
    for (int i = 0;; ++i) {
        const int k = i * X.G + ((i & 1) ? X.G - 1 - X.bid : X.bid);
        if (i * X.G >= 2048) break;
        if (k < 2048) { const int qt = 63 - (k >> 5), bg = k & 31; attn_item(X, A, bg >> 2, bg & 3, qt, mode); }
    }
    RING_DRAIN_BAR();
}
#define XB_TMO      128
#define XB_XCNT(j)  (256  + 64 * (j))
#define XB_XSUB(j)  (1280 + 64 * (j))
#define XB_XGEN(j)  (2304 + 64 * (j))
#define XB_TOP      3328
#define XB_TOPGEN   3392
#define XCD_BAR_WORDS 3456
#define XB_SPIN_CAP (1u << 18)

__device__ __forceinline__ unsigned xb_ld(unsigned* p)              { return __hip_atomic_load(p, __ATOMIC_RELAXED, __HIP_MEMORY_SCOPE_AGENT); }
__device__ __forceinline__ unsigned xb_add(unsigned* p, unsigned v) { return __hip_atomic_fetch_add(p, v, __ATOMIC_RELAXED, __HIP_MEMORY_SCOPE_AGENT); }
__device__ __forceinline__ unsigned xb_xcc_id() { return (unsigned)__builtin_amdgcn_s_getreg((3 << 11) | 20) & 0xFu; }
#define XB_SPIN(cond, bar) do { unsigned _sp = 0; while (cond) { __builtin_amdgcn_s_sleep(1); \
    if ((++_sp & 255u) == 0u) { if (xb_ld(&(bar)[XB_TMO])) break; if (_sp > XB_SPIN_CAP) { atomicAdd(&(bar)[XB_TMO], 1u); break; } } } } while (0)

struct XcdBarrier {
    unsigned* bar; unsigned x;
    volatile LAS unsigned* st;
};

__device__ __forceinline__ XcdBarrier xcd_barrier_post(unsigned* bar, volatile LAS unsigned* st) {
    XcdBarrier b; b.bar = bar; b.x = xb_xcc_id(); b.st = st;
    if (threadIdx.x == 0) (void)xb_add(&bar[XB_XCNT(b.x)], 1u);
    return b;
}
__device__ __forceinline__ void xcd_barrier_complete(unsigned* bar, unsigned x, unsigned& nloc, unsigned& nx) {
    const unsigned G = gridDim.x * gridDim.y * gridDim.z;
    unsigned sum, cnt, mine, sp = 0u;
    for (;;) {
        sum = 0u; cnt = 0u; mine = 0u;
#pragma unroll
        for (unsigned j = 0; j < 16; ++j) { const unsigned c = xb_ld(&bar[XB_XCNT(j)]); sum += c; cnt += (c > 0u) ? 1u : 0u; mine = (j == x) ? c : mine; }
        if (sum == G) break;
        __builtin_amdgcn_s_sleep(1);
        if ((++sp & 255u) == 0u) { if (xb_ld(&bar[XB_TMO])) break; if (sp > XB_SPIN_CAP) { atomicAdd(&bar[XB_TMO], 1u); break; } }
    }
    nloc = mine > 0u ? mine : 1u; nx = cnt > 0u ? cnt : 1u;
}

__device__ __forceinline__ void xcd_barrier(const XcdBarrier& b) {
    asm volatile("s_waitcnt vmcnt(0)" ::: "memory");
    __syncthreads();
    if (threadIdx.x == 0) {
        unsigned* bar = b.bar;
        __builtin_amdgcn_s_waitcnt(0);
        unsigned nloc = b.st[0], nx = b.st[1];
        if (nloc == 0u) { xcd_barrier_complete(bar, b.x, nloc, nx); b.st[0] = nloc; b.st[1] = nx; }
        const unsigned old = xb_add(&bar[XB_XSUB(b.x)], 1u);
        const unsigned gen = old / nloc;
        if (old + 1u == (gen + 1u) * nloc) {
            __builtin_amdgcn_fence(__ATOMIC_RELEASE, "agent");
            asm volatile("s_waitcnt vmcnt(0)" ::: "memory");
            const unsigned og = xb_add(&bar[XB_TOP], 1u);
            const unsigned tg = og / nx;
            if (og + 1u == (tg + 1u) * nx) xb_add(&bar[XB_TOPGEN], 1u);
            else XB_SPIN(xb_ld(&bar[XB_TOPGEN]) == tg, bar);
            __builtin_amdgcn_fence(__ATOMIC_ACQUIRE, "agent");
            xb_add(&bar[XB_XGEN(b.x)], 1u);
            asm volatile("s_waitcnt vmcnt(0)" ::: "memory");
        } else {
            XB_SPIN(xb_ld(&bar[XB_XGEN(b.x)]) == gen, bar);
            __builtin_amdgcn_fence(__ATOMIC_ACQUIRE, "agent");
            asm volatile("s_waitcnt vmcnt(0)" ::: "memory");
        }
    }
    __syncthreads();
}

__global__ void __launch_bounds__(512, 2) yoco_fwd(Params Pk) {
    extern __shared__ __attribute__((aligned(16))) unsigned char lds_raw[];
    cg::grid_group grid = cg::this_grid();
    { LAS Params* LP = (LAS Params*)((LAS unsigned char*)lds_raw); if (threadIdx.x == 0) {
#pragma unroll
        for (int i = 0; i < 19; ++i) LP->in[i] = Pk.in[i];
        LP->out = Pk.out; LP->ws = Pk.ws; LP->ph_lo = Pk.ph_lo; LP->ph_hi = Pk.ph_hi; } }
    volatile LAS unsigned* xb_st = (volatile LAS unsigned*)((LAS unsigned char*)lds_raw + 192);
    if (threadIdx.x == 0) { xb_st[0] = 0u; xb_st[1] = 0u; }
    unsigned* const xb_words = (unsigned*)(Pk.ws + WS_BAR);
    if (blockIdx.x == 0) { for (int i = threadIdx.x; i < XCD_BAR_WORDS; i += 512) __hip_atomic_store(xb_words + i, 0u, __ATOMIC_RELAXED, __HIP_MEMORY_SCOPE_AGENT); }
    __syncthreads();
    const int ph_lo = Pk.ph_lo, ph_hi = Pk.ph_hi;
    if (ph_lo == 0) {
        int tid_ = threadIdx.x, g_ = gridDim.x, b_ = blockIdx.x; asm volatile("" : "+v"(tid_), "+s"(g_), "+s"(b_));
        Ctx X; X.lds = (LAS unsigned char*)lds_raw + 256; X.tid = tid_; X.lane = X.tid & 63; X.wave = __builtin_amdgcn_readfirstlane(X.tid >> 6); X.G = g_; X.bid = b_;
#ifndef REP_P0
#define REP_P0 1
#endif
        for (int rep_ = 0; rep_ < REP_P0; ++rep_) { p0_phase(X, (const LAS Params*)(X.lds - 256)); __syncthreads(); }
        grid.sync();
    }
    (void)xcd_barrier_post(xb_words, xb_st);
    int dupflag_ = 0; (void)dupflag_;
    for (int ph = ph_lo < 1 ? 1 : ph_lo; ph < ph_hi; ++ph) {
        int cur_st_ = -1; (void)cur_st_;
        asm volatile("" ::: "memory");
        int tid_ = threadIdx.x, g_ = gridDim.x, b_ = blockIdx.x; asm volatile("" : "+v"(tid_), "+s"(g_), "+s"(b_));
        Ctx X; X.lds = (LAS unsigned char*)lds_raw + 256; X.tid = tid_; X.lane = X.tid & 63; X.wave = __builtin_amdgcn_readfirstlane(X.tid >> 6); X.G = g_; X.bid = b_;
        Params P;
        { const LAS Params* LP = (const LAS Params*)(X.lds - 256);
          P.in[I_X] = uptr(LP->in[I_X]); P.in[I_NORMG] = uptr(LP->in[I_NORMG]); P.in[I_ACONV] = uptr(LP->in[I_ACONV]); P.in[I_KVNG] = uptr(LP->in[I_KVNG]); P.in[I_CW2] = uptr(LP->in[I_CW2]);
          P.out = uptr(LP->out); P.ws = uptr(LP->ws); }
        unsigned char* ws = P.ws;
        bf16_t* const H = (bf16_t*)(ws + WS_H); bf16_t* const HID = (bf16_t*)(ws + WS_HID); bf16_t* const HID2 = (bf16_t*)(ws + WS_HID + 64 * MiB); bf16_t* const Y = (bf16_t*)(ws + WS_Y);
        float* const PART = (float*)(ws + WS_PART); float* const GATES = (float*)(ws + WS_GATES);
        const float* const MOD = (const float*)(ws + WS_MOD); const float* const KVMOD = (const float*)(ws + WS_KVMOD);
        const float* const NG = P.in[I_NORMG];
        if (ph == 1) {
            UpdArgs U{}; U.xin = P.in[I_X]; U.xout = P.out; U.bstride = 9216; U.gpre = NG; U.shift = MOD; U.scale = MOD + 1024; U.h = H;

#ifndef SKIP_UPD
update_phase(X, U);
#endif

        } else {
            int p = ph - 2, l, st;
            if (p < 20) { l = p / 10; st = p % 10; } else if (p < 23) { l = 2; st = 10 + (p - 20); } else { p -= 23; l = 2 + p / 10; st = p % 10; }
            cur_st_ = st;
            const float* modl = MOD + (size_t)l * 8 * 9216; const float* ngl = NG + (size_t)l * 6 * 1024;
            if (st == 0 || st == 7) {
                const int s = st == 0 ? 0 : 1;
                pg8::Gemm g{H, (const bf16_t*)(ws + WS_FIN) + (size_t)(l * 2 + s) * 5632 * 1024, T, 5632, 1024, 1024}; pg8::StaticOrder S; S.init(T, 5632, X.G, X.bid);
                pg8::EpiSwiglu E{HID};

#ifndef REP_G1
#define REP_G1 1
#endif
for (int rep_ = 0; rep_ < REP_G1; ++rep_) pg8::gemm_phase<pg8::EpiSwiglu, pg8::StaticOrder, true, true>(X.lds, g, S, E, X.tid);

            } else if (st == 1 || st == 8 || st == 5) {
                pg8::Gemm g;
                if (st == 5) { g = pg8::Gemm{l < 2 ? H : HID2, l < 2 ? (const bf16_t*)(ws + WS_AOUT) + (size_t)l * 1024 * 1024 : (const bf16_t*)(ws + WS_BOUT) + (size_t)(l - 2) * 1024 * 1024, T, 1024, 1024, 1024}; }
                else { g = pg8::Gemm{HID, (const bf16_t*)(ws + WS_FOUT) + (size_t)(l * 2 + (st == 8 ? 1 : 0)) * 1024 * 2816, T, 1024, 2816, 2816}; }
                pg8::StaticOrder S; S.init(T, 1024, X.G, X.bid);
                pg8::EpiY E{Y, PART};

pg8::gemm_phase<pg8::EpiY, pg8::StaticOrder, true, true>(X.lds, g, S, E, X.tid);

            } else if (st == 2 || st == 6 || st == 9) {
                const int sub = st == 2 ? 0 : (st == 6 ? 1 : 2);
                UpdArgs U{}; U.xin = P.out; U.xout = P.out; U.y = Y; U.part = PART; U.gate = modl + (sub * 3 + 2) * 1024; U.gpost = ngl + (sub * 2 + 1) * 1024; U.w = sub == 1 ? 1.0f : 0.5f; U.bstride = 9216;
                if (sub < 2) { U.gpre = ngl + ((sub + 1) * 2) * 1024; U.shift = modl + ((sub + 1) * 3) * 1024; U.scale = modl + ((sub + 1) * 3 + 1) * 1024; U.h = H; }
                else if (l < 3) { U.gpre = ngl + 6 * 1024; U.shift = modl + 8 * 9216; U.scale = modl + 8 * 9216 + 1024; U.h = H;
                    if (l == 1) { U.gpre2 = P.in[I_KVNG]; U.shift2 = KVMOD; U.scale2 = KVMOD + 1024; U.h2 = HID; } }

#ifndef SKIP_UPD
update_phase(X, U);
#endif

            } else if (st == 3) {
                if (l < 2) {
                    pg8::Gemm g{H, (const bf16_t*)(ws + WS_AIN) + (size_t)l * 3072 * 1024, T, 3072, 1024, 1024}; pg8::StaticOrder S; S.init(T, 3072, X.G, X.bid);
                    pg8::EpiConvIn E{HID, HID2};

#ifndef SKIP_G3
pg8::gemm_phase<pg8::EpiConvIn, pg8::StaticOrder, true, true>(X.lds, g, S, E, X.tid);
#endif

                } else {
                    pg8::Gemm g{H, (const bf16_t*)(ws + WS_BIN) + (size_t)(l - 2) * 1280 * 1024, T, 1280, 1024, 1024}; pg8::StaticOrder S; S.init(T, 1280, X.G, X.bid);
                    pg8::EpiQG E{HID, GATES};

#ifndef SKIP_G3B
pg8::gemm_phase<pg8::EpiQG, pg8::StaticOrder, true, true>(X.lds, g, S, E, X.tid);
#endif

                }
            } else if (st == 4) {
                if (l < 2) {
#ifndef SKIP_CONV
conv_phase(X, HID, HID2, P.in[I_ACONV] + (size_t)l * 3 * 1024, H);
#endif
}
                else { AttnArgs A{HID, GATES, (const bf16_t*)(ws + WS_KCMP), (const bf16_t*)(ws + WS_VCMPT), (const bf16_t*)(ws + WS_KS), (const bf16_t*)(ws + WS_VST), (const bf16_t*)(ws + WS_KW), (const bf16_t*)(ws + WS_VWT), HID2};

#ifndef REP_ATTN
#define REP_ATTN 1
#endif
attn_phase(X, A);
#ifdef PROBE_ATTN_MODE
{ AttnArgs A2 = A; A2.O = Y; attn_phase(X, A2, PROBE_ATTN_MODE); }
#endif
 }
            } else if (st == 10) {
                pg8::Gemm g{HID, (const bf16_t*)(ws + WS_KVW), T, 1536, 1024, 1024}; pg8::StaticOrder S; S.init(T, 1536, X.G, X.bid);
                pg8::EpiKV E{(bf16_t*)(ws + WS_KC), (bf16_t*)(ws + WS_KS), (bf16_t*)(ws + WS_KW), (bf16_t*)(ws + WS_VST), (bf16_t*)(ws + WS_VWT)};

#ifndef SKIP_GK
pg8::gemm_phase<pg8::EpiKV, pg8::StaticOrder, true, true>(X.lds, g, S, E, X.tid);
#endif

            } else if (st == 11) {
                pg8::Gemm g{(const bf16_t*)(ws + WS_KC), (const bf16_t*)(ws + WS_CW1), 16384, 512, 2048, 1024}; pg8::DiagOrder S{X.G, X.bid};
                pg8::EpiCmp1 E{(bf16_t*)(ws + WS_HIDC), (const float*)(ws + WS_CBIAS)};

#ifndef SKIP_CM1
pg8::gemm_phase<pg8::EpiCmp1, pg8::DiagOrder, true, true>(X.lds, g, S, E, X.tid);
#endif

            } else if (st == 12) {

#ifndef SKIP_CM2
cmp2_phase(X, (const bf16_t*)(ws + WS_HIDC), P.in[I_CW2], (bf16_t*)(ws + WS_KCMP), (bf16_t*)(ws + WS_VCMPT));
#endif

            }
        }
        if (ph + 1 < ph_hi) { XcdBarrier xbar; xbar.bar = (unsigned*)(ws + WS_BAR); xbar.x = xb_xcc_id(); xbar.st = (volatile LAS unsigned*)((LAS unsigned char*)lds_raw + 192); xcd_barrier(xbar);
#ifdef PROBE_EXTRA_SYNC
            xcd_barrier(xbar);
#endif
        }
#ifdef PROBE_DUP_ST
        if (cur_st_ == PROBE_DUP_ST && !dupflag_) { dupflag_ = 1; --ph; } else dupflag_ = 0;
#endif
    }
}

extern "C" void kernel_launch(void* const* d_in, const int* in_sizes, int n_in, void* d_out, int out_size, void* d_ws, size_t ws_size, hipStream_t stream) {
    static int grid = 0;
    if (grid == 0) {
        if (n_in != 19 || out_size != T * D || ws_size < WS_END) { fprintf(stderr, "kernel_launch: unexpected shapes (n_in %d, out %d, ws %zu < %zu)\n", n_in, out_size, ws_size, (size_t)WS_END); grid = -1; return; }
        int dev = 0, cus = 0, per_cu = 0;
        (void)hipGetDevice(&dev); (void)hipDeviceGetAttribute(&cus, hipDeviceAttributeMultiprocessorCount, dev);
        if (hipFuncSetAttribute((const void*)yoco_fwd, hipFuncAttributeMaxDynamicSharedMemorySize, LDS_BYTES) != hipSuccess) { fprintf(stderr, "kernel_launch: hipFuncSetAttribute failed\n"); grid = -1; return; }
        if (hipOccupancyMaxActiveBlocksPerMultiprocessor(&per_cu, (const void*)yoco_fwd, 512, LDS_BYTES) != hipSuccess || per_cu < 1) { fprintf(stderr, "kernel_launch: occupancy query says %d\n", per_cu); per_cu = 1; }
        (void)hipGetLastError();
        grid = cus * per_cu;
    }
    if (grid < 0) return;
    Params p{};
    for (int i = 0; i < 19; ++i) p.in[i] = (const float*)d_in[i];
    p.out = (float*)d_out; p.ws = (unsigned char*)d_ws;
    p.ph_lo = 0; p.ph_hi = NPH;
    void* args[] = {&p};
    hipError_t e = hipLaunchCooperativeKernel((const void*)yoco_fwd, dim3(grid), dim3(512), args, LDS_BYTES, stream);
    if (e != hipSuccess) fprintf(stderr, "kernel_launch: cooperative launch failed: %s (grid %d)\n", hipGetErrorString(e), grid);
}
```

```cpp
#include <hip/hip_runtime.h>
#include <hip/hip_cooperative_groups.h>
#include <cstdio>
#include <cstdint>
namespace cg = cooperative_groups;
namespace pg8 {
#define PG8_LAS __attribute__((address_space(3)))
typedef unsigned short bf16_t;
typedef short bf16x8 __attribute__((ext_vector_type(8)));
typedef float f32x4 __attribute__((ext_vector_type(4)));
typedef unsigned u32x4 __attribute__((ext_vector_type(4)));
constexpr int BM = 256, BK = 64, HALF = 128, HTB = HALF * BK * 2  , STAGE_BYTES = 8 * HTB, NXCD = 8, WGM = 8;

__host__ __device__ __forceinline__ int lds_byte(int r, int c) { const int st = (r >> 4) * 2 + (c >> 5), rr = r & 15, cc = c & 31, ob = rr * 64 + cc * 2; return st * 1024 + (ob ^ (((ob >> 9) & 1) << 5)); }
__host__ __device__ __forceinline__ void stage_rc(int b, int& R, int& C) { const int st = b / 1024, sb = b % 1024, swz = sb ^ (((sb >> 9) & 1) << 5); R = (st >> 1) * 16 + swz / 64; C = (st & 1) * 32 + (swz % 64) / 2; }
__host__ __device__ __forceinline__ int perm32(int rho) { const int n = rho >> 4, i = rho & 15; return 8 * (i >> 2) + 4 * n + (i & 3); }

struct Unit { int pm, pn; };
struct Gemm { const bf16_t* A; const bf16_t* Bt; int M, N, K, lda; };

struct StaticOrder {
    int nM, nN, nwg, G, c;
    __host__ __device__ void init(int M, int N, int G_, int c_) { nM = M / BM; nN = N / BM; nwg = nM * nN; G = G_; c = c_; }
    __host__ __device__ bool next(int i, Unit& u) const {
        const long L = (long)i * G + c; if (L >= nwg) return false;
        int wgid = (int)L; { const int q = nwg / NXCD, r = nwg % NXCD, xcd = wgid % NXCD, off = wgid / NXCD; wgid = (xcd < r ? xcd * (q + 1) : r * (q + 1) + (xcd - r) * q) + off; }
        const int nig = WGM * nN, gid = wgid / nig, fm = gid * WGM, gsz = (nM - fm) < WGM ? (nM - fm) : WGM;
        u.pm = fm + ((wgid % nig) % gsz); u.pn = (wgid % nig) / gsz; return true;
    }
    __device__ __forceinline__ void a_ready(const Unit&) const {}
    __device__ __forceinline__ void done(const Unit&) const {}
};

__device__ __forceinline__ unsigned cvt_pk_bf16(float lo, float hi) { unsigned r; asm volatile("v_cvt_pk_bf16_f32 %0, %1, %2" : "=v"(r) : "v"(lo), "v"(hi)); return r; }
typedef float f32x2 __attribute__((ext_vector_type(2)));
__device__ __forceinline__ f32x2 gelu_pk(f32x2 v) {
    const f32x2 av = __builtin_elementwise_abs(v), d = av * 0.2316418882f + 1.0f;
    f32x2 t; t.x = __builtin_amdgcn_rcpf(d.x); t.y = __builtin_amdgcn_rcpf(d.y);
    f32x2 q = t * 0.5307027145f + (-0.7265760135f); q = q * t + 0.7107068705f; q = q * t + (-0.142248368f); q = q * t + 0.127414796f; q = q * t;
    const f32x2 s = (v * v) * (-0.72134752044f);
    f32x2 e; e.x = __builtin_amdgcn_exp2f(s.x); e.y = __builtin_amdgcn_exp2f(s.y);
    const f32x2 m = v * (q * e), r = v - m;
    f32x2 o; o.x = v.x < 0.f ? m.x : r.x; o.y = v.y < 0.f ? m.y : r.y; return o;
}


template <class Epi, class Sched, bool ALIGN_EPI = false, bool SP2 = false>
__device__ __forceinline__ void gemm_phase(PG8_LAS unsigned char* lds, const Gemm g, const Sched& S, const Epi& E, const int tid) {
    const int wid = __builtin_amdgcn_readfirstlane(tid >> 6), lane = tid & 63, wr = wid >> 2, wc = wid & 3, fr = lane & 15, fq = lane >> 4;
    const int K = g.K, nt = K / BK;
    unsigned voffA[2], voffB[2];
#pragma unroll
    for (int i = 0; i < 2; ++i) { int R, C; stage_rc(tid * 16 + i * 8192, R, C); const int Rb = Epi::PERM ? ((R & ~31) + perm32(R & 31)) : R;
        voffA[i] = (unsigned)(R * g.lda + C) * 2u; voffB[i] = (unsigned)(Rb * K + C) * 2u; }
    const size_t kstep = (size_t)(BK * 2);
    const size_t hstepB = (size_t)HALF * K * 2, hstepA = (size_t)HALF * g.lda * 2;
    const size_t tstepB = 2 * hstepB, tstepA = 2 * hstepA;
    const unsigned ldsw = (unsigned)wid * 1024u;
    const int aoff = lds_byte(wr * 64 + fr, fq * 8), boff = lds_byte(wc * 32 + fr, fq * 8);
#define PG8_SA(b, h) (((b) * 2 + (h)) * HTB)
#define PG8_SB(b, h) ((4 + (b) * 2 + (h)) * HTB)
#define PG8_STAGE(bufoff, gbase, voff) do { _Pragma("unroll") for (int _i = 0; _i < 2; ++_i) \
        __builtin_amdgcn_global_load_lds((const unsigned*)((const char*)(gbase) + (voff)[_i]), (PG8_LAS unsigned*)(lds + (bufoff) + ldsw + _i * 8192), 16, 0, 0); } while (0)
#define PG8_LDA(dst, b, h) do { _Pragma("unroll") for (int m = 0; m < 4; ++m) _Pragma("unroll") for (int k = 0; k < 2; ++k) dst[m][k] = *(const PG8_LAS bf16x8*)(lds + PG8_SA(b, h) + aoff + m * 2048 + k * 1024); } while (0)
#define PG8_LDB(dst, b, h) do { _Pragma("unroll") for (int n = 0; n < 2; ++n) _Pragma("unroll") for (int k = 0; k < 2; ++k) dst[n][k] = *(const PG8_LAS bf16x8*)(lds + PG8_SB(b, h) + boff + n * 2048 + k * 1024); } while (0)
#define PG8_MMA(ai, bj, At, Bt) do { __builtin_amdgcn_s_setprio(1); _Pragma("unroll") for (int m = 0; m < 4; ++m) _Pragma("unroll") for (int n = 0; n < 2; ++n) _Pragma("unroll") for (int k = 0; k < 2; ++k) \
        acc[ai][bj][m][n] = __builtin_amdgcn_mfma_f32_16x16x32_bf16(Bt[n][k], At[m][k], acc[ai][bj][m][n], 0, 0, 0); __builtin_amdgcn_s_setprio(0); } while (0)
#define PG8_WAIT_V(n) asm volatile("s_waitcnt vmcnt(" #n ")" ::: "memory")
#define PG8_WAIT_L(n) asm volatile("s_waitcnt lgkmcnt(" #n ")" ::: "memory")
#define PG8_BAR __builtin_amdgcn_s_barrier()
#define PG8_SCHED __builtin_amdgcn_sched_barrier(0)
    Unit cur, nxt; int ui = 0;
    if (!S.next(0, cur)) return;
    f32x4 acc[2][2][4][2];
#pragma unroll
    for (int a = 0; a < 2; ++a)
#pragma unroll
        for (int b = 0; b < 2; ++b)
#pragma unroll
            for (int m = 0; m < 4; ++m)
#pragma unroll
                for (int n = 0; n < 2; ++n) acc[a][b][m][n] = (f32x4){0.f, 0.f, 0.f, 0.f};
    bf16x8 At[4][2], B0[2][2], B1[2][2];
    const char* cA = (const char*)g.A + (size_t)cur.pm * tstepA; const char* cB = (const char*)g.Bt + (size_t)cur.pn * tstepB;
    S.a_ready(cur);
    if constexpr (SP2) {
        PG8_STAGE(PG8_SB(0, 0), cB, voffB); PG8_STAGE(PG8_SB(0, 1), cB + hstepB, voffB); PG8_STAGE(PG8_SA(0, 0), cA, voffA); PG8_STAGE(PG8_SA(0, 1), cA + hstepA, voffA);
        if (wr == 1) PG8_BAR;
        PG8_WAIT_V(2); PG8_BAR;
        PG8_STAGE(PG8_SB(1, 0), cB + kstep, voffB); PG8_STAGE(PG8_SA(1, 0), cA + kstep, voffA); PG8_STAGE(PG8_SB(1, 1), cB + hstepB + kstep, voffB);
        PG8_WAIT_V(6); PG8_BAR;
    } else {
        PG8_STAGE(PG8_SB(0, 0), cB, voffB); PG8_STAGE(PG8_SA(0, 0), cA, voffA); PG8_STAGE(PG8_SB(0, 1), cB + hstepB, voffB); PG8_STAGE(PG8_SA(0, 1), cA + hstepA, voffA);
        if (wr == 1) PG8_BAR;
        PG8_WAIT_V(4); PG8_BAR;
        PG8_STAGE(PG8_SB(1, 0), cB + kstep, voffB); PG8_STAGE(PG8_SA(1, 0), cA + kstep, voffA); PG8_STAGE(PG8_SB(1, 1), cB + hstepB + kstep, voffB);
        PG8_WAIT_V(6); PG8_BAR;
    }
    for (;;) {
        const bool has_next = S.next(ui + 1, nxt);
        const char* nA = has_next ? (const char*)g.A + (size_t)nxt.pm * tstepA : cA; const char* nB = has_next ? (const char*)g.Bt + (size_t)nxt.pn * tstepB : cB;
        for (int t = 0; t < nt; t += 2) {
            const bool last = (t == nt - 2);
            const char* a1 = cA + (size_t)(t + 1) * kstep;
            const char* a2 = last ? nA : cA + (size_t)(t + 2) * kstep; const char* b2 = last ? nB : cB + (size_t)(t + 2) * kstep;
            const char* a3 = a2 + kstep; const char* b3 = b2 + kstep;
            if (last && has_next) S.a_ready(nxt);
            if constexpr (SP2) {
            PG8_LDB(B0, 0, 0); PG8_LDB(B1, 0, 1); PG8_SCHED; PG8_LDA(At, 0, 0); PG8_STAGE(PG8_SA(1, 1), a1 + hstepA, voffA);
            PG8_WAIT_V(8); PG8_WAIT_L(0); PG8_BAR; PG8_MMA(0, 0, At, B0); PG8_MMA(0, 1, At, B1); PG8_BAR; PG8_SCHED;
            PG8_LDA(At, 0, 1); PG8_STAGE(PG8_SB(0, 0), b2, voffB); PG8_STAGE(PG8_SB(0, 1), b2 + hstepB, voffB); PG8_STAGE(PG8_SA(0, 0), a2, voffA);
            PG8_WAIT_V(8); PG8_WAIT_L(0); PG8_BAR; PG8_MMA(1, 0, At, B0); PG8_MMA(1, 1, At, B1); PG8_BAR; PG8_SCHED;
            PG8_LDB(B0, 1, 0); PG8_LDB(B1, 1, 1); PG8_SCHED; PG8_LDA(At, 1, 0); PG8_STAGE(PG8_SA(0, 1), a2 + hstepA, voffA);
            PG8_WAIT_V(8); PG8_WAIT_L(0); PG8_BAR; PG8_MMA(0, 0, At, B0); PG8_MMA(0, 1, At, B1); PG8_BAR; PG8_SCHED;
            PG8_LDA(At, 1, 1); PG8_STAGE(PG8_SB(1, 0), b3, voffB); PG8_STAGE(PG8_SB(1, 1), b3 + hstepB, voffB); PG8_STAGE(PG8_SA(1, 0), a3, voffA);
            PG8_WAIT_V(8); PG8_WAIT_L(0); PG8_BAR; PG8_MMA(1, 0, At, B0); PG8_MMA(1, 1, At, B1); PG8_BAR; PG8_SCHED;
            } else {
            PG8_LDB(B0, 0, 0); PG8_SCHED; PG8_LDA(At, 0, 0); PG8_STAGE(PG8_SA(1, 1), a1 + hstepA, voffA);
            PG8_WAIT_L(8); PG8_BAR; PG8_WAIT_L(0); PG8_MMA(0, 0, At, B0); PG8_BAR; PG8_SCHED;
            PG8_LDB(B1, 0, 1); PG8_STAGE(PG8_SB(0, 0), b2, voffB);
            PG8_BAR; PG8_WAIT_L(0); PG8_MMA(0, 1, At, B1); PG8_BAR;
            PG8_LDA(At, 0, 1); PG8_STAGE(PG8_SA(0, 0), a2, voffA);
            PG8_BAR; PG8_WAIT_L(0); PG8_MMA(1, 0, At, B0); PG8_BAR; PG8_SCHED;
            PG8_STAGE(PG8_SB(0, 1), b2 + hstepB, voffB);
            PG8_WAIT_V(6); PG8_BAR; PG8_MMA(1, 1, At, B1); PG8_BAR;
            PG8_LDB(B0, 1, 0); PG8_SCHED; PG8_LDA(At, 1, 0); PG8_STAGE(PG8_SA(0, 1), a2 + hstepA, voffA);
            PG8_WAIT_L(8); PG8_BAR; PG8_WAIT_L(0); PG8_MMA(0, 0, At, B0); PG8_BAR; PG8_SCHED;
            PG8_LDB(B1, 1, 1); PG8_STAGE(PG8_SB(1, 0), b3, voffB);
            PG8_BAR; PG8_WAIT_L(0); PG8_MMA(0, 1, At, B1); PG8_BAR;
            PG8_LDA(At, 1, 1); PG8_STAGE(PG8_SA(1, 0), a3, voffA);
            PG8_BAR; PG8_WAIT_L(0); PG8_MMA(1, 0, At, B0); PG8_BAR; PG8_SCHED;
            PG8_STAGE(PG8_SB(1, 1), b3 + hstepB, voffB);
            PG8_WAIT_V(6); PG8_BAR; PG8_MMA(1, 1, At, B1); PG8_BAR;
            }
        }
        if constexpr (ALIGN_EPI) { if (wr == 0) PG8_BAR; }
        if constexpr (!Epi::AFTER_DRAIN) { E(acc, cur, wr, wc, fr, fq); S.done(cur); }
        if (!has_next) break;
#pragma unroll
        for (int a = 0; a < 2; ++a)
#pragma unroll
            for (int b = 0; b < 2; ++b)
#pragma unroll
                for (int m = 0; m < 4; ++m)
#pragma unroll
                    for (int n = 0; n < 2; ++n) acc[a][b][m][n] = (f32x4){0.f, 0.f, 0.f, 0.f};
        cur = nxt; cA = nA; cB = nB; ++ui;
        if constexpr (ALIGN_EPI) { if (wr == 1) PG8_BAR; }
    }
    PG8_WAIT_V(0);
    if constexpr (!ALIGN_EPI) { if (wr == 0) PG8_BAR; }
    PG8_BAR;
    if constexpr (Epi::AFTER_DRAIN) { E.fused(acc, cur, wr, wc, fr, fq, lds, wid, lane); S.done(cur); }
#undef PG8_SA
#undef PG8_SB
#undef PG8_STAGE
#undef PG8_LDA
#undef PG8_LDB
#undef PG8_MMA
#undef PG8_WAIT_V
#undef PG8_WAIT_L
#undef PG8_BAR
#undef PG8_SCHED
}
}
#define LAS __attribute__((address_space(3)))
using pg8::bf16_t; using pg8::bf16x8; using pg8::f32x4; using pg8::u32x4; using pg8::cvt_pk_bf16;
typedef float f32x16 __attribute__((ext_vector_type(16)));
typedef unsigned u32x2 __attribute__((ext_vector_type(2)));
typedef float f32x2 __attribute__((ext_vector_type(2)));

constexpr int T = 32768, D = 1024, FF = 2816, SEQ = 4096, NBATCH = 8;
constexpr int NPH = 45;
constexpr float EPS = 1e-6f, LOG2E = 1.4426950408889634f;
constexpr size_t MiB = 1u << 20;
constexpr size_t WS_FIN = 0;
constexpr size_t WS_FOUT = WS_FIN + 88 * MiB;
constexpr size_t WS_AIN = WS_FOUT + 44 * MiB;
constexpr size_t WS_AOUT = WS_AIN + 12 * MiB;
constexpr size_t WS_KVW = WS_AOUT + 4 * MiB;
constexpr size_t WS_CW1 = WS_KVW + 3 * MiB;
constexpr size_t WS_BIN = WS_CW1 + 2 * MiB;
constexpr size_t WS_BOUT = WS_BIN + 5 * MiB;
constexpr size_t WS_MOD = WS_BOUT + 4 * MiB;
constexpr size_t WS_KVMOD = WS_MOD + 4ull * 8 * 9216 * 4;
constexpr size_t WS_CBIAS = WS_KVMOD + 8ull * 2048 * 4;
constexpr size_t WS_H = WS_MOD + 2 * MiB;
constexpr size_t WS_HID = WS_H + 64 * MiB;
constexpr size_t WS_Y = WS_HID + 176 * MiB;
constexpr size_t WS_PART = WS_Y + 64 * MiB;
constexpr size_t WS_GATES = WS_PART + 2 * MiB;
constexpr size_t WS_KC = WS_GATES + 6 * MiB;
constexpr size_t WS_KS = WS_KC + 33 * MiB;
constexpr size_t WS_KW = WS_KS + 16 * MiB;
constexpr size_t WS_VST = WS_KW + 16 * MiB;
constexpr size_t WS_VWT = WS_VST + 16 * MiB;
constexpr size_t WS_HIDC = WS_VWT + 16 * MiB;
constexpr size_t WS_KCMP = WS_HIDC + 8 * MiB;
constexpr size_t WS_VCMPT = WS_KCMP + 1 * MiB;
constexpr size_t WS_BAR = WS_VCMPT + 1 * MiB;
constexpr size_t WS_END = WS_BAR + 1 * MiB;
constexpr int LDS_BYTES = 135168;

struct Params { const float* in[19]; float* out; unsigned char* ws; int ph_lo, ph_hi; };
enum { I_X = 0, I_C, I_ADAW, I_ADAB, I_NORMG, I_FIN, I_FOUT, I_AIN, I_ACONV, I_AOUT, I_KVNG, I_KVADAW, I_KVADAB, I_KVW, I_CPOS, I_CW1, I_CW2, I_BIN, I_BOUT };

__device__ __forceinline__ float bf2f(unsigned short b) { return __uint_as_float((unsigned)b << 16); }
__device__ __forceinline__ float fexp2(float x) { return __builtin_amdgcn_exp2f(x); }
__device__ __forceinline__ float frcp(float x) { return __builtin_amdgcn_rcpf(x); }
__device__ __forceinline__ float silu_f(float g) { return g * frcp(1.f + fexp2(-g * LOG2E)); }
__device__ __forceinline__ float wave_sum(float v) {
#pragma unroll
    for (int o = 1; o < 64; o <<= 1) v += __shfl_xor(v, o);
    return v;
}
template <class Tp> __device__ __forceinline__ Tp* uptr(Tp* p) { const unsigned long long v = (unsigned long long)p; const unsigned lo = __builtin_amdgcn_readfirstlane((unsigned)v), hi = __builtin_amdgcn_readfirstlane((unsigned)(v >> 32)); typedef __attribute__((address_space(1))) Tp* gptr_t; gptr_t gp = (gptr_t)(((unsigned long long)hi << 32) | lo); return (Tp*)gp; }
#define LDS_WAIT() asm volatile("s_waitcnt lgkmcnt(0)" ::: "memory")

namespace pg8 {
__device__ __forceinline__ u32x4 pack8(const f32x4 a, const f32x4 b) { u32x4 w; w.x = cvt_pk_bf16(a[0], a[1]); w.y = cvt_pk_bf16(a[2], a[3]); w.z = cvt_pk_bf16(b[0], b[1]); w.w = cvt_pk_bf16(b[2], b[3]); return w; }
struct EpiSwiglu {
    static constexpr bool PERM = true, AFTER_DRAIN = false;
    bf16_t* O;
    __device__ __forceinline__ void operator()(const f32x4 (&acc)[2][2][4][2], const Unit& u, int wr, int wc, int fr, int fq) const {
        const int row0 = u.pm * BM + wr * 64 + fr, col0 = u.pn * 128 + wc * 32 + 8 * fq;
#pragma unroll
        for (int ai = 0; ai < 2; ++ai)
#pragma unroll
            for (int m = 0; m < 4; ++m) {
                f32x4 h0, h1;
#pragma unroll
                for (int e = 0; e < 4; ++e) { h0[e] = silu_f(acc[ai][0][m][0][e]) * acc[ai][1][m][0][e]; h1[e] = silu_f(acc[ai][0][m][1][e]) * acc[ai][1][m][1][e]; }
                *(u32x4*)(O + (size_t)(row0 + ai * HALF + m * 16) * FF + col0) = pack8(h0, h1);
            }
    }
};
struct EpiY {
    static constexpr bool PERM = true, AFTER_DRAIN = false;
    bf16_t* Y; float* part;
    __device__ __forceinline__ void operator()(const f32x4 (&acc)[2][2][4][2], const Unit& u, int wr, int wc, int fr, int fq) const {
        const int row0 = u.pm * BM + wr * 64 + fr, col0 = u.pn * BM + wc * 32 + 8 * fq;
#pragma unroll
        for (int ai = 0; ai < 2; ++ai)
#pragma unroll
            for (int m = 0; m < 4; ++m) {
                const int row = row0 + ai * HALF + m * 16; float ss = 0.f;
#pragma unroll
                for (int bj = 0; bj < 2; ++bj) {
                    const f32x4 a = acc[ai][bj][m][0], b = acc[ai][bj][m][1];
                    ss += (a[0] * a[0] + a[1] * a[1]) + (a[2] * a[2] + a[3] * a[3]) + (b[0] * b[0] + b[1] * b[1]) + (b[2] * b[2] + b[3] * b[3]);
                    *(u32x4*)(Y + (size_t)row * D + col0 + bj * HALF) = pack8(a, b);
                }
                ss += __shfl_xor(ss, 16); ss += __shfl_xor(ss, 32);
                if (fq == 0) part[(size_t)row * 16 + u.pn * 4 + wc] = ss;
            }
    }
};
struct EpiConvIn {
    static constexpr bool PERM = true, AFTER_DRAIN = false;
    bf16_t* V; bf16_t* Bg;
    __device__ __forceinline__ void operator()(const f32x4 (&acc)[2][2][4][2], const Unit& u, int wr, int wc, int fr, int fq) const {
        const int row0 = u.pm * BM + wr * 64 + fr;
        if (u.pn < 8) {
            const int col0 = u.pn * 128 + wc * 32 + 8 * fq;
#pragma unroll
            for (int ai = 0; ai < 2; ++ai)
#pragma unroll
                for (int m = 0; m < 4; ++m)
                    *(u32x4*)(V + (size_t)(row0 + ai * HALF + m * 16) * D + col0) = pack8(acc[ai][0][m][0] * acc[ai][1][m][0], acc[ai][0][m][1] * acc[ai][1][m][1]);
        } else {
            const int col0 = (u.pn - 8) * BM + wc * 32 + 8 * fq;
#pragma unroll
            for (int ai = 0; ai < 2; ++ai)
#pragma unroll
                for (int m = 0; m < 4; ++m)
#pragma unroll
                    for (int bj = 0; bj < 2; ++bj)
                        *(u32x4*)(Bg + (size_t)(row0 + ai * HALF + m * 16) * D + col0 + bj * HALF) = pack8(acc[ai][bj][m][0], acc[ai][bj][m][1]);
        }
    }
};
struct EpiQG {
    static constexpr bool PERM = true, AFTER_DRAIN = false;
    bf16_t* Q; float* G;
    __device__ __forceinline__ void operator()(const f32x4 (&acc)[2][2][4][2], const Unit& u, int wr, int wc, int fr, int fq) const {
        const int row0 = u.pm * BM + wr * 64 + fr;
        if (u.pn < 4) {
            const int col0 = u.pn * BM + wc * 32 + 8 * fq; const float sc = 0.125f * LOG2E;
#pragma unroll
            for (int ai = 0; ai < 2; ++ai)
#pragma unroll
                for (int m = 0; m < 4; ++m)
#pragma unroll
                    for (int bj = 0; bj < 2; ++bj)
                        *(u32x4*)(Q + (size_t)(row0 + ai * HALF + m * 16) * D + col0 + bj * HALF) = pack8(acc[ai][bj][m][0] * sc, acc[ai][bj][m][1] * sc);
        } else {
            const int col0 = wc * 32 + 8 * fq;
            if (col0 < 48) {
#pragma unroll
                for (int ai = 0; ai < 2; ++ai)
#pragma unroll
                    for (int m = 0; m < 4; ++m) {
                        float* gp = G + (size_t)(row0 + ai * HALF + m * 16) * 48 + col0;
#pragma unroll
                        for (int n = 0; n < 2; ++n) { f32x4 s;
#pragma unroll
                            for (int e = 0; e < 4; ++e) s[e] = frcp(1.f + fexp2(-acc[ai][0][m][n][e] * LOG2E));
                            *(f32x4*)(gp + 4 * n) = s; }
                    }
            }
        }
    }
};
struct EpiKV {
    static constexpr bool PERM = true, AFTER_DRAIN = false;
    bf16_t *KC, *KS, *KW, *VSt, *VWt;
    __device__ __forceinline__ void operator()(const f32x4 (&acc)[2][2][4][2], const Unit& u, int wr, int wc, int fr, int fq) const {
        const int br = u.pn >> 1, kv = u.pn & 1;
        const int row0 = u.pm * BM + wr * 64 + fr, b = row0 >> 12;
        const int d0 = (wc & 1) * 32 + 8 * fq;
        if (br == 0 || kv == 0) {
            bf16_t* base = br == 0 ? KC + (size_t)kv * 32 * 4096 * 64 : (br == 1 ? KS : KW);
#pragma unroll
            for (int ai = 0; ai < 2; ++ai)
#pragma unroll
                for (int m = 0; m < 4; ++m)
#pragma unroll
                    for (int bj = 0; bj < 2; ++bj) {
                        const int s = (row0 + ai * HALF + m * 16) & 4095, g = 2 * bj + (wc >> 1);
                        *(u32x4*)(base + ((size_t)(b * 4 + g) * 4096 + s) * 64 + d0) = pack8(acc[ai][bj][m][0], acc[ai][bj][m][1]);
                    }
        } else {
            bf16_t* base = br == 1 ? VSt : VWt;
#pragma unroll
            for (int ai = 0; ai < 2; ++ai)
#pragma unroll
                for (int m = 0; m < 4; ++m)
#pragma unroll
                    for (int bj = 0; bj < 2; ++bj) {
                        const int s = (row0 + ai * HALF + m * 16) & 4095, g = 2 * bj + (wc >> 1);
                        bf16_t* p = base + ((size_t)(b * 4 + g) * 64 + d0) * 4096 + s;
                        const u32x4 w = pack8(acc[ai][bj][m][0], acc[ai][bj][m][1]);
                        p[0 * 4096] = (bf16_t)(w.x & 0xffffu); p[1 * 4096] = (bf16_t)(w.x >> 16); p[2 * 4096] = (bf16_t)(w.y & 0xffffu); p[3 * 4096] = (bf16_t)(w.y >> 16);
                        p[4 * 4096] = (bf16_t)(w.z & 0xffffu); p[5 * 4096] = (bf16_t)(w.z >> 16); p[6 * 4096] = (bf16_t)(w.w & 0xffffu); p[7 * 4096] = (bf16_t)(w.w >> 16);
                    }
        }
    }
};
struct EpiCmp1 {
    static constexpr bool PERM = true, AFTER_DRAIN = false;
    bf16_t* O; const float* cbias;
    __device__ __forceinline__ void operator()(const f32x4 (&acc)[2][2][4][2], const Unit& u, int wr, int wc, int fr, int fq) const {
        const int row0 = u.pm * BM + wr * 64 + fr, col0 = wc * 32 + 8 * fq;
#pragma unroll
        for (int bj = 0; bj < 2; ++bj) {
            const f32x4 b0 = *(const f32x4*)(cbias + u.pn * 256 + col0 + bj * HALF), b1 = *(const f32x4*)(cbias + u.pn * 256 + col0 + bj * HALF + 4);
#pragma unroll
            for (int ai = 0; ai < 2; ++ai)
#pragma unroll
                for (int m = 0; m < 4; ++m) {
                    f32x4 x0 = acc[ai][bj][m][0] + b0, x1 = acc[ai][bj][m][1] + b1;
#pragma unroll
                    for (int e = 0; e < 4; ++e) {
                        { const float x = x0[e], z = 1.5957691216f * (x + 0.044715f * x * x * x); x0[e] = x * frcp(1.f + fexp2(-z * LOG2E)); }
                        { const float x = x1[e], z = 1.5957691216f * (x + 0.044715f * x * x * x); x1[e] = x * frcp(1.f + fexp2(-z * LOG2E)); }
                    }
                    *(u32x4*)(O + (size_t)(row0 + ai * HALF + m * 16) * 256 + col0 + bj * HALF) = pack8(x0, x1);
                }
        }
    }
};
struct DiagOrder {
    int G, c;
    __device__ bool next(int i, Unit& u) const { const int L = i * G + c; if (L >= 64) return false; u.pm = L; u.pn = L >> 5; return true; }
    __device__ __forceinline__ void a_ready(const Unit&) const {}
    __device__ __forceinline__ void done(const Unit&) const {}
};
}
struct Ctx { LAS unsigned char* lds; int tid, lane, wave, G, bid; };

__device__ __forceinline__ void conv_item(const float* W, int ldw, int ncv, int src_col0, int K, bf16_t* WT, int dst_row0, int kb, LAS float* scr, int lane) {
    const int k0 = 64 * kb, col = src_col0 + (lane & 31); const bool ok = col < ncv;
#pragma unroll 8
    for (int i = 0; i < 32; ++i) { const int kk = 2 * i + (lane >> 5); scr[kk * 33 + (lane & 31)] = ok ? W[(size_t)(k0 + kk) * ldw + col] : 0.f; }
    LDS_WAIT(); asm volatile("" ::: "memory");
    const int c = lane & 7;
#pragma unroll
    for (int j = 0; j < 4; ++j) { const int n = (lane >> 3) + 8 * j; const LAS float* s = scr + (8 * c) * 33 + n;
        u32x4 o; o.x = cvt_pk_bf16(s[0 * 33], s[1 * 33]); o.y = cvt_pk_bf16(s[2 * 33], s[3 * 33]); o.z = cvt_pk_bf16(s[4 * 33], s[5 * 33]); o.w = cvt_pk_bf16(s[6 * 33], s[7 * 33]);
        *(u32x4*)(WT + (size_t)(dst_row0 + n) * K + k0 + 8 * c) = o; }
    LDS_WAIT(); asm volatile("" ::: "memory");
}
#define PIN(k) uptr(LP->in[k])
__device__ __forceinline__ void p0_phase(const Ctx& X, const LAS Params* LP) {
    unsigned char* ws = uptr(LP->ws);
    LAS float* sc = (LAS float*)X.lds;
    LAS float* red = (LAS float*)(X.lds + 32768);
    for (int i = X.tid; i < 8192; i += 512) { const int b = i >> 10, k = i & 1023; sc[k * 8 + b] = silu_f(PIN(I_C)[i]); }
    __syncthreads();
    for (int it = X.bid; it < 608; it += X.G) {
        const float* W; const float* bias; float* out; int N, cb;
        if (it < 576) { const int l = it / 144; cb = it % 144; N = 9216; W = PIN(I_ADAW) + (size_t)l * 1024 * 9216; bias = PIN(I_ADAB) + l * 9216; out = (float*)(ws + WS_MOD) + (size_t)l * 8 * 9216; }
        else { cb = it - 576; N = 2048; W = PIN(I_KVADAW); bias = PIN(I_KVADAB); out = (float*)(ws + WS_KVMOD); }
        float a[8];
#pragma unroll
        for (int b = 0; b < 8; ++b) a[b] = 0.f;
        const float* wp = W + (size_t)(128 * X.wave) * N + 64 * cb + X.lane;
#pragma unroll 4
        for (int k = 0; k < 128; ++k) { const float w = wp[(size_t)k * N]; const f32x4 s0 = *(const LAS f32x4*)(sc + (128 * X.wave + k) * 8), s1 = *(const LAS f32x4*)(sc + (128 * X.wave + k) * 8 + 4);
            a[0] += s0[0] * w; a[1] += s0[1] * w; a[2] += s0[2] * w; a[3] += s0[3] * w; a[4] += s1[0] * w; a[5] += s1[1] * w; a[6] += s1[2] * w; a[7] += s1[3] * w; }
#pragma unroll
        for (int b = 0; b < 8; ++b) red[(X.wave * 8 + b) * 64 + X.lane] = a[b];
        __syncthreads();
        { const int b = X.tid >> 6, col = X.tid & 63; float s = bias[64 * cb + col];
#pragma unroll
          for (int w = 0; w < 8; ++w) s += red[(w * 8 + b) * 64 + col];
          out[(size_t)b * N + 64 * cb + col] = s; }
        __syncthreads();
    }
    for (int kv = 0; kv < 2; ++kv) if (X.bid == X.G - 1 - kv) {
        const int col = X.tid & 255, half = X.tid >> 8; const float* pos = PIN(I_CPOS) + kv * 2048 + half * 1024; const float* w1 = PIN(I_CW1) + ((size_t)kv * 2048 + half * 1024) * 256 + col;
        float s = 0.f;
        for (int f = 0; f < 1024; ++f) s += pos[f] * w1[(size_t)f * 256];
        red[X.tid] = s; __syncthreads();
        if (X.tid < 256) ((float*)(ws + WS_CBIAS))[kv * 256 + X.tid] = red[X.tid] + red[X.tid + 256];
        __syncthreads();
    }
    __syncthreads();
    LAS float* scr = (LAS float*)(X.lds + X.wave * 8448);
    const int gw = X.bid * 8 + X.wave, NGW = X.G * 8;
    for (int it = gw; it < 41472; it += NGW) {
        int r = it;
        if (r < 22528) { const int id = r / 2816, q = r % 2816, nb = q >> 4, kb = q & 15, pn = nb >> 3, jb = nb & 7;
            conv_item(PIN(I_FIN) + (size_t)id * 1024 * 5632, 5632, 5632, (jb >> 2) * 2816 + 128 * pn + 32 * (jb & 3), 1024, (bf16_t*)(ws + WS_FIN) + (size_t)id * 5632 * 1024, 32 * nb, kb, scr, X.lane); continue; } r -= 22528;
        if (r < 11264) { const int id = r / 1408, q = r % 1408, nb = q / 44, kb = q % 44;
            conv_item(PIN(I_FOUT) + (size_t)id * 2816 * 1024, 1024, 1024, 32 * nb, 2816, (bf16_t*)(ws + WS_FOUT) + (size_t)id * 1024 * 2816, 32 * nb, kb, scr, X.lane); continue; } r -= 11264;
        if (r < 3072) { const int id = r / 1536, q = r % 1536, nb = q >> 4, kb = q & 15, pn = nb >> 3, jb = nb & 7;
            const int src = pn < 8 ? ((jb >> 2) ? 2048 : 1024) + 128 * pn + 32 * (jb & 3) : 256 * (pn - 8) + 32 * jb;
            conv_item(PIN(I_AIN) + (size_t)id * 1024 * 3072, 3072, 3072, src, 1024, (bf16_t*)(ws + WS_AIN) + (size_t)id * 3072 * 1024, 32 * nb, kb, scr, X.lane); continue; } r -= 3072;
        if (r < 1024) { const int id = r / 512, q = r % 512, nb = q >> 4, kb = q & 15;
            conv_item(PIN(I_AOUT) + (size_t)id * 1024 * 1024, 1024, 1024, 32 * nb, 1024, (bf16_t*)(ws + WS_AOUT) + (size_t)id * 1024 * 1024, 32 * nb, kb, scr, X.lane); continue; } r -= 1024;
        if (r < 768) { const int nb = r >> 4, kb = r & 15;
            conv_item(PIN(I_KVW), 1536, 1536, 32 * nb, 1024, (bf16_t*)(ws + WS_KVW), 32 * nb, kb, scr, X.lane); continue; } r -= 768;
        if (r < 512) { const int id = r / 256, q = r % 256, nb = q >> 5, kb = q & 31;
            conv_item(PIN(I_CW1) + (size_t)id * 2048 * 256, 256, 256, 32 * nb, 2048, (bf16_t*)(ws + WS_CW1) + (size_t)id * 256 * 2048, 32 * nb, kb, scr, X.lane); continue; } r -= 512;
        if (r < 1280) { const int id = r / 640, q = r % 640, nb = q >> 4, kb = q & 15;
            conv_item(PIN(I_BIN) + (size_t)id * 1024 * 1072, 1072, 1072, 32 * nb, 1024, (bf16_t*)(ws + WS_BIN) + (size_t)id * 1280 * 1024, 32 * nb, kb, scr, X.lane); continue; } r -= 1280;
        { const int id = r / 512, q = r % 512, nb = q >> 4, kb = q & 15;
            conv_item(PIN(I_BOUT) + (size_t)id * 1024 * 1024, 1024, 1024, 32 * nb, 1024, (bf16_t*)(ws + WS_BOUT) + (size_t)id * 1024 * 1024, 32 * nb, kb, scr, X.lane); }
    }
}

struct UpdArgs { const float* xin; float* xout; const bf16_t* y; const float* part; const float* gate; const float* gpost; float w; int bstride;
                 const float* gpre; const float* shift; const float* scale; bf16_t* h; const float* gpre2; const float* shift2; const float* scale2; bf16_t* h2; };
__device__ __forceinline__ void update_phase(const Ctx& X, const UpdArgs& A) {
    constexpr int R = 2;
    const int gw = X.bid * 8 + X.wave, NGW = X.G * 8, c0 = 4 * X.lane;
    for (int row0 = gw; row0 < T; row0 += R * NGW) {
        f32x4 xv[R][4]; u32x2 yy[R][4]; f32x4 pp[R][4];
#pragma unroll
        for (int q = 0; q < R; ++q) { const int row = min(row0 + q * NGW, T - 1);
#pragma unroll
            for (int j = 0; j < 4; ++j) xv[q][j] = *(const f32x4*)(A.xin + (size_t)row * D + c0 + 256 * j);
            if (A.y) {
#pragma unroll
                for (int j = 0; j < 4; ++j) { yy[q][j] = *(const u32x2*)(A.y + (size_t)row * D + c0 + 256 * j); pp[q][j] = *(const f32x4*)(A.part + (size_t)row * 16 + 4 * j); }
            }
        }
#pragma unroll
        for (int q = 0; q < R; ++q) { const int row = row0 + q * NGW; if (row < T) {
            const int b = row >> 12;
            if (A.y) {
                const float ssq = ((pp[q][0][0] + pp[q][0][1]) + (pp[q][0][2] + pp[q][0][3])) + ((pp[q][1][0] + pp[q][1][1]) + (pp[q][1][2] + pp[q][1][3])) + ((pp[q][2][0] + pp[q][2][1]) + (pp[q][2][2] + pp[q][2][3])) + ((pp[q][3][0] + pp[q][3][1]) + (pp[q][3][2] + pp[q][3][3]));
                const float rs = A.w * __builtin_amdgcn_rsqf(ssq * (1.f / D) + EPS);
#pragma unroll
                for (int j = 0; j < 4; ++j) { const int c = c0 + 256 * j;
                    const f32x4 gt = *(const f32x4*)(A.gate + (size_t)b * A.bstride + c), gp = *(const f32x4*)(A.gpost + c);
                    const f32x4 yv = {__uint_as_float(yy[q][j].x << 16), __uint_as_float(yy[q][j].x & 0xffff0000u), __uint_as_float(yy[q][j].y << 16), __uint_as_float(yy[q][j].y & 0xffff0000u)};
                    xv[q][j] = xv[q][j] + gt * gp * yv * rs; }
            }
            if (A.xout) {
#pragma unroll
                for (int j = 0; j < 4; ++j) *(f32x4*)(A.xout + (size_t)row * D + c0 + 256 * j) = xv[q][j];
            }
            if (A.h) {
                float s = 0.f;
#pragma unroll
                for (int j = 0; j < 4; ++j) s += (xv[q][j][0] * xv[q][j][0] + xv[q][j][1] * xv[q][j][1]) + (xv[q][j][2] * xv[q][j][2] + xv[q][j][3] * xv[q][j][3]);
                const float r = __builtin_amdgcn_rsqf(wave_sum(s) * (1.f / D) + EPS);
#pragma unroll
                for (int j = 0; j < 4; ++j) { const int c = c0 + 256 * j;
                    const f32x4 g = *(const f32x4*)(A.gpre + c), sh = *(const f32x4*)(A.shift + (size_t)b * A.bstride + c), scl = *(const f32x4*)(A.scale + (size_t)b * A.bstride + c);
                    const f32x4 hv = xv[q][j] * r * g * (scl + 1.f) + sh; u32x2 o; o.x = cvt_pk_bf16(hv[0], hv[1]); o.y = cvt_pk_bf16(hv[2], hv[3]);
                    *(u32x2*)(A.h + (size_t)row * D + c) = o; }
                if (A.h2) {
#pragma unroll
                    for (int j = 0; j < 4; ++j) { const int c = c0 + 256 * j;
                        const f32x4 g = *(const f32x4*)(A.gpre2 + c), sh = *(const f32x4*)(A.shift2 + (size_t)b * 2048 + c), scl = *(const f32x4*)(A.scale2 + (size_t)b * 2048 + c);
                        const f32x4 hv = xv[q][j] * r * g * (scl + 1.f) + sh; u32x2 o; o.x = cvt_pk_bf16(hv[0], hv[1]); o.y = cvt_pk_bf16(hv[2], hv[3]);
                        *(u32x2*)(A.h2 + (size_t)row * D + c) = o; }
                }
            }
        } }
    }
}

__device__ __forceinline__ void unpack8(const u32x4 w, float (&f)[8]) {
    f[0] = __uint_as_float(w.x << 16); f[1] = __uint_as_float(w.x & 0xffff0000u); f[2] = __uint_as_float(w.y << 16); f[3] = __uint_as_float(w.y & 0xffff0000u);
    f[4] = __uint_as_float(w.z << 16); f[5] = __uint_as_float(w.z & 0xffff0000u); f[6] = __uint_as_float(w.w << 16); f[7] = __uint_as_float(w.w & 0xffff0000u);
}
__device__ __forceinline__ void conv_phase(const Ctx& X, const bf16_t* V, const bf16_t* Bg, const float* cw, bf16_t* Z) {
    const int gt = X.bid * 512 + X.tid, NT = X.G * 512;
    for (int i = gt; i < T * 128; i += NT) {
        const int row = i >> 7, c = (i & 127) * 8, s = row & 4095;
        const u32x4 z0 = {0u, 0u, 0u, 0u};
        const u32x4 v2 = *(const u32x4*)(V + (size_t)row * D + c), v1 = s >= 1 ? *(const u32x4*)(V + (size_t)(row - 1) * D + c) : z0, v0 = s >= 2 ? *(const u32x4*)(V + (size_t)(row - 2) * D + c) : z0;
        const u32x4 bb = *(const u32x4*)(Bg + (size_t)row * D + c);
        float a0[8], a1[8], a2[8], bf[8], o[8]; unpack8(v0, a0); unpack8(v1, a1); unpack8(v2, a2); unpack8(bb, bf);
#pragma unroll
        for (int e = 0; e < 8; ++e) o[e] = bf[e] * (cw[c + e] * a0[e] + cw[D + c + e] * a1[e] + cw[2 * D + c + e] * a2[e]);
        u32x4 w; w.x = cvt_pk_bf16(o[0], o[1]); w.y = cvt_pk_bf16(o[2], o[3]); w.z = cvt_pk_bf16(o[4], o[5]); w.w = cvt_pk_bf16(o[6], o[7]);
        *(u32x4*)(Z + (size_t)row * D + c) = w;
    }
}

__device__ __forceinline__ void cmp2_phase(const Ctx& X, const bf16_t* hidc, const float* w2, bf16_t* kcmp, bf16_t* vcmpT) {
    const int gt = X.bid * 512 + X.tid, NT = X.G * 512;
    for (int i = gt; i < 16384 * 16; i += NT) {
        const int row = i >> 4, c = (i & 15) * 4, kv = row >> 13, rr = row & 8191;
        const float* w = w2 + (size_t)kv * 256 * 64 + c; const bf16_t* hp = hidc + (size_t)row * 256;
        f32x4 a = {0.f, 0.f, 0.f, 0.f};
        for (int k = 0; k < 256; k += 8) { float hf[8]; unpack8(*(const u32x4*)(hp + k), hf);
#pragma unroll
            for (int e = 0; e < 8; ++e) a += *(const f32x4*)(w + (size_t)(k + e) * 64) * hf[e]; }
        if (kv == 0) { u32x2 o; o.x = cvt_pk_bf16(a[0], a[1]); o.y = cvt_pk_bf16(a[2], a[3]); *(u32x2*)(kcmp + (size_t)rr * 64 + c) = o; }
        else { const int bg = rr >> 8, n = rr & 255; bf16_t* p = vcmpT + ((size_t)bg * 64 + c) * 256 + n; const unsigned w0 = cvt_pk_bf16(a[0], a[1]), w1 = cvt_pk_bf16(a[2], a[3]);
            p[0] = (bf16_t)(w0 & 0xffffu); p[256] = (bf16_t)(w0 >> 16); p[512] = (bf16_t)(w1 & 0xffffu); p[768] = (bf16_t)(w1 >> 16); }
    }
}
struct AttnArgs { const bf16_t* Q; const float* gates; const bf16_t *kcmp, *vcmpT, *KS, *VSt, *KW, *VWt; bf16_t* O; };

__device__ __forceinline__ void load_k(bf16x8 (&kf)[4], const bf16_t* Kb, int key0, int jr, int h) {
    const bf16x8* p = (const bf16x8*)(Kb + (size_t)(key0 + jr) * 64 + h * 8);
#pragma unroll
    for (int ks = 0; ks < 4; ++ks) kf[ks] = p[2 * ks];
}
__device__ __forceinline__ void load_v(bf16x8 (&vf)[4], const bf16_t* Vt, int ldv, int key0, int j, int h) {
#pragma unroll
    for (int s = 0; s < 2; ++s)
#pragma unroll
        for (int dt = 0; dt < 2; ++dt) vf[s * 2 + dt] = *(const bf16x8*)(Vt + (size_t)(dt * 32 + j) * ldv + key0 + 16 * s + 8 * h);
}
__device__ __forceinline__ f32x16 qk_mma(const bf16x8 (&kf)[4], const bf16x8 (&qf)[4], const f32x16& bc) {
    f32x16 acc = __builtin_amdgcn_mfma_f32_32x32x16_bf16(kf[0], qf[0], bc, 0, 0, 0);
#pragma unroll
    for (int ks = 1; ks < 4; ++ks) acc = __builtin_amdgcn_mfma_f32_32x32x16_bf16(kf[ks], qf[ks], acc, 0, 0, 0);
    return acc;
}
__device__ __forceinline__ void pv_mma(f32x16 (&o)[2], const bf16x8 (&vf)[4], const f32x16& p) {
#pragma unroll
    for (int s = 0; s < 2; ++s) {
        u32x4 w; w.x = cvt_pk_bf16(p[8 * s + 0], p[8 * s + 1]); w.y = cvt_pk_bf16(p[8 * s + 2], p[8 * s + 3]); w.z = cvt_pk_bf16(p[8 * s + 4], p[8 * s + 5]); w.w = cvt_pk_bf16(p[8 * s + 6], p[8 * s + 7]);
        const bf16x8 pb = __builtin_bit_cast(bf16x8, w);
#pragma unroll
        for (int dt = 0; dt < 2; ++dt) o[dt] = __builtin_amdgcn_mfma_f32_32x32x16_bf16(vf[s * 2 + dt], pb, o[dt], 0, 0, 0);
    }
}
__device__ __forceinline__ void pf_block(const bf16_t* Kb, const bf16_t* Vt, int ldv, int key0, int lane, LAS unsigned* junk) {
    __builtin_amdgcn_global_load_lds((const unsigned*)(Kb + (size_t)(key0 + lane) * 64), junk, 4, 0, 0);
    __builtin_amdgcn_global_load_lds((const unsigned*)(Vt + (size_t)lane * ldv + key0), junk, 4, 0, 0);
}
__device__ __forceinline__ unsigned run_mask(int kstart, int lo, int hi) {
    const int a = max(lo - kstart, 0), b = min(hi - kstart, 7);
    return a <= b ? ((1u << (b + 1)) - 1u) & ~((1u << a) - 1u) : 0u;
}
__device__ __forceinline__ float max16(const f32x16& s) {
    float a = fmaxf(fmaxf(s[0], s[1]), s[2]), b = fmaxf(fmaxf(s[3], s[4]), s[5]), c = fmaxf(fmaxf(s[6], s[7]), s[8]), d = fmaxf(fmaxf(s[9], s[10]), s[11]), e = fmaxf(fmaxf(s[12], s[13]), s[14]);
    return fmaxf(fmaxf(fmaxf(a, b), fmaxf(c, d)), fmaxf(e, s[15]));
}
__device__ __forceinline__ void softmax_step(f32x16& s, bool full, unsigned vm, float off, float& m, float& l, f32x16 (&o)[2]) {
    if (!full) {
#pragma unroll
        for (int v = 0; v < 16; ++v) s[v] = ((vm >> v) & 1u) ? s[v] : -1e30f;
    }
    float tm = max16(s);
    tm = fmaxf(tm, __shfl_xor(tm, 32)) + off;
    const float mn = fmaxf(m, tm);
    if (__any(mn > m)) { const float al = fexp2(m - mn); l *= al; o[0] = o[0] * al; o[1] = o[1] * al; }
    m = mn; const float ml = mn - off;
    float ps = 0.f;
    if (full) {
#pragma unroll
        for (int v = 0; v < 16; ++v) { const float p = fexp2(s[v] - ml); s[v] = p; ps += p; }
    } else {
#pragma unroll
        for (int v = 0; v < 16; ++v) { const float p = ((vm >> v) & 1u) ? fexp2(s[v] - ml) : 0.f; s[v] = p; ps += p; }
    }
    l += ps;
}

__device__ __forceinline__ void glds16(const void* gsrc, unsigned lds_dst) { unsigned keep;
    asm volatile("s_mov_b32 %0, m0\n\ts_mov_b32 m0, %2\n\ts_nop 0\n\tglobal_load_lds_dwordx4 %1, off\n\ts_mov_b32 m0, %0" : "=&s"(keep) : "v"(gsrc), "s"(lds_dst) : "memory"); }
struct AttnSrc { const bf16_t *Kc, *Vc, *Kw, *Vw, *Ks, *Vs; };
__device__ __forceinline__ void ring_load(const AttnSrc& S, int type, int key0, unsigned slot_addr, int wave, int lane) {
    const int q = lane & 7;
#pragma unroll
    for (int e = 0; e < 2; ++e) {
        const int pr = (2 * wave + e) & 7, i = 8 * pr + (lane >> 3), c = q ^ ((i >> 1) & 7);
        const bf16_t* src;
        if (wave < 4) { const bf16_t* kb = type == 0 ? S.Kc : (type == 1 ? S.Kw : S.Ks); const int il = i & 31, kp = (il & ~12) | ((il & 4) << 1) | ((il & 8) >> 1);
                        src = kb + (size_t)(key0 + (i & 32) + kp) * 64 + 8 * c; }
        else { const bf16_t* vb = type == 0 ? S.Vc : (type == 1 ? S.Vw : S.Vs); const int ldv = type == 0 ? 256 : 4096; src = vb + (size_t)i * ldv + key0 + 8 * c; }
        glds16(src, slot_addr + (wave < 4 ? 0u : 8192u) + (unsigned)pr * 1024u);
    }
}
#define RING_WAIT_BAR() do { asm volatile("s_waitcnt vmcnt(4)" ::: "memory"); __builtin_amdgcn_s_barrier(); asm volatile("" ::: "memory"); } while (0)
#define RING_DRAIN_BAR() do { asm volatile("s_waitcnt vmcnt(0) lgkmcnt(0)" ::: "memory"); __builtin_amdgcn_s_barrier(); asm volatile("" ::: "memory"); } while (0)
__device__ __forceinline__ void ring_read_k(bf16x8 (&kf)[4], const LAS unsigned char* slot, int hf, int rowoff, int sw, int h) {
#pragma unroll
    for (int ks = 0; ks < 4; ++ks) kf[ks] = *(const LAS bf16x8*)(slot + hf * 4096 + rowoff + (((2 * ks + h) * 16) ^ sw));
}
__device__ __forceinline__ void ring_read_v(bf16x8 (&vf)[4], const LAS unsigned char* slot, int hf, int rowoff, int sw, int h) {
#pragma unroll
    for (int s = 0; s < 2; ++s)
#pragma unroll
        for (int dt = 0; dt < 2; ++dt) vf[s * 2 + dt] = *(const LAS bf16x8*)(slot + 8192 + dt * 4096 + rowoff + (((4 * hf + 2 * s + h) * 16) ^ sw));
}

__device__ __forceinline__ void attn_item(const Ctx& X, const AttnArgs& A, int b, int g, int qt, const int mode = 3) {
    int lane_ = X.lane; asm volatile("" : "+v"(lane_));
    const int lane = lane_, h = lane >> 5, j = lane & 31, ql = j >> 2, r = j & 3, wave = X.wave;
    const int tb = qt * 64, t0 = tb + wave * 8, t = t0 + ql, head = g * 4 + r, bg = b * 4 + g, cur = qt;
    const size_t row = (size_t)b * SEQ + t;
    const int rowoff = j * 128, sw = ((j >> 1) & 7) * 16;
    RING_DRAIN_BAR();
    bf16x8 qf[4];
#pragma unroll
    for (int ks = 0; ks < 4; ++ks) qf[ks] = *(const bf16x8*)(A.Q + row * D + head * 64 + ks * 16 + h * 8);
    const float sl2 = fexp2(-0.5f * (float)(head + 1)) * LOG2E;
    const float g0 = A.gates[row * 48 + head], g1 = A.gates[row * 48 + 16 + head], g2 = A.gates[row * 48 + 32 + head];
    f32x16 o[2], bc;
#pragma unroll
    for (int v = 0; v < 16; ++v) { o[0][v] = 0.f; o[1][v] = 0.f; }
    LAS float* cm = (LAS float*)(X.lds + wave * 8192);
    LAS float* ob = cm + lane;
    const LAS unsigned char* ring = X.lds + 65536;
    const unsigned ring_a = (unsigned)(unsigned long long)ring;
    LAS unsigned long long* ux = (LAS unsigned long long*)(X.lds + 131072);
    AttnSrc S; S.Kc = A.kcmp + (size_t)bg * 256 * 64; S.Vc = A.vcmpT + (size_t)bg * 64 * 256; S.Kw = A.KW + (size_t)bg * 4096 * 64; S.Vw = A.VWt + (size_t)bg * 64 * 4096;
    S.Ks = A.KS + (size_t)bg * 4096 * 64; S.Vs = A.VSt + (size_t)bg * 64 * 4096;
    float m, l;
    bf16x8 kc[4], vf[4];

    const int ntb = (((tb + 63 - 31) >> 4) >> 5) + 1, nb1 = (ntb + 1) >> 1;
    const int nmax_w = (t0 + 7 - 31) >> 4, nmax_t = (t - 31) >> 4, nmin_w = (t0 - 31) >> 4;
    const int ntile = nmax_w >= 0 ? (nmax_w >> 5) + 1 : 0;
#pragma unroll
    for (int v = 0; v < 16; ++v) bc[v] = 16.f * sl2 * (float)(8 * h + 16 * (v >> 3) + (v & 7)) + sl2 * (float)(31 - ql);
    m = -1e30f; l = 0.f;
    {
        const int n1 = 2 * nb1;
#define CMP_BLK(i) ((i) < nb1 ? nb1 - 1 - (i) : 2 * nb1 - 1 - min((i), n1 - 1))
        for (int i = 0; i < 3; ++i) ring_load(S, 0, CMP_BLK(i) * 64, ring_a + (unsigned)(i & 3) * 16384u, wave, lane);
        float inv = 0.f;
#pragma unroll 1
        for (int i = 0; i < n1; ++i) {
            RING_WAIT_BAR();
            ring_load(S, 0, CMP_BLK(i + 3) * 64, ring_a + (unsigned)((i + 3) & 3) * 16384u, wave, lane);
            const int blk = CMP_BLK(i); const LAS unsigned char* slot = ring + (i & 3) * 16384;
            if (i == nb1) { l += __shfl_xor(l, 32); inv = 1.f / fmaxf(l, 1e-30f); }
#pragma unroll 1
            for (int hf = 1; hf >= 0; --hf) {
                const int tile = 2 * blk + hf;
                if (tile < ntile) {
                    ring_read_k(kc, slot, hf, rowoff, sw, h);
                    const unsigned vm = run_mask(tile * 32 + 8 * h, 0, nmax_t) | (run_mask(tile * 32 + 16 + 8 * h, 0, nmax_t) << 8);
                    const float off = sl2 * (float)(512 * tile - t0);
                    if (i < nb1) {
                        f32x16 s = qk_mma(kc, qf, bc);
                        softmax_step(s, tile * 32 + 31 <= nmin_w, vm, off, m, l, o);
                    } else {
                        ring_read_v(vf, slot, hf, rowoff, sw, h);
                        f32x16 s = qk_mma(kc, qf, bc);
                        const float ml = m - off;
#pragma unroll
                        for (int v = 0; v < 16; ++v) {
                            const float p = ((vm >> v) & 1u) ? fexp2(s[v] - ml) * inv : 0.f; s[v] = p;
                            float x = p; x += __shfl_xor(x, 1); x += __shfl_xor(x, 2);
                            if ((v & 3) == r) cm[ql * 256 + tile * 32 + 16 * (v >> 3) + 8 * h + (v & 7)] = x;
                        }
                        pv_mma(o, vf, s);
                    }
                }
            }
        }
#undef CMP_BLK
    }
    RING_DRAIN_BAR();
    const int wb1b = qt, wb0b = max(tb - 511, 0) >> 6, nWb = wb1b - wb0b + 1;
    const int kt0 = max(t0 - 511, 0) >> 5, kt1 = (t0 + 7) >> 5;
    int li = 0;
    for (; li < 3 && li < nWb; ++li) ring_load(S, 1, (wb1b - li) * 64, ring_a + (unsigned)(li & 3) * 16384u, wave, lane);
    unsigned long long mq = 0ull, uni = 0ull, alln = ~0ull;
    {
        const unsigned long long causal = cur >= 63 ? ~0ull : ((1ull << (cur + 1)) - 1ull);
        if (cur + 1 <= 16) { mq = causal; uni = causal; alln = causal; }
        else {
#pragma unroll 1
            for (int q = 0; q < 8; ++q) {
                float iv;
                if (lane == 0 || lane == cur || lane == cur - 1) iv = 1e30f;
                else if (lane > cur) iv = -1.f;
                else { const LAS float* c = cm + q * 256 + 4 * lane; iv = (((c[-1] + c[0]) + c[1]) + c[2]) + c[3]; }
                const int ib = __float_as_int(iv);
                int Tb = 0; unsigned long long ge = causal;
#pragma unroll 1
                for (int bit = 30; bit >= 0; --bit) {
                    const int cand = Tb | (1 << bit); const unsigned long long bm = __ballot(ib >= cand); const int c = __popcll(bm);
                    if (c >= 16) { Tb = cand; ge = bm; if (c == 16) break; }
                }
                unsigned long long mk = ge;
                if (__popcll(ge) > 16) {
                    const unsigned long long gt = __ballot(ib > Tb); unsigned long long eq = ge & ~gt; int need = 16 - __popcll(gt); mk = gt;
                    for (; need > 0; --need) { const unsigned long long low = eq & (0ull - eq); mk |= low; eq ^= low; }
                }
                mk &= causal;
                uni |= mk; alln &= mk; if (ql == q) mq = mk;
            }
        }
    }
    if (lane == 0) ux[wave] = uni;
    asm volatile("s_waitcnt lgkmcnt(0)" ::: "memory"); __builtin_amdgcn_s_barrier(); asm volatile("" ::: "memory");
    unsigned long long bun = 0ull;
#pragma unroll
    for (int w = 0; w < 8; ++w) bun |= ux[w];
    { const unsigned lo = __builtin_amdgcn_readfirstlane((unsigned)bun), hi = __builtin_amdgcn_readfirstlane((unsigned)(bun >> 32)); bun = ((unsigned long long)hi << 32) | lo; }
    const int n2 = nWb + __popcll(bun);
    unsigned long long lmask = bun; int ljb = 0;
#define LOAD_STEP2() do { int ty_, k0_; \
        if (li < nWb) { ty_ = 1; k0_ = (wb1b - li) * 64; } \
        else { ty_ = 2; if (li < n2) { ljb = 63 - __builtin_clzll(lmask); lmask &= ~(1ull << ljb); } k0_ = ljb * 64; } \
        ring_load(S, ty_, k0_, ring_a + (unsigned)(li & 3) * 16384u, wave, lane); ++li; } while (0)
    while (li < 3) LOAD_STEP2();
#pragma unroll
    for (int v = 0; v < 16; ++v) { ob[v * 64] = g0 * o[0][v]; ob[(16 + v) * 64] = g0 * o[1][v]; o[0][v] = 0.f; o[1][v] = 0.f; }
#pragma unroll
    for (int v = 0; v < 16; ++v) bc[v] = sl2 * (float)(8 * h + 16 * (v >> 3) + (v & 7) - ql);
    m = -1e30f; l = 0.f;
    int ci = 0;
#pragma unroll 1
    for (; ci < nWb; ++ci) {
        RING_WAIT_BAR();
        LOAD_STEP2();
        const int wb = wb1b - ci; const LAS unsigned char* slot = ring + (ci & 3) * 16384;
#pragma unroll 1
        for (int hf = 1; hf >= 0; --hf) {
            const int kt = 2 * wb + hf, key0 = kt * 32;
            if (kt >= kt0 && kt <= kt1 && (mode & 2)) {
                ring_read_k(kc, slot, hf, rowoff, sw, h); ring_read_v(vf, slot, hf, rowoff, sw, h);
                f32x16 s = qk_mma(kc, qf, bc);
                const bool full = (key0 + 31 <= t0) && (key0 >= t0 + 7 - 511);
                const unsigned vm = run_mask(key0 + 8 * h, t - 511, t) | (run_mask(key0 + 16 + 8 * h, t - 511, t) << 8);
                softmax_step(s, full, vm, sl2 * (float)(key0 - t0), m, l, o);
                pv_mma(o, vf, s);
            }
        }
    }
    {
        l += __shfl_xor(l, 32);
        const float sc = g2 / fmaxf(l, 1e-30f);
#pragma unroll
        for (int v = 0; v < 16; ++v) { ob[v * 64] += sc * o[0][v]; ob[(16 + v) * 64] += sc * o[1][v]; o[0][v] = 0.f; o[1][v] = 0.f; }
    }
    m = -1e30f; l = 0.f;
    {
        unsigned long long cmask = bun;
#pragma unroll 1
        for (; ci < n2; ++ci) {
            RING_WAIT_BAR();
            LOAD_STEP2();
            const int jb = 63 - __builtin_clzll(cmask); cmask &= ~(1ull << jb);
            const LAS unsigned char* slot = ring + (ci & 3) * 16384;
            if (((uni >> jb) & 1ull) && (mode & 1)) {
                const bool mine = (mq >> jb) & 1ull;
#pragma unroll 1
                for (int hf = 1; hf >= 0; --hf) {
                    const int key0 = jb * 64 + hf * 32;
                    if (key0 <= t0 + 7) {
                        ring_read_k(kc, slot, hf, rowoff, sw, h); ring_read_v(vf, slot, hf, rowoff, sw, h);
                        f32x16 s = qk_mma(kc, qf, bc);
                        const bool full = ((alln >> jb) & 1ull) && (key0 + 31 <= t0);
                        const unsigned vm = mine ? (run_mask(key0 + 8 * h, 0, t) | (run_mask(key0 + 16 + 8 * h, 0, t) << 8)) : 0u;
                        softmax_step(s, full, vm, sl2 * (float)(key0 - t0), m, l, o);
                        pv_mma(o, vf, s);
                    }
                }
            }
        }
    }
#undef LOAD_STEP2
    {
        l += __shfl_xor(l, 32);
        const float sc = g1 / fmaxf(l, 1e-30f);
#pragma unroll
        for (int v = 0; v < 16; ++v) { o[0][v] = ob[v * 64] + sc * o[0][v]; o[1][v] = ob[(16 + v) * 64] + sc * o[1][v]; }
    }
    bf16_t* op = A.O + row * D + head * 64 + 4 * h;
#pragma unroll
    for (int dt = 0; dt < 2; ++dt)
#pragma unroll
        for (int v4 = 0; v4 < 4; ++v4) { u32x2 w; w.x = cvt_pk_bf16(o[dt][4 * v4], o[dt][4 * v4 + 1]); w.y = cvt_pk_bf16(o[dt][4 * v4 + 2], o[dt][4 * v4 + 3]); *(u32x2*)(op + 32 * dt + 8 * v4) = w; }
}
__device__ __forceinline__ void attn_phase(const Ctx& X, const AttnArgs& A, const int mode = 3) {
    for (int i = 0;; ++i) {
        const int k = i * X.G + ((i & 1) ? X.G - 1 - X.bid : X.bid);
        if (i * X.G >= 2048) break;
        if (k < 2048) { const int qt = 63 - (k >> 5), bg = k & 31; attn_item(X, A, bg >> 2, bg & 3, qt, mode); }
    }
    RING_DRAIN_BAR();
}
#define XB_TMO      128
#define XB_XCNT(j)  (256  + 64 * (j))
#define XB_XSUB(j)  (1280 + 64 * (j))
#define XB_XGEN(j)  (2304 + 64 * (j))
#define XB_TOP      3328
#define XB_TOPGEN   3392
#define XCD_BAR_WORDS 3456
#define XB_SPIN_CAP (1u << 18)

__device__ __forceinline__ unsigned xb_ld(unsigned* p)              { return __hip_atomic_load(p, __ATOMIC_RELAXED, __HIP_MEMORY_SCOPE_AGENT); }
__device__ __forceinline__ unsigned xb_add(unsigned* p, unsigned v) { return __hip_atomic_fetch_add(p, v, __ATOMIC_RELAXED, __HIP_MEMORY_SCOPE_AGENT); }
__device__ __forceinline__ unsigned xb_xcc_id() { return (unsigned)__builtin_amdgcn_s_getreg((3 << 11) | 20) & 0xFu; }
#define XB_SPIN(cond, bar) do { unsigned _sp = 0; while (cond) { __builtin_amdgcn_s_sleep(1); \
    if ((++_sp & 255u) == 0u) { if (xb_ld(&(bar)[XB_TMO])) break; if (_sp > XB_SPIN_CAP) { atomicAdd(&(bar)[XB_TMO], 1u); break; } } } } while (0)

struct XcdBarrier {
    unsigned* bar; unsigned x;
    volatile LAS unsigned* st;
};

__device__ __forceinline__ XcdBarrier xcd_barrier_post(unsigned* bar, volatile LAS unsigned* st) {
    XcdBarrier b; b.bar = bar; b.x = xb_xcc_id(); b.st = st;
    if (threadIdx.x == 0) (void)xb_add(&bar[XB_XCNT(b.x)], 1u);
    return b;
}
__device__ __forceinline__ void xcd_barrier_complete(unsigned* bar, unsigned x, unsigned& nloc, unsigned& nx) {
    const unsigned G = gridDim.x * gridDim.y * gridDim.z;
    unsigned sum, cnt, mine, sp = 0u;
    for (;;) {
        sum = 0u; cnt = 0u; mine = 0u;
#pragma unroll
        for (unsigned j = 0; j < 16; ++j) { const unsigned c = xb_ld(&bar[XB_XCNT(j)]); sum += c; cnt += (c > 0u) ? 1u : 0u; mine = (j == x) ? c : mine; }
        if (sum == G) break;
        __builtin_amdgcn_s_sleep(1);
        if ((++sp & 255u) == 0u) { if (xb_ld(&bar[XB_TMO])) break; if (sp > XB_SPIN_CAP) { atomicAdd(&bar[XB_TMO], 1u); break; } }
    }
    nloc = mine > 0u ? mine : 1u; nx = cnt > 0u ? cnt : 1u;
}

__device__ __forceinline__ void xcd_barrier(const XcdBarrier& b) {
    asm volatile("s_waitcnt vmcnt(0)" ::: "memory");
    __syncthreads();
    if (threadIdx.x == 0) {
        unsigned* bar = b.bar;
        __builtin_amdgcn_s_waitcnt(0);
        unsigned nloc = b.st[0], nx = b.st[1];
        if (nloc == 0u) { xcd_barrier_complete(bar, b.x, nloc, nx); b.st[0] = nloc; b.st[1] = nx; }
        const unsigned old = xb_add(&bar[XB_XSUB(b.x)], 1u);
        const unsigned gen = old / nloc;
        if (old + 1u == (gen + 1u) * nloc) {
            __builtin_amdgcn_fence(__ATOMIC_RELEASE, "agent");
            asm volatile("s_waitcnt vmcnt(0)" ::: "memory");
            const unsigned og = xb_add(&bar[XB_TOP], 1u);
            const unsigned tg = og / nx;
            if (og + 1u == (tg + 1u) * nx) xb_add(&bar[XB_TOPGEN], 1u);
            else XB_SPIN(xb_ld(&bar[XB_TOPGEN]) == tg, bar);
            __builtin_amdgcn_fence(__ATOMIC_ACQUIRE, "agent");
            xb_add(&bar[XB_XGEN(b.x)], 1u);
            asm volatile("s_waitcnt vmcnt(0)" ::: "memory");
        } else {
            XB_SPIN(xb_ld(&bar[XB_XGEN(b.x)]) == gen, bar);
            __builtin_amdgcn_fence(__ATOMIC_ACQUIRE, "agent");
            asm volatile("s_waitcnt vmcnt(0)" ::: "memory");
        }
    }
    __syncthreads();
}

__global__ void __launch_bounds__(512, 2) yoco_fwd(Params Pk) {
    extern __shared__ __attribute__((aligned(16))) unsigned char lds_raw[];
    cg::grid_group grid = cg::this_grid();
    { LAS Params* LP = (LAS Params*)((LAS unsigned char*)lds_raw); if (threadIdx.x == 0) {
#pragma unroll
        for (int i = 0; i < 19; ++i) LP->in[i] = Pk.in[i];
        LP->out = Pk.out; LP->ws = Pk.ws; LP->ph_lo = Pk.ph_lo; LP->ph_hi = Pk.ph_hi; } }
    volatile LAS unsigned* xb_st = (volatile LAS unsigned*)((LAS unsigned char*)lds_raw + 192);
    if (threadIdx.x == 0) { xb_st[0] = 0u; xb_st[1] = 0u; }
    unsigned* const xb_words = (unsigned*)(Pk.ws + WS_BAR);
    if (blockIdx.x == 0) { for (int i = threadIdx.x; i < XCD_BAR_WORDS; i += 512) __hip_atomic_store(xb_words + i, 0u, __ATOMIC_RELAXED, __HIP_MEMORY_SCOPE_AGENT); }
    asm volatile("s_waitcnt vmcnt(0)" ::: "memory");
    __syncthreads();
    const int ph_lo = Pk.ph_lo, ph_hi = Pk.ph_hi;
    grid.sync();
    (void)xcd_barrier_post(xb_words, xb_st);
    {
        int tid_ = threadIdx.x, g_ = gridDim.x, b_ = blockIdx.x; asm volatile("" : "+v"(tid_), "+s"(g_), "+s"(b_));
        Ctx X; X.lds = (LAS unsigned char*)lds_raw + 256; X.tid = tid_; X.lane = X.tid & 63; X.wave = __builtin_amdgcn_readfirstlane(X.tid >> 6); X.G = g_; X.bid = b_;
        p0_phase(X, (const LAS Params*)(X.lds - 256)); __syncthreads();
        XcdBarrier xbar; xbar.bar = xb_words; xbar.x = xb_xcc_id(); xbar.st = xb_st; xcd_barrier(xbar);
    }
    int dupflag_ = 0; (void)dupflag_;
    for (int ph = ph_lo < 1 ? 1 : ph_lo; ph < ph_hi; ++ph) {
        int cur_st_ = -1; (void)cur_st_;
        asm volatile("" ::: "memory");
        int tid_ = threadIdx.x, g_ = gridDim.x, b_ = blockIdx.x; asm volatile("" : "+v"(tid_), "+s"(g_), "+s"(b_));
        Ctx X; X.lds = (LAS unsigned char*)lds_raw + 256; X.tid = tid_; X.lane = X.tid & 63; X.wave = __builtin_amdgcn_readfirstlane(X.tid >> 6); X.G = g_; X.bid = b_;
        Params P;
        { const LAS Params* LP = (const LAS Params*)(X.lds - 256);
          P.in[I_X] = uptr(LP->in[I_X]); P.in[I_NORMG] = uptr(LP->in[I_NORMG]); P.in[I_ACONV] = uptr(LP->in[I_ACONV]); P.in[I_KVNG] = uptr(LP->in[I_KVNG]); P.in[I_CW2] = uptr(LP->in[I_CW2]);
          P.out = uptr(LP->out); P.ws = uptr(LP->ws); }
        unsigned char* ws = P.ws;
        bf16_t* const H = (bf16_t*)(ws + WS_H); bf16_t* const HID = (bf16_t*)(ws + WS_HID); bf16_t* const HID2 = (bf16_t*)(ws + WS_HID + 64 * MiB); bf16_t* const Y = (bf16_t*)(ws + WS_Y);
        float* const PART = (float*)(ws + WS_PART); float* const GATES = (float*)(ws + WS_GATES);
        const float* const MOD = (const float*)(ws + WS_MOD); const float* const KVMOD = (const float*)(ws + WS_KVMOD);
        const float* const NG = P.in[I_NORMG];
        if (ph == 1) {
            UpdArgs U{}; U.xin = P.in[I_X]; U.xout = P.out; U.bstride = 9216; U.gpre = NG; U.shift = MOD; U.scale = MOD + 1024; U.h = H;

#ifndef SKIP_UPD
update_phase(X, U);
#endif

        } else {
            int p = ph - 2, l, st;
            if (p < 20) { l = p / 10; st = p % 10; } else if (p < 23) { l = 2; st = 10 + (p - 20); } else { p -= 23; l = 2 + p / 10; st = p % 10; }
            cur_st_ = st;
            const float* modl = MOD + (size_t)l * 8 * 9216; const float* ngl = NG + (size_t)l * 6 * 1024;
            if (st == 0 || st == 7) {
                const int s = st == 0 ? 0 : 1;
                pg8::Gemm g{H, (const bf16_t*)(ws + WS_FIN) + (size_t)(l * 2 + s) * 5632 * 1024, T, 5632, 1024, 1024}; pg8::StaticOrder S; S.init(T, 5632, X.G, X.bid);
                pg8::EpiSwiglu E{HID};

#ifndef REP_G1
#define REP_G1 1
#endif
for (int rep_ = 0; rep_ < REP_G1; ++rep_) pg8::gemm_phase<pg8::EpiSwiglu, pg8::StaticOrder, true, true>(X.lds, g, S, E, X.tid);

            } else if (st == 1 || st == 8 || st == 5) {
                pg8::Gemm g;
                if (st == 5) { g = pg8::Gemm{l < 2 ? H : HID2, l < 2 ? (const bf16_t*)(ws + WS_AOUT) + (size_t)l * 1024 * 1024 : (const bf16_t*)(ws + WS_BOUT) + (size_t)(l - 2) * 1024 * 1024, T, 1024, 1024, 1024}; }
                else { g = pg8::Gemm{HID, (const bf16_t*)(ws + WS_FOUT) + (size_t)(l * 2 + (st == 8 ? 1 : 0)) * 1024 * 2816, T, 1024, 2816, 2816}; }
                pg8::StaticOrder S; S.init(T, 1024, X.G, X.bid);
                pg8::EpiY E{Y, PART};

pg8::gemm_phase<pg8::EpiY, pg8::StaticOrder, true, true>(X.lds, g, S, E, X.tid);

            } else if (st == 2 || st == 6 || st == 9) {
                const int sub = st == 2 ? 0 : (st == 6 ? 1 : 2);
                UpdArgs U{}; U.xin = P.out; U.xout = P.out; U.y = Y; U.part = PART; U.gate = modl + (sub * 3 + 2) * 1024; U.gpost = ngl + (sub * 2 + 1) * 1024; U.w = sub == 1 ? 1.0f : 0.5f; U.bstride = 9216;
                if (sub < 2) { U.gpre = ngl + ((sub + 1) * 2) * 1024; U.shift = modl + ((sub + 1) * 3) * 1024; U.scale = modl + ((sub + 1) * 3 + 1) * 1024; U.h = H; }
                else if (l < 3) { U.gpre = ngl + 6 * 1024; U.shift = modl + 8 * 9216; U.scale = modl + 8 * 9216 + 1024; U.h = H;
                    if (l == 1) { U.gpre2 = P.in[I_KVNG]; U.shift2 = KVMOD; U.scale2 = KVMOD + 1024; U.h2 = HID; } }

#ifndef SKIP_UPD
update_phase(X, U);
#endif

            } else if (st == 3) {
                if (l < 2) {
                    pg8::Gemm g{H, (const bf16_t*)(ws + WS_AIN) + (size_t)l * 3072 * 1024, T, 3072, 1024, 1024}; pg8::StaticOrder S; S.init(T, 3072, X.G, X.bid);
                    pg8::EpiConvIn E{HID, HID2};

#ifndef SKIP_G3
pg8::gemm_phase<pg8::EpiConvIn, pg8::StaticOrder, true, true>(X.lds, g, S, E, X.tid);
#endif

                } else {
                    pg8::Gemm g{H, (const bf16_t*)(ws + WS_BIN) + (size_t)(l - 2) * 1280 * 1024, T, 1280, 1024, 1024}; pg8::StaticOrder S; S.init(T, 1280, X.G, X.bid);
                    pg8::EpiQG E{HID, GATES};

#ifndef SKIP_G3B
pg8::gemm_phase<pg8::EpiQG, pg8::StaticOrder, true, true>(X.lds, g, S, E, X.tid);
#endif

                }
            } else if (st == 4) {
                if (l < 2) {
#ifndef SKIP_CONV
conv_phase(X, HID, HID2, P.in[I_ACONV] + (size_t)l * 3 * 1024, H);
#endif
}
                else { AttnArgs A{HID, GATES, (const bf16_t*)(ws + WS_KCMP), (const bf16_t*)(ws + WS_VCMPT), (const bf16_t*)(ws + WS_KS), (const bf16_t*)(ws + WS_VST), (const bf16_t*)(ws + WS_KW), (const bf16_t*)(ws + WS_VWT), HID2};

#ifndef REP_ATTN
#define REP_ATTN 1
#endif
attn_phase(X, A);
#ifdef PROBE_ATTN_MODE
{ AttnArgs A2 = A; A2.O = Y; attn_phase(X, A2, PROBE_ATTN_MODE); }
#endif
 }
            } else if (st == 10) {
                pg8::Gemm g{HID, (const bf16_t*)(ws + WS_KVW), T, 1536, 1024, 1024}; pg8::StaticOrder S; S.init(T, 1536, X.G, X.bid);
                pg8::EpiKV E{(bf16_t*)(ws + WS_KC), (bf16_t*)(ws + WS_KS), (bf16_t*)(ws + WS_KW), (bf16_t*)(ws + WS_VST), (bf16_t*)(ws + WS_VWT)};

#ifndef SKIP_GK
pg8::gemm_phase<pg8::EpiKV, pg8::StaticOrder, true, true>(X.lds, g, S, E, X.tid);
#endif

            } else if (st == 11) {
                pg8::Gemm g{(const bf16_t*)(ws + WS_KC), (const bf16_t*)(ws + WS_CW1), 16384, 512, 2048, 1024}; pg8::DiagOrder S{X.G, X.bid};
                pg8::EpiCmp1 E{(bf16_t*)(ws + WS_HIDC), (const float*)(ws + WS_CBIAS)};

#ifndef SKIP_CM1
pg8::gemm_phase<pg8::EpiCmp1, pg8::DiagOrder, true, true>(X.lds, g, S, E, X.tid);
#endif

            } else if (st == 12) {

#ifndef SKIP_CM2
cmp2_phase(X, (const bf16_t*)(ws + WS_HIDC), P.in[I_CW2], (bf16_t*)(ws + WS_KCMP), (bf16_t*)(ws + WS_VCMPT));
#endif

            }
        }
        if (ph + 1 < ph_hi) { XcdBarrier xbar; xbar.bar = (unsigned*)(ws + WS_BAR); xbar.x = xb_xcc_id(); xbar.st = (volatile LAS unsigned*)((LAS unsigned char*)lds_raw + 192); xcd_barrier(xbar);
#ifdef PROBE_EXTRA_SYNC
            xcd_barrier(xbar);
#endif
        }
#ifdef PROBE_DUP_ST
        if (cur_st_ == PROBE_DUP_ST && !dupflag_) { dupflag_ = 1; --ph; } else dupflag_ = 0;
#endif
    }
}

extern "C" void kernel_launch(void* const* d_in, const int* in_sizes, int n_in, void* d_out, int out_size, void* d_ws, size_t ws_size, hipStream_t stream) {
    static int grid = 0;
    if (grid == 0) {
        if (n_in != 19 || out_size != T * D || ws_size < WS_END) { fprintf(stderr, "kernel_launch: unexpected shapes (n_in %d, out %d, ws %zu < %zu)\n", n_in, out_size, ws_size, (size_t)WS_END); grid = -1; return; }
        int dev = 0, cus = 0, per_cu = 0;
        (void)hipGetDevice(&dev); (void)hipDeviceGetAttribute(&cus, hipDeviceAttributeMultiprocessorCount, dev);
        if (hipFuncSetAttribute((const void*)yoco_fwd, hipFuncAttributeMaxDynamicSharedMemorySize, LDS_BYTES) != hipSuccess) { fprintf(stderr, "kernel_launch: hipFuncSetAttribute failed\n"); grid = -1; return; }
        if (hipOccupancyMaxActiveBlocksPerMultiprocessor(&per_cu, (const void*)yoco_fwd, 512, LDS_BYTES) != hipSuccess || per_cu < 1) { fprintf(stderr, "kernel_launch: occupancy query says %d\n", per_cu); per_cu = 1; }
        (void)hipGetLastError();
        grid = cus * per_cu;
    }
    if (grid < 0) return;
    Params p{};
    for (int i = 0; i < 19; ++i) p.in[i] = (const float*)d_in[i];
    p.out = (float*)d_out; p.ws = (unsigned char*)d_ws;
    p.ph_lo = 0; p.ph_hi = NPH;
    void* args[] = {&p};
    hipError_t e = hipLaunchCooperativeKernel((const void*)yoco_fwd, dim3(grid), dim3(512), args, LDS_BYTES, stream);
    if (e != hipSuccess) fprintf(stderr, "kernel_launch: cooperative launch failed: %s (grid %d)\n", hipGetErrorString(e), grid);
}
```

```cpp
#include <hip/hip_runtime.h>
#include <hip/hip_cooperative_groups.h>
#include <cstdio>
#include <cstdint>
namespace cg = cooperative_groups;
namespace pg8 {
#define PG8_LAS __attribute__((address_space(3)))
typedef unsigned short bf16_t;
typedef short bf16x8 __attribute__((ext_vector_type(8)));
typedef float f32x4 __attribute__((ext_vector_type(4)));
typedef unsigned u32x4 __attribute__((ext_vector_type(4)));
constexpr int BM = 256, BK = 64, HALF = 128, HTB = HALF * BK * 2  , STAGE_BYTES = 8 * HTB, NXCD = 8, WGM = 8;

__host__ __device__ __forceinline__ int lds_byte(int r, int c) { const int st = (r >> 4) * 2 + (c >> 5), rr = r & 15, cc = c & 31, ob = rr * 64 + cc * 2; return st * 1024 + (ob ^ (((ob >> 9) & 1) << 5)); }
__host__ __device__ __forceinline__ void stage_rc(int b, int& R, int& C) { const int st = b / 1024, sb = b % 1024, swz = sb ^ (((sb >> 9) & 1) << 5); R = (st >> 1) * 16 + swz / 64; C = (st & 1) * 32 + (swz % 64) / 2; }
__host__ __device__ __forceinline__ int perm32(int rho) { const int n = rho >> 4, i = rho & 15; return 8 * (i >> 2) + 4 * n + (i & 3); }

struct Unit { int pm, pn; };
struct Gemm { const bf16_t* A; const bf16_t* Bt; int M, N, K, lda; };

struct StaticOrder {
    int nM, nN, nwg, G, c;
    __host__ __device__ void init(int M, int N, int G_, int c_) { nM = M / BM; nN = N / BM; nwg = nM * nN; G = G_; c = c_; }
    __host__ __device__ bool next(int i, Unit& u) const {
        const long L = (long)i * G + c; if (L >= nwg) return false;
        int wgid = (int)L; { const int q = nwg / NXCD, r = nwg % NXCD, xcd = wgid % NXCD, off = wgid / NXCD; wgid = (xcd < r ? xcd * (q + 1) : r * (q + 1) + (xcd - r) * q) + off; }
        const int nig = WGM * nN, gid = wgid / nig, fm = gid * WGM, gsz = (nM - fm) < WGM ? (nM - fm) : WGM;
        u.pm = fm + ((wgid % nig) % gsz); u.pn = (wgid % nig) / gsz; return true;
    }
    __device__ __forceinline__ void a_ready(const Unit&) const {}
    __device__ __forceinline__ void done(const Unit&) const {}
};

__device__ __forceinline__ unsigned cvt_pk_bf16(float lo, float hi) { unsigned r; asm volatile("v_cvt_pk_bf16_f32 %0, %1, %2" : "=v"(r) : "v"(lo), "v"(hi)); return r; }
typedef float f32x2 __attribute__((ext_vector_type(2)));
__device__ __forceinline__ f32x2 gelu_pk(f32x2 v) {
    const f32x2 av = __builtin_elementwise_abs(v), d = av * 0.2316418882f + 1.0f;
    f32x2 t; t.x = __builtin_amdgcn_rcpf(d.x); t.y = __builtin_amdgcn_rcpf(d.y);
    f32x2 q = t * 0.5307027145f + (-0.7265760135f); q = q * t + 0.7107068705f; q = q * t + (-0.142248368f); q = q * t + 0.127414796f; q = q * t;
    const f32x2 s = (v * v) * (-0.72134752044f);
    f32x2 e; e.x = __builtin_amdgcn_exp2f(s.x); e.y = __builtin_amdgcn_exp2f(s.y);
    const f32x2 m = v * (q * e), r = v - m;
    f32x2 o; o.x = v.x < 0.f ? m.x : r.x; o.y = v.y < 0.f ? m.y : r.y; return o;
}


template <class Epi, class Sched, bool ALIGN_EPI = false, bool SP2 = false>
__device__ __forceinline__ void gemm_phase(PG8_LAS unsigned char* lds, const Gemm g, const Sched& S, const Epi& E, const int tid) {
    const int wid = __builtin_amdgcn_readfirstlane(tid >> 6), lane = tid & 63, wr = wid >> 2, wc = wid & 3, fr = lane & 15, fq = lane >> 4;
    const int K = g.K, nt = K / BK;
    unsigned voffA[2], voffB[2];
#pragma unroll
    for (int i = 0; i < 2; ++i) { int R, C; stage_rc(tid * 16 + i * 8192, R, C); const int Rb = Epi::PERM ? ((R & ~31) + perm32(R & 31)) : R;
        voffA[i] = (unsigned)(R * g.lda + C) * 2u; voffB[i] = (unsigned)(Rb * K + C) * 2u; }
    const size_t kstep = (size_t)(BK * 2);
    const size_t hstepB = (size_t)HALF * K * 2, hstepA = (size_t)HALF * g.lda * 2;
    const size_t tstepB = 2 * hstepB, tstepA = 2 * hstepA;
    const unsigned ldsw = (unsigned)wid * 1024u;
    const int aoff = lds_byte(wr * 64 + fr, fq * 8), boff = lds_byte(wc * 32 + fr, fq * 8);
#define PG8_SA(b, h) (((b) * 2 + (h)) * HTB)
#define PG8_SB(b, h) ((4 + (b) * 2 + (h)) * HTB)
#define PG8_STAGE(bufoff, gbase, voff) do { _Pragma("unroll") for (int _i = 0; _i < 2; ++_i) \
        __builtin_amdgcn_global_load_lds((const unsigned*)((const char*)(gbase) + (voff)[_i]), (PG8_LAS unsigned*)(lds + (bufoff) + ldsw + _i * 8192), 16, 0, 0); } while (0)
#define PG8_LDA(dst, b, h) do { _Pragma("unroll") for (int m = 0; m < 4; ++m) _Pragma("unroll") for (int k = 0; k < 2; ++k) dst[m][k] = *(const PG8_LAS bf16x8*)(lds + PG8_SA(b, h) + aoff + m * 2048 + k * 1024); } while (0)
#define PG8_LDB(dst, b, h) do { _Pragma("unroll") for (int n = 0; n < 2; ++n) _Pragma("unroll") for (int k = 0; k < 2; ++k) dst[n][k] = *(const PG8_LAS bf16x8*)(lds + PG8_SB(b, h) + boff + n * 2048 + k * 1024); } while (0)
#define PG8_MMA(ai, bj, At, Bt) do { __builtin_amdgcn_s_setprio(1); _Pragma("unroll") for (int m = 0; m < 4; ++m) _Pragma("unroll") for (int n = 0; n < 2; ++n) _Pragma("unroll") for (int k = 0; k < 2; ++k) \
        acc[ai][bj][m][n] = __builtin_amdgcn_mfma_f32_16x16x32_bf16(Bt[n][k], At[m][k], acc[ai][bj][m][n], 0, 0, 0); __builtin_amdgcn_s_setprio(0); } while (0)
#define PG8_WAIT_V(n) asm volatile("s_waitcnt vmcnt(" #n ")" ::: "memory")
#define PG8_WAIT_L(n) asm volatile("s_waitcnt lgkmcnt(" #n ")" ::: "memory")
#define PG8_BAR __builtin_amdgcn_s_barrier()
#define PG8_SCHED __builtin_amdgcn_sched_barrier(0)
    Unit cur, nxt; int ui = 0;
    if (!S.next(0, cur)) return;
    f32x4 acc[2][2][4][2];
#pragma unroll
    for (int a = 0; a < 2; ++a)
#pragma unroll
        for (int b = 0; b < 2; ++b)
#pragma unroll
            for (int m = 0; m < 4; ++m)
#pragma unroll
                for (int n = 0; n < 2; ++n) acc[a][b][m][n] = (f32x4){0.f, 0.f, 0.f, 0.f};
    bf16x8 At[4][2], B0[2][2], B1[2][2];
    const char* cA = (const char*)g.A + (size_t)cur.pm * tstepA; const char* cB = (const char*)g.Bt + (size_t)cur.pn * tstepB;
    S.a_ready(cur);
    if constexpr (SP2) {
        PG8_STAGE(PG8_SB(0, 0), cB, voffB); PG8_STAGE(PG8_SB(0, 1), cB + hstepB, voffB); PG8_STAGE(PG8_SA(0, 0), cA, voffA); PG8_STAGE(PG8_SA(0, 1), cA + hstepA, voffA);
        if (wr == 1) PG8_BAR;
        PG8_WAIT_V(2); PG8_BAR;
        PG8_STAGE(PG8_SB(1, 0), cB + kstep, voffB); PG8_STAGE(PG8_SA(1, 0), cA + kstep, voffA); PG8_STAGE(PG8_SB(1, 1), cB + hstepB + kstep, voffB);
        PG8_WAIT_V(6); PG8_BAR;
    } else {
        PG8_STAGE(PG8_SB(0, 0), cB, voffB); PG8_STAGE(PG8_SA(0, 0), cA, voffA); PG8_STAGE(PG8_SB(0, 1), cB + hstepB, voffB); PG8_STAGE(PG8_SA(0, 1), cA + hstepA, voffA);
        if (wr == 1) PG8_BAR;
        PG8_WAIT_V(4); PG8_BAR;
        PG8_STAGE(PG8_SB(1, 0), cB + kstep, voffB); PG8_STAGE(PG8_SA(1, 0), cA + kstep, voffA); PG8_STAGE(PG8_SB(1, 1), cB + hstepB + kstep, voffB);
        PG8_WAIT_V(6); PG8_BAR;
    }
    for (;;) {
        const bool has_next = S.next(ui + 1, nxt);
        const char* nA = has_next ? (const char*)g.A + (size_t)nxt.pm * tstepA : cA; const char* nB = has_next ? (const char*)g.Bt + (size_t)nxt.pn * tstepB : cB;
        for (int t = 0; t < nt; t += 2) {
            const bool last = (t == nt - 2);
            const char* a1 = cA + (size_t)(t + 1) * kstep;
            const char* a2 = last ? nA : cA + (size_t)(t + 2) * kstep; const char* b2 = last ? nB : cB + (size_t)(t + 2) * kstep;
            const char* a3 = a2 + kstep; const char* b3 = b2 + kstep;
            if (last && has_next) S.a_ready(nxt);
            if constexpr (SP2) {
            PG8_LDB(B0, 0, 0); PG8_LDB(B1, 0, 1); PG8_SCHED; PG8_LDA(At, 0, 0); PG8_STAGE(PG8_SA(1, 1), a1 + hstepA, voffA);
            PG8_WAIT_V(8); PG8_WAIT_L(0); PG8_BAR; PG8_MMA(0, 0, At, B0); PG8_MMA(0, 1, At, B1); PG8_BAR; PG8_SCHED;
            PG8_LDA(At, 0, 1); PG8_STAGE(PG8_SB(0, 0), b2, voffB); PG8_STAGE(PG8_SB(0, 1), b2 + hstepB, voffB); PG8_STAGE(PG8_SA(0, 0), a2, voffA);
            PG8_WAIT_V(8); PG8_WAIT_L(0); PG8_BAR; PG8_MMA(1, 0, At, B0); PG8_MMA(1, 1, At, B1); PG8_BAR; PG8_SCHED;
            PG8_LDB(B0, 1, 0); PG8_LDB(B1, 1, 1); PG8_SCHED; PG8_LDA(At, 1, 0); PG8_STAGE(PG8_SA(0, 1), a2 + hstepA, voffA);
            PG8_WAIT_V(8); PG8_WAIT_L(0); PG8_BAR; PG8_MMA(0, 0, At, B0); PG8_MMA(0, 1, At, B1); PG8_BAR; PG8_SCHED;
            PG8_LDA(At, 1, 1); PG8_STAGE(PG8_SB(1, 0), b3, voffB); PG8_STAGE(PG8_SB(1, 1), b3 + hstepB, voffB); PG8_STAGE(PG8_SA(1, 0), a3, voffA);
            PG8_WAIT_V(8); PG8_WAIT_L(0); PG8_BAR; PG8_MMA(1, 0, At, B0); PG8_MMA(1, 1, At, B1); PG8_BAR; PG8_SCHED;
            } else {
            PG8_LDB(B0, 0, 0); PG8_SCHED; PG8_LDA(At, 0, 0); PG8_STAGE(PG8_SA(1, 1), a1 + hstepA, voffA);
            PG8_WAIT_L(8); PG8_BAR; PG8_WAIT_L(0); PG8_MMA(0, 0, At, B0); PG8_BAR; PG8_SCHED;
            PG8_LDB(B1, 0, 1); PG8_STAGE(PG8_SB(0, 0), b2, voffB);
            PG8_BAR; PG8_WAIT_L(0); PG8_MMA(0, 1, At, B1); PG8_BAR;
            PG8_LDA(At, 0, 1); PG8_STAGE(PG8_SA(0, 0), a2, voffA);
            PG8_BAR; PG8_WAIT_L(0); PG8_MMA(1, 0, At, B0); PG8_BAR; PG8_SCHED;
            PG8_STAGE(PG8_SB(0, 1), b2 + hstepB, voffB);
            PG8_WAIT_V(6); PG8_BAR; PG8_MMA(1, 1, At, B1); PG8_BAR;
            PG8_LDB(B0, 1, 0); PG8_SCHED; PG8_LDA(At, 1, 0); PG8_STAGE(PG8_SA(0, 1), a2 + hstepA, voffA);
            PG8_WAIT_L(8); PG8_BAR; PG8_WAIT_L(0); PG8_MMA(0, 0, At, B0); PG8_BAR; PG8_SCHED;
            PG8_LDB(B1, 1, 1); PG8_STAGE(PG8_SB(1, 0), b3, voffB);
            PG8_BAR; PG8_WAIT_L(0); PG8_MMA(0, 1, At, B1); PG8_BAR;
            PG8_LDA(At, 1, 1); PG8_STAGE(PG8_SA(1, 0), a3, voffA);
            PG8_BAR; PG8_WAIT_L(0); PG8_MMA(1, 0, At, B0); PG8_BAR; PG8_SCHED;
            PG8_STAGE(PG8_SB(1, 1), b3 + hstepB, voffB);
            PG8_WAIT_V(6); PG8_BAR; PG8_MMA(1, 1, At, B1); PG8_BAR;
            }
        }
        if constexpr (ALIGN_EPI) { if (wr == 0) PG8_BAR; }
        if constexpr (!Epi::AFTER_DRAIN) { E(acc, cur, wr, wc, fr, fq); S.done(cur); }
        if (!has_next) break;
#pragma unroll
        for (int a = 0; a < 2; ++a)
#pragma unroll
            for (int b = 0; b < 2; ++b)
#pragma unroll
                for (int m = 0; m < 4; ++m)
#pragma unroll
                    for (int n = 0; n < 2; ++n) acc[a][b][m][n] = (f32x4){0.f, 0.f, 0.f, 0.f};
        cur = nxt; cA = nA; cB = nB; ++ui;
        if constexpr (ALIGN_EPI) { if (wr == 1) PG8_BAR; }
    }
    PG8_WAIT_V(0);
    if constexpr (!ALIGN_EPI) { if (wr == 0) PG8_BAR; }
    PG8_BAR;
    if constexpr (Epi::AFTER_DRAIN) { E.fused(acc, cur, wr, wc, fr, fq, lds, wid, lane); S.done(cur); }
#undef PG8_SA
#undef PG8_SB
#undef PG8_STAGE
#undef PG8_LDA
#undef PG8_LDB
#undef PG8_MMA
#undef PG8_WAIT_V
#undef PG8_WAIT_L
#undef PG8_BAR
#undef PG8_SCHED
}
}
#define LAS __attribute__((address_space(3)))
using pg8::bf16_t; using pg8::bf16x8; using pg8::f32x4; using pg8::u32x4; using pg8::cvt_pk_bf16;
typedef float f32x16 __attribute__((ext_vector_type(16)));
typedef unsigned u32x2 __attribute__((ext_vector_type(2)));
typedef float f32x2 __attribute__((ext_vector_type(2)));

constexpr int T = 32768, D = 1024, FF = 2816, SEQ = 4096, NBATCH = 8;
constexpr int NPH = 45;
constexpr float EPS = 1e-6f, LOG2E = 1.4426950408889634f;
constexpr size_t MiB = 1u << 20;
constexpr size_t WS_FIN = 0;
constexpr size_t WS_FOUT = WS_FIN + 88 * MiB;
constexpr size_t WS_AIN = WS_FOUT + 44 * MiB;
constexpr size_t WS_AOUT = WS_AIN + 12 * MiB;
constexpr size_t WS_KVW = WS_AOUT + 4 * MiB;
constexpr size_t WS_CW1 = WS_KVW + 3 * MiB;
constexpr size_t WS_BIN = WS_CW1 + 2 * MiB;
constexpr size_t WS_BOUT = WS_BIN + 5 * MiB;
constexpr size_t WS_MOD = WS_BOUT + 4 * MiB;
constexpr size_t WS_KVMOD = WS_MOD + 4ull * 8 * 9216 * 4;
constexpr size_t WS_CBIAS = WS_KVMOD + 8ull * 2048 * 4;
constexpr size_t WS_H = WS_MOD + 2 * MiB;
constexpr size_t WS_HID = WS_H + 64 * MiB;
constexpr size_t WS_Y = WS_HID + 176 * MiB;
constexpr size_t WS_PART = WS_Y + 64 * MiB;
constexpr size_t WS_GATES = WS_PART + 2 * MiB;
constexpr size_t WS_KC = WS_GATES + 6 * MiB;
constexpr size_t WS_KS = WS_KC + 33 * MiB;
constexpr size_t WS_KW = WS_KS + 16 * MiB;
constexpr size_t WS_VST = WS_KW + 16 * MiB;
constexpr size_t WS_VWT = WS_VST + 16 * MiB;
constexpr size_t WS_HIDC = WS_VWT + 16 * MiB;
constexpr size_t WS_KCMP = WS_HIDC + 8 * MiB;
constexpr size_t WS_VCMPT = WS_KCMP + 1 * MiB;
constexpr size_t WS_BAR = WS_VCMPT + 1 * MiB;
constexpr size_t WS_END = WS_BAR + 1 * MiB;
constexpr int LDS_BYTES = 135168;

struct Params { const float* in[19]; float* out; unsigned char* ws; int ph_lo, ph_hi; };
enum { I_X = 0, I_C, I_ADAW, I_ADAB, I_NORMG, I_FIN, I_FOUT, I_AIN, I_ACONV, I_AOUT, I_KVNG, I_KVADAW, I_KVADAB, I_KVW, I_CPOS, I_CW1, I_CW2, I_BIN, I_BOUT };

__device__ __forceinline__ float bf2f(unsigned short b) { return __uint_as_float((unsigned)b << 16); }
__device__ __forceinline__ float fexp2(float x) { return __builtin_amdgcn_exp2f(x); }
__device__ __forceinline__ float frcp(float x) { return __builtin_amdgcn_rcpf(x); }
__device__ __forceinline__ float silu_f(float g) { return g * frcp(1.f + fexp2(-g * LOG2E)); }
__device__ __forceinline__ float wave_sum(float v) {
#pragma unroll
    for (int o = 1; o < 64; o <<= 1) v += __shfl_xor(v, o);
    return v;
}
template <class Tp> __device__ __forceinline__ Tp* uptr(Tp* p) { const unsigned long long v = (unsigned long long)p; const unsigned lo = __builtin_amdgcn_readfirstlane((unsigned)v), hi = __builtin_amdgcn_readfirstlane((unsigned)(v >> 32)); typedef __attribute__((address_space(1))) Tp* gptr_t; gptr_t gp = (gptr_t)(((unsigned long long)hi << 32) | lo); return (Tp*)gp; }
#define LDS_WAIT() asm volatile("s_waitcnt lgkmcnt(0)" ::: "memory")

namespace pg8 {
__device__ __forceinline__ u32x4 pack8(const f32x4 a, const f32x4 b) { u32x4 w; w.x = cvt_pk_bf16(a[0], a[1]); w.y = cvt_pk_bf16(a[2], a[3]); w.z = cvt_pk_bf16(b[0], b[1]); w.w = cvt_pk_bf16(b[2], b[3]); return w; }
struct EpiSwiglu {
    static constexpr bool PERM = true, AFTER_DRAIN = false;
    bf16_t* O;
    __device__ __forceinline__ void operator()(const f32x4 (&acc)[2][2][4][2], const Unit& u, int wr, int wc, int fr, int fq) const {
        const int row0 = u.pm * BM + wr * 64 + fr, col0 = u.pn * 128 + wc * 32 + 8 * fq;
#pragma unroll
        for (int ai = 0; ai < 2; ++ai)
#pragma unroll
            for (int m = 0; m < 4; ++m) {
                f32x4 h0, h1;
#pragma unroll
                for (int e = 0; e < 4; ++e) { h0[e] = silu_f(acc[ai][0][m][0][e]) * acc[ai][1][m][0][e]; h1[e] = silu_f(acc[ai][0][m][1][e]) * acc[ai][1][m][1][e]; }
                *(u32x4*)(O + (size_t)(row0 + ai * HALF + m * 16) * FF + col0) = pack8(h0, h1);
            }
    }
};
struct EpiY {
    static constexpr bool PERM = true, AFTER_DRAIN = false;
    bf16_t* Y; float* part;
    __device__ __forceinline__ void operator()(const f32x4 (&acc)[2][2][4][2], const Unit& u, int wr, int wc, int fr, int fq) const {
        const int row0 = u.pm * BM + wr * 64 + fr, col0 = u.pn * BM + wc * 32 + 8 * fq;
#pragma unroll
        for (int ai = 0; ai < 2; ++ai)
#pragma unroll
            for (int m = 0; m < 4; ++m) {
                const int row = row0 + ai * HALF + m * 16; float ss = 0.f;
#pragma unroll
                for (int bj = 0; bj < 2; ++bj) {
                    const f32x4 a = acc[ai][bj][m][0], b = acc[ai][bj][m][1];
                    ss += (a[0] * a[0] + a[1] * a[1]) + (a[2] * a[2] + a[3] * a[3]) + (b[0] * b[0] + b[1] * b[1]) + (b[2] * b[2] + b[3] * b[3]);
                    *(u32x4*)(Y + (size_t)row * D + col0 + bj * HALF) = pack8(a, b);
                }
                ss += __shfl_xor(ss, 16); ss += __shfl_xor(ss, 32);
                if (fq == 0) part[(size_t)row * 16 + u.pn * 4 + wc] = ss;
            }
    }
};
struct EpiConvIn {
    static constexpr bool PERM = true, AFTER_DRAIN = false;
    bf16_t* V; bf16_t* Bg;
    __device__ __forceinline__ void operator()(const f32x4 (&acc)[2][2][4][2], const Unit& u, int wr, int wc, int fr, int fq) const {
        const int row0 = u.pm * BM + wr * 64 + fr;
        if (u.pn < 8) {
            const int col0 = u.pn * 128 + wc * 32 + 8 * fq;
#pragma unroll
            for (int ai = 0; ai < 2; ++ai)
#pragma unroll
                for (int m = 0; m < 4; ++m)
                    *(u32x4*)(V + (size_t)(row0 + ai * HALF + m * 16) * D + col0) = pack8(acc[ai][0][m][0] * acc[ai][1][m][0], acc[ai][0][m][1] * acc[ai][1][m][1]);
        } else {
            const int col0 = (u.pn - 8) * BM + wc * 32 + 8 * fq;
#pragma unroll
            for (int ai = 0; ai < 2; ++ai)
#pragma unroll
                for (int m = 0; m < 4; ++m)
#pragma unroll
                    for (int bj = 0; bj < 2; ++bj)
                        *(u32x4*)(Bg + (size_t)(row0 + ai * HALF + m * 16) * D + col0 + bj * HALF) = pack8(acc[ai][bj][m][0], acc[ai][bj][m][1]);
        }
    }
};
struct EpiQG {
    static constexpr bool PERM = true, AFTER_DRAIN = false;
    bf16_t* Q; float* G;
    __device__ __forceinline__ void operator()(const f32x4 (&acc)[2][2][4][2], const Unit& u, int wr, int wc, int fr, int fq) const {
        const int row0 = u.pm * BM + wr * 64 + fr;
        if (u.pn < 4) {
            const int col0 = u.pn * BM + wc * 32 + 8 * fq; const float sc = 0.125f * LOG2E;
#pragma unroll
            for (int ai = 0; ai < 2; ++ai)
#pragma unroll
                for (int m = 0; m < 4; ++m)
#pragma unroll
                    for (int bj = 0; bj < 2; ++bj)
                        *(u32x4*)(Q + (size_t)(row0 + ai * HALF + m * 16) * D + col0 + bj * HALF) = pack8(acc[ai][bj][m][0] * sc, acc[ai][bj][m][1] * sc);
        } else {
            const int col0 = wc * 32 + 8 * fq;
            if (col0 < 48) {
#pragma unroll
                for (int ai = 0; ai < 2; ++ai)
#pragma unroll
                    for (int m = 0; m < 4; ++m) {
                        float* gp = G + (size_t)(row0 + ai * HALF + m * 16) * 48 + col0;
#pragma unroll
                        for (int n = 0; n < 2; ++n) { f32x4 s;
#pragma unroll
                            for (int e = 0; e < 4; ++e) s[e] = frcp(1.f + fexp2(-acc[ai][0][m][n][e] * LOG2E));
                            *(f32x4*)(gp + 4 * n) = s; }
                    }
            }
        }
    }
};
struct EpiKV {
    static constexpr bool PERM = true, AFTER_DRAIN = false;
    bf16_t *KC, *KS, *KW, *VSt, *VWt;
    __device__ __forceinline__ void operator()(const f32x4 (&acc)[2][2][4][2], const Unit& u, int wr, int wc, int fr, int fq) const {
        const int br = u.pn >> 1, kv = u.pn & 1;
        const int row0 = u.pm * BM + wr * 64 + fr, b = row0 >> 12;
        const int d0 = (wc & 1) * 32 + 8 * fq;
        if (br == 0 || kv == 0) {
            bf16_t* base = br == 0 ? KC + (size_t)kv * 32 * 4096 * 64 : (br == 1 ? KS : KW);
#pragma unroll
            for (int ai = 0; ai < 2; ++ai)
#pragma unroll
                for (int m = 0; m < 4; ++m)
#pragma unroll
                    for (int bj = 0; bj < 2; ++bj) {
                        const int s = (row0 + ai * HALF + m * 16) & 4095, g = 2 * bj + (wc >> 1);
                        *(u32x4*)(base + ((size_t)(b * 4 + g) * 4096 + s) * 64 + d0) = pack8(acc[ai][bj][m][0], acc[ai][bj][m][1]);
                    }
        } else {
            bf16_t* base = br == 1 ? VSt : VWt;
#pragma unroll
            for (int ai = 0; ai < 2; ++ai)
#pragma unroll
                for (int m = 0; m < 4; ++m)
#pragma unroll
                    for (int bj = 0; bj < 2; ++bj) {
                        const int s = (row0 + ai * HALF + m * 16) & 4095, g = 2 * bj + (wc >> 1);
                        bf16_t* p = base + ((size_t)(b * 4 + g) * 64 + d0) * 4096 + s;
                        const u32x4 w = pack8(acc[ai][bj][m][0], acc[ai][bj][m][1]);
                        p[0 * 4096] = (bf16_t)(w.x & 0xffffu); p[1 * 4096] = (bf16_t)(w.x >> 16); p[2 * 4096] = (bf16_t)(w.y & 0xffffu); p[3 * 4096] = (bf16_t)(w.y >> 16);
                        p[4 * 4096] = (bf16_t)(w.z & 0xffffu); p[5 * 4096] = (bf16_t)(w.z >> 16); p[6 * 4096] = (bf16_t)(w.w & 0xffffu); p[7 * 4096] = (bf16_t)(w.w >> 16);
                    }
        }
    }
};
struct EpiCmp1 {
    static constexpr bool PERM = true, AFTER_DRAIN = false;
    bf16_t* O; const float* cbias;
    __device__ __forceinline__ void operator()(const f32x4 (&acc)[2][2][4][2], const Unit& u, int wr, int wc, int fr, int fq) const {
        const int row0 = u.pm * BM + wr * 64 + fr, col0 = wc * 32 + 8 * fq;
#pragma unroll
        for (int bj = 0; bj < 2; ++bj) {
            const f32x4 b0 = *(const f32x4*)(cbias + u.pn * 256 + col0 + bj * HALF), b1 = *(const f32x4*)(cbias + u.pn * 256 + col0 + bj * HALF + 4);
#pragma unroll
            for (int ai = 0; ai < 2; ++ai)
#pragma unroll
                for (int m = 0; m < 4; ++m) {
                    f32x4 x0 = acc[ai][bj][m][0] + b0, x1 = acc[ai][bj][m][1] + b1;
#pragma unroll
                    for (int e = 0; e < 4; ++e) {
                        { const float x = x0[e], z = 1.5957691216f * (x + 0.044715f * x * x * x); x0[e] = x * frcp(1.f + fexp2(-z * LOG2E)); }
                        { const float x = x1[e], z = 1.5957691216f * (x + 0.044715f * x * x * x); x1[e] = x * frcp(1.f + fexp2(-z * LOG2E)); }
                    }
                    *(u32x4*)(O + (size_t)(row0 + ai * HALF + m * 16) * 256 + col0 + bj * HALF) = pack8(x0, x1);
                }
        }
    }
};
struct DiagOrder {
    int G, c;
    __device__ bool next(int i, Unit& u) const { const int L = i * G + c; if (L >= 64) return false; u.pm = L; u.pn = L >> 5; return true; }
    __device__ __forceinline__ void a_ready(const Unit&) const {}
    __device__ __forceinline__ void done(const Unit&) const {}
};
}
struct Ctx { LAS unsigned char* lds; int tid, lane, wave, G, bid; };

__device__ __forceinline__ void conv_item(const float* W, int ldw, int ncv, int src_col0, int K, bf16_t* WT, int dst_row0, int kb, LAS float* scr, int lane) {
    const int k0 = 64 * kb, col = src_col0 + (lane & 31); const bool ok = col < ncv;
#pragma unroll 8
    for (int i = 0; i < 32; ++i) { const int kk = 2 * i + (lane >> 5); scr[kk * 33 + (lane & 31)] = ok ? W[(size_t)(k0 + kk) * ldw + col] : 0.f; }
    LDS_WAIT(); asm volatile("" ::: "memory");
    const int c = lane & 7;
#pragma unroll
    for (int j = 0; j < 4; ++j) { const int n = (lane >> 3) + 8 * j; const LAS float* s = scr + (8 * c) * 33 + n;
        u32x4 o; o.x = cvt_pk_bf16(s[0 * 33], s[1 * 33]); o.y = cvt_pk_bf16(s[2 * 33], s[3 * 33]); o.z = cvt_pk_bf16(s[4 * 33], s[5 * 33]); o.w = cvt_pk_bf16(s[6 * 33], s[7 * 33]);
        *(u32x4*)(WT + (size_t)(dst_row0 + n) * K + k0 + 8 * c) = o; }
    LDS_WAIT(); asm volatile("" ::: "memory");
}
#define PIN(k) uptr(LP->in[k])
__device__ __forceinline__ void p0_phase(const Ctx& X, const LAS Params* LP) {
    unsigned char* ws = uptr(LP->ws);
    LAS float* sc = (LAS float*)X.lds;
    LAS float* red = (LAS float*)(X.lds + 32768);
    for (int i = X.tid; i < 8192; i += 512) { const int b = i >> 10, k = i & 1023; sc[k * 8 + b] = silu_f(PIN(I_C)[i]); }
    __syncthreads();
    for (int it = X.bid; it < 608; it += X.G) {
        const float* W; const float* bias; float* out; int N, cb;
        if (it < 576) { const int l = it / 144; cb = it % 144; N = 9216; W = PIN(I_ADAW) + (size_t)l * 1024 * 9216; bias = PIN(I_ADAB) + l * 9216; out = (float*)(ws + WS_MOD) + (size_t)l * 8 * 9216; }
        else { cb = it - 576; N = 2048; W = PIN(I_KVADAW); bias = PIN(I_KVADAB); out = (float*)(ws + WS_KVMOD); }
        float a[8];
#pragma unroll
        for (int b = 0; b < 8; ++b) a[b] = 0.f;
        const float* wp = W + (size_t)(128 * X.wave) * N + 64 * cb + X.lane;
#pragma unroll 4
        for (int k = 0; k < 128; ++k) { const float w = wp[(size_t)k * N]; const f32x4 s0 = *(const LAS f32x4*)(sc + (128 * X.wave + k) * 8), s1 = *(const LAS f32x4*)(sc + (128 * X.wave + k) * 8 + 4);
            a[0] += s0[0] * w; a[1] += s0[1] * w; a[2] += s0[2] * w; a[3] += s0[3] * w; a[4] += s1[0] * w; a[5] += s1[1] * w; a[6] += s1[2] * w; a[7] += s1[3] * w; }
#pragma unroll
        for (int b = 0; b < 8; ++b) red[(X.wave * 8 + b) * 64 + X.lane] = a[b];
        __syncthreads();
        { const int b = X.tid >> 6, col = X.tid & 63; float s = bias[64 * cb + col];
#pragma unroll
          for (int w = 0; w < 8; ++w) s += red[(w * 8 + b) * 64 + col];
          out[(size_t)b * N + 64 * cb + col] = s; }
        __syncthreads();
    }
    for (int kv = 0; kv < 2; ++kv) if (X.bid == X.G - 1 - kv) {
        const int col = X.tid & 255, half = X.tid >> 8; const float* pos = PIN(I_CPOS) + kv * 2048 + half * 1024; const float* w1 = PIN(I_CW1) + ((size_t)kv * 2048 + half * 1024) * 256 + col;
        float s = 0.f;
        for (int f = 0; f < 1024; ++f) s += pos[f] * w1[(size_t)f * 256];
        red[X.tid] = s; __syncthreads();
        if (X.tid < 256) ((float*)(ws + WS_CBIAS))[kv * 256 + X.tid] = red[X.tid] + red[X.tid + 256];
        __syncthreads();
    }
    __syncthreads();
    LAS float* scr = (LAS float*)(X.lds + X.wave * 8448);
    const int gw = X.bid * 8 + X.wave, NGW = X.G * 8;
    for (int it = gw; it < 41472; it += NGW) {
        int r = it;
        if (r < 22528) { const int id = r / 2816, q = r % 2816, nb = q >> 4, kb = q & 15, pn = nb >> 3, jb = nb & 7;
            conv_item(PIN(I_FIN) + (size_t)id * 1024 * 5632, 5632, 5632, (jb >> 2) * 2816 + 128 * pn + 32 * (jb & 3), 1024, (bf16_t*)(ws + WS_FIN) + (size_t)id * 5632 * 1024, 32 * nb, kb, scr, X.lane); continue; } r -= 22528;
        if (r < 11264) { const int id = r / 1408, q = r % 1408, nb = q / 44, kb = q % 44;
            conv_item(PIN(I_FOUT) + (size_t)id * 2816 * 1024, 1024, 1024, 32 * nb, 2816, (bf16_t*)(ws + WS_FOUT) + (size_t)id * 1024 * 2816, 32 * nb, kb, scr, X.lane); continue; } r -= 11264;
        if (r < 3072) { const int id = r / 1536, q = r % 1536, nb = q >> 4, kb = q & 15, pn = nb >> 3, jb = nb & 7;
            const int src = pn < 8 ? ((jb >> 2) ? 2048 : 1024) + 128 * pn + 32 * (jb & 3) : 256 * (pn - 8) + 32 * jb;
            conv_item(PIN(I_AIN) + (size_t)id * 1024 * 3072, 3072, 3072, src, 1024, (bf16_t*)(ws + WS_AIN) + (size_t)id * 3072 * 1024, 32 * nb, kb, scr, X.lane); continue; } r -= 3072;
        if (r < 1024) { const int id = r / 512, q = r % 512, nb = q >> 4, kb = q & 15;
            conv_item(PIN(I_AOUT) + (size_t)id * 1024 * 1024, 1024, 1024, 32 * nb, 1024, (bf16_t*)(ws + WS_AOUT) + (size_t)id * 1024 * 1024, 32 * nb, kb, scr, X.lane); continue; } r -= 1024;
        if (r < 768) { const int nb = r >> 4, kb = r & 15;
            conv_item(PIN(I_KVW), 1536, 1536, 32 * nb, 1024, (bf16_t*)(ws + WS_KVW), 32 * nb, kb, scr, X.lane); continue; } r -= 768;
        if (r < 512) { const int id = r / 256, q = r % 256, nb = q >> 5, kb = q & 31;
            conv_item(PIN(I_CW1) + (size_t)id * 2048 * 256, 256, 256, 32 * nb, 2048, (bf16_t*)(ws + WS_CW1) + (size_t)id * 256 * 2048, 32 * nb, kb, scr, X.lane); continue; } r -= 512;
        if (r < 1280) { const int id = r / 640, q = r % 640, nb = q >> 4, kb = q & 15;
            conv_item(PIN(I_BIN) + (size_t)id * 1024 * 1072, 1072, 1072, 32 * nb, 1024, (bf16_t*)(ws + WS_BIN) + (size_t)id * 1280 * 1024, 32 * nb, kb, scr, X.lane); continue; } r -= 1280;
        { const int id = r / 512, q = r % 512, nb = q >> 4, kb = q & 15;
            conv_item(PIN(I_BOUT) + (size_t)id * 1024 * 1024, 1024, 1024, 32 * nb, 1024, (bf16_t*)(ws + WS_BOUT) + (size_t)id * 1024 * 1024, 32 * nb, kb, scr, X.lane); }
    }
}

struct UpdArgs { const float* xin; float* xout; const bf16_t* y; const float* part; const float* gate; const float* gpost; float w; int bstride;
                 const float* gpre; const float* shift; const float* scale; bf16_t* h; const float* gpre2; const float* shift2; const float* scale2; bf16_t* h2; };
__device__ __forceinline__ void update_phase(const Ctx& X, const UpdArgs& A) {
    constexpr int R = 2;
    const int gw = X.bid * 8 + X.wave, NGW = X.G * 8, c0 = 4 * X.lane;
    for (int row0 = gw; row0 < T; row0 += R * NGW) {
        f32x4 xv[R][4]; u32x2 yy[R][4]; f32x4 pp[R][4];
#pragma unroll
        for (int q = 0; q < R; ++q) { const int row = min(row0 + q * NGW, T - 1);
#pragma unroll
            for (int j = 0; j < 4; ++j) xv[q][j] = *(const f32x4*)(A.xin + (size_t)row * D + c0 + 256 * j);
            if (A.y) {
#pragma unroll
                for (int j = 0; j < 4; ++j) { yy[q][j] = *(const u32x2*)(A.y + (size_t)row * D + c0 + 256 * j); pp[q][j] = *(const f32x4*)(A.part + (size_t)row * 16 + 4 * j); }
            }
        }
#pragma unroll
        for (int q = 0; q < R; ++q) { const int row = row0 + q * NGW; if (row < T) {
            const int b = row >> 12;
            if (A.y) {
                const float ssq = ((pp[q][0][0] + pp[q][0][1]) + (pp[q][0][2] + pp[q][0][3])) + ((pp[q][1][0] + pp[q][1][1]) + (pp[q][1][2] + pp[q][1][3])) + ((pp[q][2][0] + pp[q][2][1]) + (pp[q][2][2] + pp[q][2][3])) + ((pp[q][3][0] + pp[q][3][1]) + (pp[q][3][2] + pp[q][3][3]));
                const float rs = A.w * __builtin_amdgcn_rsqf(ssq * (1.f / D) + EPS);
#pragma unroll
                for (int j = 0; j < 4; ++j) { const int c = c0 + 256 * j;
                    const f32x4 gt = *(const f32x4*)(A.gate + (size_t)b * A.bstride + c), gp = *(const f32x4*)(A.gpost + c);
                    const f32x4 yv = {__uint_as_float(yy[q][j].x << 16), __uint_as_float(yy[q][j].x & 0xffff0000u), __uint_as_float(yy[q][j].y << 16), __uint_as_float(yy[q][j].y & 0xffff0000u)};
                    xv[q][j] = xv[q][j] + gt * gp * yv * rs; }
            }
            if (A.xout) {
#pragma unroll
                for (int j = 0; j < 4; ++j) *(f32x4*)(A.xout + (size_t)row * D + c0 + 256 * j) = xv[q][j];
            }
            if (A.h) {
                float s = 0.f;
#pragma unroll
                for (int j = 0; j < 4; ++j) s += (xv[q][j][0] * xv[q][j][0] + xv[q][j][1] * xv[q][j][1]) + (xv[q][j][2] * xv[q][j][2] + xv[q][j][3] * xv[q][j][3]);
                const float r = __builtin_amdgcn_rsqf(wave_sum(s) * (1.f / D) + EPS);
#pragma unroll
                for (int j = 0; j < 4; ++j) { const int c = c0 + 256 * j;
                    const f32x4 g = *(const f32x4*)(A.gpre + c), sh = *(const f32x4*)(A.shift + (size_t)b * A.bstride + c), scl = *(const f32x4*)(A.scale + (size_t)b * A.bstride + c);
                    const f32x4 hv = xv[q][j] * r * g * (scl + 1.f) + sh; u32x2 o; o.x = cvt_pk_bf16(hv[0], hv[1]); o.y = cvt_pk_bf16(hv[2], hv[3]);
                    *(u32x2*)(A.h + (size_t)row * D + c) = o; }
                if (A.h2) {
#pragma unroll
                    for (int j = 0; j < 4; ++j) { const int c = c0 + 256 * j;
                        const f32x4 g = *(const f32x4*)(A.gpre2 + c), sh = *(const f32x4*)(A.shift2 + (size_t)b * 2048 + c), scl = *(const f32x4*)(A.scale2 + (size_t)b * 2048 + c);
                        const f32x4 hv = xv[q][j] * r * g * (scl + 1.f) + sh; u32x2 o; o.x = cvt_pk_bf16(hv[0], hv[1]); o.y = cvt_pk_bf16(hv[2], hv[3]);
                        *(u32x2*)(A.h2 + (size_t)row * D + c) = o; }
                }
            }
        } }
    }
}

__device__ __forceinline__ void unpack8(const u32x4 w, float (&f)[8]) {
    f[0] = __uint_as_float(w.x << 16); f[1] = __uint_as_float(w.x & 0xffff0000u); f[2] = __uint_as_float(w.y << 16); f[3] = __uint_as_float(w.y & 0xffff0000u);
    f[4] = __uint_as_float(w.z << 16); f[5] = __uint_as_float(w.z & 0xffff0000u); f[6] = __uint_as_float(w.w << 16); f[7] = __uint_as_float(w.w & 0xffff0000u);
}
__device__ __forceinline__ void conv_phase(const Ctx& X, const bf16_t* V, const bf16_t* Bg, const float* cw, bf16_t* Z) {
    const int gt = X.bid * 512 + X.tid, NT = X.G * 512;
    for (int i = gt; i < T * 128; i += NT) {
        const int row = i >> 7, c = (i & 127) * 8, s = row & 4095;
        const u32x4 z0 = {0u, 0u, 0u, 0u};
        const u32x4 v2 = *(const u32x4*)(V + (size_t)row * D + c), v1 = s >= 1 ? *(const u32x4*)(V + (size_t)(row - 1) * D + c) : z0, v0 = s >= 2 ? *(const u32x4*)(V + (size_t)(row - 2) * D + c) : z0;
        const u32x4 bb = *(const u32x4*)(Bg + (size_t)row * D + c);
        float a0[8], a1[8], a2[8], bf[8], o[8]; unpack8(v0, a0); unpack8(v1, a1); unpack8(v2, a2); unpack8(bb, bf);
#pragma unroll
        for (int e = 0; e < 8; ++e) o[e] = bf[e] * (cw[c + e] * a0[e] + cw[D + c + e] * a1[e] + cw[2 * D + c + e] * a2[e]);
        u32x4 w; w.x = cvt_pk_bf16(o[0], o[1]); w.y = cvt_pk_bf16(o[2], o[3]); w.z = cvt_pk_bf16(o[4], o[5]); w.w = cvt_pk_bf16(o[6], o[7]);
        *(u32x4*)(Z + (size_t)row * D + c) = w;
    }
}

__device__ __forceinline__ void cmp2_phase(const Ctx& X, const bf16_t* hidc, const float* w2, bf16_t* kcmp, bf16_t* vcmpT) {
    const int gt = X.bid * 512 + X.tid, NT = X.G * 512;
    for (int i = gt; i < 16384 * 16; i += NT) {
        const int row = i >> 4, c = (i & 15) * 4, kv = row >> 13, rr = row & 8191;
        const float* w = w2 + (size_t)kv * 256 * 64 + c; const bf16_t* hp = hidc + (size_t)row * 256;
        f32x4 a = {0.f, 0.f, 0.f, 0.f};
        for (int k = 0; k < 256; k += 8) { float hf[8]; unpack8(*(const u32x4*)(hp + k), hf);
#pragma unroll
            for (int e = 0; e < 8; ++e) a += *(const f32x4*)(w + (size_t)(k + e) * 64) * hf[e]; }
        if (kv == 0) { u32x2 o; o.x = cvt_pk_bf16(a[0], a[1]); o.y = cvt_pk_bf16(a[2], a[3]); *(u32x2*)(kcmp + (size_t)rr * 64 + c) = o; }
        else { const int bg = rr >> 8, n = rr & 255; bf16_t* p = vcmpT + ((size_t)bg * 64 + c) * 256 + n; const unsigned w0 = cvt_pk_bf16(a[0], a[1]), w1 = cvt_pk_bf16(a[2], a[3]);
            p[0] = (bf16_t)(w0 & 0xffffu); p[256] = (bf16_t)(w0 >> 16); p[512] = (bf16_t)(w1 & 0xffffu); p[768] = (bf16_t)(w1 >> 16); }
    }
}
struct AttnArgs { const bf16_t* Q; const float* gates; const bf16_t *kcmp, *vcmpT, *KS, *VSt, *KW, *VWt; bf16_t* O; };

__device__ __forceinline__ void load_k(bf16x8 (&kf)[4], const bf16_t* Kb, int key0, int jr, int h) {
    const bf16x8* p = (const bf16x8*)(Kb + (size_t)(key0 + jr) * 64 + h * 8);
#pragma unroll
    for (int ks = 0; ks < 4; ++ks) kf[ks] = p[2 * ks];
}
__device__ __forceinline__ void load_v(bf16x8 (&vf)[4], const bf16_t* Vt, int ldv, int key0, int j, int h) {
#pragma unroll
    for (int s = 0; s < 2; ++s)
#pragma unroll
        for (int dt = 0; dt < 2; ++dt) vf[s * 2 + dt] = *(const bf16x8*)(Vt + (size_t)(dt * 32 + j) * ldv + key0 + 16 * s + 8 * h);
}
__device__ __forceinline__ f32x16 qk_mma(const bf16x8 (&kf)[4], const bf16x8 (&qf)[4], const f32x16& bc) {
    f32x16 acc = __builtin_amdgcn_mfma_f32_32x32x16_bf16(kf[0], qf[0], bc, 0, 0, 0);
#pragma unroll
    for (int ks = 1; ks < 4; ++ks) acc = __builtin_amdgcn_mfma_f32_32x32x16_bf16(kf[ks], qf[ks], acc, 0, 0, 0);
    return acc;
}
__device__ __forceinline__ void pv_mma(f32x16 (&o)[2], const bf16x8 (&vf)[4], const f32x16& p) {
#pragma unroll
    for (int s = 0; s < 2; ++s) {
        u32x4 w; w.x = cvt_pk_bf16(p[8 * s + 0], p[8 * s + 1]); w.y = cvt_pk_bf16(p[8 * s + 2], p[8 * s + 3]); w.z = cvt_pk_bf16(p[8 * s + 4], p[8 * s + 5]); w.w = cvt_pk_bf16(p[8 * s + 6], p[8 * s + 7]);
        const bf16x8 pb = __builtin_bit_cast(bf16x8, w);
#pragma unroll
        for (int dt = 0; dt < 2; ++dt) o[dt] = __builtin_amdgcn_mfma_f32_32x32x16_bf16(vf[s * 2 + dt], pb, o[dt], 0, 0, 0);
    }
}
__device__ __forceinline__ void pf_block(const bf16_t* Kb, const bf16_t* Vt, int ldv, int key0, int lane, LAS unsigned* junk) {
    __builtin_amdgcn_global_load_lds((const unsigned*)(Kb + (size_t)(key0 + lane) * 64), junk, 4, 0, 0);
    __builtin_amdgcn_global_load_lds((const unsigned*)(Vt + (size_t)lane * ldv + key0), junk, 4, 0, 0);
}
__device__ __forceinline__ unsigned run_mask(int kstart, int lo, int hi) {
    const int a = max(lo - kstart, 0), b = min(hi - kstart, 7);
    return a <= b ? ((1u << (b + 1)) - 1u) & ~((1u << a) - 1u) : 0u;
}
__device__ __forceinline__ float max16(const f32x16& s) {
    float a = fmaxf(fmaxf(s[0], s[1]), s[2]), b = fmaxf(fmaxf(s[3], s[4]), s[5]), c = fmaxf(fmaxf(s[6], s[7]), s[8]), d = fmaxf(fmaxf(s[9], s[10]), s[11]), e = fmaxf(fmaxf(s[12], s[13]), s[14]);
    return fmaxf(fmaxf(fmaxf(a, b), fmaxf(c, d)), fmaxf(e, s[15]));
}
__device__ __forceinline__ void softmax_step(f32x16& s, bool full, unsigned vm, float off, float& m, float& l, f32x16 (&o)[2], bool lane_on = true) {
    if (!full) {
#pragma unroll
        for (int v = 0; v < 16; ++v) s[v] = ((vm >> v) & 1u) ? s[v] : -1e30f;
    }
    float tm = max16(s);
    if (full && !lane_on) tm = -1e30f;
    tm = fmaxf(tm, __shfl_xor(tm, 32)) + off;
    const float mn = fmaxf(m, tm);
    if (__any(mn > m)) { const float al = fexp2(m - mn); l *= al; o[0] = o[0] * al; o[1] = o[1] * al; }
    m = mn; const float ml = (full && !lane_on) ? 3e38f : mn - off;
    float ps = 0.f;
    if (full) {
#pragma unroll
        for (int v = 0; v < 16; ++v) { const float p = fexp2(s[v] - ml); s[v] = p; ps += p; }
    } else {
#pragma unroll
        for (int v = 0; v < 16; ++v) { const float p = ((vm >> v) & 1u) ? fexp2(s[v] - ml) : 0.f; s[v] = p; ps += p; }
    }
    l += ps;
}

__device__ __forceinline__ void glds16(const void* gsrc, unsigned lds_dst) { unsigned keep;
    asm volatile("s_mov_b32 %0, m0\n\ts_mov_b32 m0, %2\n\ts_nop 0\n\tglobal_load_lds_dwordx4 %1, off\n\ts_mov_b32 m0, %0" : "=&s"(keep) : "v"(gsrc), "s"(lds_dst) : "memory"); }
struct AttnSrc { const bf16_t *Kc, *Vc, *Kw, *Vw, *Ks, *Vs; };
__device__ __forceinline__ void ring_load(const AttnSrc& S, int type, int key0, unsigned slot_addr, int wave, int lane) {
    const int q = lane & 7;
#pragma unroll
    for (int e = 0; e < 2; ++e) {
        const int pr = (2 * wave + e) & 7, i = 8 * pr + (lane >> 3), c = q ^ ((i >> 1) & 7);
        const bf16_t* src;
        if (wave < 4) { const bf16_t* kb = type == 0 ? S.Kc : (type == 1 ? S.Kw : S.Ks); const int il = i & 31, kp = (il & ~12) | ((il & 4) << 1) | ((il & 8) >> 1);
                        src = kb + (size_t)(key0 + (i & 32) + kp) * 64 + 8 * c; }
        else { const bf16_t* vb = type == 0 ? S.Vc : (type == 1 ? S.Vw : S.Vs); const int ldv = type == 0 ? 256 : 4096; src = vb + (size_t)i * ldv + key0 + 8 * c; }
        glds16(src, slot_addr + (wave < 4 ? 0u : 8192u) + (unsigned)pr * 1024u);
    }
}
#define RING_WAIT_BAR() do { asm volatile("s_waitcnt vmcnt(4)" ::: "memory"); __builtin_amdgcn_s_barrier(); asm volatile("" ::: "memory"); } while (0)
#define RING_DRAIN_BAR() do { asm volatile("s_waitcnt vmcnt(0) lgkmcnt(0)" ::: "memory"); __builtin_amdgcn_s_barrier(); asm volatile("" ::: "memory"); } while (0)
__device__ __forceinline__ void ring_read_k(bf16x8 (&kf)[4], const LAS unsigned char* slot, int hf, int rowoff, int sw, int h) {
#pragma unroll
    for (int ks = 0; ks < 4; ++ks) kf[ks] = *(const LAS bf16x8*)(slot + hf * 4096 + rowoff + (((2 * ks + h) * 16) ^ sw));
}
__device__ __forceinline__ void ring_read_v(bf16x8 (&vf)[4], const LAS unsigned char* slot, int hf, int rowoff, int sw, int h) {
#pragma unroll
    for (int s = 0; s < 2; ++s)
#pragma unroll
        for (int dt = 0; dt < 2; ++dt) vf[s * 2 + dt] = *(const LAS bf16x8*)(slot + 8192 + dt * 4096 + rowoff + (((4 * hf + 2 * s + h) * 16) ^ sw));
}

__device__ __forceinline__ void attn_item(const Ctx& X, const AttnArgs& A, int b, int g, int qt, const int mode = 3) {
    int lane_ = X.lane; asm volatile("" : "+v"(lane_));
    const int lane = lane_, h = lane >> 5, j = lane & 31, ql = j >> 2, r = j & 3, wave = X.wave;
    const int tb = qt * 64, t0 = tb + wave * 8, t = t0 + ql, head = g * 4 + r, bg = b * 4 + g, cur = qt;
    const size_t row = (size_t)b * SEQ + t;
    const int rowoff = j * 128, sw = ((j >> 1) & 7) * 16;
    RING_DRAIN_BAR();
    bf16x8 qf[4];
#pragma unroll
    for (int ks = 0; ks < 4; ++ks) qf[ks] = *(const bf16x8*)(A.Q + row * D + head * 64 + ks * 16 + h * 8);
    const float sl2 = fexp2(-0.5f * (float)(head + 1)) * LOG2E;
    const float g0 = A.gates[row * 48 + head], g1 = A.gates[row * 48 + 16 + head], g2 = A.gates[row * 48 + 32 + head];
    asm volatile("" :: "v"(qf[0]), "v"(qf[1]), "v"(qf[2]), "v"(qf[3]), "v"(g0), "v"(g1), "v"(g2));
    f32x16 o[2], bc;
#pragma unroll
    for (int v = 0; v < 16; ++v) { o[0][v] = 0.f; o[1][v] = 0.f; }
    LAS float* cm = (LAS float*)(X.lds + wave * 8192);
    LAS float* ob = cm + lane;
    const LAS unsigned char* ring = X.lds + 65536;
    const unsigned ring_a = (unsigned)(unsigned long long)ring;
    LAS unsigned long long* ux = (LAS unsigned long long*)(X.lds + 131072);
    AttnSrc S; S.Kc = A.kcmp + (size_t)bg * 256 * 64; S.Vc = A.vcmpT + (size_t)bg * 64 * 256; S.Kw = A.KW + (size_t)bg * 4096 * 64; S.Vw = A.VWt + (size_t)bg * 64 * 4096;
    S.Ks = A.KS + (size_t)bg * 4096 * 64; S.Vs = A.VSt + (size_t)bg * 64 * 4096;
    float m, l;
    bf16x8 kc[4], vf[4];

    const int ntb = (((tb + 63 - 31) >> 4) >> 5) + 1, nb1 = (ntb + 1) >> 1;
    const int nmax_w = (t0 + 7 - 31) >> 4, nmax_t = (t - 31) >> 4, nmin_w = (t0 - 31) >> 4;
    const int ntile = nmax_w >= 0 ? (nmax_w >> 5) + 1 : 0;
#pragma unroll
    for (int v = 0; v < 16; ++v) bc[v] = 16.f * sl2 * (float)(8 * h + 16 * (v >> 3) + (v & 7)) + sl2 * (float)(31 - ql);
    m = -1e30f; l = 0.f;
    {
        const int n1 = 2 * nb1;
#define CMP_BLK(i) ((i) < nb1 ? nb1 - 1 - (i) : 2 * nb1 - 1 - min((i), n1 - 1))
        for (int i = 0; i < 3; ++i) ring_load(S, 0, CMP_BLK(i) * 64, ring_a + (unsigned)(i & 3) * 16384u, wave, lane);
        float inv = 0.f;
#pragma unroll 1
        for (int i = 0; i < n1; ++i) {
            RING_WAIT_BAR();
            ring_load(S, 0, CMP_BLK(i + 3) * 64, ring_a + (unsigned)((i + 3) & 3) * 16384u, wave, lane);
            const int blk = CMP_BLK(i); const LAS unsigned char* slot = ring + (i & 3) * 16384;
            if (i == nb1) { l += __shfl_xor(l, 32); inv = 1.f / fmaxf(l, 1e-30f); }
#pragma unroll 1
            for (int hf = 1; hf >= 0; --hf) {
                const int tile = 2 * blk + hf;
                if (tile < ntile) {
                    ring_read_k(kc, slot, hf, rowoff, sw, h);
                    const unsigned vm = run_mask(tile * 32 + 8 * h, 0, nmax_t) | (run_mask(tile * 32 + 16 + 8 * h, 0, nmax_t) << 8);
                    const float off = sl2 * (float)(512 * tile - t0);
                    if (i < nb1) {
                        f32x16 s = qk_mma(kc, qf, bc);
                        softmax_step(s, tile * 32 + 31 <= nmin_w, vm, off, m, l, o);
                    } else {
                        ring_read_v(vf, slot, hf, rowoff, sw, h);
                        f32x16 s = qk_mma(kc, qf, bc);
                        const float ml = m - off;
#pragma unroll
                        for (int v = 0; v < 16; ++v) {
                            const float p = ((vm >> v) & 1u) ? fexp2(s[v] - ml) * inv : 0.f; s[v] = p;
                            float x = p; x += __shfl_xor(x, 1); x += __shfl_xor(x, 2);
                            if ((v & 3) == r) cm[ql * 256 + tile * 32 + 16 * (v >> 3) + 8 * h + (v & 7)] = x;
                        }
                        pv_mma(o, vf, s);
                    }
                }
            }
        }
#undef CMP_BLK
    }
    RING_DRAIN_BAR();
    const int wb1b = qt, wb0b = max(tb - 511, 0) >> 6, nWb = wb1b - wb0b + 1;
    const int kt0 = max(t0 - 511, 0) >> 5, kt1 = (t0 + 7) >> 5;
    int li = 0;
    for (; li < 3 && li < nWb; ++li) ring_load(S, 1, (wb1b - li) * 64, ring_a + (unsigned)(li & 3) * 16384u, wave, lane);
    unsigned long long mq = 0ull, uni = 0ull, alln = ~0ull;
    {
        const unsigned long long causal = cur >= 63 ? ~0ull : ((1ull << (cur + 1)) - 1ull);
        if (cur + 1 <= 16) { mq = causal; uni = causal; alln = causal; }
        else {
#pragma unroll 1
            for (int q = 0; q < 8; ++q) {
                float iv;
                if (lane == 0 || lane == cur || lane == cur - 1) iv = 1e30f;
                else if (lane > cur) iv = -1.f;
                else { const LAS float* c = cm + q * 256 + 4 * lane; iv = (((c[-1] + c[0]) + c[1]) + c[2]) + c[3]; }
                const int ib = __float_as_int(iv);
                int Tb = 0; unsigned long long ge = causal;
#pragma unroll 1
                for (int bit = 30; bit >= 0; --bit) {
                    const int cand = Tb | (1 << bit); const unsigned long long bm = __ballot(ib >= cand); const int c = __popcll(bm);
                    if (c >= 16) { Tb = cand; ge = bm; if (c == 16) break; }
                }
                unsigned long long mk = ge;
                if (__popcll(ge) > 16) {
                    const unsigned long long gt = __ballot(ib > Tb); unsigned long long eq = ge & ~gt; int need = 16 - __popcll(gt); mk = gt;
                    for (; need > 0; --need) { const unsigned long long low = eq & (0ull - eq); mk |= low; eq ^= low; }
                }
                mk &= causal;
                uni |= mk; alln &= mk; if (ql == q) mq = mk;
            }
        }
    }
    if (lane == 0) ux[wave] = uni;
    asm volatile("s_waitcnt lgkmcnt(0)" ::: "memory"); __builtin_amdgcn_s_barrier(); asm volatile("" ::: "memory");
    unsigned long long bun = 0ull;
#pragma unroll
    for (int w = 0; w < 8; ++w) bun |= ux[w];
    { const unsigned lo = __builtin_amdgcn_readfirstlane((unsigned)bun), hi = __builtin_amdgcn_readfirstlane((unsigned)(bun >> 32)); bun = ((unsigned long long)hi << 32) | lo; }
    const int n2 = nWb + __popcll(bun);
    unsigned long long lmask = bun; int ljb = 0;
#define LOAD_STEP2() do { int ty_, k0_; \
        if (li < nWb) { ty_ = 1; k0_ = (wb1b - li) * 64; } \
        else { ty_ = 2; if (li < n2) { ljb = 63 - __builtin_clzll(lmask); lmask &= ~(1ull << ljb); } k0_ = ljb * 64; } \
        ring_load(S, ty_, k0_, ring_a + (unsigned)(li & 3) * 16384u, wave, lane); ++li; } while (0)
    while (li < 3) LOAD_STEP2();
#pragma unroll
    for (int v = 0; v < 16; ++v) { ob[v * 64] = g0 * o[0][v]; ob[(16 + v) * 64] = g0 * o[1][v]; o[0][v] = 0.f; o[1][v] = 0.f; }
#pragma unroll
    for (int v = 0; v < 16; ++v) bc[v] = sl2 * (float)(8 * h + 16 * (v >> 3) + (v & 7) - ql);
    m = -1e30f; l = 0.f;
    int ci = 0;
#pragma unroll 1
    for (; ci < nWb; ++ci) {
        RING_WAIT_BAR();
        LOAD_STEP2();
        const int wb = wb1b - ci; const LAS unsigned char* slot = ring + (ci & 3) * 16384;
#pragma unroll 1
        for (int hf = 1; hf >= 0; --hf) {
            const int kt = 2 * wb + hf, key0 = kt * 32;
            if (kt >= kt0 && kt <= kt1 && (mode & 2)) {
                ring_read_k(kc, slot, hf, rowoff, sw, h); ring_read_v(vf, slot, hf, rowoff, sw, h);
                f32x16 s = qk_mma(kc, qf, bc);
                const bool full = (key0 + 31 <= t0) && (key0 >= t0 + 7 - 511);
                const unsigned vm = run_mask(key0 + 8 * h, t - 511, t) | (run_mask(key0 + 16 + 8 * h, t - 511, t) << 8);
                softmax_step(s, full, vm, sl2 * (float)(key0 - t0), m, l, o);
                pv_mma(o, vf, s);
            }
        }
    }
    {
        l += __shfl_xor(l, 32);
        const float sc = g2 / fmaxf(l, 1e-30f);
#pragma unroll
        for (int v = 0; v < 16; ++v) { ob[v * 64] += sc * o[0][v]; ob[(16 + v) * 64] += sc * o[1][v]; o[0][v] = 0.f; o[1][v] = 0.f; }
    }
    m = -1e30f; l = 0.f;
    {
        unsigned long long cmask = bun;
#pragma unroll 1
        for (; ci < n2; ++ci) {
            RING_WAIT_BAR();
            LOAD_STEP2();
            const int jb = 63 - __builtin_clzll(cmask); cmask &= ~(1ull << jb);
            const LAS unsigned char* slot = ring + (ci & 3) * 16384;
            if (((uni >> jb) & 1ull) && (mode & 1)) {
                const bool mine = (mq >> jb) & 1ull;
#pragma unroll 1
                for (int hf = 1; hf >= 0; --hf) {
                    const int key0 = jb * 64 + hf * 32;
                    if (key0 <= t0 + 7) {
                        ring_read_k(kc, slot, hf, rowoff, sw, h); ring_read_v(vf, slot, hf, rowoff, sw, h);
                        f32x16 s = qk_mma(kc, qf, bc);
                        const bool full = key0 + 31 <= t0;
                        const unsigned vm = mine ? (run_mask(key0 + 8 * h, 0, t) | (run_mask(key0 + 16 + 8 * h, 0, t) << 8)) : 0u;
                        softmax_step(s, full, vm, sl2 * (float)(key0 - t0), m, l, o, mine);
                        pv_mma(o, vf, s);
                    }
                }
            }
        }
    }
#undef LOAD_STEP2
    {
        l += __shfl_xor(l, 32);
        const float sc = g1 / fmaxf(l, 1e-30f);
#pragma unroll
        for (int v = 0; v < 16; ++v) { o[0][v] = ob[v * 64] + sc * o[0][v]; o[1][v] = ob[(16 + v) * 64] + sc * o[1][v]; }
    }
    bf16_t* op = A.O + row * D + head * 64 + 4 * h;
#pragma unroll
    for (int dt = 0; dt < 2; ++dt)
#pragma unroll
        for (int v4 = 0; v4 < 4; ++v4) { u32x2 w; w.x = cvt_pk_bf16(o[dt][4 * v4], o[dt][4 * v4 + 1]); w.y = cvt_pk_bf16(o[dt][4 * v4 + 2], o[dt][4 * v4 + 3]); *(u32x2*)(op + 32 * dt + 8 * v4) = w; }
}
__device__ __forceinline__ void attn_phase(const Ctx& X, const AttnArgs& A, const int mode = 3) {
    for (int i = 0;; ++i) {
        const int k = i * X.G + ((i & 1) ? X.G - 1 - X.bid : X.bid);
        if (i * X.G >= 2048) break;
        if (k < 2048) { const int qt = 63 - (k >> 5), bg = k & 31; attn_item(X, A, bg >> 2, bg & 3, qt, mode); }
    }
    RING_DRAIN_BAR();
}
#define XB_TMO      128
#define XB_XCNT(j)  (256  + 64 * (j))
#define XB_XSUB(j)  (1280 + 64 * (j))
#define XB_XGEN(j)  (2304 + 64 * (j))
#define XB_TOP      3328
#define XB_TOPGEN   3392
#define XCD_BAR_WORDS 3456
#define XB_SPIN_CAP (1u << 18)

__device__ __forceinline__ unsigned xb_ld(unsigned* p)              { return __hip_atomic_load(p, __ATOMIC_RELAXED, __HIP_MEMORY_SCOPE_AGENT); }
__device__ __forceinline__ unsigned xb_add(unsigned* p, unsigned v) { return __hip_atomic_fetch_add(p, v, __ATOMIC_RELAXED, __HIP_MEMORY_SCOPE_AGENT); }
__device__ __forceinline__ unsigned xb_xcc_id() { return (unsigned)__builtin_amdgcn_s_getreg((3 << 11) | 20) & 0xFu; }
#define XB_SPIN(cond, bar) do { unsigned _sp = 0; while (cond) { __builtin_amdgcn_s_sleep(1); \
    if ((++_sp & 255u) == 0u) { if (xb_ld(&(bar)[XB_TMO])) break; if (_sp > XB_SPIN_CAP) { atomicAdd(&(bar)[XB_TMO], 1u); break; } } } } while (0)

struct XcdBarrier {
    unsigned* bar; unsigned x;
    volatile LAS unsigned* st;
};

__device__ __forceinline__ XcdBarrier xcd_barrier_post(unsigned* bar, volatile LAS unsigned* st) {
    XcdBarrier b; b.bar = bar; b.x = xb_xcc_id(); b.st = st;
    if (threadIdx.x == 0) (void)xb_add(&bar[XB_XCNT(b.x)], 1u);
    return b;
}
__device__ __forceinline__ void xcd_barrier_complete(unsigned* bar, unsigned x, unsigned& nloc, unsigned& nx) {
    const unsigned G = gridDim.x * gridDim.y * gridDim.z;
    unsigned sum, cnt, mine, sp = 0u;
    for (;;) {
        sum = 0u; cnt = 0u; mine = 0u;
#pragma unroll
        for (unsigned j = 0; j < 16; ++j) { const unsigned c = xb_ld(&bar[XB_XCNT(j)]); sum += c; cnt += (c > 0u) ? 1u : 0u; mine = (j == x) ? c : mine; }
        if (sum == G) break;
        __builtin_amdgcn_s_sleep(1);
        if ((++sp & 255u) == 0u) { if (xb_ld(&bar[XB_TMO])) break; if (sp > XB_SPIN_CAP) { atomicAdd(&bar[XB_TMO], 1u); break; } }
    }
    nloc = mine > 0u ? mine : 1u; nx = cnt > 0u ? cnt : 1u;
}

__device__ __forceinline__ void xcd_barrier(const XcdBarrier& b) {
    asm volatile("s_waitcnt vmcnt(0)" ::: "memory");
    __syncthreads();
    if (threadIdx.x == 0) {
        unsigned* bar = b.bar;
        __builtin_amdgcn_s_waitcnt(0);
        unsigned nloc = b.st[0], nx = b.st[1];
        if (nloc == 0u) { xcd_barrier_complete(bar, b.x, nloc, nx); b.st[0] = nloc; b.st[1] = nx; }
        const unsigned old = xb_add(&bar[XB_XSUB(b.x)], 1u);
        const unsigned gen = old / nloc;
        if (old + 1u == (gen + 1u) * nloc) {
            __builtin_amdgcn_fence(__ATOMIC_RELEASE, "agent");
            asm volatile("s_waitcnt vmcnt(0)" ::: "memory");
            const unsigned og = xb_add(&bar[XB_TOP], 1u);
            const unsigned tg = og / nx;
            if (og + 1u == (tg + 1u) * nx) xb_add(&bar[XB_TOPGEN], 1u);
            else XB_SPIN(xb_ld(&bar[XB_TOPGEN]) == tg, bar);
            __builtin_amdgcn_fence(__ATOMIC_ACQUIRE, "agent");
            xb_add(&bar[XB_XGEN(b.x)], 1u);
            asm volatile("s_waitcnt vmcnt(0)" ::: "memory");
        } else {
            XB_SPIN(xb_ld(&bar[XB_XGEN(b.x)]) == gen, bar);
            __builtin_amdgcn_fence(__ATOMIC_ACQUIRE, "agent");
            asm volatile("s_waitcnt vmcnt(0)" ::: "memory");
        }
    }
    __syncthreads();
}

__global__ void __launch_bounds__(512, 2) yoco_fwd(Params Pk) {
    extern __shared__ __attribute__((aligned(16))) unsigned char lds_raw[];
    cg::grid_group grid = cg::this_grid();
    { LAS Params* LP = (LAS Params*)((LAS unsigned char*)lds_raw); if (threadIdx.x == 0) {
#pragma unroll
        for (int i = 0; i < 19; ++i) LP->in[i] = Pk.in[i];
        LP->out = Pk.out; LP->ws = Pk.ws; LP->ph_lo = Pk.ph_lo; LP->ph_hi = Pk.ph_hi; } }
    volatile LAS unsigned* xb_st = (volatile LAS unsigned*)((LAS unsigned char*)lds_raw + 192);
    if (threadIdx.x == 0) { xb_st[0] = 0u; xb_st[1] = 0u; }
    unsigned* const xb_words = (unsigned*)(Pk.ws + WS_BAR);
    if (blockIdx.x == 0) { for (int i = threadIdx.x; i < XCD_BAR_WORDS; i += 512) __hip_atomic_store(xb_words + i, 0u, __ATOMIC_RELAXED, __HIP_MEMORY_SCOPE_AGENT); }
    asm volatile("s_waitcnt vmcnt(0)" ::: "memory");
    __syncthreads();
    const int ph_lo = Pk.ph_lo, ph_hi = Pk.ph_hi;
    grid.sync();
    (void)xcd_barrier_post(xb_words, xb_st);
    {
        int tid_ = threadIdx.x, g_ = gridDim.x, b_ = blockIdx.x; asm volatile("" : "+v"(tid_), "+s"(g_), "+s"(b_));
        Ctx X; X.lds = (LAS unsigned char*)lds_raw + 256; X.tid = tid_; X.lane = X.tid & 63; X.wave = __builtin_amdgcn_readfirstlane(X.tid >> 6); X.G = g_; X.bid = b_;
        p0_phase(X, (const LAS Params*)(X.lds - 256)); __syncthreads();
        XcdBarrier xbar; xbar.bar = xb_words; xbar.x = xb_xcc_id(); xbar.st = xb_st; xcd_barrier(xbar);
    }
    int dupflag_ = 0; (void)dupflag_;
    for (int ph = ph_lo < 1 ? 1 : ph_lo; ph < ph_hi; ++ph) {
        int cur_st_ = -1; (void)cur_st_;
        asm volatile("" ::: "memory");
        int tid_ = threadIdx.x, g_ = gridDim.x, b_ = blockIdx.x; asm volatile("" : "+v"(tid_), "+s"(g_), "+s"(b_));
        Ctx X; X.lds = (LAS unsigned char*)lds_raw + 256; X.tid = tid_; X.lane = X.tid & 63; X.wave = __builtin_amdgcn_readfirstlane(X.tid >> 6); X.G = g_; X.bid = b_;
        Params P;
        { const LAS Params* LP = (const LAS Params*)(X.lds - 256);
          P.in[I_X] = uptr(LP->in[I_X]); P.in[I_NORMG] = uptr(LP->in[I_NORMG]); P.in[I_ACONV] = uptr(LP->in[I_ACONV]); P.in[I_KVNG] = uptr(LP->in[I_KVNG]); P.in[I_CW2] = uptr(LP->in[I_CW2]);
          P.out = uptr(LP->out); P.ws = uptr(LP->ws); }
        unsigned char* ws = P.ws;
        bf16_t* const H = (bf16_t*)(ws + WS_H); bf16_t* const HID = (bf16_t*)(ws + WS_HID); bf16_t* const HID2 = (bf16_t*)(ws + WS_HID + 64 * MiB); bf16_t* const Y = (bf16_t*)(ws + WS_Y);
        float* const PART = (float*)(ws + WS_PART); float* const GATES = (float*)(ws + WS_GATES);
        const float* const MOD = (const float*)(ws + WS_MOD); const float* const KVMOD = (const float*)(ws + WS_KVMOD);
        const float* const NG = P.in[I_NORMG];
        if (ph == 1) {
            UpdArgs U{}; U.xin = P.in[I_X]; U.xout = P.out; U.bstride = 9216; U.gpre = NG; U.shift = MOD; U.scale = MOD + 1024; U.h = H;

#ifndef SKIP_UPD
update_phase(X, U);
#endif

        } else {
            int p = ph - 2, l, st;
            if (p < 20) { l = p / 10; st = p % 10; } else if (p < 23) { l = 2; st = 10 + (p - 20); } else { p -= 23; l = 2 + p / 10; st = p % 10; }
            cur_st_ = st;
            const float* modl = MOD + (size_t)l * 8 * 9216; const float* ngl = NG + (size_t)l * 6 * 1024;
            if (st == 0 || st == 7) {
                const int s = st == 0 ? 0 : 1;
                pg8::Gemm g{H, (const bf16_t*)(ws + WS_FIN) + (size_t)(l * 2 + s) * 5632 * 1024, T, 5632, 1024, 1024}; pg8::StaticOrder S; S.init(T, 5632, X.G, X.bid);
                pg8::EpiSwiglu E{HID};

#ifndef REP_G1
#define REP_G1 1
#endif
for (int rep_ = 0; rep_ < REP_G1; ++rep_) pg8::gemm_phase<pg8::EpiSwiglu, pg8::StaticOrder, true, true>(X.lds, g, S, E, X.tid);

            } else if (st == 1 || st == 8 || st == 5) {
                pg8::Gemm g;
                if (st == 5) { g = pg8::Gemm{l < 2 ? H : HID2, l < 2 ? (const bf16_t*)(ws + WS_AOUT) + (size_t)l * 1024 * 1024 : (const bf16_t*)(ws + WS_BOUT) + (size_t)(l - 2) * 1024 * 1024, T, 1024, 1024, 1024}; }
                else { g = pg8::Gemm{HID, (const bf16_t*)(ws + WS_FOUT) + (size_t)(l * 2 + (st == 8 ? 1 : 0)) * 1024 * 2816, T, 1024, 2816, 2816}; }
                pg8::StaticOrder S; S.init(T, 1024, X.G, X.bid);
                pg8::EpiY E{Y, PART};

pg8::gemm_phase<pg8::EpiY, pg8::StaticOrder, true, true>(X.lds, g, S, E, X.tid);

            } else if (st == 2 || st == 6 || st == 9) {
                const int sub = st == 2 ? 0 : (st == 6 ? 1 : 2);
                UpdArgs U{}; U.xin = P.out; U.xout = P.out; U.y = Y; U.part = PART; U.gate = modl + (sub * 3 + 2) * 1024; U.gpost = ngl + (sub * 2 + 1) * 1024; U.w = sub == 1 ? 1.0f : 0.5f; U.bstride = 9216;
                if (sub < 2) { U.gpre = ngl + ((sub + 1) * 2) * 1024; U.shift = modl + ((sub + 1) * 3) * 1024; U.scale = modl + ((sub + 1) * 3 + 1) * 1024; U.h = H; }
                else if (l < 3) { U.gpre = ngl + 6 * 1024; U.shift = modl + 8 * 9216; U.scale = modl + 8 * 9216 + 1024; U.h = H;
                    if (l == 1) { U.gpre2 = P.in[I_KVNG]; U.shift2 = KVMOD; U.scale2 = KVMOD + 1024; U.h2 = HID; } }

#ifndef SKIP_UPD
update_phase(X, U);
#endif

            } else if (st == 3) {
                if (l < 2) {
                    pg8::Gemm g{H, (const bf16_t*)(ws + WS_AIN) + (size_t)l * 3072 * 1024, T, 3072, 1024, 1024}; pg8::StaticOrder S; S.init(T, 3072, X.G, X.bid);
                    pg8::EpiConvIn E{HID, HID2};

#ifndef SKIP_G3
pg8::gemm_phase<pg8::EpiConvIn, pg8::StaticOrder, true, true>(X.lds, g, S, E, X.tid);
#endif

                } else {
                    pg8::Gemm g{H, (const bf16_t*)(ws + WS_BIN) + (size_t)(l - 2) * 1280 * 1024, T, 1280, 1024, 1024}; pg8::StaticOrder S; S.init(T, 1280, X.G, X.bid);
                    pg8::EpiQG E{HID, GATES};

#ifndef SKIP_G3B
pg8::gemm_phase<pg8::EpiQG, pg8::StaticOrder, true, true>(X.lds, g, S, E, X.tid);
#endif

                }
            } else if (st == 4) {
                if (l < 2) {
#ifndef SKIP_CONV
conv_phase(X, HID, HID2, P.in[I_ACONV] + (size_t)l * 3 * 1024, H);
#endif
}
                else { AttnArgs A{HID, GATES, (const bf16_t*)(ws + WS_KCMP), (const bf16_t*)(ws + WS_VCMPT), (const bf16_t*)(ws + WS_KS), (const bf16_t*)(ws + WS_VST), (const bf16_t*)(ws + WS_KW), (const bf16_t*)(ws + WS_VWT), HID2};

#ifndef REP_ATTN
#define REP_ATTN 1
#endif
attn_phase(X, A);
#ifdef PROBE_ATTN_MODE
{ AttnArgs A2 = A; A2.O = Y; attn_phase(X, A2, PROBE_ATTN_MODE); }
#endif
 }
            } else if (st == 10) {
                pg8::Gemm g{HID, (const bf16_t*)(ws + WS_KVW), T, 1536, 1024, 1024}; pg8::StaticOrder S; S.init(T, 1536, X.G, X.bid);
                pg8::EpiKV E{(bf16_t*)(ws + WS_KC), (bf16_t*)(ws + WS_KS), (bf16_t*)(ws + WS_KW), (bf16_t*)(ws + WS_VST), (bf16_t*)(ws + WS_VWT)};

#ifndef SKIP_GK
pg8::gemm_phase<pg8::EpiKV, pg8::StaticOrder, true, true>(X.lds, g, S, E, X.tid);
#endif

            } else if (st == 11) {
                pg8::Gemm g{(const bf16_t*)(ws + WS_KC), (const bf16_t*)(ws + WS_CW1), 16384, 512, 2048, 1024}; pg8::DiagOrder S{X.G, X.bid};
                pg8::EpiCmp1 E{(bf16_t*)(ws + WS_HIDC), (const float*)(ws + WS_CBIAS)};

#ifndef SKIP_CM1
pg8::gemm_phase<pg8::EpiCmp1, pg8::DiagOrder, true, true>(X.lds, g, S, E, X.tid);
#endif

            } else if (st == 12) {

#ifndef SKIP_CM2
cmp2_phase(X, (const bf16_t*)(ws + WS_HIDC), P.in[I_CW2], (bf16_t*)(ws + WS_KCMP), (bf16_t*)(ws + WS_VCMPT));
#endif

            }
        }
        if (ph + 1 < ph_hi) { XcdBarrier xbar; xbar.bar = (unsigned*)(ws + WS_BAR); xbar.x = xb_xcc_id(); xbar.st = (volatile LAS unsigned*)((LAS unsigned char*)lds_raw + 192); xcd_barrier(xbar);
#ifdef PROBE_EXTRA_SYNC
            xcd_barrier(xbar);
#endif
        }
#ifdef PROBE_DUP_ST
        if (cur_st_ == PROBE_DUP_ST && !dupflag_) { dupflag_ = 1; --ph; } else dupflag_ = 0;
#endif
    }
}

extern "C" void kernel_launch(void* const* d_in, const int* in_sizes, int n_in, void* d_out, int out_size, void* d_ws, size_t ws_size, hipStream_t stream) {
    static int grid = 0;
    if (grid == 0) {
        if (n_in != 19 || out_size != T * D || ws_size < WS_END) { fprintf(stderr, "kernel_launch: unexpected shapes (n_in %d, out %d, ws %zu < %zu)\n", n_in, out_size, ws_size, (size_t)WS_END); grid = -1; return; }
        int dev = 0, cus = 0, per_cu = 0;
        (void)hipGetDevice(&dev); (void)hipDeviceGetAttribute(&cus, hipDeviceAttributeMultiprocessorCount, dev);
        if (hipFuncSetAttribute((const void*)yoco_fwd, hipFuncAttributeMaxDynamicSharedMemorySize, LDS_BYTES) != hipSuccess) { fprintf(stderr, "kernel_launch: hipFuncSetAttribute failed\n"); grid = -1; return; }
        if (hipOccupancyMaxActiveBlocksPerMultiprocessor(&per_cu, (const void*)yoco_fwd, 512, LDS_BYTES) != hipSuccess || per_cu < 1) { fprintf(stderr, "kernel_launch: occupancy query says %d\n", per_cu); per_cu = 1; }
        (void)hipGetLastError();
        grid = cus * per_cu;
    }
    if (grid < 0) return;
    Params p{};
    for (int i = 0; i < 19; ++i) p.in[i] = (const float*)d_in[i];
    p.out = (float*)d_out; p.ws = (unsigned char*)d_ws;
    p.ph_lo = 0; p.ph_hi = NPH;
    void* args[] = {&p};
    hipError_t e = hipLaunchCooperativeKernel((const void*)yoco_fwd, dim3(grid), dim3(512), args, LDS_BYTES, stream);
    if (e != hipSuccess) fprintf(stderr, "kernel_launch: cooperative launch failed: %s (grid %d)\n", hipGetErrorString(e), grid);
}
```

```cpp
#include <hip/hip_runtime.h>
#include <hip/hip_cooperative_groups.h>
#include <cstdio>
#include <cstdint>
namespace cg = cooperative_groups;
namespace pg8 {
#define PG8_LAS __attribute__((address_space(3)))
typedef unsigned short bf16_t;
typedef short bf16x8 __attribute__((ext_vector_type(8)));
typedef float f32x4 __attribute__((ext_vector_type(4)));
typedef unsigned u32x4 __attribute__((ext_vector_type(4)));
constexpr int BM = 256, BK = 64, HALF = 128, HTB = HALF * BK * 2  , STAGE_BYTES = 8 * HTB, NXCD = 8, WGM = 8;

__host__ __device__ __forceinline__ int lds_byte(int r, int c) { const int st = (r >> 4) * 2 + (c >> 5), rr = r & 15, cc = c & 31, ob = rr * 64 + cc * 2; return st * 1024 + (ob ^ (((ob >> 9) & 1) << 5)); }
__host__ __device__ __forceinline__ void stage_rc(int b, int& R, int& C) { const int st = b / 1024, sb = b % 1024, swz = sb ^ (((sb >> 9) & 1) << 5); R = (st >> 1) * 16 + swz / 64; C = (st & 1) * 32 + (swz % 64) / 2; }
__host__ __device__ __forceinline__ int perm32(int rho) { const int n = rho >> 4, i = rho & 15; return 8 * (i >> 2) + 4 * n + (i & 3); }

struct Unit { int pm, pn; };
struct Gemm { const bf16_t* A; const bf16_t* Bt; int M, N, K, lda; };

struct StaticOrder {
    int nM, nN, nwg, G, c;
    __host__ __device__ void init(int M, int N, int G_, int c_) { nM = M / BM; nN = N / BM; nwg = nM * nN; G = G_; c = c_; }
    __host__ __device__ bool next(int i, Unit& u) const {
        const long L = (long)i * G + c; if (L >= nwg) return false;
        int wgid = (int)L; { const int q = nwg / NXCD, r = nwg % NXCD, xcd = wgid % NXCD, off = wgid / NXCD; wgid = (xcd < r ? xcd * (q + 1) : r * (q + 1) + (xcd - r) * q) + off; }
        const int nig = WGM * nN, gid = wgid / nig, fm = gid * WGM, gsz = (nM - fm) < WGM ? (nM - fm) : WGM;
        u.pm = fm + ((wgid % nig) % gsz); u.pn = (wgid % nig) / gsz; return true;
    }
    __device__ __forceinline__ void a_ready(const Unit&) const {}
    __device__ __forceinline__ void done(const Unit&) const {}
};

__device__ __forceinline__ unsigned cvt_pk_bf16(float lo, float hi) { unsigned r; asm volatile("v_cvt_pk_bf16_f32 %0, %1, %2" : "=v"(r) : "v"(lo), "v"(hi)); return r; }
typedef float f32x2 __attribute__((ext_vector_type(2)));
__device__ __forceinline__ f32x2 gelu_pk(f32x2 v) {
    const f32x2 av = __builtin_elementwise_abs(v), d = av * 0.2316418882f + 1.0f;
    f32x2 t; t.x = __builtin_amdgcn_rcpf(d.x); t.y = __builtin_amdgcn_rcpf(d.y);
    f32x2 q = t * 0.5307027145f + (-0.7265760135f); q = q * t + 0.7107068705f; q = q * t + (-0.142248368f); q = q * t + 0.127414796f; q = q * t;
    const f32x2 s = (v * v) * (-0.72134752044f);
    f32x2 e; e.x = __builtin_amdgcn_exp2f(s.x); e.y = __builtin_amdgcn_exp2f(s.y);
    const f32x2 m = v * (q * e), r = v - m;
    f32x2 o; o.x = v.x < 0.f ? m.x : r.x; o.y = v.y < 0.f ? m.y : r.y; return o;
}


template <class Epi, class Sched, bool ALIGN_EPI = false, bool SP2 = false>
__device__ __forceinline__ void gemm_phase(PG8_LAS unsigned char* lds, const Gemm g, const Sched& S, const Epi& E, const int tid) {
    const int wid = __builtin_amdgcn_readfirstlane(tid >> 6), lane = tid & 63, wr = wid >> 2, wc = wid & 3, fr = lane & 15, fq = lane >> 4;
    const int K = g.K, nt = K / BK;
    unsigned voffA[2], voffB[2];
#pragma unroll
    for (int i = 0; i < 2; ++i) { int R, C; stage_rc(tid * 16 + i * 8192, R, C); const int Rb = Epi::PERM ? ((R & ~31) + perm32(R & 31)) : R;
        voffA[i] = (unsigned)(R * g.lda + C) * 2u; voffB[i] = (unsigned)(Rb * K + C) * 2u; }
    const size_t kstep = (size_t)(BK * 2);
    const size_t hstepB = (size_t)HALF * K * 2, hstepA = (size_t)HALF * g.lda * 2;
    const size_t tstepB = 2 * hstepB, tstepA = 2 * hstepA;
    const unsigned ldsw = (unsigned)wid * 1024u;
    const int aoff = lds_byte(wr * 64 + fr, fq * 8), boff = lds_byte(wc * 32 + fr, fq * 8);
#define PG8_SA(b, h) (((b) * 2 + (h)) * HTB)
#define PG8_SB(b, h) ((4 + (b) * 2 + (h)) * HTB)
#define PG8_STAGE(bufoff, gbase, voff) do { _Pragma("unroll") for (int _i = 0; _i < 2; ++_i) \
        __builtin_amdgcn_global_load_lds((const unsigned*)((const char*)(gbase) + (voff)[_i]), (PG8_LAS unsigned*)(lds + (bufoff) + ldsw + _i * 8192), 16, 0, 0); } while (0)
#define PG8_LDA(dst, b, h) do { _Pragma("unroll") for (int m = 0; m < 4; ++m) _Pragma("unroll") for (int k = 0; k < 2; ++k) dst[m][k] = *(const PG8_LAS bf16x8*)(lds + PG8_SA(b, h) + aoff + m * 2048 + k * 1024); } while (0)
#define PG8_LDB(dst, b, h) do { _Pragma("unroll") for (int n = 0; n < 2; ++n) _Pragma("unroll") for (int k = 0; k < 2; ++k) dst[n][k] = *(const PG8_LAS bf16x8*)(lds + PG8_SB(b, h) + boff + n * 2048 + k * 1024); } while (0)
#define PG8_MMA(ai, bj, At, Bt) do { __builtin_amdgcn_s_setprio(1); _Pragma("unroll") for (int m = 0; m < 4; ++m) _Pragma("unroll") for (int n = 0; n < 2; ++n) _Pragma("unroll") for (int k = 0; k < 2; ++k) \
        acc[ai][bj][m][n] = __builtin_amdgcn_mfma_f32_16x16x32_bf16(Bt[n][k], At[m][k], acc[ai][bj][m][n], 0, 0, 0); __builtin_amdgcn_s_setprio(0); } while (0)
#define PG8_WAIT_V(n) asm volatile("s_waitcnt vmcnt(" #n ")" ::: "memory")
#define PG8_WAIT_L(n) asm volatile("s_waitcnt lgkmcnt(" #n ")" ::: "memory")
#define PG8_BAR __builtin_amdgcn_s_barrier()
#define PG8_SCHED __builtin_amdgcn_sched_barrier(0)
    Unit cur, nxt; int ui = 0;
    if (!S.next(0, cur)) return;
    f32x4 acc[2][2][4][2];
#pragma unroll
    for (int a = 0; a < 2; ++a)
#pragma unroll
        for (int b = 0; b < 2; ++b)
#pragma unroll
            for (int m = 0; m < 4; ++m)
#pragma unroll
                for (int n = 0; n < 2; ++n) acc[a][b][m][n] = (f32x4){0.f, 0.f, 0.f, 0.f};
    bf16x8 At[4][2], B0[2][2], B1[2][2];
    const char* cA = (const char*)g.A + (size_t)cur.pm * tstepA; const char* cB = (const char*)g.Bt + (size_t)cur.pn * tstepB;
    S.a_ready(cur);
    if constexpr (SP2) {
        PG8_STAGE(PG8_SB(0, 0), cB, voffB); PG8_STAGE(PG8_SB(0, 1), cB + hstepB, voffB); PG8_STAGE(PG8_SA(0, 0), cA, voffA); PG8_STAGE(PG8_SA(0, 1), cA + hstepA, voffA);
        if (wr == 1) PG8_BAR;
        PG8_WAIT_V(2); PG8_BAR;
        PG8_STAGE(PG8_SB(1, 0), cB + kstep, voffB); PG8_STAGE(PG8_SA(1, 0), cA + kstep, voffA); PG8_STAGE(PG8_SB(1, 1), cB + hstepB + kstep, voffB);
        PG8_WAIT_V(6); PG8_BAR;
    } else {
        PG8_STAGE(PG8_SB(0, 0), cB, voffB); PG8_STAGE(PG8_SA(0, 0), cA, voffA); PG8_STAGE(PG8_SB(0, 1), cB + hstepB, voffB); PG8_STAGE(PG8_SA(0, 1), cA + hstepA, voffA);
        if (wr == 1) PG8_BAR;
        PG8_WAIT_V(4); PG8_BAR;
        PG8_STAGE(PG8_SB(1, 0), cB + kstep, voffB); PG8_STAGE(PG8_SA(1, 0), cA + kstep, voffA); PG8_STAGE(PG8_SB(1, 1), cB + hstepB + kstep, voffB);
        PG8_WAIT_V(6); PG8_BAR;
    }
    for (;;) {
        const bool has_next = S.next(ui + 1, nxt);
        const char* nA = has_next ? (const char*)g.A + (size_t)nxt.pm * tstepA : cA; const char* nB = has_next ? (const char*)g.Bt + (size_t)nxt.pn * tstepB : cB;
        for (int t = 0; t < nt; t += 2) {
            const bool last = (t == nt - 2);
            const char* a1 = cA + (size_t)(t + 1) * kstep;
            const char* a2 = last ? nA : cA + (size_t)(t + 2) * kstep; const char* b2 = last ? nB : cB + (size_t)(t + 2) * kstep;
            const char* a3 = a2 + kstep; const char* b3 = b2 + kstep;
            if (last && has_next) S.a_ready(nxt);
            if constexpr (SP2) {
            PG8_LDB(B0, 0, 0); PG8_LDB(B1, 0, 1); PG8_SCHED; PG8_LDA(At, 0, 0); PG8_STAGE(PG8_SA(1, 1), a1 + hstepA, voffA);
            PG8_WAIT_V(8); PG8_WAIT_L(0); PG8_BAR; PG8_MMA(0, 0, At, B0); PG8_MMA(0, 1, At, B1); PG8_BAR; PG8_SCHED;
            PG8_LDA(At, 0, 1); PG8_STAGE(PG8_SB(0, 0), b2, voffB); PG8_STAGE(PG8_SB(0, 1), b2 + hstepB, voffB); PG8_STAGE(PG8_SA(0, 0), a2, voffA);
            PG8_WAIT_V(8); PG8_WAIT_L(0); PG8_BAR; PG8_MMA(1, 0, At, B0); PG8_MMA(1, 1, At, B1); PG8_BAR; PG8_SCHED;
            PG8_LDB(B0, 1, 0); PG8_LDB(B1, 1, 1); PG8_SCHED; PG8_LDA(At, 1, 0); PG8_STAGE(PG8_SA(0, 1), a2 + hstepA, voffA);
            PG8_WAIT_V(8); PG8_WAIT_L(0); PG8_BAR; PG8_MMA(0, 0, At, B0); PG8_MMA(0, 1, At, B1); PG8_BAR; PG8_SCHED;
            PG8_LDA(At, 1, 1); PG8_STAGE(PG8_SB(1, 0), b3, voffB); PG8_STAGE(PG8_SB(1, 1), b3 + hstepB, voffB); PG8_STAGE(PG8_SA(1, 0), a3, voffA);
            PG8_WAIT_V(8); PG8_WAIT_L(0); PG8_BAR; PG8_MMA(1, 0, At, B0); PG8_MMA(1, 1, At, B1); PG8_BAR; PG8_SCHED;
            } else {
            PG8_LDB(B0, 0, 0); PG8_SCHED; PG8_LDA(At, 0, 0); PG8_STAGE(PG8_SA(1, 1), a1 + hstepA, voffA);
            PG8_WAIT_L(8); PG8_BAR; PG8_WAIT_L(0); PG8_MMA(0, 0, At, B0); PG8_BAR; PG8_SCHED;
            PG8_LDB(B1, 0, 1); PG8_STAGE(PG8_SB(0, 0), b2, voffB);
            PG8_BAR; PG8_WAIT_L(0); PG8_MMA(0, 1, At, B1); PG8_BAR;
            PG8_LDA(At, 0, 1); PG8_STAGE(PG8_SA(0, 0), a2, voffA);
            PG8_BAR; PG8_WAIT_L(0); PG8_MMA(1, 0, At, B0); PG8_BAR; PG8_SCHED;
            PG8_STAGE(PG8_SB(0, 1), b2 + hstepB, voffB);
            PG8_WAIT_V(6); PG8_BAR; PG8_MMA(1, 1, At, B1); PG8_BAR;
            PG8_LDB(B0, 1, 0); PG8_SCHED; PG8_LDA(At, 1, 0); PG8_STAGE(PG8_SA(0, 1), a2 + hstepA, voffA);
            PG8_WAIT_L(8); PG8_BAR; PG8_WAIT_L(0); PG8_MMA(0, 0, At, B0); PG8_BAR; PG8_SCHED;
            PG8_LDB(B1, 1, 1); PG8_STAGE(PG8_SB(1, 0), b3, voffB);
            PG8_BAR; PG8_WAIT_L(0); PG8_MMA(0, 1, At, B1); PG8_BAR;
            PG8_LDA(At, 1, 1); PG8_STAGE(PG8_SA(1, 0), a3, voffA);
            PG8_BAR; PG8_WAIT_L(0); PG8_MMA(1, 0, At, B0); PG8_BAR; PG8_SCHED;
            PG8_STAGE(PG8_SB(1, 1), b3 + hstepB, voffB);
            PG8_WAIT_V(6); PG8_BAR; PG8_MMA(1, 1, At, B1); PG8_BAR;
            }
        }
        if constexpr (ALIGN_EPI) { if (wr == 0) PG8_BAR; }
        if constexpr (!Epi::AFTER_DRAIN) { E(acc, cur, wr, wc, fr, fq); S.done(cur); }
        if (!has_next) break;
#pragma unroll
        for (int a = 0; a < 2; ++a)
#pragma unroll
            for (int b = 0; b < 2; ++b)
#pragma unroll
                for (int m = 0; m < 4; ++m)
#pragma unroll
                    for (int n = 0; n < 2; ++n) acc[a][b][m][n] = (f32x4){0.f, 0.f, 0.f, 0.f};
        cur = nxt; cA = nA; cB = nB; ++ui;
        if constexpr (ALIGN_EPI) { if (wr == 1) PG8_BAR; }
    }
    PG8_WAIT_V(0);
    if constexpr (!ALIGN_EPI) { if (wr == 0) PG8_BAR; }
    PG8_BAR;
    if constexpr (Epi::AFTER_DRAIN) { E.fused(acc, cur, wr, wc, fr, fq, lds, wid, lane); S.done(cur); }
#undef PG8_SA
#undef PG8_SB
#undef PG8_STAGE
#undef PG8_LDA
#undef PG8_LDB
#undef PG8_MMA
#undef PG8_WAIT_V
#undef PG8_WAIT_L
#undef PG8_BAR
#undef PG8_SCHED
}
}
#define LAS __attribute__((address_space(3)))
using pg8::bf16_t; using pg8::bf16x8; using pg8::f32x4; using pg8::u32x4; using pg8::cvt_pk_bf16;
typedef float f32x16 __attribute__((ext_vector_type(16)));
typedef int i32x4 __attribute__((ext_vector_type(4)));
typedef unsigned u32x2 __attribute__((ext_vector_type(2)));
typedef float f32x2 __attribute__((ext_vector_type(2)));

constexpr int T = 32768, D = 1024, FF = 2816, SEQ = 4096, NBATCH = 8;
constexpr int NPH = 45;
constexpr float EPS = 1e-6f, LOG2E = 1.4426950408889634f;
constexpr size_t MiB = 1u << 20;
constexpr size_t WS_FIN = 0;
constexpr size_t WS_FOUT = WS_FIN + 88 * MiB;
constexpr size_t WS_AIN = WS_FOUT + 44 * MiB;
constexpr size_t WS_AOUT = WS_AIN + 12 * MiB;
constexpr size_t WS_KVW = WS_AOUT + 4 * MiB;
constexpr size_t WS_CW1 = WS_KVW + 3 * MiB;
constexpr size_t WS_BIN = WS_CW1 + 2 * MiB;
constexpr size_t WS_BOUT = WS_BIN + 5 * MiB;
constexpr size_t WS_MOD = WS_BOUT + 4 * MiB;
constexpr size_t WS_KVMOD = WS_MOD + 4ull * 8 * 9216 * 4;
constexpr size_t WS_CBIAS = WS_KVMOD + 8ull * 2048 * 4;
constexpr size_t WS_H = WS_MOD + 2 * MiB;
constexpr size_t WS_HID = WS_H + 64 * MiB;
constexpr size_t WS_Y = WS_HID + 176 * MiB;
constexpr size_t WS_PART = WS_Y + 64 * MiB;
constexpr size_t WS_GATES = WS_PART + 2 * MiB;
constexpr size_t WS_KC = WS_GATES + 6 * MiB;
constexpr size_t WS_KS = WS_KC + 33 * MiB;
constexpr size_t WS_KW = WS_KS + 16 * MiB;
constexpr size_t WS_VST = WS_KW + 16 * MiB;
constexpr size_t WS_VWT = WS_VST + 16 * MiB;
constexpr size_t WS_HIDC = WS_VWT + 16 * MiB;
constexpr size_t WS_KCMP = WS_HIDC + 8 * MiB;
constexpr size_t WS_VCMPT = WS_KCMP + 1 * MiB;
constexpr size_t WS_BAR = WS_VCMPT + 1 * MiB;
constexpr size_t WS_END = WS_BAR + 1 * MiB;
constexpr int LDS_BYTES = 135168;

struct Params { const float* in[19]; float* out; unsigned char* ws; int ph_lo, ph_hi; };
enum { I_X = 0, I_C, I_ADAW, I_ADAB, I_NORMG, I_FIN, I_FOUT, I_AIN, I_ACONV, I_AOUT, I_KVNG, I_KVADAW, I_KVADAB, I_KVW, I_CPOS, I_CW1, I_CW2, I_BIN, I_BOUT };

__device__ __forceinline__ float bf2f(unsigned short b) { return __uint_as_float((unsigned)b << 16); }
__device__ __forceinline__ float fexp2(float x) { return __builtin_amdgcn_exp2f(x); }
__device__ __forceinline__ float frcp(float x) { return __builtin_amdgcn_rcpf(x); }
__device__ __forceinline__ float silu_f(float g) { return g * frcp(1.f + fexp2(-g * LOG2E)); }
__device__ __forceinline__ float wave_sum(float v) {
#pragma unroll
    for (int o = 1; o < 64; o <<= 1) v += __shfl_xor(v, o);
    return v;
}
template <class Tp> __device__ __forceinline__ Tp* uptr(Tp* p) { const unsigned long long v = (unsigned long long)p; const unsigned lo = __builtin_amdgcn_readfirstlane((unsigned)v), hi = __builtin_amdgcn_readfirstlane((unsigned)(v >> 32)); typedef __attribute__((address_space(1))) Tp* gptr_t; gptr_t gp = (gptr_t)(((unsigned long long)hi << 32) | lo); return (Tp*)gp; }
#define LDS_WAIT() asm volatile("s_waitcnt lgkmcnt(0)" ::: "memory")

namespace pg8 {
__device__ __forceinline__ u32x4 pack8(const f32x4 a, const f32x4 b) { u32x4 w; w.x = cvt_pk_bf16(a[0], a[1]); w.y = cvt_pk_bf16(a[2], a[3]); w.z = cvt_pk_bf16(b[0], b[1]); w.w = cvt_pk_bf16(b[2], b[3]); return w; }
struct EpiSwiglu {
    static constexpr bool PERM = true, AFTER_DRAIN = false;
    bf16_t* O;
    __device__ __forceinline__ void operator()(const f32x4 (&acc)[2][2][4][2], const Unit& u, int wr, int wc, int fr, int fq) const {
        const int row0 = u.pm * BM + wr * 64 + fr, col0 = u.pn * 128 + wc * 32 + 8 * fq;
#pragma unroll
        for (int ai = 0; ai < 2; ++ai)
#pragma unroll
            for (int m = 0; m < 4; ++m) {
                f32x4 h0, h1;
#pragma unroll
                for (int e = 0; e < 4; ++e) { h0[e] = silu_f(acc[ai][0][m][0][e]) * acc[ai][1][m][0][e]; h1[e] = silu_f(acc[ai][0][m][1][e]) * acc[ai][1][m][1][e]; }
                *(u32x4*)(O + (size_t)(row0 + ai * HALF + m * 16) * FF + col0) = pack8(h0, h1);
            }
    }
};
struct EpiY {
    static constexpr bool PERM = true, AFTER_DRAIN = false;
    bf16_t* Y; float* part;
    __device__ __forceinline__ void operator()(const f32x4 (&acc)[2][2][4][2], const Unit& u, int wr, int wc, int fr, int fq) const {
        const int row0 = u.pm * BM + wr * 64 + fr, col0 = u.pn * BM + wc * 32 + 8 * fq;
#pragma unroll
        for (int ai = 0; ai < 2; ++ai)
#pragma unroll
            for (int m = 0; m < 4; ++m) {
                const int row = row0 + ai * HALF + m * 16; float ss = 0.f;
#pragma unroll
                for (int bj = 0; bj < 2; ++bj) {
                    const f32x4 a = acc[ai][bj][m][0], b = acc[ai][bj][m][1];
                    ss += (a[0] * a[0] + a[1] * a[1]) + (a[2] * a[2] + a[3] * a[3]) + (b[0] * b[0] + b[1] * b[1]) + (b[2] * b[2] + b[3] * b[3]);
                    *(u32x4*)(Y + (size_t)row * D + col0 + bj * HALF) = pack8(a, b);
                }
                ss += __shfl_xor(ss, 16); ss += __shfl_xor(ss, 32);
                if (fq == 0) part[(size_t)row * 16 + u.pn * 4 + wc] = ss;
            }
    }
};
struct EpiConvIn {
    static constexpr bool PERM = true, AFTER_DRAIN = false;
    bf16_t* V; bf16_t* Bg;
    __device__ __forceinline__ void operator()(const f32x4 (&acc)[2][2][4][2], const Unit& u, int wr, int wc, int fr, int fq) const {
        const int row0 = u.pm * BM + wr * 64 + fr;
        if (u.pn < 8) {
            const int col0 = u.pn * 128 + wc * 32 + 8 * fq;
#pragma unroll
            for (int ai = 0; ai < 2; ++ai)
#pragma unroll
                for (int m = 0; m < 4; ++m)
                    *(u32x4*)(V + (size_t)(row0 + ai * HALF + m * 16) * D + col0) = pack8(acc[ai][0][m][0] * acc[ai][1][m][0], acc[ai][0][m][1] * acc[ai][1][m][1]);
        } else {
            const int col0 = (u.pn - 8) * BM + wc * 32 + 8 * fq;
#pragma unroll
            for (int ai = 0; ai < 2; ++ai)
#pragma unroll
                for (int m = 0; m < 4; ++m)
#pragma unroll
                    for (int bj = 0; bj < 2; ++bj)
                        *(u32x4*)(Bg + (size_t)(row0 + ai * HALF + m * 16) * D + col0 + bj * HALF) = pack8(acc[ai][bj][m][0], acc[ai][bj][m][1]);
        }
    }
};
struct EpiQG {
    static constexpr bool PERM = true, AFTER_DRAIN = false;
    bf16_t* Q; float* G;
    __device__ __forceinline__ void operator()(const f32x4 (&acc)[2][2][4][2], const Unit& u, int wr, int wc, int fr, int fq) const {
        const int row0 = u.pm * BM + wr * 64 + fr;
        if (u.pn < 4) {
            const int col0 = u.pn * BM + wc * 32 + 8 * fq; const float sc = 0.125f * LOG2E;
#pragma unroll
            for (int ai = 0; ai < 2; ++ai)
#pragma unroll
                for (int m = 0; m < 4; ++m)
#pragma unroll
                    for (int bj = 0; bj < 2; ++bj)
                        *(u32x4*)(Q + (size_t)(row0 + ai * HALF + m * 16) * D + col0 + bj * HALF) = pack8(acc[ai][bj][m][0] * sc, acc[ai][bj][m][1] * sc);
        } else {
            const int col0 = wc * 32 + 8 * fq;
            if (col0 < 48) {
#pragma unroll
                for (int ai = 0; ai < 2; ++ai)
#pragma unroll
                    for (int m = 0; m < 4; ++m) {
                        float* gp = G + (size_t)(row0 + ai * HALF + m * 16) * 48 + col0;
#pragma unroll
                        for (int n = 0; n < 2; ++n) { f32x4 s;
#pragma unroll
                            for (int e = 0; e < 4; ++e) s[e] = frcp(1.f + fexp2(-acc[ai][0][m][n][e] * LOG2E));
                            *(f32x4*)(gp + 4 * n) = s; }
                    }
            }
        }
    }
};
struct EpiKV {
    static constexpr bool PERM = true, AFTER_DRAIN = false;
    bf16_t *KC, *KS, *KW, *VSt, *VWt;
    __device__ __forceinline__ void operator()(const f32x4 (&acc)[2][2][4][2], const Unit& u, int wr, int wc, int fr, int fq) const {
        const int br = u.pn >> 1, kv = u.pn & 1;
        const int row0 = u.pm * BM + wr * 64 + fr, b = row0 >> 12;
        const int d0 = (wc & 1) * 32 + 8 * fq;
        if (br == 0 || kv == 0) {
            bf16_t* base = br == 0 ? KC + (size_t)kv * 32 * 4096 * 64 : (br == 1 ? KS : KW);
#pragma unroll
            for (int ai = 0; ai < 2; ++ai)
#pragma unroll
                for (int m = 0; m < 4; ++m)
#pragma unroll
                    for (int bj = 0; bj < 2; ++bj) {
                        const int s = (row0 + ai * HALF + m * 16) & 4095, g = 2 * bj + (wc >> 1);
                        *(u32x4*)(base + ((size_t)(b * 4 + g) * 4096 + s) * 64 + d0) = pack8(acc[ai][bj][m][0], acc[ai][bj][m][1]);
                    }
        } else {
            bf16_t* base = br == 1 ? VSt : VWt;
#pragma unroll
            for (int ai = 0; ai < 2; ++ai)
#pragma unroll
                for (int m = 0; m < 4; ++m)
#pragma unroll
                    for (int bj = 0; bj < 2; ++bj) {
                        const int s = (row0 + ai * HALF + m * 16) & 4095, g = 2 * bj + (wc >> 1);
                        bf16_t* p = base + (((size_t)(b * 4 + g) * 64 + (s >> 6)) * 64 + d0) * 64 + (s & 63);
                        const u32x4 w = pack8(acc[ai][bj][m][0], acc[ai][bj][m][1]);
                        p[0 * 64] = (bf16_t)(w.x & 0xffffu); p[1 * 64] = (bf16_t)(w.x >> 16); p[2 * 64] = (bf16_t)(w.y & 0xffffu); p[3 * 64] = (bf16_t)(w.y >> 16);
                        p[4 * 64] = (bf16_t)(w.z & 0xffffu); p[5 * 64] = (bf16_t)(w.z >> 16); p[6 * 64] = (bf16_t)(w.w & 0xffffu); p[7 * 64] = (bf16_t)(w.w >> 16);
                    }
        }
    }
};
struct EpiCmp1 {
    static constexpr bool PERM = true, AFTER_DRAIN = false;
    bf16_t* O; const float* cbias;
    __device__ __forceinline__ void operator()(const f32x4 (&acc)[2][2][4][2], const Unit& u, int wr, int wc, int fr, int fq) const {
        const int row0 = u.pm * BM + wr * 64 + fr, col0 = wc * 32 + 8 * fq;
#pragma unroll
        for (int bj = 0; bj < 2; ++bj) {
            const f32x4 b0 = *(const f32x4*)(cbias + u.pn * 256 + col0 + bj * HALF), b1 = *(const f32x4*)(cbias + u.pn * 256 + col0 + bj * HALF + 4);
#pragma unroll
            for (int ai = 0; ai < 2; ++ai)
#pragma unroll
                for (int m = 0; m < 4; ++m) {
                    f32x4 x0 = acc[ai][bj][m][0] + b0, x1 = acc[ai][bj][m][1] + b1;
#pragma unroll
                    for (int e = 0; e < 4; ++e) {
                        { const float x = x0[e], z = 1.5957691216f * (x + 0.044715f * x * x * x); x0[e] = x * frcp(1.f + fexp2(-z * LOG2E)); }
                        { const float x = x1[e], z = 1.5957691216f * (x + 0.044715f * x * x * x); x1[e] = x * frcp(1.f + fexp2(-z * LOG2E)); }
                    }
                    *(u32x4*)(O + (size_t)(row0 + ai * HALF + m * 16) * 256 + col0 + bj * HALF) = pack8(x0, x1);
                }
        }
    }
};
struct DiagOrder {
    int G, c;
    __device__ bool next(int i, Unit& u) const { const int L = i * G + c; if (L >= 64) return false; u.pm = L; u.pn = L >> 5; return true; }
    __device__ __forceinline__ void a_ready(const Unit&) const {}
    __device__ __forceinline__ void done(const Unit&) const {}
};
}
struct Ctx { LAS unsigned char* lds; int tid, lane, wave, G, bid; };

__device__ __forceinline__ void conv_item(const float* W, int ldw, int ncv, int src_col0, int K, bf16_t* WT, int dst_row0, int kb, LAS float* scr, int lane) {
    const int k0 = 64 * kb, col = src_col0 + (lane & 31); const bool ok = col < ncv;
#pragma unroll 8
    for (int i = 0; i < 32; ++i) { const int kk = 2 * i + (lane >> 5); scr[kk * 33 + (lane & 31)] = ok ? W[(size_t)(k0 + kk) * ldw + col] : 0.f; }
    LDS_WAIT(); asm volatile("" ::: "memory");
    const int c = lane & 7;
#pragma unroll
    for (int j = 0; j < 4; ++j) { const int n = (lane >> 3) + 8 * j; const LAS float* s = scr + (8 * c) * 33 + n;
        u32x4 o; o.x = cvt_pk_bf16(s[0 * 33], s[1 * 33]); o.y = cvt_pk_bf16(s[2 * 33], s[3 * 33]); o.z = cvt_pk_bf16(s[4 * 33], s[5 * 33]); o.w = cvt_pk_bf16(s[6 * 33], s[7 * 33]);
        *(u32x4*)(WT + (size_t)(dst_row0 + n) * K + k0 + 8 * c) = o; }
    LDS_WAIT(); asm volatile("" ::: "memory");
}
#define PIN(k) uptr(LP->in[k])
__device__ __forceinline__ void p0_phase(const Ctx& X, const LAS Params* LP) {
    unsigned char* ws = uptr(LP->ws);
    LAS float* sc = (LAS float*)X.lds;
    LAS float* red = (LAS float*)(X.lds + 32768);
    for (int i = X.tid; i < 8192; i += 512) { const int b = i >> 10, k = i & 1023; sc[k * 8 + b] = silu_f(PIN(I_C)[i]); }
    __syncthreads();
    for (int it = X.bid; it < 608; it += X.G) {
        const float* W; const float* bias; float* out; int N, cb;
        if (it < 576) { const int l = it / 144; cb = it % 144; N = 9216; W = PIN(I_ADAW) + (size_t)l * 1024 * 9216; bias = PIN(I_ADAB) + l * 9216; out = (float*)(ws + WS_MOD) + (size_t)l * 8 * 9216; }
        else { cb = it - 576; N = 2048; W = PIN(I_KVADAW); bias = PIN(I_KVADAB); out = (float*)(ws + WS_KVMOD); }
        float a[8];
#pragma unroll
        for (int b = 0; b < 8; ++b) a[b] = 0.f;
        const float* wp = W + (size_t)(128 * X.wave) * N + 64 * cb + X.lane;
#pragma unroll 4
        for (int k = 0; k < 128; ++k) { const float w = wp[(size_t)k * N]; const f32x4 s0 = *(const LAS f32x4*)(sc + (128 * X.wave + k) * 8), s1 = *(const LAS f32x4*)(sc + (128 * X.wave + k) * 8 + 4);
            a[0] += s0[0] * w; a[1] += s0[1] * w; a[2] += s0[2] * w; a[3] += s0[3] * w; a[4] += s1[0] * w; a[5] += s1[1] * w; a[6] += s1[2] * w; a[7] += s1[3] * w; }
#pragma unroll
        for (int b = 0; b < 8; ++b) red[(X.wave * 8 + b) * 64 + X.lane] = a[b];
        __syncthreads();
        { const int b = X.tid >> 6, col = X.tid & 63; float s = bias[64 * cb + col];
#pragma unroll
          for (int w = 0; w < 8; ++w) s += red[(w * 8 + b) * 64 + col];
          out[(size_t)b * N + 64 * cb + col] = s; }
        __syncthreads();
    }
    for (int kv = 0; kv < 2; ++kv) if (X.bid == X.G - 1 - kv) {
        const int col = X.tid & 255, half = X.tid >> 8; const float* pos = PIN(I_CPOS) + kv * 2048 + half * 1024; const float* w1 = PIN(I_CW1) + ((size_t)kv * 2048 + half * 1024) * 256 + col;
        float s = 0.f;
        for (int f = 0; f < 1024; ++f) s += pos[f] * w1[(size_t)f * 256];
        red[X.tid] = s; __syncthreads();
        if (X.tid < 256) ((float*)(ws + WS_CBIAS))[kv * 256 + X.tid] = red[X.tid] + red[X.tid + 256];
        __syncthreads();
    }
    __syncthreads();
    LAS float* scr = (LAS float*)(X.lds + X.wave * 8448);
    const int gw = X.bid * 8 + X.wave, NGW = X.G * 8;
    for (int it = gw; it < 41472; it += NGW) {
        int r = it;
        if (r < 22528) { const int id = r / 2816, q = r % 2816, nb = q >> 4, kb = q & 15, pn = nb >> 3, jb = nb & 7;
            conv_item(PIN(I_FIN) + (size_t)id * 1024 * 5632, 5632, 5632, (jb >> 2) * 2816 + 128 * pn + 32 * (jb & 3), 1024, (bf16_t*)(ws + WS_FIN) + (size_t)id * 5632 * 1024, 32 * nb, kb, scr, X.lane); continue; } r -= 22528;
        if (r < 11264) { const int id = r / 1408, q = r % 1408, nb = q / 44, kb = q % 44;
            conv_item(PIN(I_FOUT) + (size_t)id * 2816 * 1024, 1024, 1024, 32 * nb, 2816, (bf16_t*)(ws + WS_FOUT) + (size_t)id * 1024 * 2816, 32 * nb, kb, scr, X.lane); continue; } r -= 11264;
        if (r < 3072) { const int id = r / 1536, q = r % 1536, nb = q >> 4, kb = q & 15, pn = nb >> 3, jb = nb & 7;
            const int src = pn < 8 ? ((jb >> 2) ? 2048 : 1024) + 128 * pn + 32 * (jb & 3) : 256 * (pn - 8) + 32 * jb;
            conv_item(PIN(I_AIN) + (size_t)id * 1024 * 3072, 3072, 3072, src, 1024, (bf16_t*)(ws + WS_AIN) + (size_t)id * 3072 * 1024, 32 * nb, kb, scr, X.lane); continue; } r -= 3072;
        if (r < 1024) { const int id = r / 512, q = r % 512, nb = q >> 4, kb = q & 15;
            conv_item(PIN(I_AOUT) + (size_t)id * 1024 * 1024, 1024, 1024, 32 * nb, 1024, (bf16_t*)(ws + WS_AOUT) + (size_t)id * 1024 * 1024, 32 * nb, kb, scr, X.lane); continue; } r -= 1024;
        if (r < 768) { const int nb = r >> 4, kb = r & 15;
            conv_item(PIN(I_KVW), 1536, 1536, 32 * nb, 1024, (bf16_t*)(ws + WS_KVW), 32 * nb, kb, scr, X.lane); continue; } r -= 768;
        if (r < 512) { const int id = r / 256, q = r % 256, nb = q >> 5, kb = q & 31;
            conv_item(PIN(I_CW1) + (size_t)id * 2048 * 256, 256, 256, 32 * nb, 2048, (bf16_t*)(ws + WS_CW1) + (size_t)id * 256 * 2048, 32 * nb, kb, scr, X.lane); continue; } r -= 512;
        if (r < 1280) { const int id = r / 640, q = r % 640, nb = q >> 4, kb = q & 15;
            conv_item(PIN(I_BIN) + (size_t)id * 1024 * 1072, 1072, 1072, 32 * nb, 1024, (bf16_t*)(ws + WS_BIN) + (size_t)id * 1280 * 1024, 32 * nb, kb, scr, X.lane); continue; } r -= 1280;
        { const int id = r / 512, q = r % 512, nb = q >> 4, kb = q & 15;
            conv_item(PIN(I_BOUT) + (size_t)id * 1024 * 1024, 1024, 1024, 32 * nb, 1024, (bf16_t*)(ws + WS_BOUT) + (size_t)id * 1024 * 1024, 32 * nb, kb, scr, X.lane); }
    }
}

struct UpdArgs { const float* xin; float* xout; const bf16_t* y; const float* part; const float* gate; const float* gpost; float w; int bstride;
                 const float* gpre; const float* shift; const float* scale; bf16_t* h; const float* gpre2; const float* shift2; const float* scale2; bf16_t* h2; };
__device__ __forceinline__ void update_phase(const Ctx& X, const UpdArgs& A) {
    constexpr int R = 2;
    const int gw = X.bid * 8 + X.wave, NGW = X.G * 8, c0 = 4 * X.lane;
    for (int row0 = gw; row0 < T; row0 += R * NGW) {
        f32x4 xv[R][4]; u32x2 yy[R][4]; f32x4 pp[R][4];
#pragma unroll
        for (int q = 0; q < R; ++q) { const int row = min(row0 + q * NGW, T - 1);
#pragma unroll
            for (int j = 0; j < 4; ++j) xv[q][j] = *(const f32x4*)(A.xin + (size_t)row * D + c0 + 256 * j);
            if (A.y) {
#pragma unroll
                for (int j = 0; j < 4; ++j) { yy[q][j] = *(const u32x2*)(A.y + (size_t)row * D + c0 + 256 * j); pp[q][j] = *(const f32x4*)(A.part + (size_t)row * 16 + 4 * j); }
            }
        }
#pragma unroll
        for (int q = 0; q < R; ++q) { const int row = row0 + q * NGW; if (row < T) {
            const int b = row >> 12;
            if (A.y) {
                const float ssq = ((pp[q][0][0] + pp[q][0][1]) + (pp[q][0][2] + pp[q][0][3])) + ((pp[q][1][0] + pp[q][1][1]) + (pp[q][1][2] + pp[q][1][3])) + ((pp[q][2][0] + pp[q][2][1]) + (pp[q][2][2] + pp[q][2][3])) + ((pp[q][3][0] + pp[q][3][1]) + (pp[q][3][2] + pp[q][3][3]));
                const float rs = A.w * __builtin_amdgcn_rsqf(ssq * (1.f / D) + EPS);
#pragma unroll
                for (int j = 0; j < 4; ++j) { const int c = c0 + 256 * j;
                    const f32x4 gt = *(const f32x4*)(A.gate + (size_t)b * A.bstride + c), gp = *(const f32x4*)(A.gpost + c);
                    const f32x4 yv = {__uint_as_float(yy[q][j].x << 16), __uint_as_float(yy[q][j].x & 0xffff0000u), __uint_as_float(yy[q][j].y << 16), __uint_as_float(yy[q][j].y & 0xffff0000u)};
                    xv[q][j] = xv[q][j] + gt * gp * yv * rs; }
            }
            if (A.xout) {
#pragma unroll
                for (int j = 0; j < 4; ++j) *(f32x4*)(A.xout + (size_t)row * D + c0 + 256 * j) = xv[q][j];
            }
            if (A.h) {
                float s = 0.f;
#pragma unroll
                for (int j = 0; j < 4; ++j) s += (xv[q][j][0] * xv[q][j][0] + xv[q][j][1] * xv[q][j][1]) + (xv[q][j][2] * xv[q][j][2] + xv[q][j][3] * xv[q][j][3]);
                const float r = __builtin_amdgcn_rsqf(wave_sum(s) * (1.f / D) + EPS);
#pragma unroll
                for (int j = 0; j < 4; ++j) { const int c = c0 + 256 * j;
                    const f32x4 g = *(const f32x4*)(A.gpre + c), sh = *(const f32x4*)(A.shift + (size_t)b * A.bstride + c), scl = *(const f32x4*)(A.scale + (size_t)b * A.bstride + c);
                    const f32x4 hv = xv[q][j] * r * g * (scl + 1.f) + sh; u32x2 o; o.x = cvt_pk_bf16(hv[0], hv[1]); o.y = cvt_pk_bf16(hv[2], hv[3]);
                    *(u32x2*)(A.h + (size_t)row * D + c) = o; }
                if (A.h2) {
#pragma unroll
                    for (int j = 0; j < 4; ++j) { const int c = c0 + 256 * j;
                        const f32x4 g = *(const f32x4*)(A.gpre2 + c), sh = *(const f32x4*)(A.shift2 + (size_t)b * 2048 + c), scl = *(const f32x4*)(A.scale2 + (size_t)b * 2048 + c);
                        const f32x4 hv = xv[q][j] * r * g * (scl + 1.f) + sh; u32x2 o; o.x = cvt_pk_bf16(hv[0], hv[1]); o.y = cvt_pk_bf16(hv[2], hv[3]);
                        *(u32x2*)(A.h2 + (size_t)row * D + c) = o; }
                }
            }
        } }
    }
}

__device__ __forceinline__ void unpack8(const u32x4 w, float (&f)[8]) {
    f[0] = __uint_as_float(w.x << 16); f[1] = __uint_as_float(w.x & 0xffff0000u); f[2] = __uint_as_float(w.y << 16); f[3] = __uint_as_float(w.y & 0xffff0000u);
    f[4] = __uint_as_float(w.z << 16); f[5] = __uint_as_float(w.z & 0xffff0000u); f[6] = __uint_as_float(w.w << 16); f[7] = __uint_as_float(w.w & 0xffff0000u);
}
__device__ __forceinline__ void conv_phase(const Ctx& X, const bf16_t* V, const bf16_t* Bg, const float* cw, bf16_t* Z) {
    const int gt = X.bid * 512 + X.tid, NT = X.G * 512;
    for (int i = gt; i < T * 128; i += NT) {
        const int row = i >> 7, c = (i & 127) * 8, s = row & 4095;
        const u32x4 z0 = {0u, 0u, 0u, 0u};
        const u32x4 v2 = *(const u32x4*)(V + (size_t)row * D + c), v1 = s >= 1 ? *(const u32x4*)(V + (size_t)(row - 1) * D + c) : z0, v0 = s >= 2 ? *(const u32x4*)(V + (size_t)(row - 2) * D + c) : z0;
        const u32x4 bb = *(const u32x4*)(Bg + (size_t)row * D + c);
        float a0[8], a1[8], a2[8], bf[8], o[8]; unpack8(v0, a0); unpack8(v1, a1); unpack8(v2, a2); unpack8(bb, bf);
#pragma unroll
        for (int e = 0; e < 8; ++e) o[e] = bf[e] * (cw[c + e] * a0[e] + cw[D + c + e] * a1[e] + cw[2 * D + c + e] * a2[e]);
        u32x4 w; w.x = cvt_pk_bf16(o[0], o[1]); w.y = cvt_pk_bf16(o[2], o[3]); w.z = cvt_pk_bf16(o[4], o[5]); w.w = cvt_pk_bf16(o[6], o[7]);
        *(u32x4*)(Z + (size_t)row * D + c) = w;
    }
}

__device__ __forceinline__ void cmp2_phase(const Ctx& X, const bf16_t* hidc, const float* w2, bf16_t* kcmp, bf16_t* vcmpT) {
    const int gt = X.bid * 512 + X.tid, NT = X.G * 512;
    for (int i = gt; i < 16384 * 16; i += NT) {
        const int row = i >> 4, c = (i & 15) * 4, kv = row >> 13, rr = row & 8191;
        const float* w = w2 + (size_t)kv * 256 * 64 + c; const bf16_t* hp = hidc + (size_t)row * 256;
        f32x4 a = {0.f, 0.f, 0.f, 0.f};
        for (int k = 0; k < 256; k += 8) { float hf[8]; unpack8(*(const u32x4*)(hp + k), hf);
#pragma unroll
            for (int e = 0; e < 8; ++e) a += *(const f32x4*)(w + (size_t)(k + e) * 64) * hf[e]; }
        if (kv == 0) { u32x2 o; o.x = cvt_pk_bf16(a[0], a[1]); o.y = cvt_pk_bf16(a[2], a[3]); *(u32x2*)(kcmp + (size_t)rr * 64 + c) = o; }
        else { const int bg = rr >> 8, n = rr & 255; bf16_t* p = vcmpT + (((size_t)bg * 4 + (n >> 6)) * 64 + c) * 64 + (n & 63); const unsigned w0 = cvt_pk_bf16(a[0], a[1]), w1 = cvt_pk_bf16(a[2], a[3]);
            p[0] = (bf16_t)(w0 & 0xffffu); p[64] = (bf16_t)(w0 >> 16); p[128] = (bf16_t)(w1 & 0xffffu); p[192] = (bf16_t)(w1 >> 16); }
    }
}
struct AttnArgs { const bf16_t* Q; const float* gates; const bf16_t *kcmp, *vcmpT, *KS, *VSt, *KW, *VWt; bf16_t* O; };

__device__ __forceinline__ void load_k(bf16x8 (&kf)[4], const bf16_t* Kb, int key0, int jr, int h) {
    const bf16x8* p = (const bf16x8*)(Kb + (size_t)(key0 + jr) * 64 + h * 8);
#pragma unroll
    for (int ks = 0; ks < 4; ++ks) kf[ks] = p[2 * ks];
}
__device__ __forceinline__ void load_v(bf16x8 (&vf)[4], const bf16_t* Vt, int ldv, int key0, int j, int h) {
#pragma unroll
    for (int s = 0; s < 2; ++s)
#pragma unroll
        for (int dt = 0; dt < 2; ++dt) vf[s * 2 + dt] = *(const bf16x8*)(Vt + (size_t)(dt * 32 + j) * ldv + key0 + 16 * s + 8 * h);
}
__device__ __forceinline__ f32x16 qk_mma(const bf16x8 (&kf)[4], const bf16x8 (&qf)[4], const f32x16& bc) {
    f32x16 acc = __builtin_amdgcn_mfma_f32_32x32x16_bf16(kf[0], qf[0], bc, 0, 0, 0);
#pragma unroll
    for (int ks = 1; ks < 4; ++ks) acc = __builtin_amdgcn_mfma_f32_32x32x16_bf16(kf[ks], qf[ks], acc, 0, 0, 0);
    return acc;
}
__device__ __forceinline__ void pv_mma(f32x16 (&o)[2], const bf16x8 (&vf)[4], const f32x16& p) {
#pragma unroll
    for (int s = 0; s < 2; ++s) {
        u32x4 w; w.x = cvt_pk_bf16(p[8 * s + 0], p[8 * s + 1]); w.y = cvt_pk_bf16(p[8 * s + 2], p[8 * s + 3]); w.z = cvt_pk_bf16(p[8 * s + 4], p[8 * s + 5]); w.w = cvt_pk_bf16(p[8 * s + 6], p[8 * s + 7]);
        const bf16x8 pb = __builtin_bit_cast(bf16x8, w);
#pragma unroll
        for (int dt = 0; dt < 2; ++dt) o[dt] = __builtin_amdgcn_mfma_f32_32x32x16_bf16(vf[s * 2 + dt], pb, o[dt], 0, 0, 0);
    }
}
__device__ __forceinline__ void pf_block(const bf16_t* Kb, const bf16_t* Vt, int ldv, int key0, int lane, LAS unsigned* junk) {
    __builtin_amdgcn_global_load_lds((const unsigned*)(Kb + (size_t)(key0 + lane) * 64), junk, 4, 0, 0);
    __builtin_amdgcn_global_load_lds((const unsigned*)(Vt + (size_t)lane * ldv + key0), junk, 4, 0, 0);
}
__device__ __forceinline__ unsigned run_mask(int kstart, int lo, int hi) {
    const int a = max(lo - kstart, 0), b = min(hi - kstart, 7);
    return a <= b ? ((1u << (b + 1)) - 1u) & ~((1u << a) - 1u) : 0u;
}
__device__ __forceinline__ float max16(const f32x16& s) {
    float a = fmaxf(fmaxf(s[0], s[1]), s[2]), b = fmaxf(fmaxf(s[3], s[4]), s[5]), c = fmaxf(fmaxf(s[6], s[7]), s[8]), d = fmaxf(fmaxf(s[9], s[10]), s[11]), e = fmaxf(fmaxf(s[12], s[13]), s[14]);
    return fmaxf(fmaxf(fmaxf(a, b), fmaxf(c, d)), fmaxf(e, s[15]));
}
__device__ __forceinline__ void softmax_step(f32x16& s, bool full, unsigned vm, float off, float& m, float& l, f32x16 (&o)[2], bool lane_on = true) {
    if (!full) {
#pragma unroll
        for (int v = 0; v < 16; ++v) s[v] = ((vm >> v) & 1u) ? s[v] : -1e30f;
    }
    float tm = max16(s);
    if (full && !lane_on) tm = -1e30f;
    tm = fmaxf(tm, __shfl_xor(tm, 32)) + off;
    const float mn = fmaxf(m, tm);
    if (__any(mn > m)) { const float al = fexp2(m - mn); l *= al; o[0] = o[0] * al; o[1] = o[1] * al; }
    m = mn; const float ml = (full && !lane_on) ? 3e38f : mn - off;
    float ps = 0.f;
    if (full) {
#pragma unroll
        for (int v = 0; v < 16; ++v) { const float p = fexp2(s[v] - ml); s[v] = p; ps += p; }
    } else {
#pragma unroll
        for (int v = 0; v < 16; ++v) { const float p = ((vm >> v) & 1u) ? fexp2(s[v] - ml) : 0.f; s[v] = p; ps += p; }
    }
    l += ps;
}

__device__ __forceinline__ void glds16(const void* gsrc, unsigned lds_dst) { unsigned keep;
    asm volatile("s_mov_b32 %0, m0\n\ts_mov_b32 m0, %2\n\ts_nop 0\n\tglobal_load_lds_dwordx4 %1, off\n\ts_mov_b32 m0, %0" : "=&s"(keep) : "v"(gsrc), "s"(lds_dst) : "memory"); }
struct AttnSrc { const bf16_t *Kc, *Vc, *Kw, *Vw, *Ks, *Vs; };
__device__ __forceinline__ void ring_load(const AttnSrc& S, int type, int key0, unsigned slot_addr, int wave, int lane) {
    const int q = lane & 7;
#pragma unroll
    for (int e = 0; e < 2; ++e) {
        const int pr = (2 * wave + e) & 7, i = 8 * pr + (lane >> 3), c = q ^ ((i >> 1) & 7);
        const bf16_t* src;
        if (wave < 4) { const bf16_t* kb = type == 0 ? S.Kc : (type == 1 ? S.Kw : S.Ks); const int il = i & 31, kp = (il & ~12) | ((il & 4) << 1) | ((il & 8) >> 1);
                        src = kb + (size_t)(key0 + (i & 32) + kp) * 64 + 8 * c; }
        else { const bf16_t* vb = type == 0 ? S.Vc : (type == 1 ? S.Vw : S.Vs); src = vb + ((size_t)(key0 >> 6) * 64 + i) * 64 + 8 * c; }
        glds16(src, slot_addr + (wave < 4 ? 0u : 8192u) + (unsigned)pr * 1024u);
    }
}
#define RING_WAIT_BAR() do { asm volatile("s_waitcnt vmcnt(4)" ::: "memory"); __builtin_amdgcn_s_barrier(); asm volatile("" ::: "memory"); } while (0)
#define RING_DRAIN_BAR() do { asm volatile("s_waitcnt vmcnt(0) lgkmcnt(0)" ::: "memory"); __builtin_amdgcn_s_barrier(); asm volatile("" ::: "memory"); } while (0)
__device__ __forceinline__ void ring_read_k(bf16x8 (&kf)[4], const LAS unsigned char* slot, int hf, int rowoff, int sw, int h) {
#pragma unroll
    for (int ks = 0; ks < 4; ++ks) kf[ks] = *(const LAS bf16x8*)(slot + hf * 4096 + rowoff + (((2 * ks + h) * 16) ^ sw));
}
__device__ __forceinline__ void ring_read_v(bf16x8 (&vf)[4], const LAS unsigned char* slot, int hf, int rowoff, int sw, int h) {
#pragma unroll
    for (int s = 0; s < 2; ++s)
#pragma unroll
        for (int dt = 0; dt < 2; ++dt) vf[s * 2 + dt] = *(const LAS bf16x8*)(slot + 8192 + dt * 4096 + rowoff + (((4 * hf + 2 * s + h) * 16) ^ sw));
}

__device__ __forceinline__ void attn_item(const Ctx& X, const AttnArgs& A, int b, int g, int qt, const int mode = 3) {
    int lane_ = X.lane; asm volatile("" : "+v"(lane_));
    const int lane = lane_, h = lane >> 5, j = lane & 31, ql = j >> 2, r = j & 3, wave = X.wave;
    const int tb = qt * 64, t0 = tb + wave * 8, t = t0 + ql, head = g * 4 + r, bg = b * 4 + g, cur = qt;
    const size_t row = (size_t)b * SEQ + t;
    const int rowoff = j * 128, sw = ((j >> 1) & 7) * 16;
    RING_DRAIN_BAR();
    bf16x8 qf[4];
#pragma unroll
    for (int ks = 0; ks < 4; ++ks) qf[ks] = *(const bf16x8*)(A.Q + row * D + head * 64 + ks * 16 + h * 8);
    const float sl2 = fexp2(-0.5f * (float)(head + 1)) * LOG2E;
    const float g0 = A.gates[row * 48 + head], g1 = A.gates[row * 48 + 16 + head], g2 = A.gates[row * 48 + 32 + head];
    f32x16 o[2], bc;
#pragma unroll
    for (int v = 0; v < 16; ++v) { o[0][v] = 0.f; o[1][v] = 0.f; }
    LAS float* cm = (LAS float*)(X.lds + wave * 8192);
    LAS float* ob = cm + lane;
    const LAS unsigned char* ring = X.lds + 65536;
    const unsigned ring_a = (unsigned)(unsigned long long)ring;
    LAS unsigned long long* ux = (LAS unsigned long long*)(X.lds + 131072);
    LAS int* tk = (LAS int*)(X.lds + 131072 + 64 + wave * 256);
    AttnSrc S; S.Kc = A.kcmp + (size_t)bg * 256 * 64; S.Vc = A.vcmpT + (size_t)bg * 64 * 256; S.Kw = A.KW + (size_t)bg * 4096 * 64; S.Vw = A.VWt + (size_t)bg * 64 * 4096;
    S.Ks = A.KS + (size_t)bg * 4096 * 64; S.Vs = A.VSt + (size_t)bg * 64 * 4096;
    float m, l;
    bf16x8 kc[4], vf[4];

    const int ntb = (((tb + 63 - 31) >> 4) >> 5) + 1, nb1 = (ntb + 1) >> 1;
    const int nmax_w = (t0 + 7 - 31) >> 4, nmax_t = (t - 31) >> 4, nmin_w = (t0 - 31) >> 4;
    const int ntile = nmax_w >= 0 ? (nmax_w >> 5) + 1 : 0;
#pragma unroll
    for (int v = 0; v < 16; ++v) bc[v] = 16.f * sl2 * (float)(8 * h + 16 * (v >> 3) + (v & 7)) + sl2 * (float)(31 - ql);
    m = -1e30f; l = 0.f;
    {
        for (int i = 0; i < nb1; ++i) ring_load(S, 0, i * 64, ring_a + (unsigned)i * 16384u, wave, lane);
        asm volatile("" :: "v"(qf[0]), "v"(qf[1]), "v"(qf[2]), "v"(qf[3]), "v"(g0), "v"(g1), "v"(g2));
        RING_DRAIN_BAR();
#pragma unroll 1
        for (int tile = ntile - 1; tile >= 0; --tile) {
            const LAS unsigned char* slot = ring + (tile >> 1) * 16384; const int hf = tile & 1;
            ring_read_k(kc, slot, hf, rowoff, sw, h);
            const unsigned vm = run_mask(tile * 32 + 8 * h, 0, nmax_t) | (run_mask(tile * 32 + 16 + 8 * h, 0, nmax_t) << 8);
            f32x16 s = qk_mma(kc, qf, bc);
            softmax_step(s, tile * 32 + 31 <= nmin_w, vm, sl2 * (float)(512 * tile - t0), m, l, o);
        }
        l += __shfl_xor(l, 32);
        const float inv = 1.f / fmaxf(l, 1e-30f);
#pragma unroll 1
        for (int tile = ntile - 1; tile >= 0; --tile) {
            const LAS unsigned char* slot = ring + (tile >> 1) * 16384; const int hf = tile & 1;
            ring_read_k(kc, slot, hf, rowoff, sw, h); ring_read_v(vf, slot, hf, rowoff, sw, h);
            const unsigned vm = run_mask(tile * 32 + 8 * h, 0, nmax_t) | (run_mask(tile * 32 + 16 + 8 * h, 0, nmax_t) << 8);
            f32x16 s = qk_mma(kc, qf, bc);
            const float ml = m - sl2 * (float)(512 * tile - t0);
#pragma unroll
            for (int v = 0; v < 16; ++v) {
                const float p = ((vm >> v) & 1u) ? fexp2(s[v] - ml) * inv : 0.f; s[v] = p;
                float x = p; x += __int_as_float(__builtin_amdgcn_mov_dpp(__float_as_int(x), 0xB1, 0xf, 0xf, true)); x += __int_as_float(__builtin_amdgcn_mov_dpp(__float_as_int(x), 0x4E, 0xf, 0xf, true));
                if ((v & 3) == r) cm[ql * 256 + tile * 32 + 16 * (v >> 3) + 8 * h + (v & 7)] = x;
            }
            pv_mma(o, vf, s);
        }
    }
    RING_DRAIN_BAR();
    const int wb1b = qt, wb0b = max(tb - 511, 0) >> 6, nWb = wb1b - wb0b + 1;
    const int kt0 = max(t0 - 511, 0) >> 5, kt1 = (t0 + 7) >> 5;
    int li = 0;
    for (; li < 3 && li < nWb; ++li) ring_load(S, 1, (wb1b - li) * 64, ring_a + (unsigned)(li & 3) * 16384u, wave, lane);
    unsigned long long mq = 0ull, uni = 0ull, alln = ~0ull;
    {
        const unsigned long long causal = cur >= 63 ? ~0ull : ((1ull << (cur + 1)) - 1ull);
        if (cur + 1 <= 16) { mq = causal; uni = causal; alln = causal; }
        else {
#pragma unroll 1
            for (int q = 0; q < 8; ++q) {
                float iv;
                if (lane == 0 || lane == cur || lane == cur - 1) iv = 1e30f;
                else if (lane > cur) iv = -1.f;
                else { const LAS float* c = cm + q * 256 + 4 * lane; iv = (((c[-1] + c[0]) + c[1]) + c[2]) + c[3]; }
                const int key = (__float_as_int(iv) & ~63) | (63 - lane);
                tk[lane] = key;
                int rank = 0;
#pragma unroll
                for (int i4 = 0; i4 < 16; ++i4) { const i32x4 kv = *(const LAS i32x4*)(tk + 4 * i4);
                    rank += (kv[0] > key ? 1 : 0) + (kv[1] > key ? 1 : 0) + (kv[2] > key ? 1 : 0) + (kv[3] > key ? 1 : 0); }
                unsigned long long mk = __ballot(rank < 16);
                mk &= causal;
                uni |= mk; alln &= mk; if (ql == q) mq = mk;
            }
        }
    }
    if (lane == 0) ux[wave] = uni;
    asm volatile("s_waitcnt lgkmcnt(0)" ::: "memory"); __builtin_amdgcn_s_barrier(); asm volatile("" ::: "memory");
    unsigned long long bun = 0ull;
#pragma unroll
    for (int w = 0; w < 8; ++w) bun |= ux[w];
    { const unsigned lo = __builtin_amdgcn_readfirstlane((unsigned)bun), hi = __builtin_amdgcn_readfirstlane((unsigned)(bun >> 32)); bun = ((unsigned long long)hi << 32) | lo; }
    const int n2 = nWb + __popcll(bun);
    unsigned long long lmask = bun; int ljb = 0;
#define LOAD_STEP2() do { int ty_, k0_; \
        if (li < nWb) { ty_ = 1; k0_ = (wb1b - li) * 64; } \
        else { ty_ = 2; if (li < n2) { ljb = 63 - __builtin_clzll(lmask); lmask &= ~(1ull << ljb); } k0_ = ljb * 64; } \
        ring_load(S, ty_, k0_, ring_a + (unsigned)(li & 3) * 16384u, wave, lane); ++li; } while (0)
    while (li < 3) LOAD_STEP2();
#pragma unroll
    for (int v = 0; v < 16; ++v) { ob[v * 64] = g0 * o[0][v]; ob[(16 + v) * 64] = g0 * o[1][v]; o[0][v] = 0.f; o[1][v] = 0.f; }
#pragma unroll
    for (int v = 0; v < 16; ++v) bc[v] = sl2 * (float)(8 * h + 16 * (v >> 3) + (v & 7) - ql);
    m = -1e30f; l = 0.f;
    int ci = 0;
#pragma unroll 1
    for (; ci < nWb; ++ci) {
        RING_WAIT_BAR();
        LOAD_STEP2();
        const int wb = wb1b - ci; const LAS unsigned char* slot = ring + (ci & 3) * 16384;
#pragma unroll 1
        for (int hf = 1; hf >= 0; --hf) {
            const int kt = 2 * wb + hf, key0 = kt * 32;
            if (kt >= kt0 && kt <= kt1 && (mode & 2)) {
                ring_read_k(kc, slot, hf, rowoff, sw, h); ring_read_v(vf, slot, hf, rowoff, sw, h);
                f32x16 s = qk_mma(kc, qf, bc);
                const bool full = (key0 + 31 <= t0) && (key0 >= t0 + 7 - 511);
                const unsigned vm = run_mask(key0 + 8 * h, t - 511, t) | (run_mask(key0 + 16 + 8 * h, t - 511, t) << 8);
                softmax_step(s, full, vm, sl2 * (float)(key0 - t0), m, l, o);
                pv_mma(o, vf, s);
            }
        }
    }
    {
        l += __shfl_xor(l, 32);
        const float sc = g2 / fmaxf(l, 1e-30f);
#pragma unroll
        for (int v = 0; v < 16; ++v) { ob[v * 64] += sc * o[0][v]; ob[(16 + v) * 64] += sc * o[1][v]; o[0][v] = 0.f; o[1][v] = 0.f; }
    }
    m = -1e30f; l = 0.f;
    {
        unsigned long long cmask = bun;
#pragma unroll 1
        for (; ci < n2; ++ci) {
            RING_WAIT_BAR();
            LOAD_STEP2();
            const int jb = 63 - __builtin_clzll(cmask); cmask &= ~(1ull << jb);
            const LAS unsigned char* slot = ring + (ci & 3) * 16384;
            if (((uni >> jb) & 1ull) && (mode & 1)) {
                const bool mine = (mq >> jb) & 1ull;
#pragma unroll 1
                for (int hf = 1; hf >= 0; --hf) {
                    const int key0 = jb * 64 + hf * 32;
                    if (key0 <= t0 + 7) {
                        ring_read_k(kc, slot, hf, rowoff, sw, h); ring_read_v(vf, slot, hf, rowoff, sw, h);
                        f32x16 s = qk_mma(kc, qf, bc);
                        const bool full = key0 + 31 <= t0;
                        const unsigned vm = mine ? (run_mask(key0 + 8 * h, 0, t) | (run_mask(key0 + 16 + 8 * h, 0, t) << 8)) : 0u;
                        softmax_step(s, full, vm, sl2 * (float)(key0 - t0), m, l, o, mine);
                        pv_mma(o, vf, s);
                    }
                }
            }
        }
    }
#undef LOAD_STEP2
    {
        l += __shfl_xor(l, 32);
        const float sc = g1 / fmaxf(l, 1e-30f);
#pragma unroll
        for (int v = 0; v < 16; ++v) { o[0][v] = ob[v * 64] + sc * o[0][v]; o[1][v] = ob[(16 + v) * 64] + sc * o[1][v]; }
    }
    bf16_t* op = A.O + row * D + head * 64 + 4 * h;
#pragma unroll
    for (int dt = 0; dt < 2; ++dt)
#pragma unroll
        for (int v4 = 0; v4 < 4; ++v4) { u32x2 w; w.x = cvt_pk_bf16(o[dt][4 * v4], o[dt][4 * v4 + 1]); w.y = cvt_pk_bf16(o[dt][4 * v4 + 2], o[dt][4 * v4 + 3]); *(u32x2*)(op + 32 * dt + 8 * v4) = w; }
}
__device__ __forceinline__ void attn_phase(const Ctx& X, const AttnArgs& A, const int mode = 3) {
    for (int i = 0;; ++i) {
        const int k = i * X.G + ((i & 1) ? X.G - 1 - X.bid : X.bid);
        if (i * X.G >= 2048) break;
        if (k < 2048) { const int qt = 63 - (k >> 5), bg = k & 31; attn_item(X, A, bg >> 2, bg & 3, qt, mode); }
    }
    RING_DRAIN_BAR();
}
#define XB_TMO      128
#define XB_XCNT(j)  (256  + 64 * (j))
#define XB_XSUB(j)  (1280 + 64 * (j))
#define XB_XGEN(j)  (2304 + 64 * (j))
#define XB_TOP      3328
#define XB_TOPGEN   3392
#define XCD_BAR_WORDS 3456
#define XB_SPIN_CAP (1u << 18)

__device__ __forceinline__ unsigned xb_ld(unsigned* p)              { return __hip_atomic_load(p, __ATOMIC_RELAXED, __HIP_MEMORY_SCOPE_AGENT); }
__device__ __forceinline__ unsigned xb_add(unsigned* p, unsigned v) { return __hip_atomic_fetch_add(p, v, __ATOMIC_RELAXED, __HIP_MEMORY_SCOPE_AGENT); }
__device__ __forceinline__ unsigned xb_xcc_id() { return (unsigned)__builtin_amdgcn_s_getreg((3 << 11) | 20) & 0xFu; }
#define XB_SPIN(cond, bar) do { unsigned _sp = 0; while (cond) { __builtin_amdgcn_s_sleep(1); \
    if ((++_sp & 255u) == 0u) { if (xb_ld(&(bar)[XB_TMO])) break; if (_sp > XB_SPIN_CAP) { atomicAdd(&(bar)[XB_TMO], 1u); break; } } } } while (0)

struct XcdBarrier {
    unsigned* bar; unsigned x;
    volatile LAS unsigned* st;
};

__device__ __forceinline__ XcdBarrier xcd_barrier_post(unsigned* bar, volatile LAS unsigned* st) {
    XcdBarrier b; b.bar = bar; b.x = xb_xcc_id(); b.st = st;
    if (threadIdx.x == 0) (void)xb_add(&bar[XB_XCNT(b.x)], 1u);
    return b;
}
__device__ __forceinline__ void xcd_barrier_complete(unsigned* bar, unsigned x, unsigned& nloc, unsigned& nx) {
    const unsigned G = gridDim.x * gridDim.y * gridDim.z;
    unsigned sum, cnt, mine, sp = 0u;
    for (;;) {
        sum = 0u; cnt = 0u; mine = 0u;
#pragma unroll
        for (unsigned j = 0; j < 16; ++j) { const unsigned c = xb_ld(&bar[XB_XCNT(j)]); sum += c; cnt += (c > 0u) ? 1u : 0u; mine = (j == x) ? c : mine; }
        if (sum == G) break;
        __builtin_amdgcn_s_sleep(1);
        if ((++sp & 255u) == 0u) { if (xb_ld(&bar[XB_TMO])) break; if (sp > XB_SPIN_CAP) { atomicAdd(&bar[XB_TMO], 1u); break; } }
    }
    nloc = mine > 0u ? mine : 1u; nx = cnt > 0u ? cnt : 1u;
}

__device__ __forceinline__ void xcd_barrier(const XcdBarrier& b) {
    asm volatile("s_waitcnt vmcnt(0)" ::: "memory");
    __syncthreads();
    if (threadIdx.x == 0) {
        unsigned* bar = b.bar;
        __builtin_amdgcn_s_waitcnt(0);
        unsigned nloc = b.st[0], nx = b.st[1];
        if (nloc == 0u) { xcd_barrier_complete(bar, b.x, nloc, nx); b.st[0] = nloc; b.st[1] = nx; }
        const unsigned old = xb_add(&bar[XB_XSUB(b.x)], 1u);
        const unsigned gen = old / nloc;
        if (old + 1u == (gen + 1u) * nloc) {
            __builtin_amdgcn_fence(__ATOMIC_RELEASE, "agent");
            asm volatile("s_waitcnt vmcnt(0)" ::: "memory");
            const unsigned og = xb_add(&bar[XB_TOP], 1u);
            const unsigned tg = og / nx;
            if (og + 1u == (tg + 1u) * nx) xb_add(&bar[XB_TOPGEN], 1u);
            else XB_SPIN(xb_ld(&bar[XB_TOPGEN]) == tg, bar);
            __builtin_amdgcn_fence(__ATOMIC_ACQUIRE, "agent");
            xb_add(&bar[XB_XGEN(b.x)], 1u);
            asm volatile("s_waitcnt vmcnt(0)" ::: "memory");
        } else {
            XB_SPIN(xb_ld(&bar[XB_XGEN(b.x)]) == gen, bar);
            __builtin_amdgcn_fence(__ATOMIC_ACQUIRE, "agent");
            asm volatile("s_waitcnt vmcnt(0)" ::: "memory");
        }
    }
    __syncthreads();
}

__global__ void __launch_bounds__(512, 2) yoco_fwd(Params Pk) {
    extern __shared__ __attribute__((aligned(16))) unsigned char lds_raw[];
    cg::grid_group grid = cg::this_grid();
    { LAS Params* LP = (LAS Params*)((LAS unsigned char*)lds_raw); if (threadIdx.x == 0) {
#pragma unroll
        for (int i = 0; i < 19; ++i) LP->in[i] = Pk.in[i];
        LP->out = Pk.out; LP->ws = Pk.ws; LP->ph_lo = Pk.ph_lo; LP->ph_hi = Pk.ph_hi; } }
    volatile LAS unsigned* xb_st = (volatile LAS unsigned*)((LAS unsigned char*)lds_raw + 192);
    if (threadIdx.x == 0) { xb_st[0] = 0u; xb_st[1] = 0u; }
    unsigned* const xb_words = (unsigned*)(Pk.ws + WS_BAR);
    if (blockIdx.x == 0) { for (int i = threadIdx.x; i < XCD_BAR_WORDS; i += 512) __hip_atomic_store(xb_words + i, 0u, __ATOMIC_RELAXED, __HIP_MEMORY_SCOPE_AGENT); }
    asm volatile("s_waitcnt vmcnt(0)" ::: "memory");
    __syncthreads();
    const int ph_lo = Pk.ph_lo, ph_hi = Pk.ph_hi;
    grid.sync();
    (void)xcd_barrier_post(xb_words, xb_st);
    {
        int tid_ = threadIdx.x, g_ = gridDim.x, b_ = blockIdx.x; asm volatile("" : "+v"(tid_), "+s"(g_), "+s"(b_));
        Ctx X; X.lds = (LAS unsigned char*)lds_raw + 256; X.tid = tid_; X.lane = X.tid & 63; X.wave = __builtin_amdgcn_readfirstlane(X.tid >> 6); X.G = g_; X.bid = b_;
        p0_phase(X, (const LAS Params*)(X.lds - 256)); __syncthreads();
        XcdBarrier xbar; xbar.bar = xb_words; xbar.x = xb_xcc_id(); xbar.st = xb_st; xcd_barrier(xbar);
    }
    int dupflag_ = 0; (void)dupflag_;
    for (int ph = ph_lo < 1 ? 1 : ph_lo; ph < ph_hi; ++ph) {
        int cur_st_ = -1; (void)cur_st_;
        asm volatile("" ::: "memory");
        int tid_ = threadIdx.x, g_ = gridDim.x, b_ = blockIdx.x; asm volatile("" : "+v"(tid_), "+s"(g_), "+s"(b_));
        Ctx X; X.lds = (LAS unsigned char*)lds_raw + 256; X.tid = tid_; X.lane = X.tid & 63; X.wave = __builtin_amdgcn_readfirstlane(X.tid >> 6); X.G = g_; X.bid = b_;
        Params P;
        { const LAS Params* LP = (const LAS Params*)(X.lds - 256);
          P.in[I_X] = uptr(LP->in[I_X]); P.in[I_NORMG] = uptr(LP->in[I_NORMG]); P.in[I_ACONV] = uptr(LP->in[I_ACONV]); P.in[I_KVNG] = uptr(LP->in[I_KVNG]); P.in[I_CW2] = uptr(LP->in[I_CW2]);
          P.out = uptr(LP->out); P.ws = uptr(LP->ws); }
        unsigned char* ws = P.ws;
        bf16_t* const H = (bf16_t*)(ws + WS_H); bf16_t* const HID = (bf16_t*)(ws + WS_HID); bf16_t* const HID2 = (bf16_t*)(ws + WS_HID + 64 * MiB); bf16_t* const Y = (bf16_t*)(ws + WS_Y);
        float* const PART = (float*)(ws + WS_PART); float* const GATES = (float*)(ws + WS_GATES);
        const float* const MOD = (const float*)(ws + WS_MOD); const float* const KVMOD = (const float*)(ws + WS_KVMOD);
        const float* const NG = P.in[I_NORMG];
        if (ph == 1) {
            UpdArgs U{}; U.xin = P.in[I_X]; U.xout = P.out; U.bstride = 9216; U.gpre = NG; U.shift = MOD; U.scale = MOD + 1024; U.h = H;

#ifndef SKIP_UPD
update_phase(X, U);
#endif

        } else {
            int p = ph - 2, l, st;
            if (p < 20) { l = p / 10; st = p % 10; } else if (p < 23) { l = 2; st = 10 + (p - 20); } else { p -= 23; l = 2 + p / 10; st = p % 10; }
            cur_st_ = st;
            const float* modl = MOD + (size_t)l * 8 * 9216; const float* ngl = NG + (size_t)l * 6 * 1024;
            if (st == 0 || st == 7) {
                const int s = st == 0 ? 0 : 1;
                pg8::Gemm g{H, (const bf16_t*)(ws + WS_FIN) + (size_t)(l * 2 + s) * 5632 * 1024, T, 5632, 1024, 1024}; pg8::StaticOrder S; S.init(T, 5632, X.G, X.bid);
                pg8::EpiSwiglu E{HID};

#ifndef REP_G1
#define REP_G1 1
#endif
for (int rep_ = 0; rep_ < REP_G1; ++rep_) pg8::gemm_phase<pg8::EpiSwiglu, pg8::StaticOrder, true, true>(X.lds, g, S, E, X.tid);

            } else if (st == 1 || st == 8 || st == 5) {
                pg8::Gemm g;
                if (st == 5) { g = pg8::Gemm{l < 2 ? H : HID2, l < 2 ? (const bf16_t*)(ws + WS_AOUT) + (size_t)l * 1024 * 1024 : (const bf16_t*)(ws + WS_BOUT) + (size_t)(l - 2) * 1024 * 1024, T, 1024, 1024, 1024}; }
                else { g = pg8::Gemm{HID, (const bf16_t*)(ws + WS_FOUT) + (size_t)(l * 2 + (st == 8 ? 1 : 0)) * 1024 * 2816, T, 1024, 2816, 2816}; }
                pg8::StaticOrder S; S.init(T, 1024, X.G, X.bid);
                pg8::EpiY E{Y, PART};

pg8::gemm_phase<pg8::EpiY, pg8::StaticOrder, true, true>(X.lds, g, S, E, X.tid);

            } else if (st == 2 || st == 6 || st == 9) {
                const int sub = st == 2 ? 0 : (st == 6 ? 1 : 2);
                UpdArgs U{}; U.xin = P.out; U.xout = P.out; U.y = Y; U.part = PART; U.gate = modl + (sub * 3 + 2) * 1024; U.gpost = ngl + (sub * 2 + 1) * 1024; U.w = sub == 1 ? 1.0f : 0.5f; U.bstride = 9216;
                if (sub < 2) { U.gpre = ngl + ((sub + 1) * 2) * 1024; U.shift = modl + ((sub + 1) * 3) * 1024; U.scale = modl + ((sub + 1) * 3 + 1) * 1024; U.h = H; }
                else if (l < 3) { U.gpre = ngl + 6 * 1024; U.shift = modl + 8 * 9216; U.scale = modl + 8 * 9216 + 1024; U.h = H;
                    if (l == 1) { U.gpre2 = P.in[I_KVNG]; U.shift2 = KVMOD; U.scale2 = KVMOD + 1024; U.h2 = HID; } }

#ifndef SKIP_UPD
update_phase(X, U);
#endif

            } else if (st == 3) {
                if (l < 2) {
                    pg8::Gemm g{H, (const bf16_t*)(ws + WS_AIN) + (size_t)l * 3072 * 1024, T, 3072, 1024, 1024}; pg8::StaticOrder S; S.init(T, 3072, X.G, X.bid);
                    pg8::EpiConvIn E{HID, HID2};

#ifndef SKIP_G3
pg8::gemm_phase<pg8::EpiConvIn, pg8::StaticOrder, true, true>(X.lds, g, S, E, X.tid);
#endif

                } else {
                    pg8::Gemm g{H, (const bf16_t*)(ws + WS_BIN) + (size_t)(l - 2) * 1280 * 1024, T, 1280, 1024, 1024}; pg8::StaticOrder S; S.init(T, 1280, X.G, X.bid);
                    pg8::EpiQG E{HID, GATES};

#ifndef SKIP_G3B
pg8::gemm_phase<pg8::EpiQG, pg8::StaticOrder, true, true>(X.lds, g, S, E, X.tid);
#endif

                }
            } else if (st == 4) {
                if (l < 2) {
#ifndef SKIP_CONV
conv_phase(X, HID, HID2, P.in[I_ACONV] + (size_t)l * 3 * 1024, H);
#endif
}
                else { AttnArgs A{HID, GATES, (const bf16_t*)(ws + WS_KCMP), (const bf16_t*)(ws + WS_VCMPT), (const bf16_t*)(ws + WS_KS), (const bf16_t*)(ws + WS_VST), (const bf16_t*)(ws + WS_KW), (const bf16_t*)(ws + WS_VWT), HID2};

#ifndef REP_ATTN
#define REP_ATTN 1
#endif
attn_phase(X, A);
#ifdef PROBE_ATTN_MODE
{ AttnArgs A2 = A; A2.O = Y; attn_phase(X, A2, PROBE_ATTN_MODE); }
#endif
 }
            } else if (st == 10) {
                pg8::Gemm g{HID, (const bf16_t*)(ws + WS_KVW), T, 1536, 1024, 1024}; pg8::StaticOrder S; S.init(T, 1536, X.G, X.bid);
                pg8::EpiKV E{(bf16_t*)(ws + WS_KC), (bf16_t*)(ws + WS_KS), (bf16_t*)(ws + WS_KW), (bf16_t*)(ws + WS_VST), (bf16_t*)(ws + WS_VWT)};

#ifndef SKIP_GK
pg8::gemm_phase<pg8::EpiKV, pg8::StaticOrder, true, true>(X.lds, g, S, E, X.tid);
#endif

            } else if (st == 11) {
                pg8::Gemm g{(const bf16_t*)(ws + WS_KC), (const bf16_t*)(ws + WS_CW1), 16384, 512, 2048, 1024}; pg8::DiagOrder S{X.G, X.bid};
                pg8::EpiCmp1 E{(bf16_t*)(ws + WS_HIDC), (const float*)(ws + WS_CBIAS)};

#ifndef SKIP_CM1
pg8::gemm_phase<pg8::EpiCmp1, pg8::DiagOrder, true, true>(X.lds, g, S, E, X.tid);
#endif

            } else if (st == 12) {

#ifndef SKIP_CM2
cmp2_phase(X, (const bf16_t*)(ws + WS_HIDC), P.in[I_CW2], (bf16_t*)(ws + WS_KCMP), (bf16_t*)(ws + WS_VCMPT));
#endif

            }
        }
        if (ph + 1 < ph_hi) { XcdBarrier xbar; xbar.bar = (unsigned*)(ws + WS_BAR); xbar.x = xb_xcc_id(); xbar.st = (volatile LAS unsigned*)((LAS unsigned char*)lds_raw + 192); xcd_barrier(xbar);
#ifdef PROBE_EXTRA_SYNC
            xcd_barrier(xbar);
#endif
        }
#ifdef PROBE_DUP_ST
        if (cur_st_ == PROBE_DUP_ST && !dupflag_) { dupflag_ = 1; --ph; } else dupflag_ = 0;
#endif
    }
}

extern "C" void kernel_launch(void* const* d_in, const int* in_sizes, int n_in, void* d_out, int out_size, void* d_ws, size_t ws_size, hipStream_t stream) {
    static int grid = 0;
    if (grid == 0) {
        if (n_in != 19 || out_size != T * D || ws_size < WS_END) { fprintf(stderr, "kernel_launch: unexpected shapes (n_in %d, out %d, ws %zu < %zu)\n", n_in, out_size, ws_size, (size_t)WS_END); grid = -1; return; }
        int dev = 0, cus = 0, per_cu = 0;
        (void)hipGetDevice(&dev); (void)hipDeviceGetAttribute(&cus, hipDeviceAttributeMultiprocessorCount, dev);
        if (hipFuncSetAttribute((const void*)yoco_fwd, hipFuncAttributeMaxDynamicSharedMemorySize, LDS_BYTES) != hipSuccess) { fprintf(stderr, "kernel_launch: hipFuncSetAttribute failed\n"); grid = -1; return; }
        if (hipOccupancyMaxActiveBlocksPerMultiprocessor(&per_cu, (const void*)yoco_fwd, 512, LDS_BYTES) != hipSuccess || per_cu < 1) { fprintf(stderr, "kernel_launch: occupancy query says %d\n", per_cu); per_cu = 1; }
        (void)hipGetLastError();
        grid = cus * per_cu;
    }
    if (grid < 0) return;
    Params p{};
    for (int i = 0; i < 19; ++i) p.in[i] = (const float*)d_in[i];
    p.out = (float*)d_out; p.ws = (unsigned char*)d_ws;
    p.ph_lo = 0; p.ph_hi = NPH;
    void* args[] = {&p};
    hipError_t e = hipLaunchCooperativeKernel((const void*)yoco_fwd, dim3(grid), dim3(512), args, LDS_BYTES, stream);
    if (e != hipSuccess) fprintf(stderr, "kernel_launch: cooperative launch failed: %s (grid %d)\n", hipGetErrorString(e), grid);
}
```

```cpp
#include <hip/hip_runtime.h>
#include <hip/hip_cooperative_groups.h>
#include <cstdio>
#include <cstdint>
namespace cg = cooperative_groups;
namespace pg8 {
#define PG8_LAS __attribute__((address_space(3)))
typedef unsigned short bf16_t;
typedef short bf16x8 __attribute__((ext_vector_type(8)));
typedef float f32x4 __attribute__((ext_vector_type(4)));
typedef unsigned u32x4 __attribute__((ext_vector_type(4)));
constexpr int BM = 256, BK = 64, HALF = 128, HTB = HALF * BK * 2  , STAGE_BYTES = 8 * HTB, NXCD = 8, WGM = 8;

__host__ __device__ __forceinline__ int lds_byte(int r, int c) { const int st = (r >> 4) * 2 + (c >> 5), rr = r & 15, cc = c & 31, ob = rr * 64 + cc * 2; return st * 1024 + (ob ^ (((ob >> 9) & 1) << 5)); }
__host__ __device__ __forceinline__ void stage_rc(int b, int& R, int& C) { const int st = b / 1024, sb = b % 1024, swz = sb ^ (((sb >> 9) & 1) << 5); R = (st >> 1) * 16 + swz / 64; C = (st & 1) * 32 + (swz % 64) / 2; }
__host__ __device__ __forceinline__ int perm32(int rho) { const int n = rho >> 4, i = rho & 15; return 8 * (i >> 2) + 4 * n + (i & 3); }

struct Unit { int pm, pn; };
struct Gemm { const bf16_t* A; const bf16_t* Bt; int M, N, K, lda; };

struct StaticOrder {
    int nM, nN, nwg, G, c;
    __host__ __device__ void init(int M, int N, int G_, int c_) { nM = M / BM; nN = N / BM; nwg = nM * nN; G = G_; c = c_; }
    __host__ __device__ bool next(int i, Unit& u) const {
        const long L = (long)i * G + c; if (L >= nwg) return false;
        int wgid = (int)L; { const int q = nwg / NXCD, r = nwg % NXCD, xcd = wgid % NXCD, off = wgid / NXCD; wgid = (xcd < r ? xcd * (q + 1) : r * (q + 1) + (xcd - r) * q) + off; }
        const int nig = WGM * nN, gid = wgid / nig, fm = gid * WGM, gsz = (nM - fm) < WGM ? (nM - fm) : WGM;
        u.pm = fm + ((wgid % nig) % gsz); u.pn = (wgid % nig) / gsz; return true;
    }
    __device__ __forceinline__ void a_ready(const Unit&) const {}
    __device__ __forceinline__ void done(const Unit&) const {}
};

__device__ __forceinline__ unsigned cvt_pk_bf16(float lo, float hi) { unsigned r; asm volatile("v_cvt_pk_bf16_f32 %0, %1, %2" : "=v"(r) : "v"(lo), "v"(hi)); return r; }
typedef float f32x2 __attribute__((ext_vector_type(2)));
__device__ __forceinline__ f32x2 gelu_pk(f32x2 v) {
    const f32x2 av = __builtin_elementwise_abs(v), d = av * 0.2316418882f + 1.0f;
    f32x2 t; t.x = __builtin_amdgcn_rcpf(d.x); t.y = __builtin_amdgcn_rcpf(d.y);
    f32x2 q = t * 0.5307027145f + (-0.7265760135f); q = q * t + 0.7107068705f; q = q * t + (-0.142248368f); q = q * t + 0.127414796f; q = q * t;
    const f32x2 s = (v * v) * (-0.72134752044f);
    f32x2 e; e.x = __builtin_amdgcn_exp2f(s.x); e.y = __builtin_amdgcn_exp2f(s.y);
    const f32x2 m = v * (q * e), r = v - m;
    f32x2 o; o.x = v.x < 0.f ? m.x : r.x; o.y = v.y < 0.f ? m.y : r.y; return o;
}


template <class Epi, class Sched, bool ALIGN_EPI = false, bool SP2 = false>
__device__ __forceinline__ void gemm_phase(PG8_LAS unsigned char* lds, const Gemm g, const Sched& S, const Epi& E, const int tid) {
    const int wid = __builtin_amdgcn_readfirstlane(tid >> 6), lane = tid & 63, wr = wid >> 2, wc = wid & 3, fr = lane & 15, fq = lane >> 4;
    const int K = g.K, nt = K / BK;
    unsigned voffA[2], voffB[2];
#pragma unroll
    for (int i = 0; i < 2; ++i) { int R, C; stage_rc(tid * 16 + i * 8192, R, C); const int Rb = Epi::PERM ? ((R & ~31) + perm32(R & 31)) : R;
        voffA[i] = (unsigned)(R * g.lda + C) * 2u; voffB[i] = (unsigned)(Rb * K + C) * 2u; }
    const size_t kstep = (size_t)(BK * 2);
    const size_t hstepB = (size_t)HALF * K * 2, hstepA = (size_t)HALF * g.lda * 2;
    const size_t tstepB = 2 * hstepB, tstepA = 2 * hstepA;
    const unsigned ldsw = (unsigned)wid * 1024u;
    const int aoff = lds_byte(wr * 64 + fr, fq * 8), boff = lds_byte(wc * 32 + fr, fq * 8);
#define PG8_SA(b, h) (((b) * 2 + (h)) * HTB)
#define PG8_SB(b, h) ((4 + (b) * 2 + (h)) * HTB)
#define PG8_STAGE(bufoff, gbase, voff) do { _Pragma("unroll") for (int _i = 0; _i < 2; ++_i) \
        __builtin_amdgcn_global_load_lds((const unsigned*)((const char*)(gbase) + (voff)[_i]), (PG8_LAS unsigned*)(lds + (bufoff) + ldsw + _i * 8192), 16, 0, 0); } while (0)
#define PG8_LDA(dst, b, h) do { _Pragma("unroll") for (int m = 0; m < 4; ++m) _Pragma("unroll") for (int k = 0; k < 2; ++k) dst[m][k] = *(const PG8_LAS bf16x8*)(lds + PG8_SA(b, h) + aoff + m * 2048 + k * 1024); } while (0)
#define PG8_LDB(dst, b, h) do { _Pragma("unroll") for (int n = 0; n < 2; ++n) _Pragma("unroll") for (int k = 0; k < 2; ++k) dst[n][k] = *(const PG8_LAS bf16x8*)(lds + PG8_SB(b, h) + boff + n * 2048 + k * 1024); } while (0)
#define PG8_MMA(ai, bj, At, Bt) do { __builtin_amdgcn_s_setprio(1); _Pragma("unroll") for (int m = 0; m < 4; ++m) _Pragma("unroll") for (int n = 0; n < 2; ++n) _Pragma("unroll") for (int k = 0; k < 2; ++k) \
        acc[ai][bj][m][n] = __builtin_amdgcn_mfma_f32_16x16x32_bf16(Bt[n][k], At[m][k], acc[ai][bj][m][n], 0, 0, 0); __builtin_amdgcn_s_setprio(0); } while (0)
#define PG8_WAIT_V(n) asm volatile("s_waitcnt vmcnt(" #n ")" ::: "memory")
#define PG8_WAIT_L(n) asm volatile("s_waitcnt lgkmcnt(" #n ")" ::: "memory")
#define PG8_BAR __builtin_amdgcn_s_barrier()
#define PG8_SCHED __builtin_amdgcn_sched_barrier(0)
    Unit cur, nxt; int ui = 0;
    if (!S.next(0, cur)) return;
    f32x4 acc[2][2][4][2];
#pragma unroll
    for (int a = 0; a < 2; ++a)
#pragma unroll
        for (int b = 0; b < 2; ++b)
#pragma unroll
            for (int m = 0; m < 4; ++m)
#pragma unroll
                for (int n = 0; n < 2; ++n) acc[a][b][m][n] = (f32x4){0.f, 0.f, 0.f, 0.f};
    bf16x8 At[4][2], B0[2][2], B1[2][2];
    const char* cA = (const char*)g.A + (size_t)cur.pm * tstepA; const char* cB = (const char*)g.Bt + (size_t)cur.pn * tstepB;
    S.a_ready(cur);
    if constexpr (SP2) {
        PG8_STAGE(PG8_SB(0, 0), cB, voffB); PG8_STAGE(PG8_SB(0, 1), cB + hstepB, voffB); PG8_STAGE(PG8_SA(0, 0), cA, voffA); PG8_STAGE(PG8_SA(0, 1), cA + hstepA, voffA);
        if (wr == 1) PG8_BAR;
        PG8_WAIT_V(2); PG8_BAR;
        PG8_STAGE(PG8_SB(1, 0), cB + kstep, voffB); PG8_STAGE(PG8_SA(1, 0), cA + kstep, voffA); PG8_STAGE(PG8_SB(1, 1), cB + hstepB + kstep, voffB);
        PG8_WAIT_V(6); PG8_BAR;
    } else {
        PG8_STAGE(PG8_SB(0, 0), cB, voffB); PG8_STAGE(PG8_SA(0, 0), cA, voffA); PG8_STAGE(PG8_SB(0, 1), cB + hstepB, voffB); PG8_STAGE(PG8_SA(0, 1), cA + hstepA, voffA);
        if (wr == 1) PG8_BAR;
        PG8_WAIT_V(4); PG8_BAR;
        PG8_STAGE(PG8_SB(1, 0), cB + kstep, voffB); PG8_STAGE(PG8_SA(1, 0), cA + kstep, voffA); PG8_STAGE(PG8_SB(1, 1), cB + hstepB + kstep, voffB);
        PG8_WAIT_V(6); PG8_BAR;
    }
    for (;;) {
        const bool has_next = S.next(ui + 1, nxt);
        const char* nA = has_next ? (const char*)g.A + (size_t)nxt.pm * tstepA : cA; const char* nB = has_next ? (const char*)g.Bt + (size_t)nxt.pn * tstepB : cB;
        for (int t = 0; t < nt; t += 2) {
            const bool last = (t == nt - 2);
            const char* a1 = cA + (size_t)(t + 1) * kstep;
            const char* a2 = last ? nA : cA + (size_t)(t + 2) * kstep; const char* b2 = last ? nB : cB + (size_t)(t + 2) * kstep;
            const char* a3 = a2 + kstep; const char* b3 = b2 + kstep;
            if (last && has_next) S.a_ready(nxt);
            if constexpr (SP2) {
            PG8_LDB(B0, 0, 0); PG8_LDB(B1, 0, 1); PG8_SCHED; PG8_LDA(At, 0, 0); PG8_STAGE(PG8_SA(1, 1), a1 + hstepA, voffA);
            PG8_WAIT_V(8); PG8_WAIT_L(0); PG8_BAR; PG8_MMA(0, 0, At, B0); PG8_MMA(0, 1, At, B1); PG8_BAR; PG8_SCHED;
            PG8_LDA(At, 0, 1); PG8_STAGE(PG8_SB(0, 0), b2, voffB); PG8_STAGE(PG8_SB(0, 1), b2 + hstepB, voffB); PG8_STAGE(PG8_SA(0, 0), a2, voffA);
            PG8_WAIT_V(8); PG8_WAIT_L(0); PG8_BAR; PG8_MMA(1, 0, At, B0); PG8_MMA(1, 1, At, B1); PG8_BAR; PG8_SCHED;
            PG8_LDB(B0, 1, 0); PG8_LDB(B1, 1, 1); PG8_SCHED; PG8_LDA(At, 1, 0); PG8_STAGE(PG8_SA(0, 1), a2 + hstepA, voffA);
            PG8_WAIT_V(8); PG8_WAIT_L(0); PG8_BAR; PG8_MMA(0, 0, At, B0); PG8_MMA(0, 1, At, B1); PG8_BAR; PG8_SCHED;
            PG8_LDA(At, 1, 1); PG8_STAGE(PG8_SB(1, 0), b3, voffB); PG8_STAGE(PG8_SB(1, 1), b3 + hstepB, voffB); PG8_STAGE(PG8_SA(1, 0), a3, voffA);
            PG8_WAIT_V(8); PG8_WAIT_L(0); PG8_BAR; PG8_MMA(1, 0, At, B0); PG8_MMA(1, 1, At, B1); PG8_BAR; PG8_SCHED;
            } else {
            PG8_LDB(B0, 0, 0); PG8_SCHED; PG8_LDA(At, 0, 0); PG8_STAGE(PG8_SA(1, 1), a1 + hstepA, voffA);
            PG8_WAIT_L(8); PG8_BAR; PG8_WAIT_L(0); PG8_MMA(0, 0, At, B0); PG8_BAR; PG8_SCHED;
            PG8_LDB(B1, 0, 1); PG8_STAGE(PG8_SB(0, 0), b2, voffB);
            PG8_BAR; PG8_WAIT_L(0); PG8_MMA(0, 1, At, B1); PG8_BAR;
            PG8_LDA(At, 0, 1); PG8_STAGE(PG8_SA(0, 0), a2, voffA);
            PG8_BAR; PG8_WAIT_L(0); PG8_MMA(1, 0, At, B0); PG8_BAR; PG8_SCHED;
            PG8_STAGE(PG8_SB(0, 1), b2 + hstepB, voffB);
            PG8_WAIT_V(6); PG8_BAR; PG8_MMA(1, 1, At, B1); PG8_BAR;
            PG8_LDB(B0, 1, 0); PG8_SCHED; PG8_LDA(At, 1, 0); PG8_STAGE(PG8_SA(0, 1), a2 + hstepA, voffA);
            PG8_WAIT_L(8); PG8_BAR; PG8_WAIT_L(0); PG8_MMA(0, 0, At, B0); PG8_BAR; PG8_SCHED;
            PG8_LDB(B1, 1, 1); PG8_STAGE(PG8_SB(1, 0), b3, voffB);
            PG8_BAR; PG8_WAIT_L(0); PG8_MMA(0, 1, At, B1); PG8_BAR;
            PG8_LDA(At, 1, 1); PG8_STAGE(PG8_SA(1, 0), a3, voffA);
            PG8_BAR; PG8_WAIT_L(0); PG8_MMA(1, 0, At, B0); PG8_BAR; PG8_SCHED;
            PG8_STAGE(PG8_SB(1, 1), b3 + hstepB, voffB);
            PG8_WAIT_V(6); PG8_BAR; PG8_MMA(1, 1, At, B1); PG8_BAR;
            }
        }
        if constexpr (ALIGN_EPI) { if (wr == 0) PG8_BAR; }
        if constexpr (!Epi::AFTER_DRAIN) { E(acc, cur, wr, wc, fr, fq); S.done(cur); }
        if (!has_next) break;
#pragma unroll
        for (int a = 0; a < 2; ++a)
#pragma unroll
            for (int b = 0; b < 2; ++b)
#pragma unroll
                for (int m = 0; m < 4; ++m)
#pragma unroll
                    for (int n = 0; n < 2; ++n) acc[a][b][m][n] = (f32x4){0.f, 0.f, 0.f, 0.f};
        cur = nxt; cA = nA; cB = nB; ++ui;
        if constexpr (ALIGN_EPI) { if (wr == 1) PG8_BAR; }
    }
    PG8_WAIT_V(0);
    if constexpr (!ALIGN_EPI) { if (wr == 0) PG8_BAR; }
    PG8_BAR;
    if constexpr (Epi::AFTER_DRAIN) { E.fused(acc, cur, wr, wc, fr, fq, lds, wid, lane); S.done(cur); }
#undef PG8_SA
#undef PG8_SB
#undef PG8_STAGE
#undef PG8_LDA
#undef PG8_LDB
#undef PG8_MMA
#undef PG8_WAIT_V
#undef PG8_WAIT_L
#undef PG8_BAR
#undef PG8_SCHED
}
}
#define LAS __attribute__((address_space(3)))
using pg8::bf16_t; using pg8::bf16x8; using pg8::f32x4; using pg8::u32x4; using pg8::cvt_pk_bf16;
typedef float f32x16 __attribute__((ext_vector_type(16)));
typedef int i32x4 __attribute__((ext_vector_type(4)));
typedef unsigned u32x2 __attribute__((ext_vector_type(2)));
typedef float f32x2 __attribute__((ext_vector_type(2)));

constexpr int T = 32768, D = 1024, FF = 2816, SEQ = 4096, NBATCH = 8;
constexpr int NPH = 45;
constexpr float EPS = 1e-6f, LOG2E = 1.4426950408889634f;
constexpr size_t MiB = 1u << 20;
constexpr size_t WS_FIN = 0;
constexpr size_t WS_FOUT = WS_FIN + 88 * MiB;
constexpr size_t WS_AIN = WS_FOUT + 44 * MiB;
constexpr size_t WS_AOUT = WS_AIN + 12 * MiB;
constexpr size_t WS_KVW = WS_AOUT + 4 * MiB;
constexpr size_t WS_CW1 = WS_KVW + 3 * MiB;
constexpr size_t WS_BIN = WS_CW1 + 2 * MiB;
constexpr size_t WS_BOUT = WS_BIN + 5 * MiB;
constexpr size_t WS_MOD = WS_BOUT + 4 * MiB;
constexpr size_t WS_KVMOD = WS_MOD + 4ull * 8 * 9216 * 4;
constexpr size_t WS_CBIAS = WS_KVMOD + 8ull * 2048 * 4;
constexpr size_t WS_H = WS_MOD + 2 * MiB;
constexpr size_t WS_HID = WS_H + 64 * MiB;
constexpr size_t WS_Y = WS_HID + 176 * MiB;
constexpr size_t WS_PART = WS_Y + 64 * MiB;
constexpr size_t WS_GATES = WS_PART + 2 * MiB;
constexpr size_t WS_KC = WS_GATES + 6 * MiB;
constexpr size_t WS_KS = WS_KC + 33 * MiB;
constexpr size_t WS_KW = WS_KS + 16 * MiB;
constexpr size_t WS_VST = WS_KW + 16 * MiB;
constexpr size_t WS_VWT = WS_VST + 16 * MiB;
constexpr size_t WS_HIDC = WS_VWT + 16 * MiB;
constexpr size_t WS_KCMP = WS_HIDC + 8 * MiB;
constexpr size_t WS_VCMPT = WS_KCMP + 1 * MiB;
constexpr size_t WS_BAR = WS_VCMPT + 1 * MiB;
constexpr size_t WS_END = WS_BAR + 1 * MiB;
constexpr int LDS_BYTES = 135168;

struct Params { const float* in[19]; float* out; unsigned char* ws; int ph_lo, ph_hi; };
enum { I_X = 0, I_C, I_ADAW, I_ADAB, I_NORMG, I_FIN, I_FOUT, I_AIN, I_ACONV, I_AOUT, I_KVNG, I_KVADAW, I_KVADAB, I_KVW, I_CPOS, I_CW1, I_CW2, I_BIN, I_BOUT };

__device__ __forceinline__ float bf2f(unsigned short b) { return __uint_as_float((unsigned)b << 16); }
__device__ __forceinline__ float fexp2(float x) { return __builtin_amdgcn_exp2f(x); }
__device__ __forceinline__ float frcp(float x) { return __builtin_amdgcn_rcpf(x); }
__device__ __forceinline__ float silu_f(float g) { return g * frcp(1.f + fexp2(-g * LOG2E)); }
__device__ __forceinline__ float wave_sum(float v) {
#pragma unroll
    for (int o = 1; o < 64; o <<= 1) v += __shfl_xor(v, o);
    return v;
}
template <class Tp> __device__ __forceinline__ Tp* uptr(Tp* p) { const unsigned long long v = (unsigned long long)p; const unsigned lo = __builtin_amdgcn_readfirstlane((unsigned)v), hi = __builtin_amdgcn_readfirstlane((unsigned)(v >> 32)); typedef __attribute__((address_space(1))) Tp* gptr_t; gptr_t gp = (gptr_t)(((unsigned long long)hi << 32) | lo); return (Tp*)gp; }
#define LDS_WAIT() asm volatile("s_waitcnt lgkmcnt(0)" ::: "memory")

namespace pg8 {
__device__ __forceinline__ u32x4 pack8(const f32x4 a, const f32x4 b) { u32x4 w; w.x = cvt_pk_bf16(a[0], a[1]); w.y = cvt_pk_bf16(a[2], a[3]); w.z = cvt_pk_bf16(b[0], b[1]); w.w = cvt_pk_bf16(b[2], b[3]); return w; }
struct EpiSwiglu {
    static constexpr bool PERM = true, AFTER_DRAIN = false;
    bf16_t* O;
    __device__ __forceinline__ void operator()(const f32x4 (&acc)[2][2][4][2], const Unit& u, int wr, int wc, int fr, int fq) const {
        const int row0 = u.pm * BM + wr * 64 + fr, col0 = u.pn * 128 + wc * 32 + 8 * fq;
#pragma unroll
        for (int ai = 0; ai < 2; ++ai)
#pragma unroll
            for (int m = 0; m < 4; ++m) {
                f32x4 h0, h1;
#pragma unroll
                for (int e = 0; e < 4; ++e) { h0[e] = silu_f(acc[ai][0][m][0][e]) * acc[ai][1][m][0][e]; h1[e] = silu_f(acc[ai][0][m][1][e]) * acc[ai][1][m][1][e]; }
                *(u32x4*)(O + (size_t)(row0 + ai * HALF + m * 16) * FF + col0) = pack8(h0, h1);
            }
    }
};
struct EpiY {
    static constexpr bool PERM = true, AFTER_DRAIN = false;
    bf16_t* Y; float* part;
    __device__ __forceinline__ void operator()(const f32x4 (&acc)[2][2][4][2], const Unit& u, int wr, int wc, int fr, int fq) const {
        const int row0 = u.pm * BM + wr * 64 + fr, col0 = u.pn * BM + wc * 32 + 8 * fq;
#pragma unroll
        for (int ai = 0; ai < 2; ++ai)
#pragma unroll
            for (int m = 0; m < 4; ++m) {
                const int row = row0 + ai * HALF + m * 16; float ss = 0.f;
#pragma unroll
                for (int bj = 0; bj < 2; ++bj) {
                    const f32x4 a = acc[ai][bj][m][0], b = acc[ai][bj][m][1];
                    ss += (a[0] * a[0] + a[1] * a[1]) + (a[2] * a[2] + a[3] * a[3]) + (b[0] * b[0] + b[1] * b[1]) + (b[2] * b[2] + b[3] * b[3]);
                    *(u32x4*)(Y + (size_t)row * D + col0 + bj * HALF) = pack8(a, b);
                }
                ss += __shfl_xor(ss, 16); ss += __shfl_xor(ss, 32);
                if (fq == 0) part[(size_t)row * 16 + u.pn * 4 + wc] = ss;
            }
    }
};
struct EpiConvIn {
    static constexpr bool PERM = true, AFTER_DRAIN = false;
    bf16_t* V; bf16_t* Bg;
    __device__ __forceinline__ void operator()(const f32x4 (&acc)[2][2][4][2], const Unit& u, int wr, int wc, int fr, int fq) const {
        const int row0 = u.pm * BM + wr * 64 + fr;
        if (u.pn < 8) {
            const int col0 = u.pn * 128 + wc * 32 + 8 * fq;
#pragma unroll
            for (int ai = 0; ai < 2; ++ai)
#pragma unroll
                for (int m = 0; m < 4; ++m)
                    *(u32x4*)(V + (size_t)(row0 + ai * HALF + m * 16) * D + col0) = pack8(acc[ai][0][m][0] * acc[ai][1][m][0], acc[ai][0][m][1] * acc[ai][1][m][1]);
        } else {
            const int col0 = (u.pn - 8) * BM + wc * 32 + 8 * fq;
#pragma unroll
            for (int ai = 0; ai < 2; ++ai)
#pragma unroll
                for (int m = 0; m < 4; ++m)
#pragma unroll
                    for (int bj = 0; bj < 2; ++bj)
                        *(u32x4*)(Bg + (size_t)(row0 + ai * HALF + m * 16) * D + col0 + bj * HALF) = pack8(acc[ai][bj][m][0], acc[ai][bj][m][1]);
        }
    }
};
struct EpiQG {
    static constexpr bool PERM = true, AFTER_DRAIN = false;
    bf16_t* Q; float* G;
    __device__ __forceinline__ void operator()(const f32x4 (&acc)[2][2][4][2], const Unit& u, int wr, int wc, int fr, int fq) const {
        const int row0 = u.pm * BM + wr * 64 + fr;
        if (u.pn < 4) {
            const int col0 = u.pn * BM + wc * 32 + 8 * fq; const float sc = 0.125f * LOG2E;
#pragma unroll
            for (int ai = 0; ai < 2; ++ai)
#pragma unroll
                for (int m = 0; m < 4; ++m)
#pragma unroll
                    for (int bj = 0; bj < 2; ++bj)
                        *(u32x4*)(Q + (size_t)(row0 + ai * HALF + m * 16) * D + col0 + bj * HALF) = pack8(acc[ai][bj][m][0] * sc, acc[ai][bj][m][1] * sc);
        } else {
            const int col0 = wc * 32 + 8 * fq;
            if (col0 < 48) {
#pragma unroll
                for (int ai = 0; ai < 2; ++ai)
#pragma unroll
                    for (int m = 0; m < 4; ++m) {
                        float* gp = G + (size_t)(row0 + ai * HALF + m * 16) * 48 + col0;
#pragma unroll
                        for (int n = 0; n < 2; ++n) { f32x4 s;
#pragma unroll
                            for (int e = 0; e < 4; ++e) s[e] = frcp(1.f + fexp2(-acc[ai][0][m][n][e] * LOG2E));
                            *(f32x4*)(gp + 4 * n) = s; }
                    }
            }
        }
    }
};
struct EpiKV {
    static constexpr bool PERM = true, AFTER_DRAIN = false;
    bf16_t *KC, *KS, *KW, *VSt, *VWt;
    __device__ __forceinline__ void operator()(const f32x4 (&acc)[2][2][4][2], const Unit& u, int wr, int wc, int fr, int fq) const {
        const int br = u.pn >> 1, kv = u.pn & 1;
        const int row0 = u.pm * BM + wr * 64 + fr, b = row0 >> 12;
        const int d0 = (wc & 1) * 32 + 8 * fq;
        if (br == 0 || kv == 0) {
            bf16_t* base = br == 0 ? KC + (size_t)kv * 32 * 4096 * 64 : (br == 1 ? KS : KW);
#pragma unroll
            for (int ai = 0; ai < 2; ++ai)
#pragma unroll
                for (int m = 0; m < 4; ++m)
#pragma unroll
                    for (int bj = 0; bj < 2; ++bj) {
                        const int s = (row0 + ai * HALF + m * 16) & 4095, g = 2 * bj + (wc >> 1);
                        *(u32x4*)(base + ((size_t)(b * 4 + g) * 4096 + s) * 64 + d0) = pack8(acc[ai][bj][m][0], acc[ai][bj][m][1]);
                    }
        } else {
            bf16_t* base = br == 1 ? VSt : VWt;
#pragma unroll
            for (int ai = 0; ai < 2; ++ai)
#pragma unroll
                for (int m = 0; m < 4; ++m)
#pragma unroll
                    for (int bj = 0; bj < 2; ++bj) {
                        const int s = (row0 + ai * HALF + m * 16) & 4095, g = 2 * bj + (wc >> 1);
                        bf16_t* p = base + (((size_t)(b * 4 + g) * 64 + (s >> 6)) * 64 + d0) * 64 + (s & 63);
                        const u32x4 w = pack8(acc[ai][bj][m][0], acc[ai][bj][m][1]);
                        p[0 * 64] = (bf16_t)(w.x & 0xffffu); p[1 * 64] = (bf16_t)(w.x >> 16); p[2 * 64] = (bf16_t)(w.y & 0xffffu); p[3 * 64] = (bf16_t)(w.y >> 16);
                        p[4 * 64] = (bf16_t)(w.z & 0xffffu); p[5 * 64] = (bf16_t)(w.z >> 16); p[6 * 64] = (bf16_t)(w.w & 0xffffu); p[7 * 64] = (bf16_t)(w.w >> 16);
                    }
        }
    }
};
struct EpiCmp1 {
    static constexpr bool PERM = true, AFTER_DRAIN = false;
    bf16_t* O; const float* cbias;
    __device__ __forceinline__ void operator()(const f32x4 (&acc)[2][2][4][2], const Unit& u, int wr, int wc, int fr, int fq) const {
        const int row0 = u.pm * BM + wr * 64 + fr, col0 = wc * 32 + 8 * fq;
#pragma unroll
        for (int bj = 0; bj < 2; ++bj) {
            const f32x4 b0 = *(const f32x4*)(cbias + u.pn * 256 + col0 + bj * HALF), b1 = *(const f32x4*)(cbias + u.pn * 256 + col0 + bj * HALF + 4);
#pragma unroll
            for (int ai = 0; ai < 2; ++ai)
#pragma unroll
                for (int m = 0; m < 4; ++m) {
                    f32x4 x0 = acc[ai][bj][m][0] + b0, x1 = acc[ai][bj][m][1] + b1;
#pragma unroll
                    for (int e = 0; e < 4; ++e) {
                        { const float x = x0[e], z = 1.5957691216f * (x + 0.044715f * x * x * x); x0[e] = x * frcp(1.f + fexp2(-z * LOG2E)); }
                        { const float x = x1[e], z = 1.5957691216f * (x + 0.044715f * x * x * x); x1[e] = x * frcp(1.f + fexp2(-z * LOG2E)); }
                    }
                    *(u32x4*)(O + (size_t)(row0 + ai * HALF + m * 16) * 256 + col0 + bj * HALF) = pack8(x0, x1);
                }
        }
    }
};
struct DiagOrder {
    int G, c;
    __device__ bool next(int i, Unit& u) const { const int L = i * G + c; if (L >= 64) return false; u.pm = L; u.pn = L >> 5; return true; }
    __device__ __forceinline__ void a_ready(const Unit&) const {}
    __device__ __forceinline__ void done(const Unit&) const {}
};
}
struct Ctx { LAS unsigned char* lds; int tid, lane, wave, G, bid; };

__device__ __forceinline__ void conv_item(const float* W, int ldw, int ncv, int src_col0, int K, bf16_t* WT, int dst_row0, int kb, LAS float* scr, int lane) {
    const int k0 = 64 * kb, col = src_col0 + (lane & 31); const bool ok = col < ncv;
    float wv[32];
#pragma unroll
    for (int i = 0; i < 32; ++i) { const int kk = 2 * i + (lane >> 5); wv[i] = ok ? W[(size_t)(k0 + kk) * ldw + col] : 0.f; }
#pragma unroll
    for (int i = 0; i < 32; ++i) { const int kk = 2 * i + (lane >> 5); scr[kk * 33 + (lane & 31)] = wv[i]; }
    LDS_WAIT(); asm volatile("" ::: "memory");
    const int c = lane & 7;
#pragma unroll
    for (int j = 0; j < 4; ++j) { const int n = (lane >> 3) + 8 * j; const LAS float* s = scr + (8 * c) * 33 + n;
        u32x4 o; o.x = cvt_pk_bf16(s[0 * 33], s[1 * 33]); o.y = cvt_pk_bf16(s[2 * 33], s[3 * 33]); o.z = cvt_pk_bf16(s[4 * 33], s[5 * 33]); o.w = cvt_pk_bf16(s[6 * 33], s[7 * 33]);
        *(u32x4*)(WT + (size_t)(dst_row0 + n) * K + k0 + 8 * c) = o; }
    LDS_WAIT(); asm volatile("" ::: "memory");
}
#define PIN(k) uptr(LP->in[k])
__device__ __forceinline__ void p0_phase(const Ctx& X, const LAS Params* LP) {
    unsigned char* ws = uptr(LP->ws);
    LAS float* sc = (LAS float*)X.lds;
    LAS float* red = (LAS float*)(X.lds + 32768);
    for (int i = X.tid; i < 8192; i += 512) { const int b = i >> 10, k = i & 1023; sc[k * 8 + b] = silu_f(PIN(I_C)[i]); }
    __syncthreads();
    for (int it = X.bid; it < 152; it += X.G) {
        const float* W; const float* bias; float* out; int N, cb;
        if (it < 144) { const int l = it / 36; cb = it % 36; N = 9216; W = PIN(I_ADAW) + (size_t)l * 1024 * 9216; bias = PIN(I_ADAB) + l * 9216; out = (float*)(ws + WS_MOD) + (size_t)l * 8 * 9216; }
        else { cb = it - 144; N = 2048; W = PIN(I_KVADAW); bias = PIN(I_KVADAB); out = (float*)(ws + WS_KVMOD); }
        f32x4 a[8];
#pragma unroll
        for (int b = 0; b < 8; ++b) a[b] = (f32x4){0.f, 0.f, 0.f, 0.f};
        const float* wp = W + (size_t)(128 * X.wave) * N + 256 * cb + 4 * X.lane;
#pragma unroll 1
        for (int k0 = 0; k0 < 128; k0 += 8) {
            f32x4 w[8];
#pragma unroll
            for (int k = 0; k < 8; ++k) w[k] = *(const f32x4*)(wp + (size_t)(k0 + k) * N);
#pragma unroll
            for (int k = 0; k < 8; ++k) { const f32x4 s0 = *(const LAS f32x4*)(sc + (128 * X.wave + k0 + k) * 8), s1 = *(const LAS f32x4*)(sc + (128 * X.wave + k0 + k) * 8 + 4);
                a[0] += w[k] * s0[0]; a[1] += w[k] * s0[1]; a[2] += w[k] * s0[2]; a[3] += w[k] * s0[3]; a[4] += w[k] * s1[0]; a[5] += w[k] * s1[1]; a[6] += w[k] * s1[2]; a[7] += w[k] * s1[3]; }
        }
#pragma unroll
        for (int b = 0; b < 8; ++b) *(LAS f32x4*)(red + ((X.wave * 8 + b) * 256 + 4 * X.lane)) = a[b];
        __syncthreads();
#pragma unroll
        for (int r4 = 0; r4 < 4; ++r4) { const int o = X.tid + 512 * r4, b = o >> 8, col = o & 255; float s = bias[256 * cb + col];
#pragma unroll
            for (int w = 0; w < 8; ++w) s += red[(w * 8 + b) * 256 + col];
            out[(size_t)b * N + 256 * cb + col] = s; }
        __syncthreads();
    }
    for (int kv = 0; kv < 2; ++kv) if (X.bid == X.G - 1 - kv) {
        const int col = X.tid & 255, half = X.tid >> 8; const float* pos = PIN(I_CPOS) + kv * 2048 + half * 1024; const float* w1 = PIN(I_CW1) + ((size_t)kv * 2048 + half * 1024) * 256 + col;
        float s = 0.f;
        for (int f = 0; f < 1024; ++f) s += pos[f] * w1[(size_t)f * 256];
        red[X.tid] = s; __syncthreads();
        if (X.tid < 256) ((float*)(ws + WS_CBIAS))[kv * 256 + X.tid] = red[X.tid] + red[X.tid + 256];
        __syncthreads();
    }
    __syncthreads();
    LAS float* scr = (LAS float*)(X.lds + X.wave * 8448);
    unsigned* const ctr = (unsigned*)(ws + WS_BAR) + 3520;
    for (;;) {
        unsigned base_ = 0u; if (X.lane == 0) base_ = __hip_atomic_fetch_add(ctr, 8u, __ATOMIC_RELAXED, __HIP_MEMORY_SCOPE_AGENT);
        const int base = __builtin_amdgcn_readfirstlane((int)base_); if (base >= 41472) break;
      for (int it = base; it < base + 8; ++it) {
        int r = it;
        if (r < 22528) { const int id = r / 2816, q = r % 2816, nb = q >> 4, kb = q & 15, pn = nb >> 3, jb = nb & 7;
            conv_item(PIN(I_FIN) + (size_t)id * 1024 * 5632, 5632, 5632, (jb >> 2) * 2816 + 128 * pn + 32 * (jb & 3), 1024, (bf16_t*)(ws + WS_FIN) + (size_t)id * 5632 * 1024, 32 * nb, kb, scr, X.lane); continue; } r -= 22528;
        if (r < 11264) { const int id = r / 1408, q = r % 1408, nb = q / 44, kb = q % 44;
            conv_item(PIN(I_FOUT) + (size_t)id * 2816 * 1024, 1024, 1024, 32 * nb, 2816, (bf16_t*)(ws + WS_FOUT) + (size_t)id * 1024 * 2816, 32 * nb, kb, scr, X.lane); continue; } r -= 11264;
        if (r < 3072) { const int id = r / 1536, q = r % 1536, nb = q >> 4, kb = q & 15, pn = nb >> 3, jb = nb & 7;
            const int src = pn < 8 ? ((jb >> 2) ? 2048 : 1024) + 128 * pn + 32 * (jb & 3) : 256 * (pn - 8) + 32 * jb;
            conv_item(PIN(I_AIN) + (size_t)id * 1024 * 3072, 3072, 3072, src, 1024, (bf16_t*)(ws + WS_AIN) + (size_t)id * 3072 * 1024, 32 * nb, kb, scr, X.lane); continue; } r -= 3072;
        if (r < 1024) { const int id = r / 512, q = r % 512, nb = q >> 4, kb = q & 15;
            conv_item(PIN(I_AOUT) + (size_t)id * 1024 * 1024, 1024, 1024, 32 * nb, 1024, (bf16_t*)(ws + WS_AOUT) + (size_t)id * 1024 * 1024, 32 * nb, kb, scr, X.lane); continue; } r -= 1024;
        if (r < 768) { const int nb = r >> 4, kb = r & 15;
            conv_item(PIN(I_KVW), 1536, 1536, 32 * nb, 1024, (bf16_t*)(ws + WS_KVW), 32 * nb, kb, scr, X.lane); continue; } r -= 768;
        if (r < 512) { const int id = r / 256, q = r % 256, nb = q >> 5, kb = q & 31;
            conv_item(PIN(I_CW1) + (size_t)id * 2048 * 256, 256, 256, 32 * nb, 2048, (bf16_t*)(ws + WS_CW1) + (size_t)id * 256 * 2048, 32 * nb, kb, scr, X.lane); continue; } r -= 512;
        if (r < 1280) { const int id = r / 640, q = r % 640, nb = q >> 4, kb = q & 15;
            conv_item(PIN(I_BIN) + (size_t)id * 1024 * 1072, 1072, 1072, 32 * nb, 1024, (bf16_t*)(ws + WS_BIN) + (size_t)id * 1280 * 1024, 32 * nb, kb, scr, X.lane); continue; } r -= 1280;
        { const int id = r / 512, q = r % 512, nb = q >> 4, kb = q & 15;
            conv_item(PIN(I_BOUT) + (size_t)id * 1024 * 1024, 1024, 1024, 32 * nb, 1024, (bf16_t*)(ws + WS_BOUT) + (size_t)id * 1024 * 1024, 32 * nb, kb, scr, X.lane); }
      }
    }
}

struct UpdArgs { const float* xin; float* xout; const bf16_t* y; const float* part; const float* gate; const float* gpost; float w; int bstride;
                 const float* gpre; const float* shift; const float* scale; bf16_t* h; const float* gpre2; const float* shift2; const float* scale2; bf16_t* h2; };
__device__ __forceinline__ void update_phase(const Ctx& X, const UpdArgs& A) {
    constexpr int R = 2;
    const int gw = X.bid * 8 + X.wave, NGW = X.G * 8, c0 = 4 * X.lane;
    for (int row0 = gw; row0 < T; row0 += R * NGW) {
        f32x4 xv[R][4]; u32x2 yy[R][4]; f32x4 pp[R][4];
#pragma unroll
        for (int q = 0; q < R; ++q) { const int row = min(row0 + q * NGW, T - 1);
#pragma unroll
            for (int j = 0; j < 4; ++j) xv[q][j] = *(const f32x4*)(A.xin + (size_t)row * D + c0 + 256 * j);
            if (A.y) {
#pragma unroll
                for (int j = 0; j < 4; ++j) { yy[q][j] = *(const u32x2*)(A.y + (size_t)row * D + c0 + 256 * j); pp[q][j] = *(const f32x4*)(A.part + (size_t)row * 16 + 4 * j); }
            }
        }
#pragma unroll
        for (int q = 0; q < R; ++q) { const int row = row0 + q * NGW; if (row < T) {
            const int b = row >> 12;
            if (A.y) {
                const float ssq = ((pp[q][0][0] + pp[q][0][1]) + (pp[q][0][2] + pp[q][0][3])) + ((pp[q][1][0] + pp[q][1][1]) + (pp[q][1][2] + pp[q][1][3])) + ((pp[q][2][0] + pp[q][2][1]) + (pp[q][2][2] + pp[q][2][3])) + ((pp[q][3][0] + pp[q][3][1]) + (pp[q][3][2] + pp[q][3][3]));
                const float rs = A.w * __builtin_amdgcn_rsqf(ssq * (1.f / D) + EPS);
#pragma unroll
                for (int j = 0; j < 4; ++j) { const int c = c0 + 256 * j;
                    const f32x4 gt = *(const f32x4*)(A.gate + (size_t)b * A.bstride + c), gp = *(const f32x4*)(A.gpost + c);
                    const f32x4 yv = {__uint_as_float(yy[q][j].x << 16), __uint_as_float(yy[q][j].x & 0xffff0000u), __uint_as_float(yy[q][j].y << 16), __uint_as_float(yy[q][j].y & 0xffff0000u)};
                    xv[q][j] = xv[q][j] + gt * gp * yv * rs; }
            }
            if (A.xout) {
#pragma unroll
                for (int j = 0; j < 4; ++j) *(f32x4*)(A.xout + (size_t)row * D + c0 + 256 * j) = xv[q][j];
            }
            if (A.h) {
                float s = 0.f;
#pragma unroll
                for (int j = 0; j < 4; ++j) s += (xv[q][j][0] * xv[q][j][0] + xv[q][j][1] * xv[q][j][1]) + (xv[q][j][2] * xv[q][j][2] + xv[q][j][3] * xv[q][j][3]);
                const float r = __builtin_amdgcn_rsqf(wave_sum(s) * (1.f / D) + EPS);
#pragma unroll
                for (int j = 0; j < 4; ++j) { const int c = c0 + 256 * j;
                    const f32x4 g = *(const f32x4*)(A.gpre + c), sh = *(const f32x4*)(A.shift + (size_t)b * A.bstride + c), scl = *(const f32x4*)(A.scale + (size_t)b * A.bstride + c);
                    const f32x4 hv = xv[q][j] * r * g * (scl + 1.f) + sh; u32x2 o; o.x = cvt_pk_bf16(hv[0], hv[1]); o.y = cvt_pk_bf16(hv[2], hv[3]);
                    *(u32x2*)(A.h + (size_t)row * D + c) = o; }
                if (A.h2) {
#pragma unroll
                    for (int j = 0; j < 4; ++j) { const int c = c0 + 256 * j;
                        const f32x4 g = *(const f32x4*)(A.gpre2 + c), sh = *(const f32x4*)(A.shift2 + (size_t)b * 2048 + c), scl = *(const f32x4*)(A.scale2 + (size_t)b * 2048 + c);
                        const f32x4 hv = xv[q][j] * r * g * (scl + 1.f) + sh; u32x2 o; o.x = cvt_pk_bf16(hv[0], hv[1]); o.y = cvt_pk_bf16(hv[2], hv[3]);
                        *(u32x2*)(A.h2 + (size_t)row * D + c) = o; }
                }
            }
        } }
    }
}

__device__ __forceinline__ void unpack8(const u32x4 w, float (&f)[8]) {
    f[0] = __uint_as_float(w.x << 16); f[1] = __uint_as_float(w.x & 0xffff0000u); f[2] = __uint_as_float(w.y << 16); f[3] = __uint_as_float(w.y & 0xffff0000u);
    f[4] = __uint_as_float(w.z << 16); f[5] = __uint_as_float(w.z & 0xffff0000u); f[6] = __uint_as_float(w.w << 16); f[7] = __uint_as_float(w.w & 0xffff0000u);
}
__device__ __forceinline__ void conv_phase(const Ctx& X, const bf16_t* V, const bf16_t* Bg, const float* cw, bf16_t* Z) {
    const int gt = X.bid * 512 + X.tid, NT = X.G * 512;
    for (int i = gt; i < T * 128; i += NT) {
        const int row = i >> 7, c = (i & 127) * 8, s = row & 4095;
        const u32x4 z0 = {0u, 0u, 0u, 0u};
        const u32x4 v2 = *(const u32x4*)(V + (size_t)row * D + c), v1 = s >= 1 ? *(const u32x4*)(V + (size_t)(row - 1) * D + c) : z0, v0 = s >= 2 ? *(const u32x4*)(V + (size_t)(row - 2) * D + c) : z0;
        const u32x4 bb = *(const u32x4*)(Bg + (size_t)row * D + c);
        float a0[8], a1[8], a2[8], bf[8], o[8]; unpack8(v0, a0); unpack8(v1, a1); unpack8(v2, a2); unpack8(bb, bf);
#pragma unroll
        for (int e = 0; e < 8; ++e) o[e] = bf[e] * (cw[c + e] * a0[e] + cw[D + c + e] * a1[e] + cw[2 * D + c + e] * a2[e]);
        u32x4 w; w.x = cvt_pk_bf16(o[0], o[1]); w.y = cvt_pk_bf16(o[2], o[3]); w.z = cvt_pk_bf16(o[4], o[5]); w.w = cvt_pk_bf16(o[6], o[7]);
        *(u32x4*)(Z + (size_t)row * D + c) = w;
    }
}

__device__ __forceinline__ void cmp2_phase(const Ctx& X, const bf16_t* hidc, const float* w2, bf16_t* kcmp, bf16_t* vcmpT) {
    const int gt = X.bid * 512 + X.tid, NT = X.G * 512;
    for (int i = gt; i < 16384 * 16; i += NT) {
        const int row = i >> 4, c = (i & 15) * 4, kv = row >> 13, rr = row & 8191;
        const float* w = w2 + (size_t)kv * 256 * 64 + c; const bf16_t* hp = hidc + (size_t)row * 256;
        f32x4 a = {0.f, 0.f, 0.f, 0.f};
        for (int k = 0; k < 256; k += 8) { float hf[8]; unpack8(*(const u32x4*)(hp + k), hf);
#pragma unroll
            for (int e = 0; e < 8; ++e) a += *(const f32x4*)(w + (size_t)(k + e) * 64) * hf[e]; }
        if (kv == 0) { u32x2 o; o.x = cvt_pk_bf16(a[0], a[1]); o.y = cvt_pk_bf16(a[2], a[3]); *(u32x2*)(kcmp + (size_t)rr * 64 + c) = o; }
        else { const int bg = rr >> 8, n = rr & 255; bf16_t* p = vcmpT + (((size_t)bg * 4 + (n >> 6)) * 64 + c) * 64 + (n & 63); const unsigned w0 = cvt_pk_bf16(a[0], a[1]), w1 = cvt_pk_bf16(a[2], a[3]);
            p[0] = (bf16_t)(w0 & 0xffffu); p[64] = (bf16_t)(w0 >> 16); p[128] = (bf16_t)(w1 & 0xffffu); p[192] = (bf16_t)(w1 >> 16); }
    }
}
struct AttnArgs { const bf16_t* Q; const float* gates; const bf16_t *kcmp, *vcmpT, *KS, *VSt, *KW, *VWt; bf16_t* O; };

__device__ __forceinline__ void load_k(bf16x8 (&kf)[4], const bf16_t* Kb, int key0, int jr, int h) {
    const bf16x8* p = (const bf16x8*)(Kb + (size_t)(key0 + jr) * 64 + h * 8);
#pragma unroll
    for (int ks = 0; ks < 4; ++ks) kf[ks] = p[2 * ks];
}
__device__ __forceinline__ void load_v(bf16x8 (&vf)[4], const bf16_t* Vt, int ldv, int key0, int j, int h) {
#pragma unroll
    for (int s = 0; s < 2; ++s)
#pragma unroll
        for (int dt = 0; dt < 2; ++dt) vf[s * 2 + dt] = *(const bf16x8*)(Vt + (size_t)(dt * 32 + j) * ldv + key0 + 16 * s + 8 * h);
}
__device__ __forceinline__ f32x16 qk_mma(const bf16x8 (&kf)[4], const bf16x8 (&qf)[4], const f32x16& bc) {
    f32x16 acc = __builtin_amdgcn_mfma_f32_32x32x16_bf16(kf[0], qf[0], bc, 0, 0, 0);
#pragma unroll
    for (int ks = 1; ks < 4; ++ks) acc = __builtin_amdgcn_mfma_f32_32x32x16_bf16(kf[ks], qf[ks], acc, 0, 0, 0);
    return acc;
}
__device__ __forceinline__ void pv_mma(f32x16 (&o)[2], const bf16x8 (&vf)[4], const f32x16& p) {
#pragma unroll
    for (int s = 0; s < 2; ++s) {
        u32x4 w; w.x = cvt_pk_bf16(p[8 * s + 0], p[8 * s + 1]); w.y = cvt_pk_bf16(p[8 * s + 2], p[8 * s + 3]); w.z = cvt_pk_bf16(p[8 * s + 4], p[8 * s + 5]); w.w = cvt_pk_bf16(p[8 * s + 6], p[8 * s + 7]);
        const bf16x8 pb = __builtin_bit_cast(bf16x8, w);
#pragma unroll
        for (int dt = 0; dt < 2; ++dt) o[dt] = __builtin_amdgcn_mfma_f32_32x32x16_bf16(vf[s * 2 + dt], pb, o[dt], 0, 0, 0);
    }
}
__device__ __forceinline__ void pf_block(const bf16_t* Kb, const bf16_t* Vt, int ldv, int key0, int lane, LAS unsigned* junk) {
    __builtin_amdgcn_global_load_lds((const unsigned*)(Kb + (size_t)(key0 + lane) * 64), junk, 4, 0, 0);
    __builtin_amdgcn_global_load_lds((const unsigned*)(Vt + (size_t)lane * ldv + key0), junk, 4, 0, 0);
}
__device__ __forceinline__ unsigned run_mask(int kstart, int lo, int hi) {
    const int a = max(lo - kstart, 0), b = min(hi - kstart, 7);
    return a <= b ? ((1u << (b + 1)) - 1u) & ~((1u << a) - 1u) : 0u;
}
__device__ __forceinline__ float max16(const f32x16& s) {
    float a = fmaxf(fmaxf(s[0], s[1]), s[2]), b = fmaxf(fmaxf(s[3], s[4]), s[5]), c = fmaxf(fmaxf(s[6], s[7]), s[8]), d = fmaxf(fmaxf(s[9], s[10]), s[11]), e = fmaxf(fmaxf(s[12], s[13]), s[14]);
    return fmaxf(fmaxf(fmaxf(a, b), fmaxf(c, d)), fmaxf(e, s[15]));
}
__device__ __forceinline__ void softmax_step(f32x16& s, bool full, unsigned vm, float off, float& m, float& l, f32x16 (&o)[2], bool lane_on = true) {
    if (!full) {
#pragma unroll
        for (int v = 0; v < 16; ++v) s[v] = ((vm >> v) & 1u) ? s[v] : -1e30f;
    }
    float tm = max16(s);
    if (full && !lane_on) tm = -1e30f;
    tm = fmaxf(tm, __shfl_xor(tm, 32)) + off;
    const float mn = fmaxf(m, tm);
    if (__any(mn > m)) { const float al = fexp2(m - mn); l *= al; o[0] = o[0] * al; o[1] = o[1] * al; }
    m = mn; const float ml = (full && !lane_on) ? 3e38f : mn - off;
    float ps = 0.f;
    if (full) {
#pragma unroll
        for (int v = 0; v < 16; ++v) { const float p = fexp2(s[v] - ml); s[v] = p; ps += p; }
    } else {
#pragma unroll
        for (int v = 0; v < 16; ++v) { const float p = ((vm >> v) & 1u) ? fexp2(s[v] - ml) : 0.f; s[v] = p; ps += p; }
    }
    l += ps;
}

__device__ __forceinline__ void glds16(const void* gsrc, unsigned lds_dst) { unsigned keep;
    asm volatile("s_mov_b32 %0, m0\n\ts_mov_b32 m0, %2\n\ts_nop 0\n\tglobal_load_lds_dwordx4 %1, off\n\ts_mov_b32 m0, %0" : "=&s"(keep) : "v"(gsrc), "s"(lds_dst) : "memory"); }
struct AttnSrc { const bf16_t *Kc, *Vc, *Kw, *Vw, *Ks, *Vs; };
__device__ __forceinline__ void ring_load(const AttnSrc& S, int type, int key0, unsigned slot_addr, int wave, int lane) {
    const int q = lane & 7;
#pragma unroll
    for (int e = 0; e < 2; ++e) {
        const int pr = (2 * wave + e) & 7, i = 8 * pr + (lane >> 3), c = q ^ ((i >> 1) & 7);
        const bf16_t* src;
        if (wave < 4) { const bf16_t* kb = type == 0 ? S.Kc : (type == 1 ? S.Kw : S.Ks); const int il = i & 31, kp = (il & ~12) | ((il & 4) << 1) | ((il & 8) >> 1);
                        src = kb + (size_t)(key0 + (i & 32) + kp) * 64 + 8 * c; }
        else { const bf16_t* vb = type == 0 ? S.Vc : (type == 1 ? S.Vw : S.Vs); src = vb + ((size_t)(key0 >> 6) * 64 + i) * 64 + 8 * c; }
        glds16(src, slot_addr + (wave < 4 ? 0u : 8192u) + (unsigned)pr * 1024u);
    }
}
#define RING_WAIT_BAR() do { asm volatile("s_waitcnt vmcnt(4)" ::: "memory"); __builtin_amdgcn_s_barrier(); asm volatile("" ::: "memory"); } while (0)
#define RING_DRAIN_BAR() do { asm volatile("s_waitcnt vmcnt(0) lgkmcnt(0)" ::: "memory"); __builtin_amdgcn_s_barrier(); asm volatile("" ::: "memory"); } while (0)
__device__ __forceinline__ void ring_read_k(bf16x8 (&kf)[4], const LAS unsigned char* slot, int hf, int rowoff, int sw, int h) {
#pragma unroll
    for (int ks = 0; ks < 4; ++ks) kf[ks] = *(const LAS bf16x8*)(slot + hf * 4096 + rowoff + (((2 * ks + h) * 16) ^ sw));
}
__device__ __forceinline__ void ring_read_v(bf16x8 (&vf)[4], const LAS unsigned char* slot, int hf, int rowoff, int sw, int h) {
#pragma unroll
    for (int s = 0; s < 2; ++s)
#pragma unroll
        for (int dt = 0; dt < 2; ++dt) vf[s * 2 + dt] = *(const LAS bf16x8*)(slot + 8192 + dt * 4096 + rowoff + (((4 * hf + 2 * s + h) * 16) ^ sw));
}

__device__ __forceinline__ void attn_item(const Ctx& X, const AttnArgs& A, int b, int g, int qt, const int mode = 3) {
    int lane_ = X.lane; asm volatile("" : "+v"(lane_));
    const int lane = lane_, h = lane >> 5, j = lane & 31, ql = j >> 2, r = j & 3, wave = X.wave;
    const int tb = qt * 64, t0 = tb + wave * 8, t = t0 + ql, head = g * 4 + r, bg = b * 4 + g, cur = qt;
    const size_t row = (size_t)b * SEQ + t;
    const int rowoff = j * 128, sw = ((j >> 1) & 7) * 16;
    RING_DRAIN_BAR();
    bf16x8 qf[4];
#pragma unroll
    for (int ks = 0; ks < 4; ++ks) qf[ks] = *(const bf16x8*)(A.Q + row * D + head * 64 + ks * 16 + h * 8);
    const float sl2 = fexp2(-0.5f * (float)(head + 1)) * LOG2E;
    const float g0 = A.gates[row * 48 + head], g1 = A.gates[row * 48 + 16 + head], g2 = A.gates[row * 48 + 32 + head];
    f32x16 o[2], bc;
#pragma unroll
    for (int v = 0; v < 16; ++v) { o[0][v] = 0.f; o[1][v] = 0.f; }
    LAS float* cm = (LAS float*)(X.lds + wave * 8192);
    LAS float* ob = cm + lane;
    const LAS unsigned char* ring = X.lds + 65536;
    const unsigned ring_a = (unsigned)(unsigned long long)ring;
    LAS unsigned long long* ux = (LAS unsigned long long*)(X.lds + 131072);
    LAS int* tk = (LAS int*)(X.lds + 131072 + 64 + wave * 256);
    AttnSrc S; S.Kc = A.kcmp + (size_t)bg * 256 * 64; S.Vc = A.vcmpT + (size_t)bg * 64 * 256; S.Kw = A.KW + (size_t)bg * 4096 * 64; S.Vw = A.VWt + (size_t)bg * 64 * 4096;
    S.Ks = A.KS + (size_t)bg * 4096 * 64; S.Vs = A.VSt + (size_t)bg * 64 * 4096;
    float m, l;
    bf16x8 kc[4], vf[4];

    const int ntb = (((tb + 63 - 31) >> 4) >> 5) + 1, nb1 = (ntb + 1) >> 1;
    const int nmax_w = (t0 + 7 - 31) >> 4, nmax_t = (t - 31) >> 4, nmin_w = (t0 - 31) >> 4;
    const int ntile = nmax_w >= 0 ? (nmax_w >> 5) + 1 : 0;
#pragma unroll
    for (int v = 0; v < 16; ++v) bc[v] = 16.f * sl2 * (float)(8 * h + 16 * (v >> 3) + (v & 7)) + sl2 * (float)(31 - ql);
    m = -1e30f; l = 0.f;
    {
        for (int i = 0; i < nb1; ++i) ring_load(S, 0, i * 64, ring_a + (unsigned)i * 16384u, wave, lane);
        asm volatile("" :: "v"(qf[0]), "v"(qf[1]), "v"(qf[2]), "v"(qf[3]), "v"(g0), "v"(g1), "v"(g2));
        RING_DRAIN_BAR();
#pragma unroll 1
        for (int tile = ntile - 1; tile >= 0; --tile) {
            const LAS unsigned char* slot = ring + (tile >> 1) * 16384; const int hf = tile & 1;
            ring_read_k(kc, slot, hf, rowoff, sw, h);
            const unsigned vm = run_mask(tile * 32 + 8 * h, 0, nmax_t) | (run_mask(tile * 32 + 16 + 8 * h, 0, nmax_t) << 8);
            f32x16 s = qk_mma(kc, qf, bc);
            softmax_step(s, tile * 32 + 31 <= nmin_w, vm, sl2 * (float)(512 * tile - t0), m, l, o);
        }
        l += __shfl_xor(l, 32);
        const float inv = 1.f / fmaxf(l, 1e-30f);
#pragma unroll 1
        for (int tile = ntile - 1; tile >= 0; --tile) {
            const LAS unsigned char* slot = ring + (tile >> 1) * 16384; const int hf = tile & 1;
            ring_read_k(kc, slot, hf, rowoff, sw, h); ring_read_v(vf, slot, hf, rowoff, sw, h);
            const unsigned vm = run_mask(tile * 32 + 8 * h, 0, nmax_t) | (run_mask(tile * 32 + 16 + 8 * h, 0, nmax_t) << 8);
            f32x16 s = qk_mma(kc, qf, bc);
            const float ml = m - sl2 * (float)(512 * tile - t0);
#pragma unroll
            for (int v = 0; v < 16; ++v) {
                const float p = ((vm >> v) & 1u) ? fexp2(s[v] - ml) * inv : 0.f; s[v] = p;
                float x = p; x += __int_as_float(__builtin_amdgcn_mov_dpp(__float_as_int(x), 0xB1, 0xf, 0xf, true)); x += __int_as_float(__builtin_amdgcn_mov_dpp(__float_as_int(x), 0x4E, 0xf, 0xf, true));
                if ((v & 3) == r) cm[ql * 256 + tile * 32 + 16 * (v >> 3) + 8 * h + (v & 7)] = x;
            }
            pv_mma(o, vf, s);
        }
    }
    RING_DRAIN_BAR();
    const int wb1b = qt, wb0b = max(tb - 511, 0) >> 6, nWb = wb1b - wb0b + 1;
    const int kt0 = max(t0 - 511, 0) >> 5, kt1 = (t0 + 7) >> 5;
    int li = 0;
    for (; li < 3 && li < nWb; ++li) ring_load(S, 1, (wb1b - li) * 64, ring_a + (unsigned)(li & 3) * 16384u, wave, lane);
    unsigned long long mq = 0ull, uni = 0ull, alln = ~0ull;
    {
        const unsigned long long causal = cur >= 63 ? ~0ull : ((1ull << (cur + 1)) - 1ull);
        if (cur + 1 <= 16) { mq = causal; uni = causal; alln = causal; }
        else {
#pragma unroll 1
            for (int q = 0; q < 8; ++q) {
                float iv;
                if (lane == 0 || lane == cur || lane == cur - 1) iv = 1e30f;
                else if (lane > cur) iv = -1.f;
                else { const LAS float* c = cm + q * 256 + 4 * lane; iv = (((c[-1] + c[0]) + c[1]) + c[2]) + c[3]; }
                const int key = (__float_as_int(iv) & ~63) | (63 - lane);
                tk[lane] = key;
                int rank = 0;
#pragma unroll
                for (int i4 = 0; i4 < 16; ++i4) { const i32x4 kv = *(const LAS i32x4*)(tk + 4 * i4);
                    rank += (kv[0] > key ? 1 : 0) + (kv[1] > key ? 1 : 0) + (kv[2] > key ? 1 : 0) + (kv[3] > key ? 1 : 0); }
                unsigned long long mk = __ballot(rank < 16);
                mk &= causal;
                uni |= mk; alln &= mk; if (ql == q) mq = mk;
            }
        }
    }
    if (lane == 0) ux[wave] = uni;
    asm volatile("s_waitcnt lgkmcnt(0)" ::: "memory"); __builtin_amdgcn_s_barrier(); asm volatile("" ::: "memory");
    unsigned long long bun = 0ull;
#pragma unroll
    for (int w = 0; w < 8; ++w) bun |= ux[w];
    { const unsigned lo = __builtin_amdgcn_readfirstlane((unsigned)bun), hi = __builtin_amdgcn_readfirstlane((unsigned)(bun >> 32)); bun = ((unsigned long long)hi << 32) | lo; }
    const int n2 = nWb + __popcll(bun);
    unsigned long long lmask = bun; int ljb = 0;
#define LOAD_STEP2() do { int ty_, k0_; \
        if (li < nWb) { ty_ = 1; k0_ = (wb1b - li) * 64; } \
        else { ty_ = 2; if (li < n2) { ljb = 63 - __builtin_clzll(lmask); lmask &= ~(1ull << ljb); } k0_ = ljb * 64; } \
        ring_load(S, ty_, k0_, ring_a + (unsigned)(li & 3) * 16384u, wave, lane); ++li; } while (0)
    while (li < 3) LOAD_STEP2();
#pragma unroll
    for (int v = 0; v < 16; ++v) { ob[v * 64] = g0 * o[0][v]; ob[(16 + v) * 64] = g0 * o[1][v]; o[0][v] = 0.f; o[1][v] = 0.f; }
#pragma unroll
    for (int v = 0; v < 16; ++v) bc[v] = sl2 * (float)(8 * h + 16 * (v >> 3) + (v & 7) - ql);
    m = -1e30f; l = 0.f;
    int ci = 0;
#pragma unroll 1
    for (; ci < nWb; ++ci) {
        RING_WAIT_BAR();
        LOAD_STEP2();
        const int wb = wb1b - ci; const LAS unsigned char* slot = ring + (ci & 3) * 16384;
#pragma unroll 1
        for (int hf = 1; hf >= 0; --hf) {
            const int kt = 2 * wb + hf, key0 = kt * 32;
            if (kt >= kt0 && kt <= kt1 && (mode & 2)) {
                ring_read_k(kc, slot, hf, rowoff, sw, h); ring_read_v(vf, slot, hf, rowoff, sw, h);
                f32x16 s = qk_mma(kc, qf, bc);
                const bool full = (key0 + 31 <= t0) && (key0 >= t0 + 7 - 511);
                const unsigned vm = run_mask(key0 + 8 * h, t - 511, t) | (run_mask(key0 + 16 + 8 * h, t - 511, t) << 8);
                softmax_step(s, full, vm, sl2 * (float)(key0 - t0), m, l, o);
                pv_mma(o, vf, s);
            }
        }
    }
    {
        l += __shfl_xor(l, 32);
        const float sc = g2 / fmaxf(l, 1e-30f);
#pragma unroll
        for (int v = 0; v < 16; ++v) { ob[v * 64] += sc * o[0][v]; ob[(16 + v) * 64] += sc * o[1][v]; o[0][v] = 0.f; o[1][v] = 0.f; }
    }
    m = -1e30f; l = 0.f;
    {
        unsigned long long cmask = bun;
#pragma unroll 1
        for (; ci < n2; ++ci) {
            RING_WAIT_BAR();
            LOAD_STEP2();
            const int jb = 63 - __builtin_clzll(cmask); cmask &= ~(1ull << jb);
            const LAS unsigned char* slot = ring + (ci & 3) * 16384;
            if (((uni >> jb) & 1ull) && (mode & 1)) {
                const bool mine = (mq >> jb) & 1ull;
#pragma unroll 1
                for (int hf = 1; hf >= 0; --hf) {
                    const int key0 = jb * 64 + hf * 32;
                    if (key0 <= t0 + 7) {
                        ring_read_k(kc, slot, hf, rowoff, sw, h); ring_read_v(vf, slot, hf, rowoff, sw, h);
                        f32x16 s = qk_mma(kc, qf, bc);
                        const bool full = key0 + 31 <= t0;
                        const unsigned vm = mine ? (run_mask(key0 + 8 * h, 0, t) | (run_mask(key0 + 16 + 8 * h, 0, t) << 8)) : 0u;
                        softmax_step(s, full, vm, sl2 * (float)(key0 - t0), m, l, o, mine);
                        pv_mma(o, vf, s);
                    }
                }
            }
        }
    }
#undef LOAD_STEP2
    {
        l += __shfl_xor(l, 32);
        const float sc = g1 / fmaxf(l, 1e-30f);
#pragma unroll
        for (int v = 0; v < 16; ++v) { o[0][v] = ob[v * 64] + sc * o[0][v]; o[1][v] = ob[(16 + v) * 64] + sc * o[1][v]; }
    }
    bf16_t* op = A.O + row * D + head * 64 + 4 * h;
#pragma unroll
    for (int dt = 0; dt < 2; ++dt)
#pragma unroll
        for (int v4 = 0; v4 < 4; ++v4) { u32x2 w; w.x = cvt_pk_bf16(o[dt][4 * v4], o[dt][4 * v4 + 1]); w.y = cvt_pk_bf16(o[dt][4 * v4 + 2], o[dt][4 * v4 + 3]); *(u32x2*)(op + 32 * dt + 8 * v4) = w; }
}
__device__ __forceinline__ void attn_phase(const Ctx& X, const AttnArgs& A, const int mode = 3) {
    for (int i = 0;; ++i) {
        const int k = i * X.G + ((i & 1) ? X.G - 1 - X.bid : X.bid);
        if (i * X.G >= 2048) break;
        if (k < 2048) { const int qt = 63 - (k >> 5), bg = k & 31; attn_item(X, A, bg >> 2, bg & 3, qt, mode); }
    }
    RING_DRAIN_BAR();
}
#define XB_TMO      128
#define XB_XCNT(j)  (256  + 64 * (j))
#define XB_XSUB(j)  (1280 + 64 * (j))
#define XB_XGEN(j)  (2304 + 64 * (j))
#define XB_TOP      3328
#define XB_TOPGEN   3392
#define XCD_BAR_WORDS 3456
#define XB_SPIN_CAP (1u << 18)

__device__ __forceinline__ unsigned xb_ld(unsigned* p)              { return __hip_atomic_load(p, __ATOMIC_RELAXED, __HIP_MEMORY_SCOPE_AGENT); }
__device__ __forceinline__ unsigned xb_add(unsigned* p, unsigned v) { return __hip_atomic_fetch_add(p, v, __ATOMIC_RELAXED, __HIP_MEMORY_SCOPE_AGENT); }
__device__ __forceinline__ unsigned xb_xcc_id() { return (unsigned)__builtin_amdgcn_s_getreg((3 << 11) | 20) & 0xFu; }
#define XB_SPIN(cond, bar) do { unsigned _sp = 0; while (cond) { __builtin_amdgcn_s_sleep(1); \
    if ((++_sp & 255u) == 0u) { if (xb_ld(&(bar)[XB_TMO])) break; if (_sp > XB_SPIN_CAP) { atomicAdd(&(bar)[XB_TMO], 1u); break; } } } } while (0)

struct XcdBarrier {
    unsigned* bar; unsigned x;
    volatile LAS unsigned* st;
};

__device__ __forceinline__ XcdBarrier xcd_barrier_post(unsigned* bar, volatile LAS unsigned* st) {
    XcdBarrier b; b.bar = bar; b.x = xb_xcc_id(); b.st = st;
    if (threadIdx.x == 0) (void)xb_add(&bar[XB_XCNT(b.x)], 1u);
    return b;
}
__device__ __forceinline__ void xcd_barrier_complete(unsigned* bar, unsigned x, unsigned& nloc, unsigned& nx) {
    const unsigned G = gridDim.x * gridDim.y * gridDim.z;
    unsigned sum, cnt, mine, sp = 0u;
    for (;;) {
        sum = 0u; cnt = 0u; mine = 0u;
#pragma unroll
        for (unsigned j = 0; j < 16; ++j) { const unsigned c = xb_ld(&bar[XB_XCNT(j)]); sum += c; cnt += (c > 0u) ? 1u : 0u; mine = (j == x) ? c : mine; }
        if (sum == G) break;
        __builtin_amdgcn_s_sleep(1);
        if ((++sp & 255u) == 0u) { if (xb_ld(&bar[XB_TMO])) break; if (sp > XB_SPIN_CAP) { atomicAdd(&bar[XB_TMO], 1u); break; } }
    }
    nloc = mine > 0u ? mine : 1u; nx = cnt > 0u ? cnt : 1u;
}

__device__ __forceinline__ void xcd_barrier(const XcdBarrier& b) {
    asm volatile("s_waitcnt vmcnt(0)" ::: "memory");
    __syncthreads();
    if (threadIdx.x == 0) {
        unsigned* bar = b.bar;
        __builtin_amdgcn_s_waitcnt(0);
        unsigned nloc = b.st[0], nx = b.st[1];
        if (nloc == 0u) { xcd_barrier_complete(bar, b.x, nloc, nx); b.st[0] = nloc; b.st[1] = nx; }
        const unsigned old = xb_add(&bar[XB_XSUB(b.x)], 1u);
        const unsigned gen = old / nloc;
        if (old + 1u == (gen + 1u) * nloc) {
            __builtin_amdgcn_fence(__ATOMIC_RELEASE, "agent");
            asm volatile("s_waitcnt vmcnt(0)" ::: "memory");
            const unsigned og = xb_add(&bar[XB_TOP], 1u);
            const unsigned tg = og / nx;
            if (og + 1u == (tg + 1u) * nx) xb_add(&bar[XB_TOPGEN], 1u);
            else XB_SPIN(xb_ld(&bar[XB_TOPGEN]) == tg, bar);
            __builtin_amdgcn_fence(__ATOMIC_ACQUIRE, "agent");
            xb_add(&bar[XB_XGEN(b.x)], 1u);
            asm volatile("s_waitcnt vmcnt(0)" ::: "memory");
        } else {
            XB_SPIN(xb_ld(&bar[XB_XGEN(b.x)]) == gen, bar);
            __builtin_amdgcn_fence(__ATOMIC_ACQUIRE, "agent");
            asm volatile("s_waitcnt vmcnt(0)" ::: "memory");
        }
    }
    __syncthreads();
}

__global__ void __launch_bounds__(512, 2) yoco_fwd(Params Pk) {
    extern __shared__ __attribute__((aligned(16))) unsigned char lds_raw[];
    cg::grid_group grid = cg::this_grid();
    { LAS Params* LP = (LAS Params*)((LAS unsigned char*)lds_raw); if (threadIdx.x == 0) {
#pragma unroll
        for (int i = 0; i < 19; ++i) LP->in[i] = Pk.in[i];
        LP->out = Pk.out; LP->ws = Pk.ws; LP->ph_lo = Pk.ph_lo; LP->ph_hi = Pk.ph_hi; } }
    volatile LAS unsigned* xb_st = (volatile LAS unsigned*)((LAS unsigned char*)lds_raw + 192);
    if (threadIdx.x == 0) { xb_st[0] = 0u; xb_st[1] = 0u; }
    unsigned* const xb_words = (unsigned*)(Pk.ws + WS_BAR);
    if (blockIdx.x == 0) { for (int i = threadIdx.x; i < XCD_BAR_WORDS + 128; i += 512) __hip_atomic_store(xb_words + i, 0u, __ATOMIC_RELAXED, __HIP_MEMORY_SCOPE_AGENT); }
    asm volatile("s_waitcnt vmcnt(0)" ::: "memory");
    __syncthreads();
    const int ph_lo = Pk.ph_lo, ph_hi = Pk.ph_hi;
    grid.sync();
    (void)xcd_barrier_post(xb_words, xb_st);
    {
        int tid_ = threadIdx.x, g_ = gridDim.x, b_ = blockIdx.x; asm volatile("" : "+v"(tid_), "+s"(g_), "+s"(b_));
        Ctx X; X.lds = (LAS unsigned char*)lds_raw + 256; X.tid = tid_; X.lane = X.tid & 63; X.wave = __builtin_amdgcn_readfirstlane(X.tid >> 6); X.G = g_; X.bid = b_;
        p0_phase(X, (const LAS Params*)(X.lds - 256)); __syncthreads();
        XcdBarrier xbar; xbar.bar = xb_words; xbar.x = xb_xcc_id(); xbar.st = xb_st; xcd_barrier(xbar);
    }
    int dupflag_ = 0; (void)dupflag_;
    for (int ph = ph_lo < 1 ? 1 : ph_lo; ph < ph_hi; ++ph) {
        int cur_st_ = -1; (void)cur_st_;
        asm volatile("" ::: "memory");
        int tid_ = threadIdx.x, g_ = gridDim.x, b_ = blockIdx.x; asm volatile("" : "+v"(tid_), "+s"(g_), "+s"(b_));
        Ctx X; X.lds = (LAS unsigned char*)lds_raw + 256; X.tid = tid_; X.lane = X.tid & 63; X.wave = __builtin_amdgcn_readfirstlane(X.tid >> 6); X.G = g_; X.bid = b_;
        Params P;
        { const LAS Params* LP = (const LAS Params*)(X.lds - 256);
          P.in[I_X] = uptr(LP->in[I_X]); P.in[I_NORMG] = uptr(LP->in[I_NORMG]); P.in[I_ACONV] = uptr(LP->in[I_ACONV]); P.in[I_KVNG] = uptr(LP->in[I_KVNG]); P.in[I_CW2] = uptr(LP->in[I_CW2]);
          P.out = uptr(LP->out); P.ws = uptr(LP->ws); }
        unsigned char* ws = P.ws;
        bf16_t* const H = (bf16_t*)(ws + WS_H); bf16_t* const HID = (bf16_t*)(ws + WS_HID); bf16_t* const HID2 = (bf16_t*)(ws + WS_HID + 64 * MiB); bf16_t* const Y = (bf16_t*)(ws + WS_Y);
        float* const PART = (float*)(ws + WS_PART); float* const GATES = (float*)(ws + WS_GATES);
        const float* const MOD = (const float*)(ws + WS_MOD); const float* const KVMOD = (const float*)(ws + WS_KVMOD);
        const float* const NG = P.in[I_NORMG];
        if (ph == 1) {
            UpdArgs U{}; U.xin = P.in[I_X]; U.xout = P.out; U.bstride = 9216; U.gpre = NG; U.shift = MOD; U.scale = MOD + 1024; U.h = H;

#ifndef SKIP_UPD
update_phase(X, U);
#endif

        } else {
            int p = ph - 2, l, st;
            if (p < 20) { l = p / 10; st = p % 10; } else if (p < 23) { l = 2; st = 10 + (p - 20); } else { p -= 23; l = 2 + p / 10; st = p % 10; }
            cur_st_ = st;
            const float* modl = MOD + (size_t)l * 8 * 9216; const float* ngl = NG + (size_t)l * 6 * 1024;
            if (st == 0 || st == 7) {
                const int s = st == 0 ? 0 : 1;
                pg8::Gemm g{H, (const bf16_t*)(ws + WS_FIN) + (size_t)(l * 2 + s) * 5632 * 1024, T, 5632, 1024, 1024}; pg8::StaticOrder S; S.init(T, 5632, X.G, X.bid);
                pg8::EpiSwiglu E{HID};

#ifndef REP_G1
#define REP_G1 1
#endif
for (int rep_ = 0; rep_ < REP_G1; ++rep_) pg8::gemm_phase<pg8::EpiSwiglu, pg8::StaticOrder, true, true>(X.lds, g, S, E, X.tid);

            } else if (st == 1 || st == 8 || st == 5) {
                pg8::Gemm g;
                if (st == 5) { g = pg8::Gemm{l < 2 ? H : HID2, l < 2 ? (const bf16_t*)(ws + WS_AOUT) + (size_t)l * 1024 * 1024 : (const bf16_t*)(ws + WS_BOUT) + (size_t)(l - 2) * 1024 * 1024, T, 1024, 1024, 1024}; }
                else { g = pg8::Gemm{HID, (const bf16_t*)(ws + WS_FOUT) + (size_t)(l * 2 + (st == 8 ? 1 : 0)) * 1024 * 2816, T, 1024, 2816, 2816}; }
                pg8::StaticOrder S; S.init(T, 1024, X.G, X.bid);
                pg8::EpiY E{Y, PART};

pg8::gemm_phase<pg8::EpiY, pg8::StaticOrder, true, true>(X.lds, g, S, E, X.tid);

            } else if (st == 2 || st == 6 || st == 9) {
                const int sub = st == 2 ? 0 : (st == 6 ? 1 : 2);
                UpdArgs U{}; U.xin = P.out; U.xout = P.out; U.y = Y; U.part = PART; U.gate = modl + (sub * 3 + 2) * 1024; U.gpost = ngl + (sub * 2 + 1) * 1024; U.w = sub == 1 ? 1.0f : 0.5f; U.bstride = 9216;
                if (sub < 2) { U.gpre = ngl + ((sub + 1) * 2) * 1024; U.shift = modl + ((sub + 1) * 3) * 1024; U.scale = modl + ((sub + 1) * 3 + 1) * 1024; U.h = H; }
                else if (l < 3) { U.gpre = ngl + 6 * 1024; U.shift = modl + 8 * 9216; U.scale = modl + 8 * 9216 + 1024; U.h = H;
                    if (l == 1) { U.gpre2 = P.in[I_KVNG]; U.shift2 = KVMOD; U.scale2 = KVMOD + 1024; U.h2 = HID; } }

#ifndef SKIP_UPD
update_phase(X, U);
#endif

            } else if (st == 3) {
                if (l < 2) {
                    pg8::Gemm g{H, (const bf16_t*)(ws + WS_AIN) + (size_t)l * 3072 * 1024, T, 3072, 1024, 1024}; pg8::StaticOrder S; S.init(T, 3072, X.G, X.bid);
                    pg8::EpiConvIn E{HID, HID2};

#ifndef SKIP_G3
pg8::gemm_phase<pg8::EpiConvIn, pg8::StaticOrder, true, true>(X.lds, g, S, E, X.tid);
#endif

                } else {
                    pg8::Gemm g{H, (const bf16_t*)(ws + WS_BIN) + (size_t)(l - 2) * 1280 * 1024, T, 1280, 1024, 1024}; pg8::StaticOrder S; S.init(T, 1280, X.G, X.bid);
                    pg8::EpiQG E{HID, GATES};

#ifndef SKIP_G3B
pg8::gemm_phase<pg8::EpiQG, pg8::StaticOrder, true, true>(X.lds, g, S, E, X.tid);
#endif

                }
            } else if (st == 4) {
                if (l < 2) {
#ifndef SKIP_CONV
conv_phase(X, HID, HID2, P.in[I_ACONV] + (size_t)l * 3 * 1024, H);
#endif
}
                else { AttnArgs A{HID, GATES, (const bf16_t*)(ws + WS_KCMP), (const bf16_t*)(ws + WS_VCMPT), (const bf16_t*)(ws + WS_KS), (const bf16_t*)(ws + WS_VST), (const bf16_t*)(ws + WS_KW), (const bf16_t*)(ws + WS_VWT), HID2};

#ifndef REP_ATTN
#define REP_ATTN 1
#endif
attn_phase(X, A);
#ifdef PROBE_ATTN_MODE
{ AttnArgs A2 = A; A2.O = Y; attn_phase(X, A2, PROBE_ATTN_MODE); }
#endif
 }
            } else if (st == 10) {
                pg8::Gemm g{HID, (const bf16_t*)(ws + WS_KVW), T, 1536, 1024, 1024}; pg8::StaticOrder S; S.init(T, 1536, X.G, X.bid);
                pg8::EpiKV E{(bf16_t*)(ws + WS_KC), (bf16_t*)(ws + WS_KS), (bf16_t*)(ws + WS_KW), (bf16_t*)(ws + WS_VST), (bf16_t*)(ws + WS_VWT)};

#ifndef SKIP_GK
pg8::gemm_phase<pg8::EpiKV, pg8::StaticOrder, true, true>(X.lds, g, S, E, X.tid);
#endif

            } else if (st == 11) {
                pg8::Gemm g{(const bf16_t*)(ws + WS_KC), (const bf16_t*)(ws + WS_CW1), 16384, 512, 2048, 1024}; pg8::DiagOrder S{X.G, X.bid};
                pg8::EpiCmp1 E{(bf16_t*)(ws + WS_HIDC), (const float*)(ws + WS_CBIAS)};

#ifndef SKIP_CM1
pg8::gemm_phase<pg8::EpiCmp1, pg8::DiagOrder, true, true>(X.lds, g, S, E, X.tid);
#endif

            } else if (st == 12) {

#ifndef SKIP_CM2
cmp2_phase(X, (const bf16_t*)(ws + WS_HIDC), P.in[I_CW2], (bf16_t*)(ws + WS_KCMP), (bf16_t*)(ws + WS_VCMPT));
#endif

            }
        }
        if (ph + 1 < ph_hi) { XcdBarrier xbar; xbar.bar = (unsigned*)(ws + WS_BAR); xbar.x = xb_xcc_id(); xbar.st = (volatile LAS unsigned*)((LAS unsigned char*)lds_raw + 192); xcd_barrier(xbar);
#ifdef PROBE_EXTRA_SYNC
            xcd_barrier(xbar);
#endif
        }
#ifdef PROBE_DUP_ST
        if (cur_st_ == PROBE_DUP_ST && !dupflag_) { dupflag_ = 1; --ph; } else dupflag_ = 0;
#endif
    }
}

extern "C" void kernel_launch(void* const* d_in, const int* in_sizes, int n_in, void* d_out, int out_size, void* d_ws, size_t ws_size, hipStream_t stream) {
    static int grid = 0;
    if (grid == 0) {
        if (n_in != 19 || out_size != T * D || ws_size < WS_END) { fprintf(stderr, "kernel_launch: unexpected shapes (n_in %d, out %d, ws %zu < %zu)\n", n_in, out_size, ws_size, (size_t)WS_END); grid = -1; return; }
        int dev = 0, cus = 0, per_cu = 0;
        (void)hipGetDevice(&dev); (void)hipDeviceGetAttribute(&cus, hipDeviceAttributeMultiprocessorCount, dev);
        if (hipFuncSetAttribute((const void*)yoco_fwd, hipFuncAttributeMaxDynamicSharedMemorySize, LDS_BYTES) != hipSuccess) { fprintf(stderr, "kernel_launch: hipFuncSetAttribute failed\n"); grid = -1; return; }
        if (hipOccupancyMaxActiveBlocksPerMultiprocessor(&per_cu, (const void*)yoco_fwd, 512, LDS_BYTES) != hipSuccess || per_cu < 1) { fprintf(stderr, "kernel_launch: occupancy query says %d\n", per_cu); per_cu = 1; }
        (void)hipGetLastError();
        grid = cus * per_cu;
    }
    if (grid < 0) return;
    Params p{};
    for (int i = 0; i < 19; ++i) p.in[i] = (const float*)d_in[i];
    p.out = (float*)d_out; p.ws = (unsigned char*)d_ws;
    p.ph_lo = 0; p.ph_hi = NPH;
    void* args[] = {&p};
    hipError_t e = hipLaunchCooperativeKernel((const void*)yoco_fwd, dim3(grid), dim3(512), args, LDS_BYTES, stream);
    if (e != hipSuccess) fprintf(stderr, "kernel_launch: cooperative launch failed: %s (grid %d)\n", hipGetErrorString(e), grid);
}
```

```cpp
#include <hip/hip_runtime.h>
#include <hip/hip_cooperative_groups.h>
#include <cstdio>
#include <cstdint>
namespace cg = cooperative_groups;
namespace pg8 {
#define PG8_LAS __attribute__((address_space(3)))
typedef unsigned short bf16_t;
typedef short bf16x8 __attribute__((ext_vector_type(8)));
typedef float f32x4 __attribute__((ext_vector_type(4)));
typedef unsigned u32x4 __attribute__((ext_vector_type(4)));
constexpr int BM = 256, BK = 64, HALF = 128, HTB = HALF * BK * 2  , STAGE_BYTES = 8 * HTB, NXCD = 8, WGM = 8;

__host__ __device__ __forceinline__ int lds_byte(int r, int c) { const int st = (r >> 4) * 2 + (c >> 5), rr = r & 15, cc = c & 31, ob = rr * 64 + cc * 2; return st * 1024 + (ob ^ (((ob >> 9) & 1) << 5)); }
__host__ __device__ __forceinline__ void stage_rc(int b, int& R, int& C) { const int st = b / 1024, sb = b % 1024, swz = sb ^ (((sb >> 9) & 1) << 5); R = (st >> 1) * 16 + swz / 64; C = (st & 1) * 32 + (swz % 64) / 2; }
__host__ __device__ __forceinline__ int perm32(int rho) { const int n = rho >> 4, i = rho & 15; return 8 * (i >> 2) + 4 * n + (i & 3); }

struct Unit { int pm, pn; };
struct Gemm { const bf16_t* A; const bf16_t* Bt; int M, N, K, lda; };

struct StaticOrder {
    int nM, nN, nwg, G, c;
    __host__ __device__ void init(int M, int N, int G_, int c_) { nM = M / BM; nN = N / BM; nwg = nM * nN; G = G_; c = c_; }
    __host__ __device__ bool next(int i, Unit& u) const {
        const long L = (long)i * G + c; if (L >= nwg) return false;
        int wgid = (int)L; { const int q = nwg / NXCD, r = nwg % NXCD, xcd = wgid % NXCD, off = wgid / NXCD; wgid = (xcd < r ? xcd * (q + 1) : r * (q + 1) + (xcd - r) * q) + off; }
        const int nig = WGM * nN, gid = wgid / nig, fm = gid * WGM, gsz = (nM - fm) < WGM ? (nM - fm) : WGM;
        u.pm = fm + ((wgid % nig) % gsz); u.pn = (wgid % nig) / gsz; return true;
    }
    __device__ __forceinline__ void a_ready(const Unit&) const {}
    __device__ __forceinline__ void done(const Unit&) const {}
};

__device__ __forceinline__ unsigned cvt_pk_bf16(float lo, float hi) { unsigned r; asm volatile("v_cvt_pk_bf16_f32 %0, %1, %2" : "=v"(r) : "v"(lo), "v"(hi)); return r; }
typedef float f32x2 __attribute__((ext_vector_type(2)));
__device__ __forceinline__ f32x2 gelu_pk(f32x2 v) {
    const f32x2 av = __builtin_elementwise_abs(v), d = av * 0.2316418882f + 1.0f;
    f32x2 t; t.x = __builtin_amdgcn_rcpf(d.x); t.y = __builtin_amdgcn_rcpf(d.y);
    f32x2 q = t * 0.5307027145f + (-0.7265760135f); q = q * t + 0.7107068705f; q = q * t + (-0.142248368f); q = q * t + 0.127414796f; q = q * t;
    const f32x2 s = (v * v) * (-0.72134752044f);
    f32x2 e; e.x = __builtin_amdgcn_exp2f(s.x); e.y = __builtin_amdgcn_exp2f(s.y);
    const f32x2 m = v * (q * e), r = v - m;
    f32x2 o; o.x = v.x < 0.f ? m.x : r.x; o.y = v.y < 0.f ? m.y : r.y; return o;
}


template <class Epi, class Sched, bool ALIGN_EPI = false, bool SP2 = false>
__device__ __forceinline__ void gemm_phase(PG8_LAS unsigned char* lds, const Gemm g, const Sched& S, const Epi& E, const int tid) {
    const int wid = __builtin_amdgcn_readfirstlane(tid >> 6), lane = tid & 63, wr = wid >> 2, wc = wid & 3, fr = lane & 15, fq = lane >> 4;
    const int K = g.K, nt = K / BK;
    unsigned voffA[2], voffB[2];
#pragma unroll
    for (int i = 0; i < 2; ++i) { int R, C; stage_rc(tid * 16 + i * 8192, R, C); const int Rb = Epi::PERM ? ((R & ~31) + perm32(R & 31)) : R;
        voffA[i] = (unsigned)(R * g.lda + C) * 2u; voffB[i] = (unsigned)(Rb * K + C) * 2u; }
    const size_t kstep = (size_t)(BK * 2);
    const size_t hstepB = (size_t)HALF * K * 2, hstepA = (size_t)HALF * g.lda * 2;
    const size_t tstepB = 2 * hstepB, tstepA = 2 * hstepA;
    const unsigned ldsw = (unsigned)wid * 1024u;
    const int aoff = lds_byte(wr * 64 + fr, fq * 8), boff = lds_byte(wc * 32 + fr, fq * 8);
#define PG8_SA(b, h) (((b) * 2 + (h)) * HTB)
#define PG8_SB(b, h) ((4 + (b) * 2 + (h)) * HTB)
#define PG8_STAGE(bufoff, gbase, voff) do { _Pragma("unroll") for (int _i = 0; _i < 2; ++_i) \
        __builtin_amdgcn_global_load_lds((const unsigned*)((const char*)(gbase) + (voff)[_i]), (PG8_LAS unsigned*)(lds + (bufoff) + ldsw + _i * 8192), 16, 0, 0); } while (0)
#define PG8_LDA(dst, b, h) do { _Pragma("unroll") for (int m = 0; m < 4; ++m) _Pragma("unroll") for (int k = 0; k < 2; ++k) dst[m][k] = *(const PG8_LAS bf16x8*)(lds + PG8_SA(b, h) + aoff + m * 2048 + k * 1024); } while (0)
#define PG8_LDB(dst, b, h) do { _Pragma("unroll") for (int n = 0; n < 2; ++n) _Pragma("unroll") for (int k = 0; k < 2; ++k) dst[n][k] = *(const PG8_LAS bf16x8*)(lds + PG8_SB(b, h) + boff + n * 2048 + k * 1024); } while (0)
#define PG8_MMA(ai, bj, At, Bt) do { __builtin_amdgcn_s_setprio(1); _Pragma("unroll") for (int m = 0; m < 4; ++m) _Pragma("unroll") for (int n = 0; n < 2; ++n) _Pragma("unroll") for (int k = 0; k < 2; ++k) \
        acc[ai][bj][m][n] = __builtin_amdgcn_mfma_f32_16x16x32_bf16(Bt[n][k], At[m][k], acc[ai][bj][m][n], 0, 0, 0); __builtin_amdgcn_s_setprio(0); } while (0)
#define PG8_WAIT_V(n) asm volatile("s_waitcnt vmcnt(" #n ")" ::: "memory")
#define PG8_WAIT_L(n) asm volatile("s_waitcnt lgkmcnt(" #n ")" ::: "memory")
#define PG8_BAR __builtin_amdgcn_s_barrier()
#define PG8_SCHED __builtin_amdgcn_sched_barrier(0)
    Unit cur, nxt; int ui = 0;
    if (!S.next(0, cur)) return;
    f32x4 acc[2][2][4][2];
#pragma unroll
    for (int a = 0; a < 2; ++a)
#pragma unroll
        for (int b = 0; b < 2; ++b)
#pragma unroll
            for (int m = 0; m < 4; ++m)
#pragma unroll
                for (int n = 0; n < 2; ++n) acc[a][b][m][n] = (f32x4){0.f, 0.f, 0.f, 0.f};
    bf16x8 At[4][2], B0[2][2], B1[2][2];
    const char* cA = (const char*)g.A + (size_t)cur.pm * tstepA; const char* cB = (const char*)g.Bt + (size_t)cur.pn * tstepB;
    S.a_ready(cur);
    if constexpr (SP2) {
        PG8_STAGE(PG8_SB(0, 0), cB, voffB); PG8_STAGE(PG8_SB(0, 1), cB + hstepB, voffB); PG8_STAGE(PG8_SA(0, 0), cA, voffA); PG8_STAGE(PG8_SA(0, 1), cA + hstepA, voffA);
        if (wr == 1) PG8_BAR;
        PG8_WAIT_V(2); PG8_BAR;
        PG8_STAGE(PG8_SB(1, 0), cB + kstep, voffB); PG8_STAGE(PG8_SA(1, 0), cA + kstep, voffA); PG8_STAGE(PG8_SB(1, 1), cB + hstepB + kstep, voffB);
        PG8_WAIT_V(6); PG8_BAR;
    } else {
        PG8_STAGE(PG8_SB(0, 0), cB, voffB); PG8_STAGE(PG8_SA(0, 0), cA, voffA); PG8_STAGE(PG8_SB(0, 1), cB + hstepB, voffB); PG8_STAGE(PG8_SA(0, 1), cA + hstepA, voffA);
        if (wr == 1) PG8_BAR;
        PG8_WAIT_V(4); PG8_BAR;
        PG8_STAGE(PG8_SB(1, 0), cB + kstep, voffB); PG8_STAGE(PG8_SA(1, 0), cA + kstep, voffA); PG8_STAGE(PG8_SB(1, 1), cB + hstepB + kstep, voffB);
        PG8_WAIT_V(6); PG8_BAR;
    }
    for (;;) {
        const bool has_next = S.next(ui + 1, nxt);
        const char* nA = has_next ? (const char*)g.A + (size_t)nxt.pm * tstepA : cA; const char* nB = has_next ? (const char*)g.Bt + (size_t)nxt.pn * tstepB : cB;
        for (int t = 0; t < nt; t += 2) {
            const bool last = (t == nt - 2);
            const char* a1 = cA + (size_t)(t + 1) * kstep;
            const char* a2 = last ? nA : cA + (size_t)(t + 2) * kstep; const char* b2 = last ? nB : cB + (size_t)(t + 2) * kstep;
            const char* a3 = a2 + kstep; const char* b3 = b2 + kstep;
            if (last && has_next) S.a_ready(nxt);
            if constexpr (SP2) {
            PG8_LDB(B0, 0, 0); PG8_LDB(B1, 0, 1); PG8_SCHED; PG8_LDA(At, 0, 0); PG8_STAGE(PG8_SA(1, 1), a1 + hstepA, voffA);
            PG8_WAIT_V(8); PG8_WAIT_L(0); PG8_BAR; PG8_MMA(0, 0, At, B0); PG8_MMA(0, 1, At, B1); PG8_BAR; PG8_SCHED;
            PG8_LDA(At, 0, 1); PG8_STAGE(PG8_SB(0, 0), b2, voffB); PG8_STAGE(PG8_SB(0, 1), b2 + hstepB, voffB); PG8_STAGE(PG8_SA(0, 0), a2, voffA);
            PG8_WAIT_V(8); PG8_WAIT_L(0); PG8_BAR; PG8_MMA(1, 0, At, B0); PG8_MMA(1, 1, At, B1); PG8_BAR; PG8_SCHED;
            PG8_LDB(B0, 1, 0); PG8_LDB(B1, 1, 1); PG8_SCHED; PG8_LDA(At, 1, 0); PG8_STAGE(PG8_SA(0, 1), a2 + hstepA, voffA);
            PG8_WAIT_V(8); PG8_WAIT_L(0); PG8_BAR; PG8_MMA(0, 0, At, B0); PG8_MMA(0, 1, At, B1); PG8_BAR; PG8_SCHED;
            PG8_LDA(At, 1, 1); PG8_STAGE(PG8_SB(1, 0), b3, voffB); PG8_STAGE(PG8_SB(1, 1), b3 + hstepB, voffB); PG8_STAGE(PG8_SA(1, 0), a3, voffA);
            PG8_WAIT_V(8); PG8_WAIT_L(0); PG8_BAR; PG8_MMA(1, 0, At, B0); PG8_MMA(1, 1, At, B1); PG8_BAR; PG8_SCHED;
            } else {
            PG8_LDB(B0, 0, 0); PG8_SCHED; PG8_LDA(At, 0, 0); PG8_STAGE(PG8_SA(1, 1), a1 + hstepA, voffA);
            PG8_WAIT_L(8); PG8_BAR; PG8_WAIT_L(0); PG8_MMA(0, 0, At, B0); PG8_BAR; PG8_SCHED;
            PG8_LDB(B1, 0, 1); PG8_STAGE(PG8_SB(0, 0), b2, voffB);
            PG8_BAR; PG8_WAIT_L(0); PG8_MMA(0, 1, At, B1); PG8_BAR;
            PG8_LDA(At, 0, 1); PG8_STAGE(PG8_SA(0, 0), a2, voffA);
            PG8_BAR; PG8_WAIT_L(0); PG8_MMA(1, 0, At, B0); PG8_BAR; PG8_SCHED;
            PG8_STAGE(PG8_SB(0, 1), b2 + hstepB, voffB);
            PG8_WAIT_V(6); PG8_BAR; PG8_MMA(1, 1, At, B1); PG8_BAR;
            PG8_LDB(B0, 1, 0); PG8_SCHED; PG8_LDA(At, 1, 0); PG8_STAGE(PG8_SA(0, 1), a2 + hstepA, voffA);
            PG8_WAIT_L(8); PG8_BAR; PG8_WAIT_L(0); PG8_MMA(0, 0, At, B0); PG8_BAR; PG8_SCHED;
            PG8_LDB(B1, 1, 1); PG8_STAGE(PG8_SB(1, 0), b3, voffB);
            PG8_BAR; PG8_WAIT_L(0); PG8_MMA(0, 1, At, B1); PG8_BAR;
            PG8_LDA(At, 1, 1); PG8_STAGE(PG8_SA(1, 0), a3, voffA);
            PG8_BAR; PG8_WAIT_L(0); PG8_MMA(1, 0, At, B0); PG8_BAR; PG8_SCHED;
            PG8_STAGE(PG8_SB(1, 1), b3 + hstepB, voffB);
            PG8_WAIT_V(6); PG8_BAR; PG8_MMA(1, 1, At, B1); PG8_BAR;
            }
        }
        if constexpr (ALIGN_EPI) { if (wr == 0) PG8_BAR; }
        if constexpr (!Epi::AFTER_DRAIN) { E(acc, cur, wr, wc, fr, fq); S.done(cur); }
        if (!has_next) break;
#pragma unroll
        for (int a = 0; a < 2; ++a)
#pragma unroll
            for (int b = 0; b < 2; ++b)
#pragma unroll
                for (int m = 0; m < 4; ++m)
#pragma unroll
                    for (int n = 0; n < 2; ++n) acc[a][b][m][n] = (f32x4){0.f, 0.f, 0.f, 0.f};
        cur = nxt; cA = nA; cB = nB; ++ui;
        if constexpr (ALIGN_EPI) { if (wr == 1) PG8_BAR; }
    }
    PG8_WAIT_V(0);
    if constexpr (!ALIGN_EPI) { if (wr == 0) PG8_BAR; }
    PG8_BAR;
    if constexpr (Epi::AFTER_DRAIN) { E.fused(acc, cur, wr, wc, fr, fq, lds, wid, lane); S.done(cur); }
#undef PG8_SA
#undef PG8_SB
#undef PG8_STAGE
#undef PG8_LDA
#undef PG8_LDB
#undef PG8_MMA
#undef PG8_WAIT_V
#undef PG8_WAIT_L
#undef PG8_BAR
#undef PG8_SCHED
}
}
#define LAS __attribute__((address_space(3)))
using pg8::bf16_t; using pg8::bf16x8; using pg8::f32x4; using pg8::u32x4; using pg8::cvt_pk_bf16;
typedef float f32x16 __attribute__((ext_vector_type(16)));
typedef int i32x4 __attribute__((ext_vector_type(4)));
typedef unsigned u32x2 __attribute__((ext_vector_type(2)));
typedef float f32x2 __attribute__((ext_vector_type(2)));

constexpr int T = 32768, D = 1024, FF = 2816, SEQ = 4096, NBATCH = 8;
constexpr int NPH = 45;
constexpr float EPS = 1e-6f, LOG2E = 1.4426950408889634f;
constexpr size_t MiB = 1u << 20;
constexpr size_t WS_FIN = 0;
constexpr size_t WS_FOUT = WS_FIN + 88 * MiB;
constexpr size_t WS_AIN = WS_FOUT + 44 * MiB;
constexpr size_t WS_AOUT = WS_AIN + 12 * MiB;
constexpr size_t WS_KVW = WS_AOUT + 4 * MiB;
constexpr size_t WS_CW1 = WS_KVW + 3 * MiB;
constexpr size_t WS_BIN = WS_CW1 + 2 * MiB;
constexpr size_t WS_BOUT = WS_BIN + 5 * MiB;
constexpr size_t WS_MOD = WS_BOUT + 4 * MiB;
constexpr size_t WS_KVMOD = WS_MOD + 4ull * 8 * 9216 * 4;
constexpr size_t WS_CBIAS = WS_KVMOD + 8ull * 2048 * 4;
constexpr size_t WS_H = WS_MOD + 2 * MiB;
constexpr size_t WS_HID = WS_H + 64 * MiB;
constexpr size_t WS_Y = WS_HID + 176 * MiB;
constexpr size_t WS_PART = WS_Y + 64 * MiB;
constexpr size_t WS_GATES = WS_PART + 2 * MiB;
constexpr size_t WS_KC = WS_GATES + 6 * MiB;
constexpr size_t WS_KS = WS_KC + 33 * MiB;
constexpr size_t WS_KW = WS_KS + 16 * MiB;
constexpr size_t WS_VST = WS_KW + 16 * MiB;
constexpr size_t WS_VWT = WS_VST + 16 * MiB;
constexpr size_t WS_HIDC = WS_VWT + 16 * MiB;
constexpr size_t WS_KCMP = WS_HIDC + 8 * MiB;
constexpr size_t WS_VCMPT = WS_KCMP + 1 * MiB;
constexpr size_t WS_BAR = WS_VCMPT + 1 * MiB;
constexpr size_t WS_END = WS_BAR + 1 * MiB;
constexpr int LDS_BYTES = 135168;

struct Params { const float* in[19]; float* out; unsigned char* ws; int ph_lo, ph_hi; };
enum { I_X = 0, I_C, I_ADAW, I_ADAB, I_NORMG, I_FIN, I_FOUT, I_AIN, I_ACONV, I_AOUT, I_KVNG, I_KVADAW, I_KVADAB, I_KVW, I_CPOS, I_CW1, I_CW2, I_BIN, I_BOUT };

__device__ __forceinline__ float bf2f(unsigned short b) { return __uint_as_float((unsigned)b << 16); }
__device__ __forceinline__ float fexp2(float x) { return __builtin_amdgcn_exp2f(x); }
__device__ __forceinline__ float frcp(float x) { return __builtin_amdgcn_rcpf(x); }
__device__ __forceinline__ float silu_f(float g) { return g * frcp(1.f + fexp2(-g * LOG2E)); }
__device__ __forceinline__ float wave_sum(float v) {
#pragma unroll
    for (int o = 1; o < 64; o <<= 1) v += __shfl_xor(v, o);
    return v;
}
template <class Tp> __device__ __forceinline__ Tp* uptr(Tp* p) { const unsigned long long v = (unsigned long long)p; const unsigned lo = __builtin_amdgcn_readfirstlane((unsigned)v), hi = __builtin_amdgcn_readfirstlane((unsigned)(v >> 32)); typedef __attribute__((address_space(1))) Tp* gptr_t; gptr_t gp = (gptr_t)(((unsigned long long)hi << 32) | lo); return (Tp*)gp; }
#define LDS_WAIT() asm volatile("s_waitcnt lgkmcnt(0)" ::: "memory")

namespace pg8 {
__device__ __forceinline__ u32x4 pack8(const f32x4 a, const f32x4 b) { u32x4 w; w.x = cvt_pk_bf16(a[0], a[1]); w.y = cvt_pk_bf16(a[2], a[3]); w.z = cvt_pk_bf16(b[0], b[1]); w.w = cvt_pk_bf16(b[2], b[3]); return w; }
struct EpiSwiglu {
    static constexpr bool PERM = true, AFTER_DRAIN = false;
    bf16_t* O;
    __device__ __forceinline__ void operator()(const f32x4 (&acc)[2][2][4][2], const Unit& u, int wr, int wc, int fr, int fq) const {
        const int row0 = u.pm * BM + wr * 64 + fr, col0 = u.pn * 128 + wc * 32 + 8 * fq;
#pragma unroll
        for (int ai = 0; ai < 2; ++ai)
#pragma unroll
            for (int m = 0; m < 4; ++m) {
                f32x4 h0, h1;
#pragma unroll
                for (int e = 0; e < 4; ++e) { h0[e] = silu_f(acc[ai][0][m][0][e]) * acc[ai][1][m][0][e]; h1[e] = silu_f(acc[ai][0][m][1][e]) * acc[ai][1][m][1][e]; }
                *(u32x4*)(O + (size_t)(row0 + ai * HALF + m * 16) * FF + col0) = pack8(h0, h1);
            }
    }
};
struct EpiY {
    static constexpr bool PERM = true, AFTER_DRAIN = false;
    bf16_t* Y; float* part;
    __device__ __forceinline__ void operator()(const f32x4 (&acc)[2][2][4][2], const Unit& u, int wr, int wc, int fr, int fq) const {
        const int row0 = u.pm * BM + wr * 64 + fr, col0 = u.pn * BM + wc * 32 + 8 * fq;
#pragma unroll
        for (int ai = 0; ai < 2; ++ai)
#pragma unroll
            for (int m = 0; m < 4; ++m) {
                const int row = row0 + ai * HALF + m * 16; float ss = 0.f;
#pragma unroll
                for (int bj = 0; bj < 2; ++bj) {
                    const f32x4 a = acc[ai][bj][m][0], b = acc[ai][bj][m][1];
                    ss += (a[0] * a[0] + a[1] * a[1]) + (a[2] * a[2] + a[3] * a[3]) + (b[0] * b[0] + b[1] * b[1]) + (b[2] * b[2] + b[3] * b[3]);
                    *(u32x4*)(Y + (size_t)row * D + col0 + bj * HALF) = pack8(a, b);
                }
                ss += __shfl_xor(ss, 16); ss += __shfl_xor(ss, 32);
                if (fq == 0) part[(size_t)row * 16 + u.pn * 4 + wc] = ss;
            }
    }
};
struct EpiConvIn {
    static constexpr bool PERM = true, AFTER_DRAIN = false;
    bf16_t* V; bf16_t* Bg;
    __device__ __forceinline__ void operator()(const f32x4 (&acc)[2][2][4][2], const Unit& u, int wr, int wc, int fr, int fq) const {
        const int row0 = u.pm * BM + wr * 64 + fr;
        if (u.pn < 8) {
            const int col0 = u.pn * 128 + wc * 32 + 8 * fq;
#pragma unroll
            for (int ai = 0; ai < 2; ++ai)
#pragma unroll
                for (int m = 0; m < 4; ++m)
                    *(u32x4*)(V + (size_t)(row0 + ai * HALF + m * 16) * D + col0) = pack8(acc[ai][0][m][0] * acc[ai][1][m][0], acc[ai][0][m][1] * acc[ai][1][m][1]);
        } else {
            const int col0 = (u.pn - 8) * BM + wc * 32 + 8 * fq;
#pragma unroll
            for (int ai = 0; ai < 2; ++ai)
#pragma unroll
                for (int m = 0; m < 4; ++m)
#pragma unroll
                    for (int bj = 0; bj < 2; ++bj)
                        *(u32x4*)(Bg + (size_t)(row0 + ai * HALF + m * 16) * D + col0 + bj * HALF) = pack8(acc[ai][bj][m][0], acc[ai][bj][m][1]);
        }
    }
};
struct EpiQG {
    static constexpr bool PERM = true, AFTER_DRAIN = false;
    bf16_t* Q; float* G;
    __device__ __forceinline__ void operator()(const f32x4 (&acc)[2][2][4][2], const Unit& u, int wr, int wc, int fr, int fq) const {
        const int row0 = u.pm * BM + wr * 64 + fr;
        if (u.pn < 4) {
            const int col0 = u.pn * BM + wc * 32 + 8 * fq; const float sc = 0.125f * LOG2E;
#pragma unroll
            for (int ai = 0; ai < 2; ++ai)
#pragma unroll
                for (int m = 0; m < 4; ++m)
#pragma unroll
                    for (int bj = 0; bj < 2; ++bj)
                        *(u32x4*)(Q + (size_t)(row0 + ai * HALF + m * 16) * D + col0 + bj * HALF) = pack8(acc[ai][bj][m][0] * sc, acc[ai][bj][m][1] * sc);
        } else {
            const int col0 = wc * 32 + 8 * fq;
            if (col0 < 48) {
#pragma unroll
                for (int ai = 0; ai < 2; ++ai)
#pragma unroll
                    for (int m = 0; m < 4; ++m) {
                        float* gp = G + (size_t)(row0 + ai * HALF + m * 16) * 48 + col0;
#pragma unroll
                        for (int n = 0; n < 2; ++n) { f32x4 s;
#pragma unroll
                            for (int e = 0; e < 4; ++e) s[e] = frcp(1.f + fexp2(-acc[ai][0][m][n][e] * LOG2E));
                            *(f32x4*)(gp + 4 * n) = s; }
                    }
            }
        }
    }
};
struct EpiKV {
    static constexpr bool PERM = true, AFTER_DRAIN = false;
    bf16_t *KC, *KS, *KW, *VSt, *VWt;
    __device__ __forceinline__ void operator()(const f32x4 (&acc)[2][2][4][2], const Unit& u, int wr, int wc, int fr, int fq) const {
        const int br = u.pn >> 1, kv = u.pn & 1;
        const int row0 = u.pm * BM + wr * 64 + fr, b = row0 >> 12;
        const int d0 = (wc & 1) * 32 + 8 * fq;
        if (br == 0 || kv == 0) {
            bf16_t* base = br == 0 ? KC + (size_t)kv * 32 * 4096 * 64 : (br == 1 ? KS : KW);
#pragma unroll
            for (int ai = 0; ai < 2; ++ai)
#pragma unroll
                for (int m = 0; m < 4; ++m)
#pragma unroll
                    for (int bj = 0; bj < 2; ++bj) {
                        const int s = (row0 + ai * HALF + m * 16) & 4095, g = 2 * bj + (wc >> 1);
                        *(u32x4*)(base + ((size_t)(b * 4 + g) * 4096 + s) * 64 + d0) = pack8(acc[ai][bj][m][0], acc[ai][bj][m][1]);
                    }
        } else {
            bf16_t* base = br == 1 ? VSt : VWt;
#pragma unroll
            for (int ai = 0; ai < 2; ++ai)
#pragma unroll
                for (int m = 0; m < 4; ++m)
#pragma unroll
                    for (int bj = 0; bj < 2; ++bj) {
                        const int s = (row0 + ai * HALF + m * 16) & 4095, g = 2 * bj + (wc >> 1);
                        bf16_t* p = base + (((size_t)(b * 4 + g) * 64 + (s >> 6)) * 64 + d0) * 64 + (s & 63);
                        const u32x4 w = pack8(acc[ai][bj][m][0], acc[ai][bj][m][1]);
                        p[0 * 64] = (bf16_t)(w.x & 0xffffu); p[1 * 64] = (bf16_t)(w.x >> 16); p[2 * 64] = (bf16_t)(w.y & 0xffffu); p[3 * 64] = (bf16_t)(w.y >> 16);
                        p[4 * 64] = (bf16_t)(w.z & 0xffffu); p[5 * 64] = (bf16_t)(w.z >> 16); p[6 * 64] = (bf16_t)(w.w & 0xffffu); p[7 * 64] = (bf16_t)(w.w >> 16);
                    }
        }
    }
};
struct EpiCmp1 {
    static constexpr bool PERM = true, AFTER_DRAIN = false;
    bf16_t* O; const float* cbias;
    __device__ __forceinline__ void operator()(const f32x4 (&acc)[2][2][4][2], const Unit& u, int wr, int wc, int fr, int fq) const {
        const int row0 = u.pm * BM + wr * 64 + fr, col0 = wc * 32 + 8 * fq;
#pragma unroll
        for (int bj = 0; bj < 2; ++bj) {
            const f32x4 b0 = *(const f32x4*)(cbias + u.pn * 256 + col0 + bj * HALF), b1 = *(const f32x4*)(cbias + u.pn * 256 + col0 + bj * HALF + 4);
#pragma unroll
            for (int ai = 0; ai < 2; ++ai)
#pragma unroll
                for (int m = 0; m < 4; ++m) {
                    f32x4 x0 = acc[ai][bj][m][0] + b0, x1 = acc[ai][bj][m][1] + b1;
#pragma unroll
                    for (int e = 0; e < 4; ++e) {
                        { const float x = x0[e], z = 1.5957691216f * (x + 0.044715f * x * x * x); x0[e] = x * frcp(1.f + fexp2(-z * LOG2E)); }
                        { const float x = x1[e], z = 1.5957691216f * (x + 0.044715f * x * x * x); x1[e] = x * frcp(1.f + fexp2(-z * LOG2E)); }
                    }
                    *(u32x4*)(O + (size_t)(row0 + ai * HALF + m * 16) * 256 + col0 + bj * HALF) = pack8(x0, x1);
                }
        }
    }
};
struct DiagOrder {
    int G, c;
    __device__ bool next(int i, Unit& u) const { const int L = i * G + c; if (L >= 64) return false; u.pm = L; u.pn = L >> 5; return true; }
    __device__ __forceinline__ void a_ready(const Unit&) const {}
    __device__ __forceinline__ void done(const Unit&) const {}
};
}
struct Ctx { LAS unsigned char* lds; int tid, lane, wave, G, bid; };

__device__ __forceinline__ void conv_item(const float* W, int ldw, int ncv, int src_col0, int K, bf16_t* WT, int dst_row0, int kb, LAS float* scr, int lane) {
    const int k0 = 64 * kb, col = src_col0 + (lane & 31); const bool ok = col < ncv;
    float wv[32];
#pragma unroll
    for (int i = 0; i < 32; ++i) { const int kk = 2 * i + (lane >> 5); wv[i] = ok ? W[(size_t)(k0 + kk) * ldw + col] : 0.f; }
#pragma unroll
    for (int i = 0; i < 32; ++i) { const int kk = 2 * i + (lane >> 5); scr[kk * 33 + (lane & 31)] = wv[i]; }
    LDS_WAIT(); asm volatile("" ::: "memory");
    const int c = lane & 7;
#pragma unroll
    for (int j = 0; j < 4; ++j) { const int n = (lane >> 3) + 8 * j; const LAS float* s = scr + (8 * c) * 33 + n;
        u32x4 o; o.x = cvt_pk_bf16(s[0 * 33], s[1 * 33]); o.y = cvt_pk_bf16(s[2 * 33], s[3 * 33]); o.z = cvt_pk_bf16(s[4 * 33], s[5 * 33]); o.w = cvt_pk_bf16(s[6 * 33], s[7 * 33]);
        *(u32x4*)(WT + (size_t)(dst_row0 + n) * K + k0 + 8 * c) = o; }
    LDS_WAIT(); asm volatile("" ::: "memory");
}
#define PIN(k) uptr(LP->in[k])
__device__ __forceinline__ void p0_phase(const Ctx& X, const LAS Params* LP) {
    unsigned char* ws = uptr(LP->ws);
    LAS float* sc = (LAS float*)X.lds;
    LAS float* red = (LAS float*)(X.lds + 32768);
    for (int i = X.tid; i < 8192; i += 512) { const int b = i >> 10, k = i & 1023; sc[k * 8 + b] = silu_f(PIN(I_C)[i]); }
    __syncthreads();
    for (int it = X.bid; it < 152; it += X.G) {
        const float* W; const float* bias; float* out; int N, cb;
        if (it < 144) { const int l = it / 36; cb = it % 36; N = 9216; W = PIN(I_ADAW) + (size_t)l * 1024 * 9216; bias = PIN(I_ADAB) + l * 9216; out = (float*)(ws + WS_MOD) + (size_t)l * 8 * 9216; }
        else { cb = it - 144; N = 2048; W = PIN(I_KVADAW); bias = PIN(I_KVADAB); out = (float*)(ws + WS_KVMOD); }
        f32x4 a[8];
#pragma unroll
        for (int b = 0; b < 8; ++b) a[b] = (f32x4){0.f, 0.f, 0.f, 0.f};
        const float* wp = W + (size_t)(128 * X.wave) * N + 256 * cb + 4 * X.lane;
#pragma unroll 1
        for (int k0 = 0; k0 < 128; k0 += 8) {
            f32x4 w[8];
#pragma unroll
            for (int k = 0; k < 8; ++k) w[k] = *(const f32x4*)(wp + (size_t)(k0 + k) * N);
#pragma unroll
            for (int k = 0; k < 8; ++k) { const f32x4 s0 = *(const LAS f32x4*)(sc + (128 * X.wave + k0 + k) * 8), s1 = *(const LAS f32x4*)(sc + (128 * X.wave + k0 + k) * 8 + 4);
                a[0] += w[k] * s0[0]; a[1] += w[k] * s0[1]; a[2] += w[k] * s0[2]; a[3] += w[k] * s0[3]; a[4] += w[k] * s1[0]; a[5] += w[k] * s1[1]; a[6] += w[k] * s1[2]; a[7] += w[k] * s1[3]; }
        }
#pragma unroll
        for (int b = 0; b < 8; ++b) *(LAS f32x4*)(red + ((X.wave * 8 + b) * 256 + 4 * X.lane)) = a[b];
        __syncthreads();
#pragma unroll
        for (int r4 = 0; r4 < 4; ++r4) { const int o = X.tid + 512 * r4, b = o >> 8, col = o & 255; float s = bias[256 * cb + col];
#pragma unroll
            for (int w = 0; w < 8; ++w) s += red[(w * 8 + b) * 256 + col];
            out[(size_t)b * N + 256 * cb + col] = s; }
        __syncthreads();
    }
    for (int kv = 0; kv < 2; ++kv) if (X.bid == X.G - 1 - kv) {
        const int col = X.tid & 255, half = X.tid >> 8; const float* pos = PIN(I_CPOS) + kv * 2048 + half * 1024; const float* w1 = PIN(I_CW1) + ((size_t)kv * 2048 + half * 1024) * 256 + col;
        float s = 0.f;
        for (int f = 0; f < 1024; ++f) s += pos[f] * w1[(size_t)f * 256];
        red[X.tid] = s; __syncthreads();
        if (X.tid < 256) ((float*)(ws + WS_CBIAS))[kv * 256 + X.tid] = red[X.tid] + red[X.tid + 256];
        __syncthreads();
    }
    __syncthreads();
    LAS float* scr = (LAS float*)(X.lds + X.wave * 8448);
    unsigned* const ctr = (unsigned*)(ws + WS_BAR) + 3520;
    for (;;) {
        unsigned base_ = 0u; if (X.lane == 0) base_ = __hip_atomic_fetch_add(ctr, 8u, __ATOMIC_RELAXED, __HIP_MEMORY_SCOPE_AGENT);
        const int base = __builtin_amdgcn_readfirstlane((int)base_); if (base >= 41472) break;
      for (int it = base; it < base + 8; ++it) {
        int r = it;
        if (r < 22528) { const int id = r / 2816, q = r % 2816, nb = q >> 4, kb = q & 15, pn = nb >> 3, jb = nb & 7;
            conv_item(PIN(I_FIN) + (size_t)id * 1024 * 5632, 5632, 5632, (jb >> 2) * 2816 + 128 * pn + 32 * (jb & 3), 1024, (bf16_t*)(ws + WS_FIN) + (size_t)id * 5632 * 1024, 32 * nb, kb, scr, X.lane); continue; } r -= 22528;
        if (r < 11264) { const int id = r / 1408, q = r % 1408, nb = q / 44, kb = q % 44;
            conv_item(PIN(I_FOUT) + (size_t)id * 2816 * 1024, 1024, 1024, 32 * nb, 2816, (bf16_t*)(ws + WS_FOUT) + (size_t)id * 1024 * 2816, 32 * nb, kb, scr, X.lane); continue; } r -= 11264;
        if (r < 3072) { const int id = r / 1536, q = r % 1536, nb = q >> 4, kb = q & 15, pn = nb >> 3, jb = nb & 7;
            const int src = pn < 8 ? ((jb >> 2) ? 2048 : 1024) + 128 * pn + 32 * (jb & 3) : 256 * (pn - 8) + 32 * jb;
            conv_item(PIN(I_AIN) + (size_t)id * 1024 * 3072, 3072, 3072, src, 1024, (bf16_t*)(ws + WS_AIN) + (size_t)id * 3072 * 1024, 32 * nb, kb, scr, X.lane); continue; } r -= 3072;
        if (r < 1024) { const int id = r / 512, q = r % 512, nb = q >> 4, kb = q & 15;
            conv_item(PIN(I_AOUT) + (size_t)id * 1024 * 1024, 1024, 1024, 32 * nb, 1024, (bf16_t*)(ws + WS_AOUT) + (size_t)id * 1024 * 1024, 32 * nb, kb, scr, X.lane); continue; } r -= 1024;
        if (r < 768) { const int nb = r >> 4, kb = r & 15;
            conv_item(PIN(I_KVW), 1536, 1536, 32 * nb, 1024, (bf16_t*)(ws + WS_KVW), 32 * nb, kb, scr, X.lane); continue; } r -= 768;
        if (r < 512) { const int id = r / 256, q = r % 256, nb = q >> 5, kb = q & 31;
            conv_item(PIN(I_CW1) + (size_t)id * 2048 * 256, 256, 256, 32 * nb, 2048, (bf16_t*)(ws + WS_CW1) + (size_t)id * 256 * 2048, 32 * nb, kb, scr, X.lane); continue; } r -= 512;
        if (r < 1280) { const int id = r / 640, q = r % 640, nb = q >> 4, kb = q & 15;
            conv_item(PIN(I_BIN) + (size_t)id * 1024 * 1072, 1072, 1072, 32 * nb, 1024, (bf16_t*)(ws + WS_BIN) + (size_t)id * 1280 * 1024, 32 * nb, kb, scr, X.lane); continue; } r -= 1280;
        { const int id = r / 512, q = r % 512, nb = q >> 4, kb = q & 15;
            conv_item(PIN(I_BOUT) + (size_t)id * 1024 * 1024, 1024, 1024, 32 * nb, 1024, (bf16_t*)(ws + WS_BOUT) + (size_t)id * 1024 * 1024, 32 * nb, kb, scr, X.lane); }
      }
    }
}

struct UpdArgs { const float* xin; float* xout; const bf16_t* y; const float* part; const float* gate; const float* gpost; float w; int bstride;
                 const float* gpre; const float* shift; const float* scale; bf16_t* h; const float* gpre2; const float* shift2; const float* scale2; bf16_t* h2; };
__device__ __forceinline__ void update_phase(const Ctx& X, const UpdArgs& A) {
    constexpr int R = 2;
    const int gw = X.bid * 8 + X.wave, NGW = X.G * 8, c0 = 4 * X.lane;
    for (int row0 = gw; row0 < T; row0 += R * NGW) {
        f32x4 xv[R][4]; u32x2 yy[R][4]; f32x4 pp[R][4];
#pragma unroll
        for (int q = 0; q < R; ++q) { const int row = min(row0 + q * NGW, T - 1);
#pragma unroll
            for (int j = 0; j < 4; ++j) xv[q][j] = *(const f32x4*)(A.xin + (size_t)row * D + c0 + 256 * j);
            if (A.y) {
#pragma unroll
                for (int j = 0; j < 4; ++j) { yy[q][j] = *(const u32x2*)(A.y + (size_t)row * D + c0 + 256 * j); pp[q][j] = *(const f32x4*)(A.part + (size_t)row * 16 + 4 * j); }
            }
        }
#pragma unroll
        for (int q = 0; q < R; ++q) { const int row = row0 + q * NGW; if (row < T) {
            const int b = row >> 12;
            if (A.y) {
                const float ssq = ((pp[q][0][0] + pp[q][0][1]) + (pp[q][0][2] + pp[q][0][3])) + ((pp[q][1][0] + pp[q][1][1]) + (pp[q][1][2] + pp[q][1][3])) + ((pp[q][2][0] + pp[q][2][1]) + (pp[q][2][2] + pp[q][2][3])) + ((pp[q][3][0] + pp[q][3][1]) + (pp[q][3][2] + pp[q][3][3]));
                const float rs = A.w * __builtin_amdgcn_rsqf(ssq * (1.f / D) + EPS);
#pragma unroll
                for (int j = 0; j < 4; ++j) { const int c = c0 + 256 * j;
                    const f32x4 gt = *(const f32x4*)(A.gate + (size_t)b * A.bstride + c), gp = *(const f32x4*)(A.gpost + c);
                    const f32x4 yv = {__uint_as_float(yy[q][j].x << 16), __uint_as_float(yy[q][j].x & 0xffff0000u), __uint_as_float(yy[q][j].y << 16), __uint_as_float(yy[q][j].y & 0xffff0000u)};
                    xv[q][j] = xv[q][j] + gt * gp * yv * rs; }
            }
            if (A.xout) {
#pragma unroll
                for (int j = 0; j < 4; ++j) *(f32x4*)(A.xout + (size_t)row * D + c0 + 256 * j) = xv[q][j];
            }
            if (A.h) {
                float s = 0.f;
#pragma unroll
                for (int j = 0; j < 4; ++j) s += (xv[q][j][0] * xv[q][j][0] + xv[q][j][1] * xv[q][j][1]) + (xv[q][j][2] * xv[q][j][2] + xv[q][j][3] * xv[q][j][3]);
                const float r = __builtin_amdgcn_rsqf(wave_sum(s) * (1.f / D) + EPS);
#pragma unroll
                for (int j = 0; j < 4; ++j) { const int c = c0 + 256 * j;
                    const f32x4 g = *(const f32x4*)(A.gpre + c), sh = *(const f32x4*)(A.shift + (size_t)b * A.bstride + c), scl = *(const f32x4*)(A.scale + (size_t)b * A.bstride + c);
                    const f32x4 hv = xv[q][j] * r * g * (scl + 1.f) + sh; u32x2 o; o.x = cvt_pk_bf16(hv[0], hv[1]); o.y = cvt_pk_bf16(hv[2], hv[3]);
                    *(u32x2*)(A.h + (size_t)row * D + c) = o; }
                if (A.h2) {
#pragma unroll
                    for (int j = 0; j < 4; ++j) { const int c = c0 + 256 * j;
                        const f32x4 g = *(const f32x4*)(A.gpre2 + c), sh = *(const f32x4*)(A.shift2 + (size_t)b * 2048 + c), scl = *(const f32x4*)(A.scale2 + (size_t)b * 2048 + c);
                        const f32x4 hv = xv[q][j] * r * g * (scl + 1.f) + sh; u32x2 o; o.x = cvt_pk_bf16(hv[0], hv[1]); o.y = cvt_pk_bf16(hv[2], hv[3]);
                        *(u32x2*)(A.h2 + (size_t)row * D + c) = o; }
                }
            }
        } }
    }
}

__device__ __forceinline__ void unpack8(const u32x4 w, float (&f)[8]) {
    f[0] = __uint_as_float(w.x << 16); f[1] = __uint_as_float(w.x & 0xffff0000u); f[2] = __uint_as_float(w.y << 16); f[3] = __uint_as_float(w.y & 0xffff0000u);
    f[4] = __uint_as_float(w.z << 16); f[5] = __uint_as_float(w.z & 0xffff0000u); f[6] = __uint_as_float(w.w << 16); f[7] = __uint_as_float(w.w & 0xffff0000u);
}
__device__ __forceinline__ void conv_phase(const Ctx& X, const bf16_t* V, const bf16_t* Bg, const float* cw, bf16_t* Z) {
    const int gt = X.bid * 512 + X.tid, NT = X.G * 512;
    for (int i = gt; i < T * 128; i += NT) {
        const int row = i >> 7, c = (i & 127) * 8, s = row & 4095;
        const u32x4 z0 = {0u, 0u, 0u, 0u};
        const u32x4 v2 = *(const u32x4*)(V + (size_t)row * D + c), v1 = s >= 1 ? *(const u32x4*)(V + (size_t)(row - 1) * D + c) : z0, v0 = s >= 2 ? *(const u32x4*)(V + (size_t)(row - 2) * D + c) : z0;
        const u32x4 bb = *(const u32x4*)(Bg + (size_t)row * D + c);
        float a0[8], a1[8], a2[8], bf[8], o[8]; unpack8(v0, a0); unpack8(v1, a1); unpack8(v2, a2); unpack8(bb, bf);
#pragma unroll
        for (int e = 0; e < 8; ++e) o[e] = bf[e] * (cw[c + e] * a0[e] + cw[D + c + e] * a1[e] + cw[2 * D + c + e] * a2[e]);
        u32x4 w; w.x = cvt_pk_bf16(o[0], o[1]); w.y = cvt_pk_bf16(o[2], o[3]); w.z = cvt_pk_bf16(o[4], o[5]); w.w = cvt_pk_bf16(o[6], o[7]);
        *(u32x4*)(Z + (size_t)row * D + c) = w;
    }
}

__device__ __forceinline__ void cmp2_phase(const Ctx& X, const bf16_t* hidc, const float* w2, bf16_t* kcmp, bf16_t* vcmpT) {
    const int gt = X.bid * 512 + X.tid, NT = X.G * 512;
    for (int i = gt; i < 16384 * 16; i += NT) {
        const int row = i >> 4, c = (i & 15) * 4, kv = row >> 13, rr = row & 8191;
        const float* w = w2 + (size_t)kv * 256 * 64 + c; const bf16_t* hp = hidc + (size_t)row * 256;
        f32x4 a = {0.f, 0.f, 0.f, 0.f};
        for (int k = 0; k < 256; k += 8) { float hf[8]; unpack8(*(const u32x4*)(hp + k), hf);
#pragma unroll
            for (int e = 0; e < 8; ++e) a += *(const f32x4*)(w + (size_t)(k + e) * 64) * hf[e]; }
        if (kv == 0) { u32x2 o; o.x = cvt_pk_bf16(a[0], a[1]); o.y = cvt_pk_bf16(a[2], a[3]); *(u32x2*)(kcmp + (size_t)rr * 64 + c) = o; }
        else { const int bg = rr >> 8, n = rr & 255; bf16_t* p = vcmpT + (((size_t)bg * 4 + (n >> 6)) * 64 + c) * 64 + (n & 63); const unsigned w0 = cvt_pk_bf16(a[0], a[1]), w1 = cvt_pk_bf16(a[2], a[3]);
            p[0] = (bf16_t)(w0 & 0xffffu); p[64] = (bf16_t)(w0 >> 16); p[128] = (bf16_t)(w1 & 0xffffu); p[192] = (bf16_t)(w1 >> 16); }
    }
}
struct AttnArgs { const bf16_t* Q; const float* gates; const bf16_t *kcmp, *vcmpT, *KS, *VSt, *KW, *VWt; bf16_t* O; };

__device__ __forceinline__ void load_k(bf16x8 (&kf)[4], const bf16_t* Kb, int key0, int jr, int h) {
    const bf16x8* p = (const bf16x8*)(Kb + (size_t)(key0 + jr) * 64 + h * 8);
#pragma unroll
    for (int ks = 0; ks < 4; ++ks) kf[ks] = p[2 * ks];
}
__device__ __forceinline__ void load_v(bf16x8 (&vf)[4], const bf16_t* Vt, int ldv, int key0, int j, int h) {
#pragma unroll
    for (int s = 0; s < 2; ++s)
#pragma unroll
        for (int dt = 0; dt < 2; ++dt) vf[s * 2 + dt] = *(const bf16x8*)(Vt + (size_t)(dt * 32 + j) * ldv + key0 + 16 * s + 8 * h);
}
__device__ __forceinline__ f32x16 qk_mma(const bf16x8 (&kf)[4], const bf16x8 (&qf)[4], const f32x16& bc) {
    f32x16 acc = __builtin_amdgcn_mfma_f32_32x32x16_bf16(kf[0], qf[0], bc, 0, 0, 0);
#pragma unroll
    for (int ks = 1; ks < 4; ++ks) acc = __builtin_amdgcn_mfma_f32_32x32x16_bf16(kf[ks], qf[ks], acc, 0, 0, 0);
    return acc;
}
__device__ __forceinline__ void pv_mma(f32x16 (&o)[2], const bf16x8 (&vf)[4], const f32x16& p) {
#pragma unroll
    for (int s = 0; s < 2; ++s) {
        u32x4 w; w.x = cvt_pk_bf16(p[8 * s + 0], p[8 * s + 1]); w.y = cvt_pk_bf16(p[8 * s + 2], p[8 * s + 3]); w.z = cvt_pk_bf16(p[8 * s + 4], p[8 * s + 5]); w.w = cvt_pk_bf16(p[8 * s + 6], p[8 * s + 7]);
        const bf16x8 pb = __builtin_bit_cast(bf16x8, w);
#pragma unroll
        for (int dt = 0; dt < 2; ++dt) o[dt] = __builtin_amdgcn_mfma_f32_32x32x16_bf16(vf[s * 2 + dt], pb, o[dt], 0, 0, 0);
    }
}
__device__ __forceinline__ void pf_block(const bf16_t* Kb, const bf16_t* Vt, int ldv, int key0, int lane, LAS unsigned* junk) {
    __builtin_amdgcn_global_load_lds((const unsigned*)(Kb + (size_t)(key0 + lane) * 64), junk, 4, 0, 0);
    __builtin_amdgcn_global_load_lds((const unsigned*)(Vt + (size_t)lane * ldv + key0), junk, 4, 0, 0);
}
__device__ __forceinline__ unsigned run_mask(int kstart, int lo, int hi) {
    const int a = max(lo - kstart, 0), b = min(hi - kstart, 7);
    return a <= b ? ((1u << (b + 1)) - 1u) & ~((1u << a) - 1u) : 0u;
}
__device__ __forceinline__ float max16(const f32x16& s) {
    float a = fmaxf(fmaxf(s[0], s[1]), s[2]), b = fmaxf(fmaxf(s[3], s[4]), s[5]), c = fmaxf(fmaxf(s[6], s[7]), s[8]), d = fmaxf(fmaxf(s[9], s[10]), s[11]), e = fmaxf(fmaxf(s[12], s[13]), s[14]);
    return fmaxf(fmaxf(fmaxf(a, b), fmaxf(c, d)), fmaxf(e, s[15]));
}
__device__ __forceinline__ void softmax_step(f32x16& s, bool full, unsigned vm, float off, float& m, float& l, f32x16 (&o)[2], bool lane_on = true) {
    if (!full) {
#pragma unroll
        for (int v = 0; v < 16; ++v) s[v] = ((vm >> v) & 1u) ? s[v] : -1e30f;
    }
    float tm = max16(s);
    if (full && !lane_on) tm = -1e30f;
    tm = fmaxf(tm, __shfl_xor(tm, 32)) + off;
    const float mn = fmaxf(m, tm);
    if (__any(mn > m)) { const float al = fexp2(m - mn); l *= al; o[0] = o[0] * al; o[1] = o[1] * al; }
    m = mn; const float ml = (full && !lane_on) ? 3e38f : mn - off;
    float ps = 0.f;
    if (full) {
#pragma unroll
        for (int v = 0; v < 16; ++v) { const float p = fexp2(s[v] - ml); s[v] = p; ps += p; }
    } else {
#pragma unroll
        for (int v = 0; v < 16; ++v) { const float p = ((vm >> v) & 1u) ? fexp2(s[v] - ml) : 0.f; s[v] = p; ps += p; }
    }
    l += ps;
}

__device__ __forceinline__ void softmax_step64(f32x16& s1, f32x16& s0, float off1, float off0, bool lane_on, float& m, float& l, f32x16 (&o)[2]) {
    float tm = fmaxf(max16(s1) + off1, max16(s0) + off0);
    if (!lane_on) tm = -1e30f;
    tm = fmaxf(tm, __shfl_xor(tm, 32));
    const float mn = fmaxf(m, tm);
    if (__any(mn > m)) { const float al = fexp2(m - mn); l *= al; o[0] = o[0] * al; o[1] = o[1] * al; }
    m = mn; const float ml1 = lane_on ? mn - off1 : 3e38f, ml0 = lane_on ? mn - off0 : 3e38f;
    float ps = 0.f;
#pragma unroll
    for (int v = 0; v < 16; ++v) { const float p = fexp2(s1[v] - ml1); s1[v] = p; ps += p; }
#pragma unroll
    for (int v = 0; v < 16; ++v) { const float p = fexp2(s0[v] - ml0); s0[v] = p; ps += p; }
    l += ps;
}
__device__ __forceinline__ void glds16(const void* gsrc, unsigned lds_dst) { unsigned keep;
    asm volatile("s_mov_b32 %0, m0\n\ts_mov_b32 m0, %2\n\ts_nop 0\n\tglobal_load_lds_dwordx4 %1, off\n\ts_mov_b32 m0, %0" : "=&s"(keep) : "v"(gsrc), "s"(lds_dst) : "memory"); }
struct AttnSrc { const bf16_t *Kc, *Vc, *Kw, *Vw, *Ks, *Vs; };
__device__ __forceinline__ void ring_load(const AttnSrc& S, int type, int key0, unsigned slot_addr, int wave, int lane) {
    const int q = lane & 7;
#pragma unroll
    for (int e = 0; e < 2; ++e) {
        const int pr = (2 * wave + e) & 7, i = 8 * pr + (lane >> 3), c = q ^ ((i >> 1) & 7);
        const bf16_t* src;
        if (wave < 4) { const bf16_t* kb = type == 0 ? S.Kc : (type == 1 ? S.Kw : S.Ks); const int il = i & 31, kp = (il & ~12) | ((il & 4) << 1) | ((il & 8) >> 1);
                        src = kb + (size_t)(key0 + (i & 32) + kp) * 64 + 8 * c; }
        else { const bf16_t* vb = type == 0 ? S.Vc : (type == 1 ? S.Vw : S.Vs); src = vb + ((size_t)(key0 >> 6) * 64 + i) * 64 + 8 * c; }
        glds16(src, slot_addr + (wave < 4 ? 0u : 8192u) + (unsigned)pr * 1024u);
    }
}
#define RING_WAIT_BAR() do { asm volatile("s_waitcnt vmcnt(4)" ::: "memory"); __builtin_amdgcn_s_barrier(); asm volatile("" ::: "memory"); } while (0)
#define RING_DRAIN_BAR() do { asm volatile("s_waitcnt vmcnt(0) lgkmcnt(0)" ::: "memory"); __builtin_amdgcn_s_barrier(); asm volatile("" ::: "memory"); } while (0)
__device__ __forceinline__ void ring_read_k(bf16x8 (&kf)[4], const LAS unsigned char* slot, int hf, int rowoff, int sw, int h) {
#pragma unroll
    for (int ks = 0; ks < 4; ++ks) kf[ks] = *(const LAS bf16x8*)(slot + hf * 4096 + rowoff + (((2 * ks + h) * 16) ^ sw));
}
__device__ __forceinline__ void ring_read_v(bf16x8 (&vf)[4], const LAS unsigned char* slot, int hf, int rowoff, int sw, int h) {
#pragma unroll
    for (int s = 0; s < 2; ++s)
#pragma unroll
        for (int dt = 0; dt < 2; ++dt) vf[s * 2 + dt] = *(const LAS bf16x8*)(slot + 8192 + dt * 4096 + rowoff + (((4 * hf + 2 * s + h) * 16) ^ sw));
}

__device__ __forceinline__ void attn_item(const Ctx& X, const AttnArgs& A, int b, int g, int qt, const int mode = 3) {
    int lane_ = X.lane; asm volatile("" : "+v"(lane_));
    const int lane = lane_, h = lane >> 5, j = lane & 31, ql = j >> 2, r = j & 3, wave = X.wave;
    const int tb = qt * 64, t0 = tb + wave * 8, t = t0 + ql, head = g * 4 + r, bg = b * 4 + g, cur = qt;
    const size_t row = (size_t)b * SEQ + t;
    const int rowoff = j * 128, sw = ((j >> 1) & 7) * 16;
    RING_DRAIN_BAR();
    bf16x8 qf[4];
#pragma unroll
    for (int ks = 0; ks < 4; ++ks) qf[ks] = *(const bf16x8*)(A.Q + row * D + head * 64 + ks * 16 + h * 8);
    const float sl2 = fexp2(-0.5f * (float)(head + 1)) * LOG2E;
    const float g0 = A.gates[row * 48 + head], g1 = A.gates[row * 48 + 16 + head], g2 = A.gates[row * 48 + 32 + head];
    f32x16 o[2], bc;
#pragma unroll
    for (int v = 0; v < 16; ++v) { o[0][v] = 0.f; o[1][v] = 0.f; }
    LAS float* cm = (LAS float*)(X.lds + wave * 8192);
    LAS float* ob = cm + lane;
    const LAS unsigned char* ring = X.lds + 65536;
    const unsigned ring_a = (unsigned)(unsigned long long)ring;
    LAS unsigned long long* ux = (LAS unsigned long long*)(X.lds + 131072);
    LAS int* tk = (LAS int*)(X.lds + 131072 + 64 + wave * 256);
    AttnSrc S; S.Kc = A.kcmp + (size_t)bg * 256 * 64; S.Vc = A.vcmpT + (size_t)bg * 64 * 256; S.Kw = A.KW + (size_t)bg * 4096 * 64; S.Vw = A.VWt + (size_t)bg * 64 * 4096;
    S.Ks = A.KS + (size_t)bg * 4096 * 64; S.Vs = A.VSt + (size_t)bg * 64 * 4096;
    float m, l;
    bf16x8 kc[4], vf[4];

    const int ntb = (((tb + 63 - 31) >> 4) >> 5) + 1, nb1 = (ntb + 1) >> 1;
    const int nmax_w = (t0 + 7 - 31) >> 4, nmax_t = (t - 31) >> 4, nmin_w = (t0 - 31) >> 4;
    const int ntile = nmax_w >= 0 ? (nmax_w >> 5) + 1 : 0;
#pragma unroll
    for (int v = 0; v < 16; ++v) bc[v] = 16.f * sl2 * (float)(8 * h + 16 * (v >> 3) + (v & 7)) + sl2 * (float)(31 - ql);
    m = -1e30f; l = 0.f;
    {
        for (int i = 0; i < nb1; ++i) ring_load(S, 0, i * 64, ring_a + (unsigned)i * 16384u, wave, lane);
        asm volatile("" :: "v"(qf[0]), "v"(qf[1]), "v"(qf[2]), "v"(qf[3]), "v"(g0), "v"(g1), "v"(g2));
        RING_DRAIN_BAR();
#pragma unroll 1
        for (int tile = ntile - 1; tile >= 0; --tile) {
            const LAS unsigned char* slot = ring + (tile >> 1) * 16384; const int hf = tile & 1;
            ring_read_k(kc, slot, hf, rowoff, sw, h);
            const unsigned vm = run_mask(tile * 32 + 8 * h, 0, nmax_t) | (run_mask(tile * 32 + 16 + 8 * h, 0, nmax_t) << 8);
            f32x16 s = qk_mma(kc, qf, bc);
            softmax_step(s, tile * 32 + 31 <= nmin_w, vm, sl2 * (float)(512 * tile - t0), m, l, o);
        }
        l += __shfl_xor(l, 32);
        const float inv = 1.f / fmaxf(l, 1e-30f);
#pragma unroll 1
        for (int tile = ntile - 1; tile >= 0; --tile) {
            const LAS unsigned char* slot = ring + (tile >> 1) * 16384; const int hf = tile & 1;
            ring_read_k(kc, slot, hf, rowoff, sw, h); ring_read_v(vf, slot, hf, rowoff, sw, h);
            const unsigned vm = run_mask(tile * 32 + 8 * h, 0, nmax_t) | (run_mask(tile * 32 + 16 + 8 * h, 0, nmax_t) << 8);
            f32x16 s = qk_mma(kc, qf, bc);
            const float ml = m - sl2 * (float)(512 * tile - t0);
#pragma unroll
            for (int v = 0; v < 16; ++v) {
                const float p = ((vm >> v) & 1u) ? fexp2(s[v] - ml) * inv : 0.f; s[v] = p;
                float x = p; x += __int_as_float(__builtin_amdgcn_mov_dpp(__float_as_int(x), 0xB1, 0xf, 0xf, true)); x += __int_as_float(__builtin_amdgcn_mov_dpp(__float_as_int(x), 0x4E, 0xf, 0xf, true));
                if ((v & 3) == r) cm[ql * 256 + tile * 32 + 16 * (v >> 3) + 8 * h + (v & 7)] = x;
            }
            pv_mma(o, vf, s);
        }
    }
    RING_DRAIN_BAR();
    const int wb1b = qt, wb0b = max(tb - 511, 0) >> 6, nWb = wb1b - wb0b + 1;
    const int kt0 = max(t0 - 511, 0) >> 5, kt1 = (t0 + 7) >> 5;
    int li = 0;
    for (; li < 3 && li < nWb; ++li) ring_load(S, 1, (wb1b - li) * 64, ring_a + (unsigned)(li & 3) * 16384u, wave, lane);
    unsigned long long mq = 0ull, uni = 0ull, alln = ~0ull;
    {
        const unsigned long long causal = cur >= 63 ? ~0ull : ((1ull << (cur + 1)) - 1ull);
        if (cur + 1 <= 16) { mq = causal; uni = causal; alln = causal; }
        else {
#pragma unroll 1
            for (int q = 0; q < 8; ++q) {
                float iv;
                if (lane == 0 || lane == cur || lane == cur - 1) iv = 1e30f;
                else if (lane > cur) iv = -1.f;
                else { const LAS float* c = cm + q * 256 + 4 * lane; iv = (((c[-1] + c[0]) + c[1]) + c[2]) + c[3]; }
                const int key = (__float_as_int(iv) & ~63) | (63 - lane);
                tk[lane] = key;
                int rank = 0;
#pragma unroll
                for (int i4 = 0; i4 < 16; ++i4) { const i32x4 kv = *(const LAS i32x4*)(tk + 4 * i4);
                    rank += (kv[0] > key ? 1 : 0) + (kv[1] > key ? 1 : 0) + (kv[2] > key ? 1 : 0) + (kv[3] > key ? 1 : 0); }
                unsigned long long mk = __ballot(rank < 16);
                mk &= causal;
                uni |= mk; alln &= mk; if (ql == q) mq = mk;
            }
        }
    }
    if (lane == 0) ux[wave] = uni;
    asm volatile("s_waitcnt lgkmcnt(0)" ::: "memory"); __builtin_amdgcn_s_barrier(); asm volatile("" ::: "memory");
    unsigned long long bun = 0ull;
#pragma unroll
    for (int w = 0; w < 8; ++w) bun |= ux[w];
    { const unsigned lo = __builtin_amdgcn_readfirstlane((unsigned)bun), hi = __builtin_amdgcn_readfirstlane((unsigned)(bun >> 32)); bun = ((unsigned long long)hi << 32) | lo; }
    const int n2 = nWb + __popcll(bun);
    unsigned long long lmask = bun; int ljb = 0;
#define LOAD_STEP2() do { int ty_, k0_; \
        if (li < nWb) { ty_ = 1; k0_ = (wb1b - li) * 64; } \
        else { ty_ = 2; if (li < n2) { ljb = 63 - __builtin_clzll(lmask); lmask &= ~(1ull << ljb); } k0_ = ljb * 64; } \
        ring_load(S, ty_, k0_, ring_a + (unsigned)(li & 3) * 16384u, wave, lane); ++li; } while (0)
    while (li < 3) LOAD_STEP2();
#pragma unroll
    for (int v = 0; v < 16; ++v) { ob[v * 64] = g0 * o[0][v]; ob[(16 + v) * 64] = g0 * o[1][v]; o[0][v] = 0.f; o[1][v] = 0.f; }
#pragma unroll
    for (int v = 0; v < 16; ++v) bc[v] = sl2 * (float)(8 * h + 16 * (v >> 3) + (v & 7) - ql);
    m = -1e30f; l = 0.f;
    int ci = 0;
#pragma unroll 1
    for (; ci < nWb; ++ci) {
        RING_WAIT_BAR();
        LOAD_STEP2();
        const int wb = wb1b - ci; const LAS unsigned char* slot = ring + (ci & 3) * 16384;
        if ((mode & 2) && wb * 64 + 63 <= t0 && wb * 64 >= t0 + 7 - 511) {
            ring_read_k(kc, slot, 1, rowoff, sw, h); f32x16 s1 = qk_mma(kc, qf, bc);
            ring_read_k(kc, slot, 0, rowoff, sw, h); f32x16 s0 = qk_mma(kc, qf, bc);
            softmax_step64(s1, s0, sl2 * (float)(wb * 64 + 32 - t0), sl2 * (float)(wb * 64 - t0), true, m, l, o);
            ring_read_v(vf, slot, 1, rowoff, sw, h); pv_mma(o, vf, s1);
            ring_read_v(vf, slot, 0, rowoff, sw, h); pv_mma(o, vf, s0);
        } else
#pragma unroll 1
        for (int hf = 1; hf >= 0; --hf) {
            const int kt = 2 * wb + hf, key0 = kt * 32;
            if (kt >= kt0 && kt <= kt1 && (mode & 2)) {
                ring_read_k(kc, slot, hf, rowoff, sw, h); ring_read_v(vf, slot, hf, rowoff, sw, h);
                f32x16 s = qk_mma(kc, qf, bc);
                const bool full = (key0 + 31 <= t0) && (key0 >= t0 + 7 - 511);
                const unsigned vm = run_mask(key0 + 8 * h, t - 511, t) | (run_mask(key0 + 16 + 8 * h, t - 511, t) << 8);
                softmax_step(s, full, vm, sl2 * (float)(key0 - t0), m, l, o);
                pv_mma(o, vf, s);
            }
        }
    }
    {
        l += __shfl_xor(l, 32);
        const float sc = g2 / fmaxf(l, 1e-30f);
#pragma unroll
        for (int v = 0; v < 16; ++v) { ob[v * 64] += sc * o[0][v]; ob[(16 + v) * 64] += sc * o[1][v]; o[0][v] = 0.f; o[1][v] = 0.f; }
    }
    m = -1e30f; l = 0.f;
    {
        unsigned long long cmask = bun;
#pragma unroll 1
        for (; ci < n2; ++ci) {
            RING_WAIT_BAR();
            LOAD_STEP2();
            const int jb = 63 - __builtin_clzll(cmask); cmask &= ~(1ull << jb);
            const LAS unsigned char* slot = ring + (ci & 3) * 16384;
            if (((uni >> jb) & 1ull) && (mode & 1)) {
                const bool mine = (mq >> jb) & 1ull;
                if (jb * 64 + 63 <= t0) {
                    ring_read_k(kc, slot, 1, rowoff, sw, h); f32x16 s1 = qk_mma(kc, qf, bc);
                    ring_read_k(kc, slot, 0, rowoff, sw, h); f32x16 s0 = qk_mma(kc, qf, bc);
                    softmax_step64(s1, s0, sl2 * (float)(jb * 64 + 32 - t0), sl2 * (float)(jb * 64 - t0), mine, m, l, o);
                    ring_read_v(vf, slot, 1, rowoff, sw, h); pv_mma(o, vf, s1);
                    ring_read_v(vf, slot, 0, rowoff, sw, h); pv_mma(o, vf, s0);
                } else
#pragma unroll 1
                for (int hf = 1; hf >= 0; --hf) {
                    const int key0 = jb * 64 + hf * 32;
                    if (key0 <= t0 + 7) {
                        ring_read_k(kc, slot, hf, rowoff, sw, h); ring_read_v(vf, slot, hf, rowoff, sw, h);
                        f32x16 s = qk_mma(kc, qf, bc);
                        const bool full = key0 + 31 <= t0;
                        const unsigned vm = mine ? (run_mask(key0 + 8 * h, 0, t) | (run_mask(key0 + 16 + 8 * h, 0, t) << 8)) : 0u;
                        softmax_step(s, full, vm, sl2 * (float)(key0 - t0), m, l, o, mine);
                        pv_mma(o, vf, s);
                    }
                }
            }
        }
    }
#undef LOAD_STEP2
    {
        l += __shfl_xor(l, 32);
        const float sc = g1 / fmaxf(l, 1e-30f);
#pragma unroll
        for (int v = 0; v < 16; ++v) { o[0][v] = ob[v * 64] + sc * o[0][v]; o[1][v] = ob[(16 + v) * 64] + sc * o[1][v]; }
    }
    bf16_t* op = A.O + row * D + head * 64 + 4 * h;
#pragma unroll
    for (int dt = 0; dt < 2; ++dt)
#pragma unroll
        for (int v4 = 0; v4 < 4; ++v4) { u32x2 w; w.x = cvt_pk_bf16(o[dt][4 * v4], o[dt][4 * v4 + 1]); w.y = cvt_pk_bf16(o[dt][4 * v4 + 2], o[dt][4 * v4 + 3]); *(u32x2*)(op + 32 * dt + 8 * v4) = w; }
}
__device__ __forceinline__ void attn_phase(const Ctx& X, const AttnArgs& A, const int mode = 3) {
    for (int i = 0;; ++i) {
        const int k = i * X.G + ((i & 1) ? X.G - 1 - X.bid : X.bid);
        if (i * X.G >= 2048) break;
        if (k < 2048) { const int qt = 63 - (k >> 5), bg = k & 31; attn_item(X, A, bg >> 2, bg & 3, qt, mode); }
    }
    RING_DRAIN_BAR();
}
#define XB_TMO      128
#define XB_XCNT(j)  (256  + 64 * (j))
#define XB_XSUB(j)  (1280 + 64 * (j))
#define XB_XGEN(j)  (2304 + 64 * (j))
#define XB_TOP      3328
#define XB_TOPGEN   3392
#define XCD_BAR_WORDS 3456
#define XB_SPIN_CAP (1u << 18)

__device__ __forceinline__ unsigned xb_ld(unsigned* p)              { return __hip_atomic_load(p, __ATOMIC_RELAXED, __HIP_MEMORY_SCOPE_AGENT); }
__device__ __forceinline__ unsigned xb_add(unsigned* p, unsigned v) { return __hip_atomic_fetch_add(p, v, __ATOMIC_RELAXED, __HIP_MEMORY_SCOPE_AGENT); }
__device__ __forceinline__ unsigned xb_xcc_id() { return (unsigned)__builtin_amdgcn_s_getreg((3 << 11) | 20) & 0xFu; }
#define XB_SPIN(cond, bar) do { unsigned _sp = 0; while (cond) { __builtin_amdgcn_s_sleep(1); \
    if ((++_sp & 255u) == 0u) { if (xb_ld(&(bar)[XB_TMO])) break; if (_sp > XB_SPIN_CAP) { atomicAdd(&(bar)[XB_TMO], 1u); break; } } } } while (0)

struct XcdBarrier {
    unsigned* bar; unsigned x;
    volatile LAS unsigned* st;
};

__device__ __forceinline__ XcdBarrier xcd_barrier_post(unsigned* bar, volatile LAS unsigned* st) {
    XcdBarrier b; b.bar = bar; b.x = xb_xcc_id(); b.st = st;
    if (threadIdx.x == 0) (void)xb_add(&bar[XB_XCNT(b.x)], 1u);
    return b;
}
__device__ __forceinline__ void xcd_barrier_complete(unsigned* bar, unsigned x, unsigned& nloc, unsigned& nx) {
    const unsigned G = gridDim.x * gridDim.y * gridDim.z;
    unsigned sum, cnt, mine, sp = 0u;
    for (;;) {
        sum = 0u; cnt = 0u; mine = 0u;
#pragma unroll
        for (unsigned j = 0; j < 16; ++j) { const unsigned c = xb_ld(&bar[XB_XCNT(j)]); sum += c; cnt += (c > 0u) ? 1u : 0u; mine = (j == x) ? c : mine; }
        if (sum == G) break;
        __builtin_amdgcn_s_sleep(1);
        if ((++sp & 255u) == 0u) { if (xb_ld(&bar[XB_TMO])) break; if (sp > XB_SPIN_CAP) { atomicAdd(&bar[XB_TMO], 1u); break; } }
    }
    nloc = mine > 0u ? mine : 1u; nx = cnt > 0u ? cnt : 1u;
}

__device__ __forceinline__ void xcd_barrier(const XcdBarrier& b) {
    asm volatile("s_waitcnt vmcnt(0)" ::: "memory");
    __syncthreads();
    if (threadIdx.x == 0) {
        unsigned* bar = b.bar;
        __builtin_amdgcn_s_waitcnt(0);
        unsigned nloc = b.st[0], nx = b.st[1];
        if (nloc == 0u) { xcd_barrier_complete(bar, b.x, nloc, nx); b.st[0] = nloc; b.st[1] = nx; }
        const unsigned old = xb_add(&bar[XB_XSUB(b.x)], 1u);
        const unsigned gen = old / nloc;
        if (old + 1u == (gen + 1u) * nloc) {
            __builtin_amdgcn_fence(__ATOMIC_RELEASE, "agent");
            asm volatile("s_waitcnt vmcnt(0)" ::: "memory");
            const unsigned og = xb_add(&bar[XB_TOP], 1u);
            const unsigned tg = og / nx;
            if (og + 1u == (tg + 1u) * nx) xb_add(&bar[XB_TOPGEN], 1u);
            else XB_SPIN(xb_ld(&bar[XB_TOPGEN]) == tg, bar);
            __builtin_amdgcn_fence(__ATOMIC_ACQUIRE, "agent");
            xb_add(&bar[XB_XGEN(b.x)], 1u);
            asm volatile("s_waitcnt vmcnt(0)" ::: "memory");
        } else {
            XB_SPIN(xb_ld(&bar[XB_XGEN(b.x)]) == gen, bar);
            __builtin_amdgcn_fence(__ATOMIC_ACQUIRE, "agent");
            asm volatile("s_waitcnt vmcnt(0)" ::: "memory");
        }
    }
    __syncthreads();
}

__global__ void __launch_bounds__(512, 2) yoco_fwd(Params Pk) {
    extern __shared__ __attribute__((aligned(16))) unsigned char lds_raw[];
    cg::grid_group grid = cg::this_grid();
    { LAS Params* LP = (LAS Params*)((LAS unsigned char*)lds_raw); if (threadIdx.x == 0) {
#pragma unroll
        for (int i = 0; i < 19; ++i) LP->in[i] = Pk.in[i];
        LP->out = Pk.out; LP->ws = Pk.ws; LP->ph_lo = Pk.ph_lo; LP->ph_hi = Pk.ph_hi; } }
    volatile LAS unsigned* xb_st = (volatile LAS unsigned*)((LAS unsigned char*)lds_raw + 192);
    if (threadIdx.x == 0) { xb_st[0] = 0u; xb_st[1] = 0u; }
    unsigned* const xb_words = (unsigned*)(Pk.ws + WS_BAR);
    if (blockIdx.x == 0) { for (int i = threadIdx.x; i < XCD_BAR_WORDS + 128; i += 512) __hip_atomic_store(xb_words + i, 0u, __ATOMIC_RELAXED, __HIP_MEMORY_SCOPE_AGENT); }
    asm volatile("s_waitcnt vmcnt(0)" ::: "memory");
    __syncthreads();
    const int ph_lo = Pk.ph_lo, ph_hi = Pk.ph_hi;
    grid.sync();
    (void)xcd_barrier_post(xb_words, xb_st);
    {
        int tid_ = threadIdx.x, g_ = gridDim.x, b_ = blockIdx.x; asm volatile("" : "+v"(tid_), "+s"(g_), "+s"(b_));
        Ctx X; X.lds = (LAS unsigned char*)lds_raw + 256; X.tid = tid_; X.lane = X.tid & 63; X.wave = __builtin_amdgcn_readfirstlane(X.tid >> 6); X.G = g_; X.bid = b_;
        p0_phase(X, (const LAS Params*)(X.lds - 256)); __syncthreads();
        XcdBarrier xbar; xbar.bar = xb_words; xbar.x = xb_xcc_id(); xbar.st = xb_st; xcd_barrier(xbar);
    }
    int dupflag_ = 0; (void)dupflag_;
    for (int ph = ph_lo < 1 ? 1 : ph_lo; ph < ph_hi; ++ph) {
        int cur_st_ = -1; (void)cur_st_;
        asm volatile("" ::: "memory");
        int tid_ = threadIdx.x, g_ = gridDim.x, b_ = blockIdx.x; asm volatile("" : "+v"(tid_), "+s"(g_), "+s"(b_));
        Ctx X; X.lds = (LAS unsigned char*)lds_raw + 256; X.tid = tid_; X.lane = X.tid & 63; X.wave = __builtin_amdgcn_readfirstlane(X.tid >> 6); X.G = g_; X.bid = b_;
        Params P;
        { const LAS Params* LP = (const LAS Params*)(X.lds - 256);
          P.in[I_X] = uptr(LP->in[I_X]); P.in[I_NORMG] = uptr(LP->in[I_NORMG]); P.in[I_ACONV] = uptr(LP->in[I_ACONV]); P.in[I_KVNG] = uptr(LP->in[I_KVNG]); P.in[I_CW2] = uptr(LP->in[I_CW2]);
          P.out = uptr(LP->out); P.ws = uptr(LP->ws); }
        unsigned char* ws = P.ws;
        bf16_t* const H = (bf16_t*)(ws + WS_H); bf16_t* const HID = (bf16_t*)(ws + WS_HID); bf16_t* const HID2 = (bf16_t*)(ws + WS_HID + 64 * MiB); bf16_t* const Y = (bf16_t*)(ws + WS_Y);
        float* const PART = (float*)(ws + WS_PART); float* const GATES = (float*)(ws + WS_GATES);
        const float* const MOD = (const float*)(ws + WS_MOD); const float* const KVMOD = (const float*)(ws + WS_KVMOD);
        const float* const NG = P.in[I_NORMG];
        if (ph == 1) {
            UpdArgs U{}; U.xin = P.in[I_X]; U.xout = P.out; U.bstride = 9216; U.gpre = NG; U.shift = MOD; U.scale = MOD + 1024; U.h = H;

#ifndef SKIP_UPD
update_phase(X, U);
#endif

        } else {
            int p = ph - 2, l, st;
            if (p < 20) { l = p / 10; st = p % 10; } else if (p < 23) { l = 2; st = 10 + (p - 20); } else { p -= 23; l = 2 + p / 10; st = p % 10; }
            cur_st_ = st;
            const float* modl = MOD + (size_t)l * 8 * 9216; const float* ngl = NG + (size_t)l * 6 * 1024;
            if (st == 0 || st == 7) {
                const int s = st == 0 ? 0 : 1;
                pg8::Gemm g{H, (const bf16_t*)(ws + WS_FIN) + (size_t)(l * 2 + s) * 5632 * 1024, T, 5632, 1024, 1024}; pg8::StaticOrder S; S.init(T, 5632, X.G, X.bid);
                pg8::EpiSwiglu E{HID};

#ifndef REP_G1
#define REP_G1 1
#endif
for (int rep_ = 0; rep_ < REP_G1; ++rep_) pg8::gemm_phase<pg8::EpiSwiglu, pg8::StaticOrder, true, true>(X.lds, g, S, E, X.tid);

            } else if (st == 1 || st == 8 || st == 5) {
                pg8::Gemm g;
                if (st == 5) { g = pg8::Gemm{l < 2 ? H : HID2, l < 2 ? (const bf16_t*)(ws + WS_AOUT) + (size_t)l * 1024 * 1024 : (const bf16_t*)(ws + WS_BOUT) + (size_t)(l - 2) * 1024 * 1024, T, 1024, 1024, 1024}; }
                else { g = pg8::Gemm{HID, (const bf16_t*)(ws + WS_FOUT) + (size_t)(l * 2 + (st == 8 ? 1 : 0)) * 1024 * 2816, T, 1024, 2816, 2816}; }
                pg8::StaticOrder S; S.init(T, 1024, X.G, X.bid);
                pg8::EpiY E{Y, PART};

pg8::gemm_phase<pg8::EpiY, pg8::StaticOrder, true, true>(X.lds, g, S, E, X.tid);

            } else if (st == 2 || st == 6 || st == 9) {
                const int sub = st == 2 ? 0 : (st == 6 ? 1 : 2);
                UpdArgs U{}; U.xin = P.out; U.xout = P.out; U.y = Y; U.part = PART; U.gate = modl + (sub * 3 + 2) * 1024; U.gpost = ngl + (sub * 2 + 1) * 1024; U.w = sub == 1 ? 1.0f : 0.5f; U.bstride = 9216;
                if (sub < 2) { U.gpre = ngl + ((sub + 1) * 2) * 1024; U.shift = modl + ((sub + 1) * 3) * 1024; U.scale = modl + ((sub + 1) * 3 + 1) * 1024; U.h = H; }
                else if (l < 3) { U.gpre = ngl + 6 * 1024; U.shift = modl + 8 * 9216; U.scale = modl + 8 * 9216 + 1024; U.h = H;
                    if (l == 1) { U.gpre2 = P.in[I_KVNG]; U.shift2 = KVMOD; U.scale2 = KVMOD + 1024; U.h2 = HID; } }

#ifndef SKIP_UPD
update_phase(X, U);
#endif

            } else if (st == 3) {
                if (l < 2) {
                    pg8::Gemm g{H, (const bf16_t*)(ws + WS_AIN) + (size_t)l * 3072 * 1024, T, 3072, 1024, 1024}; pg8::StaticOrder S; S.init(T, 3072, X.G, X.bid);
                    pg8::EpiConvIn E{HID, HID2};

#ifndef SKIP_G3
pg8::gemm_phase<pg8::EpiConvIn, pg8::StaticOrder, true, true>(X.lds, g, S, E, X.tid);
#endif

                } else {
                    pg8::Gemm g{H, (const bf16_t*)(ws + WS_BIN) + (size_t)(l - 2) * 1280 * 1024, T, 1280, 1024, 1024}; pg8::StaticOrder S; S.init(T, 1280, X.G, X.bid);
                    pg8::EpiQG E{HID, GATES};

#ifndef SKIP_G3B
pg8::gemm_phase<pg8::EpiQG, pg8::StaticOrder, true, true>(X.lds, g, S, E, X.tid);
#endif

                }
            } else if (st == 4) {
                if (l < 2) {
#ifndef SKIP_CONV
conv_phase(X, HID, HID2, P.in[I_ACONV] + (size_t)l * 3 * 1024, H);
#endif
}
                else { AttnArgs A{HID, GATES, (const bf16_t*)(ws + WS_KCMP), (const bf16_t*)(ws + WS_VCMPT), (const bf16_t*)(ws + WS_KS), (const bf16_t*)(ws + WS_VST), (const bf16_t*)(ws + WS_KW), (const bf16_t*)(ws + WS_VWT), HID2};

#ifndef REP_ATTN
#define REP_ATTN 1
#endif
attn_phase(X, A);
#ifdef PROBE_ATTN_MODE
{ AttnArgs A2 = A; A2.O = Y; attn_phase(X, A2, PROBE_ATTN_MODE); }
#endif
 }
            } else if (st == 10) {
                pg8::Gemm g{HID, (const bf16_t*)(ws + WS_KVW), T, 1536, 1024, 1024}; pg8::StaticOrder S; S.init(T, 1536, X.G, X.bid);
                pg8::EpiKV E{(bf16_t*)(ws + WS_KC), (bf16_t*)(ws + WS_KS), (bf16_t*)(ws + WS_KW), (bf16_t*)(ws + WS_VST), (bf16_t*)(ws + WS_VWT)};

#ifndef SKIP_GK
pg8::gemm_phase<pg8::EpiKV, pg8::StaticOrder, true, true>(X.lds, g, S, E, X.tid);
#endif

            } else if (st == 11) {
                pg8::Gemm g{(const bf16_t*)(ws + WS_KC), (const bf16_t*)(ws + WS_CW1), 16384, 512, 2048, 1024}; pg8::DiagOrder S{X.G, X.bid};
                pg8::EpiCmp1 E{(bf16_t*)(ws + WS_HIDC), (const float*)(ws + WS_CBIAS)};

#ifndef SKIP_CM1
pg8::gemm_phase<pg8::EpiCmp1, pg8::DiagOrder, true, true>(X.lds, g, S, E, X.tid);
#endif

            } else if (st == 12) {

#ifndef SKIP_CM2
cmp2_phase(X, (const bf16_t*)(ws + WS_HIDC), P.in[I_CW2], (bf16_t*)(ws + WS_KCMP), (bf16_t*)(ws + WS_VCMPT));
#endif

            }
        }
        if (ph + 1 < ph_hi) { XcdBarrier xbar; xbar.bar = (unsigned*)(ws + WS_BAR); xbar.x = xb_xcc_id(); xbar.st = (volatile LAS unsigned*)((LAS unsigned char*)lds_raw + 192); xcd_barrier(xbar);
#ifdef PROBE_EXTRA_SYNC
            xcd_barrier(xbar);
#endif
        }
#ifdef PROBE_DUP_ST
        if (cur_st_ == PROBE_DUP_ST && !dupflag_) { dupflag_ = 1; --ph; } else dupflag_ = 0;
#endif
    }
}

extern "C" void kernel_launch(void* const* d_in, const int* in_sizes, int n_in, void* d_out, int out_size, void* d_ws, size_t ws_size, hipStream_t stream) {
    static int grid = 0;
    if (grid == 0) {
        if (n_in != 19 || out_size != T * D || ws_size < WS_END) { fprintf(stderr, "kernel_launch: unexpected shapes (n_in %d, out %d, ws %zu < %zu)\n", n_in, out_size, ws_size, (size_t)WS_END); grid = -1; return; }
        int dev = 0, cus = 0, per_cu = 0;
        (void)hipGetDevice(&dev); (void)hipDeviceGetAttribute(&cus, hipDeviceAttributeMultiprocessorCount, dev);
        if (hipFuncSetAttribute((const void*)yoco_fwd, hipFuncAttributeMaxDynamicSharedMemorySize, LDS_BYTES) != hipSuccess) { fprintf(stderr, "kernel_launch: hipFuncSetAttribute failed\n"); grid = -1; return; }
        if (hipOccupancyMaxActiveBlocksPerMultiprocessor(&per_cu, (const void*)yoco_fwd, 512, LDS_BYTES) != hipSuccess || per_cu < 1) { fprintf(stderr, "kernel_launch: occupancy query says %d\n", per_cu); per_cu = 1; }
        (void)hipGetLastError();
        grid = cus * per_cu;
    }
    if (grid < 0) return;
    Params p{};
    for (int i = 0; i < 19; ++i) p.in[i] = (const float*)d_in[i];
    p.out = (float*)d_out; p.ws = (unsigned char*)d_ws;
    p.ph_lo = 0; p.ph_hi = NPH;
    void* args[] = {&p};
    hipError_t e = hipLaunchCooperativeKernel((const void*)yoco_fwd, dim3(grid), dim3(512), args, LDS_BYTES, stream);
    if (e != hipSuccess) fprintf(stderr, "kernel_launch: cooperative launch failed: %s (grid %d)\n", hipGetErrorString(e), grid);
}
```

```cpp
#include <hip/hip_runtime.h>
#include <hip/hip_cooperative_groups.h>
#include <cstdio>
#include <cstdint>
namespace cg = cooperative_groups;
namespace pg8 {
#define PG8_LAS __attribute__((address_space(3)))
typedef unsigned short bf16_t;
typedef short bf16x8 __attribute__((ext_vector_type(8)));
typedef float f32x4 __attribute__((ext_vector_type(4)));
typedef unsigned u32x4 __attribute__((ext_vector_type(4)));
constexpr int BM = 256, BK = 64, HALF = 128, HTB = HALF * BK * 2  , STAGE_BYTES = 8 * HTB, NXCD = 8, WGM = 8;

__host__ __device__ __forceinline__ int lds_byte(int r, int c) { const int st = (r >> 4) * 2 + (c >> 5), rr = r & 15, cc = c & 31, ob = rr * 64 + cc * 2; return st * 1024 + (ob ^ (((ob >> 9) & 1) << 5)); }
__host__ __device__ __forceinline__ void stage_rc(int b, int& R, int& C) { const int st = b / 1024, sb = b % 1024, swz = sb ^ (((sb >> 9) & 1) << 5); R = (st >> 1) * 16 + swz / 64; C = (st & 1) * 32 + (swz % 64) / 2; }
__host__ __device__ __forceinline__ int perm32(int rho) { const int n = rho >> 4, i = rho & 15; return 8 * (i >> 2) + 4 * n + (i & 3); }

struct Unit { int pm, pn; };
struct Gemm { const bf16_t* A; const bf16_t* Bt; int M, N, K, lda; };

struct StaticOrder {
    int nM, nN, nwg, G, c;
    __host__ __device__ void init(int M, int N, int G_, int c_) { nM = M / BM; nN = N / BM; nwg = nM * nN; G = G_; c = c_; }
    __host__ __device__ bool next(int i, Unit& u) const {
        const long L = (long)i * G + c; if (L >= nwg) return false;
        int wgid = (int)L; { const int q = nwg / NXCD, r = nwg % NXCD, xcd = wgid % NXCD, off = wgid / NXCD; wgid = (xcd < r ? xcd * (q + 1) : r * (q + 1) + (xcd - r) * q) + off; }
        const int nig = WGM * nN, gid = wgid / nig, fm = gid * WGM, gsz = (nM - fm) < WGM ? (nM - fm) : WGM;
        u.pm = fm + ((wgid % nig) % gsz); u.pn = (wgid % nig) / gsz; return true;
    }
    __device__ __forceinline__ void a_ready(const Unit&) const {}
    __device__ __forceinline__ void done(const Unit&) const {}
};

__device__ __forceinline__ unsigned cvt_pk_bf16(float lo, float hi) { unsigned r; asm volatile("v_cvt_pk_bf16_f32 %0, %1, %2" : "=v"(r) : "v"(lo), "v"(hi)); return r; }
typedef float f32x2 __attribute__((ext_vector_type(2)));
__device__ __forceinline__ f32x2 gelu_pk(f32x2 v) {
    const f32x2 av = __builtin_elementwise_abs(v), d = av * 0.2316418882f + 1.0f;
    f32x2 t; t.x = __builtin_amdgcn_rcpf(d.x); t.y = __builtin_amdgcn_rcpf(d.y);
    f32x2 q = t * 0.5307027145f + (-0.7265760135f); q = q * t + 0.7107068705f; q = q * t + (-0.142248368f); q = q * t + 0.127414796f; q = q * t;
    const f32x2 s = (v * v) * (-0.72134752044f);
    f32x2 e; e.x = __builtin_amdgcn_exp2f(s.x); e.y = __builtin_amdgcn_exp2f(s.y);
    const f32x2 m = v * (q * e), r = v - m;
    f32x2 o; o.x = v.x < 0.f ? m.x : r.x; o.y = v.y < 0.f ? m.y : r.y; return o;
}


template <class Epi, class Sched, bool ALIGN_EPI = false, bool SP2 = false>
__device__ __forceinline__ void gemm_phase(PG8_LAS unsigned char* lds, const Gemm g, const Sched& S, const Epi& E, const int tid) {
    const int wid = __builtin_amdgcn_readfirstlane(tid >> 6), lane = tid & 63, wr = wid >> 2, wc = wid & 3, fr = lane & 15, fq = lane >> 4;
    const int K = g.K, nt = K / BK;
    unsigned voffA[2], voffB[2];
#pragma unroll
    for (int i = 0; i < 2; ++i) { int R, C; stage_rc(tid * 16 + i * 8192, R, C); const int Rb = Epi::PERM ? ((R & ~31) + perm32(R & 31)) : R;
        voffA[i] = (unsigned)(R * g.lda + C) * 2u; voffB[i] = (unsigned)(Rb * K + C) * 2u; }
    const size_t kstep = (size_t)(BK * 2);
    const size_t hstepB = (size_t)HALF * K * 2, hstepA = (size_t)HALF * g.lda * 2;
    const size_t tstepB = 2 * hstepB, tstepA = 2 * hstepA;
    const unsigned ldsw = (unsigned)wid * 1024u;
    const int aoff = lds_byte(wr * 64 + fr, fq * 8), boff = lds_byte(wc * 32 + fr, fq * 8);
#define PG8_SA(b, h) (((b) * 2 + (h)) * HTB)
#define PG8_SB(b, h) ((4 + (b) * 2 + (h)) * HTB)
#define PG8_STAGE(bufoff, gbase, voff) do { _Pragma("unroll") for (int _i = 0; _i < 2; ++_i) \
        __builtin_amdgcn_global_load_lds((const unsigned*)((const char*)(gbase) + (voff)[_i]), (PG8_LAS unsigned*)(lds + (bufoff) + ldsw + _i * 8192), 16, 0, 0); } while (0)
#define PG8_LDA(dst, b, h) do { _Pragma("unroll") for (int m = 0; m < 4; ++m) _Pragma("unroll") for (int k = 0; k < 2; ++k) dst[m][k] = *(const PG8_LAS bf16x8*)(lds + PG8_SA(b, h) + aoff + m * 2048 + k * 1024); } while (0)
#define PG8_LDB(dst, b, h) do { _Pragma("unroll") for (int n = 0; n < 2; ++n) _Pragma("unroll") for (int k = 0; k < 2; ++k) dst[n][k] = *(const PG8_LAS bf16x8*)(lds + PG8_SB(b, h) + boff + n * 2048 + k * 1024); } while (0)
#define PG8_MMA(ai, bj, At, Bt) do { __builtin_amdgcn_s_setprio(1); _Pragma("unroll") for (int m = 0; m < 4; ++m) _Pragma("unroll") for (int n = 0; n < 2; ++n) _Pragma("unroll") for (int k = 0; k < 2; ++k) \
        acc[ai][bj][m][n] = __builtin_amdgcn_mfma_f32_16x16x32_bf16(Bt[n][k], At[m][k], acc[ai][bj][m][n], 0, 0, 0); __builtin_amdgcn_s_setprio(0); } while (0)
#define PG8_WAIT_V(n) asm volatile("s_waitcnt vmcnt(" #n ")" ::: "memory")
#define PG8_WAIT_L(n) asm volatile("s_waitcnt lgkmcnt(" #n ")" ::: "memory")
#define PG8_BAR __builtin_amdgcn_s_barrier()
#define PG8_SCHED __builtin_amdgcn_sched_barrier(0)
    Unit cur, nxt; int ui = 0;
    if (!S.next(0, cur)) return;
    f32x4 acc[2][2][4][2];
#pragma unroll
    for (int a = 0; a < 2; ++a)
#pragma unroll
        for (int b = 0; b < 2; ++b)
#pragma unroll
            for (int m = 0; m < 4; ++m)
#pragma unroll
                for (int n = 0; n < 2; ++n) acc[a][b][m][n] = (f32x4){0.f, 0.f, 0.f, 0.f};
    bf16x8 At[4][2], B0[2][2], B1[2][2];
    const char* cA = (const char*)g.A + (size_t)cur.pm * tstepA; const char* cB = (const char*)g.Bt + (size_t)cur.pn * tstepB;
    S.a_ready(cur);
    if constexpr (SP2) {
        PG8_STAGE(PG8_SB(0, 0), cB, voffB); PG8_STAGE(PG8_SB(0, 1), cB + hstepB, voffB); PG8_STAGE(PG8_SA(0, 0), cA, voffA); PG8_STAGE(PG8_SA(0, 1), cA + hstepA, voffA);
        if (wr == 1) PG8_BAR;
        PG8_WAIT_V(2); PG8_BAR;
        PG8_STAGE(PG8_SB(1, 0), cB + kstep, voffB); PG8_STAGE(PG8_SA(1, 0), cA + kstep, voffA); PG8_STAGE(PG8_SB(1, 1), cB + hstepB + kstep, voffB);
        PG8_WAIT_V(6); PG8_BAR;
    } else {
        PG8_STAGE(PG8_SB(0, 0), cB, voffB); PG8_STAGE(PG8_SA(0, 0), cA, voffA); PG8_STAGE(PG8_SB(0, 1), cB + hstepB, voffB); PG8_STAGE(PG8_SA(0, 1), cA + hstepA, voffA);
        if (wr == 1) PG8_BAR;
        PG8_WAIT_V(4); PG8_BAR;
        PG8_STAGE(PG8_SB(1, 0), cB + kstep, voffB); PG8_STAGE(PG8_SA(1, 0), cA + kstep, voffA); PG8_STAGE(PG8_SB(1, 1), cB + hstepB + kstep, voffB);
        PG8_WAIT_V(6); PG8_BAR;
    }
    for (;;) {
        const bool has_next = S.next(ui + 1, nxt);
        const char* nA = has_next ? (const char*)g.A + (size_t)nxt.pm * tstepA : cA; const char* nB = has_next ? (const char*)g.Bt + (size_t)nxt.pn * tstepB : cB;
        for (int t = 0; t < nt; t += 2) {
            const bool last = (t == nt - 2);
            const char* a1 = cA + (size_t)(t + 1) * kstep;
            const char* a2 = last ? nA : cA + (size_t)(t + 2) * kstep; const char* b2 = last ? nB : cB + (size_t)(t + 2) * kstep;
            const char* a3 = a2 + kstep; const char* b3 = b2 + kstep;
            if (last && has_next) S.a_ready(nxt);
            if constexpr (SP2) {
            PG8_LDB(B0, 0, 0); PG8_LDB(B1, 0, 1); PG8_SCHED; PG8_LDA(At, 0, 0); PG8_STAGE(PG8_SA(1, 1), a1 + hstepA, voffA);
            PG8_WAIT_V(8); PG8_WAIT_L(0); PG8_BAR; PG8_MMA(0, 0, At, B0); PG8_MMA(0, 1, At, B1); PG8_BAR; PG8_SCHED;
            PG8_LDA(At, 0, 1); PG8_STAGE(PG8_SB(0, 0), b2, voffB); PG8_STAGE(PG8_SB(0, 1), b2 + hstepB, voffB); PG8_STAGE(PG8_SA(0, 0), a2, voffA);
            PG8_WAIT_V(8); PG8_WAIT_L(0); PG8_BAR; PG8_MMA(1, 0, At, B0); PG8_MMA(1, 1, At, B1); PG8_BAR; PG8_SCHED;
            PG8_LDB(B0, 1, 0); PG8_LDB(B1, 1, 1); PG8_SCHED; PG8_LDA(At, 1, 0); PG8_STAGE(PG8_SA(0, 1), a2 + hstepA, voffA);
            PG8_WAIT_V(8); PG8_WAIT_L(0); PG8_BAR; PG8_MMA(0, 0, At, B0); PG8_MMA(0, 1, At, B1); PG8_BAR; PG8_SCHED;
            PG8_LDA(At, 1, 1); PG8_STAGE(PG8_SB(1, 0), b3, voffB); PG8_STAGE(PG8_SB(1, 1), b3 + hstepB, voffB); PG8_STAGE(PG8_SA(1, 0), a3, voffA);
            PG8_WAIT_V(8); PG8_WAIT_L(0); PG8_BAR; PG8_MMA(1, 0, At, B0); PG8_MMA(1, 1, At, B1); PG8_BAR; PG8_SCHED;
            } else {
            PG8_LDB(B0, 0, 0); PG8_SCHED; PG8_LDA(At, 0, 0); PG8_STAGE(PG8_SA(1, 1), a1 + hstepA, voffA);
            PG8_WAIT_L(8); PG8_BAR; PG8_WAIT_L(0); PG8_MMA(0, 0, At, B0); PG8_BAR; PG8_SCHED;
            PG8_LDB(B1, 0, 1); PG8_STAGE(PG8_SB(0, 0), b2, voffB);
            PG8_BAR; PG8_WAIT_L(0); PG8_MMA(0, 1, At, B1); PG8_BAR;
            PG8_LDA(At, 0, 1); PG8_STAGE(PG8_SA(0, 0), a2, voffA);
            PG8_BAR; PG8_WAIT_L(0); PG8_MMA(1, 0, At, B0); PG8_BAR; PG8_SCHED;
            PG8_STAGE(PG8_SB(0, 1), b2 + hstepB, voffB);
            PG8_WAIT_V(6); PG8_BAR; PG8_MMA(1, 1, At, B1); PG8_BAR;
            PG8_LDB(B0, 1, 0); PG8_SCHED; PG8_LDA(At, 1, 0); PG8_STAGE(PG8_SA(0, 1), a2 + hstepA, voffA);
            PG8_WAIT_L(8); PG8_BAR; PG8_WAIT_L(0); PG8_MMA(0, 0, At, B0); PG8_BAR; PG8_SCHED;
            PG8_LDB(B1, 1, 1); PG8_STAGE(PG8_SB(1, 0), b3, voffB);
            PG8_BAR; PG8_WAIT_L(0); PG8_MMA(0, 1, At, B1); PG8_BAR;
            PG8_LDA(At, 1, 1); PG8_STAGE(PG8_SA(1, 0), a3, voffA);
            PG8_BAR; PG8_WAIT_L(0); PG8_MMA(1, 0, At, B0); PG8_BAR; PG8_SCHED;
            PG8_STAGE(PG8_SB(1, 1), b3 + hstepB, voffB);
            PG8_WAIT_V(6); PG8_BAR; PG8_MMA(1, 1, At, B1); PG8_BAR;
            }
        }
        if constexpr (ALIGN_EPI) { if (wr == 0) PG8_BAR; }
        if constexpr (!Epi::AFTER_DRAIN) { E(acc, cur, wr, wc, fr, fq); S.done(cur); }
        if (!has_next) break;
#pragma unroll
        for (int a = 0; a < 2; ++a)
#pragma unroll
            for (int b = 0; b < 2; ++b)
#pragma unroll
                for (int m = 0; m < 4; ++m)
#pragma unroll
                    for (int n = 0; n < 2; ++n) acc[a][b][m][n] = (f32x4){0.f, 0.f, 0.f, 0.f};
        cur = nxt; cA = nA; cB = nB; ++ui;
        if constexpr (ALIGN_EPI) { if (wr == 1) PG8_BAR; }
    }
    PG8_WAIT_V(0);
    if constexpr (!ALIGN_EPI) { if (wr == 0) PG8_BAR; }
    PG8_BAR;
    if constexpr (Epi::AFTER_DRAIN) { E.fused(acc, cur, wr, wc, fr, fq, lds, wid, lane); S.done(cur); }
#undef PG8_SA
#undef PG8_SB
#undef PG8_STAGE
#undef PG8_LDA
#undef PG8_LDB
#undef PG8_MMA
#undef PG8_WAIT_V
#undef PG8_WAIT_L
#undef PG8_BAR
#undef PG8_SCHED
}
}
#define LAS __attribute__((address_space(3)))
using pg8::bf16_t; using pg8::bf16x8; using pg8::f32x4; using pg8::u32x4; using pg8::cvt_pk_bf16;
typedef float f32x16 __attribute__((ext_vector_type(16)));
typedef int i32x4 __attribute__((ext_vector_type(4)));
typedef unsigned u32x2 __attribute__((ext_vector_type(2)));
typedef float f32x2 __attribute__((ext_vector_type(2)));

constexpr int T = 32768, D = 1024, FF = 2816, SEQ = 4096, NBATCH = 8;
constexpr int NPH = 45;
constexpr float EPS = 1e-6f, LOG2E = 1.4426950408889634f;
constexpr size_t MiB = 1u << 20;
constexpr size_t WS_FIN = 0;
constexpr size_t WS_FOUT = WS_FIN + 88 * MiB;
constexpr size_t WS_AIN = WS_FOUT + 44 * MiB;
constexpr size_t WS_AOUT = WS_AIN + 12 * MiB;
constexpr size_t WS_KVW = WS_AOUT + 4 * MiB;
constexpr size_t WS_CW1 = WS_KVW + 3 * MiB;
constexpr size_t WS_BIN = WS_CW1 + 2 * MiB;
constexpr size_t WS_BOUT = WS_BIN + 5 * MiB;
constexpr size_t WS_MOD = WS_BOUT + 4 * MiB;
constexpr size_t WS_KVMOD = WS_MOD + 4ull * 8 * 9216 * 4;
constexpr size_t WS_CBIAS = WS_KVMOD + 8ull * 2048 * 4;
constexpr size_t WS_H = WS_MOD + 2 * MiB;
constexpr size_t WS_HID = WS_H + 64 * MiB;
constexpr size_t WS_Y = WS_HID + 176 * MiB;
constexpr size_t WS_PART = WS_Y + 64 * MiB;
constexpr size_t WS_GATES = WS_PART + 2 * MiB;
constexpr size_t WS_KC = WS_GATES + 6 * MiB;
constexpr size_t WS_KS = WS_KC + 33 * MiB;
constexpr size_t WS_KW = WS_KS + 16 * MiB;
constexpr size_t WS_VST = WS_KW + 16 * MiB;
constexpr size_t WS_VWT = WS_VST + 16 * MiB;
constexpr size_t WS_HIDC = WS_VWT + 16 * MiB;
constexpr size_t WS_KCMP = WS_HIDC + 8 * MiB;
constexpr size_t WS_VCMPT = WS_KCMP + 1 * MiB;
constexpr size_t WS_BAR = WS_VCMPT + 1 * MiB;
constexpr size_t WS_END = WS_BAR + 1 * MiB;
constexpr int LDS_BYTES = 135168;

struct Params { const float* in[19]; float* out; unsigned char* ws; int ph_lo, ph_hi; };
enum { I_X = 0, I_C, I_ADAW, I_ADAB, I_NORMG, I_FIN, I_FOUT, I_AIN, I_ACONV, I_AOUT, I_KVNG, I_KVADAW, I_KVADAB, I_KVW, I_CPOS, I_CW1, I_CW2, I_BIN, I_BOUT };

__device__ __forceinline__ float bf2f(unsigned short b) { return __uint_as_float((unsigned)b << 16); }
__device__ __forceinline__ float fexp2(float x) { return __builtin_amdgcn_exp2f(x); }
__device__ __forceinline__ float frcp(float x) { return __builtin_amdgcn_rcpf(x); }
__device__ __forceinline__ float silu_f(float g) { return g * frcp(1.f + fexp2(-g * LOG2E)); }
__device__ __forceinline__ float wave_sum(float v) {
#pragma unroll
    for (int o = 1; o < 64; o <<= 1) v += __shfl_xor(v, o);
    return v;
}
template <class Tp> __device__ __forceinline__ Tp* uptr(Tp* p) { const unsigned long long v = (unsigned long long)p; const unsigned lo = __builtin_amdgcn_readfirstlane((unsigned)v), hi = __builtin_amdgcn_readfirstlane((unsigned)(v >> 32)); typedef __attribute__((address_space(1))) Tp* gptr_t; gptr_t gp = (gptr_t)(((unsigned long long)hi << 32) | lo); return (Tp*)gp; }
#define LDS_WAIT() asm volatile("s_waitcnt lgkmcnt(0)" ::: "memory")

namespace pg8 {
__device__ __forceinline__ u32x4 pack8(const f32x4 a, const f32x4 b) { u32x4 w; w.x = cvt_pk_bf16(a[0], a[1]); w.y = cvt_pk_bf16(a[2], a[3]); w.z = cvt_pk_bf16(b[0], b[1]); w.w = cvt_pk_bf16(b[2], b[3]); return w; }
struct EpiSwiglu {
    static constexpr bool PERM = true, AFTER_DRAIN = false;
    bf16_t* O;
    __device__ __forceinline__ void operator()(const f32x4 (&acc)[2][2][4][2], const Unit& u, int wr, int wc, int fr, int fq) const {
        const int row0 = u.pm * BM + wr * 64 + fr, col0 = u.pn * 128 + wc * 32 + 8 * fq;
#pragma unroll
        for (int ai = 0; ai < 2; ++ai)
#pragma unroll
            for (int m = 0; m < 4; ++m) {
                f32x4 h0, h1;
                { const f32x4 g0 = acc[ai][0][m][0], g1 = acc[ai][0][m][1], u0 = acc[ai][1][m][0], u1 = acc[ai][1][m][1];
                  const f32x4 m0 = g0 * (-LOG2E), m1 = g1 * (-LOG2E); f32x4 d0, d1;
#pragma unroll
                  for (int e = 0; e < 4; ++e) { d0[e] = fexp2(m0[e]); d1[e] = fexp2(m1[e]); }
                  d0 = d0 + 1.f; d1 = d1 + 1.f;
#pragma unroll
                  for (int e = 0; e < 4; ++e) { d0[e] = frcp(d0[e]); d1[e] = frcp(d1[e]); }
                  h0 = (g0 * u0) * d0; h1 = (g1 * u1) * d1; }
                *(u32x4*)(O + (size_t)(row0 + ai * HALF + m * 16) * FF + col0) = pack8(h0, h1);
            }
    }
};
struct EpiY {
    static constexpr bool PERM = true, AFTER_DRAIN = false;
    bf16_t* Y; float* part;
    __device__ __forceinline__ void operator()(const f32x4 (&acc)[2][2][4][2], const Unit& u, int wr, int wc, int fr, int fq) const {
        const int row0 = u.pm * BM + wr * 64 + fr, col0 = u.pn * BM + wc * 32 + 8 * fq;
#pragma unroll
        for (int ai = 0; ai < 2; ++ai)
#pragma unroll
            for (int m = 0; m < 4; ++m) {
                const int row = row0 + ai * HALF + m * 16; float ss = 0.f;
#pragma unroll
                for (int bj = 0; bj < 2; ++bj) {
                    const f32x4 a = acc[ai][bj][m][0], b = acc[ai][bj][m][1];
                    ss += (a[0] * a[0] + a[1] * a[1]) + (a[2] * a[2] + a[3] * a[3]) + (b[0] * b[0] + b[1] * b[1]) + (b[2] * b[2] + b[3] * b[3]);
                    *(u32x4*)(Y + (size_t)row * D + col0 + bj * HALF) = pack8(a, b);
                }
                ss += __shfl_xor(ss, 16); ss += __shfl_xor(ss, 32);
                if (fq == 0) part[(size_t)row * 16 + u.pn * 4 + wc] = ss;
            }
    }
};
struct EpiConvIn {
    static constexpr bool PERM = true, AFTER_DRAIN = false;
    bf16_t* V; bf16_t* Bg;
    __device__ __forceinline__ void operator()(const f32x4 (&acc)[2][2][4][2], const Unit& u, int wr, int wc, int fr, int fq) const {
        const int row0 = u.pm * BM + wr * 64 + fr;
        if (u.pn < 8) {
            const int col0 = u.pn * 128 + wc * 32 + 8 * fq;
#pragma unroll
            for (int ai = 0; ai < 2; ++ai)
#pragma unroll
                for (int m = 0; m < 4; ++m)
                    *(u32x4*)(V + (size_t)(row0 + ai * HALF + m * 16) * D + col0) = pack8(acc[ai][0][m][0] * acc[ai][1][m][0], acc[ai][0][m][1] * acc[ai][1][m][1]);
        } else {
            const int col0 = (u.pn - 8) * BM + wc * 32 + 8 * fq;
#pragma unroll
            for (int ai = 0; ai < 2; ++ai)
#pragma unroll
                for (int m = 0; m < 4; ++m)
#pragma unroll
                    for (int bj = 0; bj < 2; ++bj)
                        *(u32x4*)(Bg + (size_t)(row0 + ai * HALF + m * 16) * D + col0 + bj * HALF) = pack8(acc[ai][bj][m][0], acc[ai][bj][m][1]);
        }
    }
};
struct EpiQG {
    static constexpr bool PERM = true, AFTER_DRAIN = false;
    bf16_t* Q; float* G;
    __device__ __forceinline__ void operator()(const f32x4 (&acc)[2][2][4][2], const Unit& u, int wr, int wc, int fr, int fq) const {
        const int row0 = u.pm * BM + wr * 64 + fr;
        if (u.pn < 4) {
            const int col0 = u.pn * BM + wc * 32 + 8 * fq; const float sc = 0.125f * LOG2E;
#pragma unroll
            for (int ai = 0; ai < 2; ++ai)
#pragma unroll
                for (int m = 0; m < 4; ++m)
#pragma unroll
                    for (int bj = 0; bj < 2; ++bj)
                        *(u32x4*)(Q + (size_t)(row0 + ai * HALF + m * 16) * D + col0 + bj * HALF) = pack8(acc[ai][bj][m][0] * sc, acc[ai][bj][m][1] * sc);
        } else {
            const int col0 = wc * 32 + 8 * fq;
            if (col0 < 48) {
#pragma unroll
                for (int ai = 0; ai < 2; ++ai)
#pragma unroll
                    for (int m = 0; m < 4; ++m) {
                        float* gp = G + (size_t)(row0 + ai * HALF + m * 16) * 48 + col0;
#pragma unroll
                        for (int n = 0; n < 2; ++n) { f32x4 s;
#pragma unroll
                            for (int e = 0; e < 4; ++e) s[e] = frcp(1.f + fexp2(-acc[ai][0][m][n][e] * LOG2E));
                            *(f32x4*)(gp + 4 * n) = s; }
                    }
            }
        }
    }
};
struct EpiKV {
    static constexpr bool PERM = true, AFTER_DRAIN = false;
    bf16_t *KC, *KS, *KW, *VSt, *VWt;
    __device__ __forceinline__ void operator()(const f32x4 (&acc)[2][2][4][2], const Unit& u, int wr, int wc, int fr, int fq) const {
        const int br = u.pn >> 1, kv = u.pn & 1;
        const int row0 = u.pm * BM + wr * 64 + fr, b = row0 >> 12;
        const int d0 = (wc & 1) * 32 + 8 * fq;
        if (br == 0 || kv == 0) {
            bf16_t* base = br == 0 ? KC + (size_t)kv * 32 * 4096 * 64 : (br == 1 ? KS : KW);
#pragma unroll
            for (int ai = 0; ai < 2; ++ai)
#pragma unroll
                for (int m = 0; m < 4; ++m)
#pragma unroll
                    for (int bj = 0; bj < 2; ++bj) {
                        const int s = (row0 + ai * HALF + m * 16) & 4095, g = 2 * bj + (wc >> 1);
                        *(u32x4*)(base + ((size_t)(b * 4 + g) * 4096 + s) * 64 + d0) = pack8(acc[ai][bj][m][0], acc[ai][bj][m][1]);
                    }
        } else {
            bf16_t* base = br == 1 ? VSt : VWt;
#pragma unroll
            for (int ai = 0; ai < 2; ++ai)
#pragma unroll
                for (int m = 0; m < 4; ++m)
#pragma unroll
                    for (int bj = 0; bj < 2; ++bj) {
                        const int s = (row0 + ai * HALF + m * 16) & 4095, g = 2 * bj + (wc >> 1);
                        bf16_t* p = base + (((size_t)(b * 4 + g) * 64 + (s >> 6)) * 64 + d0) * 64 + (s & 63);
                        const u32x4 w = pack8(acc[ai][bj][m][0], acc[ai][bj][m][1]);
                        const unsigned n0 = (unsigned)__builtin_amdgcn_mov_dpp((int)w.x, 0xB1, 0xf, 0xf, true), n1 = (unsigned)__builtin_amdgcn_mov_dpp((int)w.y, 0xB1, 0xf, 0xf, true),
                                       n2 = (unsigned)__builtin_amdgcn_mov_dpp((int)w.z, 0xB1, 0xf, 0xf, true), n3 = (unsigned)__builtin_amdgcn_mov_dpp((int)w.w, 0xB1, 0xf, 0xf, true);
                        const bool odd = s & 1; unsigned* q = (unsigned*)(p + (odd ? 64 - 1 : 0));
                        q[0 * 64] = odd ? ((n0 >> 16) | (w.x & 0xffff0000u)) : ((w.x & 0xffffu) | (n0 << 16));
                        q[1 * 64] = odd ? ((n1 >> 16) | (w.y & 0xffff0000u)) : ((w.y & 0xffffu) | (n1 << 16));
                        q[2 * 64] = odd ? ((n2 >> 16) | (w.z & 0xffff0000u)) : ((w.z & 0xffffu) | (n2 << 16));
                        q[3 * 64] = odd ? ((n3 >> 16) | (w.w & 0xffff0000u)) : ((w.w & 0xffffu) | (n3 << 16));
                    }
        }
    }
};
struct EpiCmp1 {
    static constexpr bool PERM = true, AFTER_DRAIN = false;
    bf16_t* O; const float* cbias;
    __device__ __forceinline__ void operator()(const f32x4 (&acc)[2][2][4][2], const Unit& u, int wr, int wc, int fr, int fq) const {
        const int row0 = u.pm * BM + wr * 64 + fr, col0 = wc * 32 + 8 * fq;
#pragma unroll
        for (int bj = 0; bj < 2; ++bj) {
            const f32x4 b0 = *(const f32x4*)(cbias + u.pn * 256 + col0 + bj * HALF), b1 = *(const f32x4*)(cbias + u.pn * 256 + col0 + bj * HALF + 4);
#pragma unroll
            for (int ai = 0; ai < 2; ++ai)
#pragma unroll
                for (int m = 0; m < 4; ++m) {
                    f32x4 x0 = acc[ai][bj][m][0] + b0, x1 = acc[ai][bj][m][1] + b1;
#pragma unroll
                    for (int e = 0; e < 4; ++e) {
                        { const float x = x0[e], z = 1.5957691216f * (x + 0.044715f * x * x * x); x0[e] = x * frcp(1.f + fexp2(-z * LOG2E)); }
                        { const float x = x1[e], z = 1.5957691216f * (x + 0.044715f * x * x * x); x1[e] = x * frcp(1.f + fexp2(-z * LOG2E)); }
                    }
                    *(u32x4*)(O + (size_t)(row0 + ai * HALF + m * 16) * 256 + col0 + bj * HALF) = pack8(x0, x1);
                }
        }
    }
};
struct DiagOrder {
    int G, c;
    __device__ bool next(int i, Unit& u) const { const int L = i * G + c; if (L >= 64) return false; u.pm = L; u.pn = L >> 5; return true; }
    __device__ __forceinline__ void a_ready(const Unit&) const {}
    __device__ __forceinline__ void done(const Unit&) const {}
};
}
struct Ctx { LAS unsigned char* lds; int tid, lane, wave, G, bid; };

__device__ __forceinline__ void conv_item(const float* W, int ldw, int ncv, int src_col0, int K, bf16_t* WT, int dst_row0, int kb, LAS float* scr, int lane) {
    const int k0 = 64 * kb, col = src_col0 + (lane & 31); const bool ok = col < ncv;
    float wv[32];
#pragma unroll
    for (int i = 0; i < 32; ++i) { const int kk = 2 * i + (lane >> 5); wv[i] = ok ? W[(size_t)(k0 + kk) * ldw + col] : 0.f; }
#pragma unroll
    for (int i = 0; i < 32; ++i) { const int kk = 2 * i + (lane >> 5); scr[kk * 33 + (lane & 31)] = wv[i]; }
    LDS_WAIT(); asm volatile("" ::: "memory");
    const int c = lane & 7;
#pragma unroll
    for (int j = 0; j < 4; ++j) { const int n = (lane >> 3) + 8 * j; const LAS float* s = scr + (8 * c) * 33 + n;
        u32x4 o; o.x = cvt_pk_bf16(s[0 * 33], s[1 * 33]); o.y = cvt_pk_bf16(s[2 * 33], s[3 * 33]); o.z = cvt_pk_bf16(s[4 * 33], s[5 * 33]); o.w = cvt_pk_bf16(s[6 * 33], s[7 * 33]);
        *(u32x4*)(WT + (size_t)(dst_row0 + n) * K + k0 + 8 * c) = o; }
    LDS_WAIT(); asm volatile("" ::: "memory");
}
#define PIN(k) uptr(LP->in[k])
__device__ __forceinline__ void p0_phase(const Ctx& X, const LAS Params* LP) {
    unsigned char* ws = uptr(LP->ws);
    LAS float* sc = (LAS float*)X.lds;
    LAS float* red = (LAS float*)(X.lds + 32768);
    for (int i = X.tid; i < 8192; i += 512) { const int b = i >> 10, k = i & 1023; sc[k * 8 + b] = silu_f(PIN(I_C)[i]); }
    __syncthreads();
    for (int it = X.bid; it < 152; it += X.G) {
        const float* W; const float* bias; float* out; int N, cb;
        if (it < 144) { const int l = it / 36; cb = it % 36; N = 9216; W = PIN(I_ADAW) + (size_t)l * 1024 * 9216; bias = PIN(I_ADAB) + l * 9216; out = (float*)(ws + WS_MOD) + (size_t)l * 8 * 9216; }
        else { cb = it - 144; N = 2048; W = PIN(I_KVADAW); bias = PIN(I_KVADAB); out = (float*)(ws + WS_KVMOD); }
        f32x4 a[8];
#pragma unroll
        for (int b = 0; b < 8; ++b) a[b] = (f32x4){0.f, 0.f, 0.f, 0.f};
        const float* wp = W + (size_t)(128 * X.wave) * N + 256 * cb + 4 * X.lane;
#pragma unroll 1
        for (int k0 = 0; k0 < 128; k0 += 8) {
            f32x4 w[8];
#pragma unroll
            for (int k = 0; k < 8; ++k) w[k] = *(const f32x4*)(wp + (size_t)(k0 + k) * N);
#pragma unroll
            for (int k = 0; k < 8; ++k) { const f32x4 s0 = *(const LAS f32x4*)(sc + (128 * X.wave + k0 + k) * 8), s1 = *(const LAS f32x4*)(sc + (128 * X.wave + k0 + k) * 8 + 4);
                a[0] += w[k] * s0[0]; a[1] += w[k] * s0[1]; a[2] += w[k] * s0[2]; a[3] += w[k] * s0[3]; a[4] += w[k] * s1[0]; a[5] += w[k] * s1[1]; a[6] += w[k] * s1[2]; a[7] += w[k] * s1[3]; }
        }
#pragma unroll
        for (int b = 0; b < 8; ++b) *(LAS f32x4*)(red + ((X.wave * 8 + b) * 256 + 4 * X.lane)) = a[b];
        __syncthreads();
#pragma unroll
        for (int r4 = 0; r4 < 4; ++r4) { const int o = X.tid + 512 * r4, b = o >> 8, col = o & 255; float s = bias[256 * cb + col];
#pragma unroll
            for (int w = 0; w < 8; ++w) s += red[(w * 8 + b) * 256 + col];
            out[(size_t)b * N + 256 * cb + col] = s; }
        __syncthreads();
    }
    for (int kv = 0; kv < 2; ++kv) if (X.bid == X.G - 1 - kv) {
        const int col = X.tid & 255, half = X.tid >> 8; const float* pos = PIN(I_CPOS) + kv * 2048 + half * 1024; const float* w1 = PIN(I_CW1) + ((size_t)kv * 2048 + half * 1024) * 256 + col;
        float s = 0.f;
        for (int f = 0; f < 1024; ++f) s += pos[f] * w1[(size_t)f * 256];
        red[X.tid] = s; __syncthreads();
        if (X.tid < 256) ((float*)(ws + WS_CBIAS))[kv * 256 + X.tid] = red[X.tid] + red[X.tid + 256];
        __syncthreads();
    }
    __syncthreads();
    LAS float* scr = (LAS float*)(X.lds + X.wave * 8448);
    unsigned* const ctr = (unsigned*)(ws + WS_BAR) + 3520;
    for (;;) {
        unsigned base_ = 0u; if (X.lane == 0) base_ = __hip_atomic_fetch_add(ctr, 8u, __ATOMIC_RELAXED, __HIP_MEMORY_SCOPE_AGENT);
        const int base = __builtin_amdgcn_readfirstlane((int)base_); if (base >= 41472) break;
      for (int it = base; it < base + 8; ++it) {
        int r = it;
        if (r < 22528) { const int id = r / 2816, q = r % 2816, nb = q >> 4, kb = q & 15, pn = nb >> 3, jb = nb & 7;
            conv_item(PIN(I_FIN) + (size_t)id * 1024 * 5632, 5632, 5632, (jb >> 2) * 2816 + 128 * pn + 32 * (jb & 3), 1024, (bf16_t*)(ws + WS_FIN) + (size_t)id * 5632 * 1024, 32 * nb, kb, scr, X.lane); continue; } r -= 22528;
        if (r < 11264) { const int id = r / 1408, q = r % 1408, nb = q / 44, kb = q % 44;
            conv_item(PIN(I_FOUT) + (size_t)id * 2816 * 1024, 1024, 1024, 32 * nb, 2816, (bf16_t*)(ws + WS_FOUT) + (size_t)id * 1024 * 2816, 32 * nb, kb, scr, X.lane); continue; } r -= 11264;
        if (r < 3072) { const int id = r / 1536, q = r % 1536, nb = q >> 4, kb = q & 15, pn = nb >> 3, jb = nb & 7;
            const int src = pn < 8 ? ((jb >> 2) ? 2048 : 1024) + 128 * pn + 32 * (jb & 3) : 256 * (pn - 8) + 32 * jb;
            conv_item(PIN(I_AIN) + (size_t)id * 1024 * 3072, 3072, 3072, src, 1024, (bf16_t*)(ws + WS_AIN) + (size_t)id * 3072 * 1024, 32 * nb, kb, scr, X.lane); continue; } r -= 3072;
        if (r < 1024) { const int id = r / 512, q = r % 512, nb = q >> 4, kb = q & 15;
            conv_item(PIN(I_AOUT) + (size_t)id * 1024 * 1024, 1024, 1024, 32 * nb, 1024, (bf16_t*)(ws + WS_AOUT) + (size_t)id * 1024 * 1024, 32 * nb, kb, scr, X.lane); continue; } r -= 1024;
        if (r < 768) { const int nb = r >> 4, kb = r & 15;
            conv_item(PIN(I_KVW), 1536, 1536, 32 * nb, 1024, (bf16_t*)(ws + WS_KVW), 32 * nb, kb, scr, X.lane); continue; } r -= 768;
        if (r < 512) { const int id = r / 256, q = r % 256, nb = q >> 5, kb = q & 31;
            conv_item(PIN(I_CW1) + (size_t)id * 2048 * 256, 256, 256, 32 * nb, 2048, (bf16_t*)(ws + WS_CW1) + (size_t)id * 256 * 2048, 32 * nb, kb, scr, X.lane); continue; } r -= 512;
        if (r < 1280) { const int id = r / 640, q = r % 640, nb = q >> 4, kb = q & 15;
            conv_item(PIN(I_BIN) + (size_t)id * 1024 * 1072, 1072, 1072, 32 * nb, 1024, (bf16_t*)(ws + WS_BIN) + (size_t)id * 1280 * 1024, 32 * nb, kb, scr, X.lane); continue; } r -= 1280;
        { const int id = r / 512, q = r % 512, nb = q >> 4, kb = q & 15;
            conv_item(PIN(I_BOUT) + (size_t)id * 1024 * 1024, 1024, 1024, 32 * nb, 1024, (bf16_t*)(ws + WS_BOUT) + (size_t)id * 1024 * 1024, 32 * nb, kb, scr, X.lane); }
      }
    }
}

struct UpdArgs { const float* xin; float* xout; const bf16_t* y; const float* part; const float* gate; const float* gpost; float w; int bstride;
                 const float* gpre; const float* shift; const float* scale; bf16_t* h; const float* gpre2; const float* shift2; const float* scale2; bf16_t* h2; };
__device__ __forceinline__ void update_phase(const Ctx& X, const UpdArgs& A) {
    constexpr int R = 2;
    const int gw = X.bid * 8 + X.wave, NGW = X.G * 8, c0 = 4 * X.lane;
    for (int row0 = gw; row0 < T; row0 += R * NGW) {
        f32x4 xv[R][4]; u32x2 yy[R][4]; f32x4 pp[R][4];
#pragma unroll
        for (int q = 0; q < R; ++q) { const int row = min(row0 + q * NGW, T - 1);
#pragma unroll
            for (int j = 0; j < 4; ++j) xv[q][j] = *(const f32x4*)(A.xin + (size_t)row * D + c0 + 256 * j);
            if (A.y) {
#pragma unroll
                for (int j = 0; j < 4; ++j) { yy[q][j] = *(const u32x2*)(A.y + (size_t)row * D + c0 + 256 * j); pp[q][j] = *(const f32x4*)(A.part + (size_t)row * 16 + 4 * j); }
            }
        }
#pragma unroll
        for (int q = 0; q < R; ++q) { const int row = row0 + q * NGW; if (row < T) {
            const int b = row >> 12;
            if (A.y) {
                const float ssq = ((pp[q][0][0] + pp[q][0][1]) + (pp[q][0][2] + pp[q][0][3])) + ((pp[q][1][0] + pp[q][1][1]) + (pp[q][1][2] + pp[q][1][3])) + ((pp[q][2][0] + pp[q][2][1]) + (pp[q][2][2] + pp[q][2][3])) + ((pp[q][3][0] + pp[q][3][1]) + (pp[q][3][2] + pp[q][3][3]));
                const float rs = A.w * __builtin_amdgcn_rsqf(ssq * (1.f / D) + EPS);
#pragma unroll
                for (int j = 0; j < 4; ++j) { const int c = c0 + 256 * j;
                    const f32x4 gt = *(const f32x4*)(A.gate + (size_t)b * A.bstride + c), gp = *(const f32x4*)(A.gpost + c);
                    const f32x4 yv = {__uint_as_float(yy[q][j].x << 16), __uint_as_float(yy[q][j].x & 0xffff0000u), __uint_as_float(yy[q][j].y << 16), __uint_as_float(yy[q][j].y & 0xffff0000u)};
                    xv[q][j] = xv[q][j] + gt * gp * yv * rs; }
            }
            if (A.xout) {
#pragma unroll
                for (int j = 0; j < 4; ++j) *(f32x4*)(A.xout + (size_t)row * D + c0 + 256 * j) = xv[q][j];
            }
            if (A.h) {
                float s = 0.f;
#pragma unroll
                for (int j = 0; j < 4; ++j) s += (xv[q][j][0] * xv[q][j][0] + xv[q][j][1] * xv[q][j][1]) + (xv[q][j][2] * xv[q][j][2] + xv[q][j][3] * xv[q][j][3]);
                const float r = __builtin_amdgcn_rsqf(wave_sum(s) * (1.f / D) + EPS);
#pragma unroll
                for (int j = 0; j < 4; ++j) { const int c = c0 + 256 * j;
                    const f32x4 g = *(const f32x4*)(A.gpre + c), sh = *(const f32x4*)(A.shift + (size_t)b * A.bstride + c), scl = *(const f32x4*)(A.scale + (size_t)b * A.bstride + c);
                    const f32x4 hv = xv[q][j] * r * g * (scl + 1.f) + sh; u32x2 o; o.x = cvt_pk_bf16(hv[0], hv[1]); o.y = cvt_pk_bf16(hv[2], hv[3]);
                    *(u32x2*)(A.h + (size_t)row * D + c) = o; }
                if (A.h2) {
#pragma unroll
                    for (int j = 0; j < 4; ++j) { const int c = c0 + 256 * j;
                        const f32x4 g = *(const f32x4*)(A.gpre2 + c), sh = *(const f32x4*)(A.shift2 + (size_t)b * 2048 + c), scl = *(const f32x4*)(A.scale2 + (size_t)b * 2048 + c);
                        const f32x4 hv = xv[q][j] * r * g * (scl + 1.f) + sh; u32x2 o; o.x = cvt_pk_bf16(hv[0], hv[1]); o.y = cvt_pk_bf16(hv[2], hv[3]);
                        *(u32x2*)(A.h2 + (size_t)row * D + c) = o; }
                }
            }
        } }
    }
}

__device__ __forceinline__ void unpack8(const u32x4 w, float (&f)[8]) {
    f[0] = __uint_as_float(w.x << 16); f[1] = __uint_as_float(w.x & 0xffff0000u); f[2] = __uint_as_float(w.y << 16); f[3] = __uint_as_float(w.y & 0xffff0000u);
    f[4] = __uint_as_float(w.z << 16); f[5] = __uint_as_float(w.z & 0xffff0000u); f[6] = __uint_as_float(w.w << 16); f[7] = __uint_as_float(w.w & 0xffff0000u);
}
__device__ __forceinline__ void conv_phase(const Ctx& X, const bf16_t* V, const bf16_t* Bg, const float* cw, bf16_t* Z) {
    const int gt = X.bid * 512 + X.tid, NT = X.G * 512;
    for (int i0 = gt; i0 < T * 128; i0 += 2 * NT) {
        u32x4 v0[2], v1[2], v2[2], bb[2]; int rw[2], cc[2]; bool ok[2];
#pragma unroll
        for (int q = 0; q < 2; ++q) { const int i = i0 + q * NT; ok[q] = i < T * 128; const int ii = ok[q] ? i : i0; const int row = ii >> 7, c = (ii & 127) * 8, sq = row & 4095; rw[q] = row; cc[q] = c;
            const u32x4 z0 = {0u, 0u, 0u, 0u};
            v2[q] = *(const u32x4*)(V + (size_t)row * D + c); v1[q] = sq >= 1 ? *(const u32x4*)(V + (size_t)(row - 1) * D + c) : z0; v0[q] = sq >= 2 ? *(const u32x4*)(V + (size_t)(row - 2) * D + c) : z0;
            bb[q] = *(const u32x4*)(Bg + (size_t)row * D + c); }
#pragma unroll
        for (int q = 0; q < 2; ++q) if (ok[q]) { const int c = cc[q];
            float a0[8], a1[8], a2[8], bf[8], o[8]; unpack8(v0[q], a0); unpack8(v1[q], a1); unpack8(v2[q], a2); unpack8(bb[q], bf);
#pragma unroll
            for (int e = 0; e < 8; ++e) o[e] = bf[e] * (cw[c + e] * a0[e] + cw[D + c + e] * a1[e] + cw[2 * D + c + e] * a2[e]);
            u32x4 w; w.x = cvt_pk_bf16(o[0], o[1]); w.y = cvt_pk_bf16(o[2], o[3]); w.z = cvt_pk_bf16(o[4], o[5]); w.w = cvt_pk_bf16(o[6], o[7]);
            *(u32x4*)(Z + (size_t)rw[q] * D + c) = w; }
    }
}

__device__ __forceinline__ void cmp2_phase(const Ctx& X, const bf16_t* hidc, const float* w2, bf16_t* kcmp, bf16_t* vcmpT) {
    const int gt = X.bid * 512 + X.tid, NT = X.G * 512;
    for (int i = gt; i < 16384 * 16; i += NT) {
        const int row = i >> 4, c = (i & 15) * 4, kv = row >> 13, rr = row & 8191;
        const float* w = w2 + (size_t)kv * 256 * 64 + c; const bf16_t* hp = hidc + (size_t)row * 256;
        f32x4 a = {0.f, 0.f, 0.f, 0.f};
        for (int k = 0; k < 256; k += 8) { float hf[8]; unpack8(*(const u32x4*)(hp + k), hf);
#pragma unroll
            for (int e = 0; e < 8; ++e) a += *(const f32x4*)(w + (size_t)(k + e) * 64) * hf[e]; }
        if (kv == 0) { u32x2 o; o.x = cvt_pk_bf16(a[0], a[1]); o.y = cvt_pk_bf16(a[2], a[3]); *(u32x2*)(kcmp + (size_t)rr * 64 + c) = o; }
        else { const int bg = rr >> 8, n = rr & 255; bf16_t* p = vcmpT + (((size_t)bg * 4 + (n >> 6)) * 64 + c) * 64 + (n & 63); const unsigned w0 = cvt_pk_bf16(a[0], a[1]), w1 = cvt_pk_bf16(a[2], a[3]);
            p[0] = (bf16_t)(w0 & 0xffffu); p[64] = (bf16_t)(w0 >> 16); p[128] = (bf16_t)(w1 & 0xffffu); p[192] = (bf16_t)(w1 >> 16); }
    }
}
struct AttnArgs { const bf16_t* Q; const float* gates; const bf16_t *kcmp, *vcmpT, *KS, *VSt, *KW, *VWt; bf16_t* O; };

__device__ __forceinline__ void load_k(bf16x8 (&kf)[4], const bf16_t* Kb, int key0, int jr, int h) {
    const bf16x8* p = (const bf16x8*)(Kb + (size_t)(key0 + jr) * 64 + h * 8);
#pragma unroll
    for (int ks = 0; ks < 4; ++ks) kf[ks] = p[2 * ks];
}
__device__ __forceinline__ void load_v(bf16x8 (&vf)[4], const bf16_t* Vt, int ldv, int key0, int j, int h) {
#pragma unroll
    for (int s = 0; s < 2; ++s)
#pragma unroll
        for (int dt = 0; dt < 2; ++dt) vf[s * 2 + dt] = *(const bf16x8*)(Vt + (size_t)(dt * 32 + j) * ldv + key0 + 16 * s + 8 * h);
}
__device__ __forceinline__ f32x16 qk_mma(const bf16x8 (&kf)[4], const bf16x8 (&qf)[4], const f32x16& bc) {
    f32x16 acc = __builtin_amdgcn_mfma_f32_32x32x16_bf16(kf[0], qf[0], bc, 0, 0, 0);
#pragma unroll
    for (int ks = 1; ks < 4; ++ks) acc = __builtin_amdgcn_mfma_f32_32x32x16_bf16(kf[ks], qf[ks], acc, 0, 0, 0);
    return acc;
}
__device__ __forceinline__ void pv_mma(f32x16 (&o)[2], const bf16x8 (&vf)[4], const f32x16& p) {
#pragma unroll
    for (int s = 0; s < 2; ++s) {
        u32x4 w; w.x = cvt_pk_bf16(p[8 * s + 0], p[8 * s + 1]); w.y = cvt_pk_bf16(p[8 * s + 2], p[8 * s + 3]); w.z = cvt_pk_bf16(p[8 * s + 4], p[8 * s + 5]); w.w = cvt_pk_bf16(p[8 * s + 6], p[8 * s + 7]);
        const bf16x8 pb = __builtin_bit_cast(bf16x8, w);
#pragma unroll
        for (int dt = 0; dt < 2; ++dt) o[dt] = __builtin_amdgcn_mfma_f32_32x32x16_bf16(vf[s * 2 + dt], pb, o[dt], 0, 0, 0);
    }
}
__device__ __forceinline__ void pf_block(const bf16_t* Kb, const bf16_t* Vt, int ldv, int key0, int lane, LAS unsigned* junk) {
    __builtin_amdgcn_global_load_lds((const unsigned*)(Kb + (size_t)(key0 + lane) * 64), junk, 4, 0, 0);
    __builtin_amdgcn_global_load_lds((const unsigned*)(Vt + (size_t)lane * ldv + key0), junk, 4, 0, 0);
}
__device__ __forceinline__ unsigned run_mask(int kstart, int lo, int hi) {
    const int a = max(lo - kstart, 0), b = min(hi - kstart, 7);
    return a <= b ? ((1u << (b + 1)) - 1u) & ~((1u << a) - 1u) : 0u;
}
__device__ __forceinline__ float max16(const f32x16& s) {
    float a = fmaxf(fmaxf(s[0], s[1]), s[2]), b = fmaxf(fmaxf(s[3], s[4]), s[5]), c = fmaxf(fmaxf(s[6], s[7]), s[8]), d = fmaxf(fmaxf(s[9], s[10]), s[11]), e = fmaxf(fmaxf(s[12], s[13]), s[14]);
    return fmaxf(fmaxf(fmaxf(a, b), fmaxf(c, d)), fmaxf(e, s[15]));
}
__device__ __forceinline__ void softmax_step(f32x16& s, bool full, unsigned vm, float off, float& m, float& l, f32x16 (&o)[2], bool lane_on = true) {
    if (!full) {
#pragma unroll
        for (int v = 0; v < 16; ++v) s[v] = ((vm >> v) & 1u) ? s[v] : -1e30f;
    }
    float tm = max16(s);
    if (full && !lane_on) tm = -1e30f;
    tm = fmaxf(tm, __shfl_xor(tm, 32)) + off;
    const float mn = fmaxf(m, tm);
    if (__any(mn > m)) { const float al = fexp2(m - mn); l *= al; o[0] = o[0] * al; o[1] = o[1] * al; }
    m = mn; const float ml = (full && !lane_on) ? 3e38f : mn - off;
    float ps = 0.f;
    if (full) {
#pragma unroll
        for (int v = 0; v < 16; ++v) { const float p = fexp2(s[v] - ml); s[v] = p; ps += p; }
    } else {
#pragma unroll
        for (int v = 0; v < 16; ++v) { const float p = ((vm >> v) & 1u) ? fexp2(s[v] - ml) : 0.f; s[v] = p; ps += p; }
    }
    l += ps;
}

__device__ __forceinline__ void softmax_step64(f32x16& s1, f32x16& s0, float off1, float off0, bool lane_on, float& m, float& l, f32x16 (&o)[2]) {
    float tm = fmaxf(max16(s1) + off1, max16(s0) + off0);
    if (!lane_on) tm = -1e30f;
    tm = fmaxf(tm, __shfl_xor(tm, 32));
    const float mn = fmaxf(m, tm);
    if (__any(mn > m)) { const float al = fexp2(m - mn); l *= al; o[0] = o[0] * al; o[1] = o[1] * al; }
    m = mn; const float ml1 = lane_on ? mn - off1 : 3e38f, ml0 = lane_on ? mn - off0 : 3e38f;
    float ps = 0.f;
#pragma unroll
    for (int v = 0; v < 16; ++v) { const float p = fexp2(s1[v] - ml1); s1[v] = p; ps += p; }
#pragma unroll
    for (int v = 0; v < 16; ++v) { const float p = fexp2(s0[v] - ml0); s0[v] = p; ps += p; }
    l += ps;
}
__device__ __forceinline__ void glds16(const void* gsrc, unsigned lds_dst) { unsigned keep;
    asm volatile("s_mov_b32 %0, m0\n\ts_mov_b32 m0, %2\n\ts_nop 0\n\tglobal_load_lds_dwordx4 %1, off\n\ts_mov_b32 m0, %0" : "=&s"(keep) : "v"(gsrc), "s"(lds_dst) : "memory"); }
struct AttnSrc { const bf16_t *Kc, *Vc, *Kw, *Vw, *Ks, *Vs; };
__device__ __forceinline__ void ring_load(const AttnSrc& S, int type, int key0, unsigned slot_addr, int wave, int lane) {
    const int q = lane & 7;
#pragma unroll
    for (int e = 0; e < 2; ++e) {
        const int pr = (2 * wave + e) & 7, i = 8 * pr + (lane >> 3), c = q ^ ((i >> 1) & 7);
        const bf16_t* src;
        if (wave < 4) { const bf16_t* kb = type == 0 ? S.Kc : (type == 1 ? S.Kw : S.Ks); const int il = i & 31, kp = (il & ~12) | ((il & 4) << 1) | ((il & 8) >> 1);
                        src = kb + (size_t)(key0 + (i & 32) + kp) * 64 + 8 * c; }
        else { const bf16_t* vb = type == 0 ? S.Vc : (type == 1 ? S.Vw : S.Vs); src = vb + ((size_t)(key0 >> 6) * 64 + i) * 64 + 8 * c; }
        glds16(src, slot_addr + (wave < 4 ? 0u : 8192u) + (unsigned)pr * 1024u);
    }
}
#define RING_WAIT_BAR() do { asm volatile("s_waitcnt vmcnt(4)" ::: "memory"); __builtin_amdgcn_s_barrier(); asm volatile("" ::: "memory"); } while (0)
#define RING_DRAIN_BAR() do { asm volatile("s_waitcnt vmcnt(0) lgkmcnt(0)" ::: "memory"); __builtin_amdgcn_s_barrier(); asm volatile("" ::: "memory"); } while (0)
__device__ __forceinline__ void ring_read_k(bf16x8 (&kf)[4], const LAS unsigned char* slot, int hf, int rowoff, int sw, int h) {
#pragma unroll
    for (int ks = 0; ks < 4; ++ks) kf[ks] = *(const LAS bf16x8*)(slot + hf * 4096 + rowoff + (((2 * ks + h) * 16) ^ sw));
}
__device__ __forceinline__ void ring_read_v(bf16x8 (&vf)[4], const LAS unsigned char* slot, int hf, int rowoff, int sw, int h) {
#pragma unroll
    for (int s = 0; s < 2; ++s)
#pragma unroll
        for (int dt = 0; dt < 2; ++dt) vf[s * 2 + dt] = *(const LAS bf16x8*)(slot + 8192 + dt * 4096 + rowoff + (((4 * hf + 2 * s + h) * 16) ^ sw));
}

__device__ __forceinline__ void attn_item(const Ctx& X, const AttnArgs& A, int b, int g, int qt, const int mode = 3) {
    int lane_ = X.lane; asm volatile("" : "+v"(lane_));
    const int lane = lane_, h = lane >> 5, j = lane & 31, ql = j >> 2, r = j & 3, wave = X.wave;
    const int tb = qt * 64, t0 = tb + wave * 8, t = t0 + ql, head = g * 4 + r, bg = b * 4 + g, cur = qt;
    const size_t row = (size_t)b * SEQ + t;
    const int rowoff = j * 128, sw = ((j >> 1) & 7) * 16;
    RING_DRAIN_BAR();
    bf16x8 qf[4];
#pragma unroll
    for (int ks = 0; ks < 4; ++ks) qf[ks] = *(const bf16x8*)(A.Q + row * D + head * 64 + ks * 16 + h * 8);
    const float sl2 = fexp2(-0.5f * (float)(head + 1)) * LOG2E;
    const float g0 = A.gates[row * 48 + head], g1 = A.gates[row * 48 + 16 + head], g2 = A.gates[row * 48 + 32 + head];
    f32x16 o[2], bc;
#pragma unroll
    for (int v = 0; v < 16; ++v) { o[0][v] = 0.f; o[1][v] = 0.f; }
    LAS float* cm = (LAS float*)(X.lds + wave * 8192);
    LAS float* ob = cm + lane;
    const LAS unsigned char* ring = X.lds + 65536;
    const unsigned ring_a = (unsigned)(unsigned long long)ring;
    LAS unsigned long long* ux = (LAS unsigned long long*)(X.lds + 131072);
    LAS int* tk = (LAS int*)(X.lds + 131072 + 64 + wave * 256);
    AttnSrc S; S.Kc = A.kcmp + (size_t)bg * 256 * 64; S.Vc = A.vcmpT + (size_t)bg * 64 * 256; S.Kw = A.KW + (size_t)bg * 4096 * 64; S.Vw = A.VWt + (size_t)bg * 64 * 4096;
    S.Ks = A.KS + (size_t)bg * 4096 * 64; S.Vs = A.VSt + (size_t)bg * 64 * 4096;
    float m, l;
    bf16x8 kc[4], vf[4];

    const int ntb = (((tb + 63 - 31) >> 4) >> 5) + 1, nb1 = (ntb + 1) >> 1;
    const int nmax_w = (t0 + 7 - 31) >> 4, nmax_t = (t - 31) >> 4, nmin_w = (t0 - 31) >> 4;
    const int ntile = nmax_w >= 0 ? (nmax_w >> 5) + 1 : 0;
#pragma unroll
    for (int v = 0; v < 16; ++v) bc[v] = 16.f * sl2 * (float)(8 * h + 16 * (v >> 3) + (v & 7)) + sl2 * (float)(31 - ql);
    m = -1e30f; l = 0.f;
    {
        for (int i = 0; i < nb1; ++i) ring_load(S, 0, i * 64, ring_a + (unsigned)i * 16384u, wave, lane);
        asm volatile("" :: "v"(qf[0]), "v"(qf[1]), "v"(qf[2]), "v"(qf[3]), "v"(g0), "v"(g1), "v"(g2));
        RING_DRAIN_BAR();
#pragma unroll 1
        for (int tile = ntile - 1; tile >= 0; --tile) {
            const LAS unsigned char* slot = ring + (tile >> 1) * 16384; const int hf = tile & 1;
            ring_read_k(kc, slot, hf, rowoff, sw, h);
            const unsigned vm = run_mask(tile * 32 + 8 * h, 0, nmax_t) | (run_mask(tile * 32 + 16 + 8 * h, 0, nmax_t) << 8);
            f32x16 s = qk_mma(kc, qf, bc);
            softmax_step(s, tile * 32 + 31 <= nmin_w, vm, sl2 * (float)(512 * tile - t0), m, l, o);
        }
        l += __shfl_xor(l, 32);
        const float inv = 1.f / fmaxf(l, 1e-30f);
#pragma unroll 1
        for (int tile = ntile - 1; tile >= 0; --tile) {
            const LAS unsigned char* slot = ring + (tile >> 1) * 16384; const int hf = tile & 1;
            ring_read_k(kc, slot, hf, rowoff, sw, h); ring_read_v(vf, slot, hf, rowoff, sw, h);
            const unsigned vm = run_mask(tile * 32 + 8 * h, 0, nmax_t) | (run_mask(tile * 32 + 16 + 8 * h, 0, nmax_t) << 8);
            f32x16 s = qk_mma(kc, qf, bc);
            const float ml = m - sl2 * (float)(512 * tile - t0);
#pragma unroll
            for (int v = 0; v < 16; ++v) {
                const float p = ((vm >> v) & 1u) ? fexp2(s[v] - ml) * inv : 0.f; s[v] = p;
                float x = p; x += __int_as_float(__builtin_amdgcn_mov_dpp(__float_as_int(x), 0xB1, 0xf, 0xf, true)); x += __int_as_float(__builtin_amdgcn_mov_dpp(__float_as_int(x), 0x4E, 0xf, 0xf, true));
                if ((v & 3) == r) cm[ql * 256 + tile * 32 + 16 * (v >> 3) + 8 * h + (v & 7)] = x;
            }
            pv_mma(o, vf, s);
        }
    }
    RING_DRAIN_BAR();
    const int wb1b = qt, wb0b = max(tb - 511, 0) >> 6, nWb = wb1b - wb0b + 1;
    const int kt0 = max(t0 - 511, 0) >> 5, kt1 = (t0 + 7) >> 5;
    int li = 0;
    for (; li < 3 && li < nWb; ++li) ring_load(S, 1, (wb1b - li) * 64, ring_a + (unsigned)(li & 3) * 16384u, wave, lane);
    unsigned long long mq = 0ull, uni = 0ull, alln = ~0ull;
    {
        const unsigned long long causal = cur >= 63 ? ~0ull : ((1ull << (cur + 1)) - 1ull);
        if (cur + 1 <= 16) { mq = causal; uni = causal; alln = causal; }
        else {
#pragma unroll 1
            for (int q = 0; q < 8; ++q) {
                float iv;
                if (lane == 0 || lane == cur || lane == cur - 1) iv = 1e30f;
                else if (lane > cur) iv = -1.f;
                else { const LAS float* c = cm + q * 256 + 4 * lane; iv = (((c[-1] + c[0]) + c[1]) + c[2]) + c[3]; }
                const int key = (__float_as_int(iv) & ~63) | (63 - lane);
                tk[lane] = key;
                int rank = 0;
#pragma unroll
                for (int i4 = 0; i4 < 16; ++i4) { const i32x4 kv = *(const LAS i32x4*)(tk + 4 * i4);
                    rank += (kv[0] > key ? 1 : 0) + (kv[1] > key ? 1 : 0) + (kv[2] > key ? 1 : 0) + (kv[3] > key ? 1 : 0); }
                unsigned long long mk = __ballot(rank < 16);
                mk &= causal;
                uni |= mk; alln &= mk; if (ql == q) mq = mk;
            }
        }
    }
    if (lane == 0) ux[wave] = uni;
    asm volatile("s_waitcnt lgkmcnt(0)" ::: "memory"); __builtin_amdgcn_s_barrier(); asm volatile("" ::: "memory");
    unsigned long long bun = 0ull;
#pragma unroll
    for (int w = 0; w < 8; ++w) bun |= ux[w];
    { const unsigned lo = __builtin_amdgcn_readfirstlane((unsigned)bun), hi = __builtin_amdgcn_readfirstlane((unsigned)(bun >> 32)); bun = ((unsigned long long)hi << 32) | lo; }
    const int n2 = nWb + __popcll(bun);
    unsigned long long lmask = bun; int ljb = 0;
#define LOAD_STEP2() do { int ty_, k0_; \
        if (li < nWb) { ty_ = 1; k0_ = (wb1b - li) * 64; } \
        else { ty_ = 2; if (li < n2) { ljb = 63 - __builtin_clzll(lmask); lmask &= ~(1ull << ljb); } k0_ = ljb * 64; } \
        ring_load(S, ty_, k0_, ring_a + (unsigned)(li & 3) * 16384u, wave, lane); ++li; } while (0)
    while (li < 3) LOAD_STEP2();
#pragma unroll
    for (int v = 0; v < 16; ++v) { ob[v * 64] = g0 * o[0][v]; ob[(16 + v) * 64] = g0 * o[1][v]; o[0][v] = 0.f; o[1][v] = 0.f; }
#pragma unroll
    for (int v = 0; v < 16; ++v) bc[v] = sl2 * (float)(8 * h + 16 * (v >> 3) + (v & 7) - ql);
    m = -1e30f; l = 0.f;
    int ci = 0;
#pragma unroll 1
    for (; ci < nWb; ++ci) {
        RING_WAIT_BAR();
        LOAD_STEP2();
        const int wb = wb1b - ci; const LAS unsigned char* slot = ring + (ci & 3) * 16384;
        if ((mode & 2) && wb * 64 + 63 <= t0 && wb * 64 >= t0 + 7 - 511) {
            ring_read_k(kc, slot, 1, rowoff, sw, h); f32x16 s1 = qk_mma(kc, qf, bc);
            ring_read_k(kc, slot, 0, rowoff, sw, h); f32x16 s0 = qk_mma(kc, qf, bc);
            softmax_step64(s1, s0, sl2 * (float)(wb * 64 + 32 - t0), sl2 * (float)(wb * 64 - t0), true, m, l, o);
            ring_read_v(vf, slot, 1, rowoff, sw, h); pv_mma(o, vf, s1);
            ring_read_v(vf, slot, 0, rowoff, sw, h); pv_mma(o, vf, s0);
        } else
#pragma unroll 1
        for (int hf = 1; hf >= 0; --hf) {
            const int kt = 2 * wb + hf, key0 = kt * 32;
            if (kt >= kt0 && kt <= kt1 && (mode & 2)) {
                ring_read_k(kc, slot, hf, rowoff, sw, h); ring_read_v(vf, slot, hf, rowoff, sw, h);
                f32x16 s = qk_mma(kc, qf, bc);
                const bool full = (key0 + 31 <= t0) && (key0 >= t0 + 7 - 511);
                const unsigned vm = run_mask(key0 + 8 * h, t - 511, t) | (run_mask(key0 + 16 + 8 * h, t - 511, t) << 8);
                softmax_step(s, full, vm, sl2 * (float)(key0 - t0), m, l, o);
                pv_mma(o, vf, s);
            }
        }
    }
    {
        l += __shfl_xor(l, 32);
        const float sc = g2 / fmaxf(l, 1e-30f);
#pragma unroll
        for (int v = 0; v < 16; ++v) { ob[v * 64] += sc * o[0][v]; ob[(16 + v) * 64] += sc * o[1][v]; o[0][v] = 0.f; o[1][v] = 0.f; }
    }
    m = -1e30f; l = 0.f;
    {
        unsigned long long cmask = bun;
#pragma unroll 1
        for (; ci < n2; ++ci) {
            RING_WAIT_BAR();
            LOAD_STEP2();
            const int jb = 63 - __builtin_clzll(cmask); cmask &= ~(1ull << jb);
            const LAS unsigned char* slot = ring + (ci & 3) * 16384;
            if (((uni >> jb) & 1ull) && (mode & 1)) {
                const bool mine = (mq >> jb) & 1ull;
                if (jb * 64 + 63 <= t0) {
                    ring_read_k(kc, slot, 1, rowoff, sw, h); f32x16 s1 = qk_mma(kc, qf, bc);
                    ring_read_k(kc, slot, 0, rowoff, sw, h); f32x16 s0 = qk_mma(kc, qf, bc);
                    softmax_step64(s1, s0, sl2 * (float)(jb * 64 + 32 - t0), sl2 * (float)(jb * 64 - t0), mine, m, l, o);
                    ring_read_v(vf, slot, 1, rowoff, sw, h); pv_mma(o, vf, s1);
                    ring_read_v(vf, slot, 0, rowoff, sw, h); pv_mma(o, vf, s0);
                } else
#pragma unroll 1
                for (int hf = 1; hf >= 0; --hf) {
                    const int key0 = jb * 64 + hf * 32;
                    if (key0 <= t0 + 7) {
                        ring_read_k(kc, slot, hf, rowoff, sw, h); ring_read_v(vf, slot, hf, rowoff, sw, h);
                        f32x16 s = qk_mma(kc, qf, bc);
                        const bool full = key0 + 31 <= t0;
                        const unsigned vm = mine ? (run_mask(key0 + 8 * h, 0, t) | (run_mask(key0 + 16 + 8 * h, 0, t) << 8)) : 0u;
                        softmax_step(s, full, vm, sl2 * (float)(key0 - t0), m, l, o, mine);
                        pv_mma(o, vf, s);
                    }
                }
            }
        }
    }
#undef LOAD_STEP2
    {
        l += __shfl_xor(l, 32);
        const float sc = g1 / fmaxf(l, 1e-30f);
#pragma unroll
        for (int v = 0; v < 16; ++v) { o[0][v] = ob[v * 64] + sc * o[0][v]; o[1][v] = ob[(16 + v) * 64] + sc * o[1][v]; }
    }
    bf16_t* op = A.O + row * D + head * 64 + 4 * h;
#pragma unroll
    for (int dt = 0; dt < 2; ++dt)
#pragma unroll
        for (int v4 = 0; v4 < 4; ++v4) { u32x2 w; w.x = cvt_pk_bf16(o[dt][4 * v4], o[dt][4 * v4 + 1]); w.y = cvt_pk_bf16(o[dt][4 * v4 + 2], o[dt][4 * v4 + 3]); *(u32x2*)(op + 32 * dt + 8 * v4) = w; }
}
__device__ __forceinline__ void attn_phase(const Ctx& X, const AttnArgs& A, const int mode = 3) {
    for (int i = 0;; ++i) {
        const int k = i * X.G + ((i & 1) ? X.G - 1 - X.bid : X.bid);
        if (i * X.G >= 2048) break;
        if (k < 2048) { const int qt = 63 - (k >> 5), bg = k & 31; attn_item(X, A, bg >> 2, bg & 3, qt, mode); }
    }
    RING_DRAIN_BAR();
}
#define XB_TMO      128
#define XB_XCNT(j)  (256  + 64 * (j))
#define XB_XSUB(j)  (1280 + 64 * (j))
#define XB_XGEN(j)  (2304 + 64 * (j))
#define XB_TOP      3328
#define XB_TOPGEN   3392
#define XCD_BAR_WORDS 3456
#define XB_SPIN_CAP (1u << 18)

__device__ __forceinline__ unsigned xb_ld(unsigned* p)              { return __hip_atomic_load(p, __ATOMIC_RELAXED, __HIP_MEMORY_SCOPE_AGENT); }
__device__ __forceinline__ unsigned xb_add(unsigned* p, unsigned v) { return __hip_atomic_fetch_add(p, v, __ATOMIC_RELAXED, __HIP_MEMORY_SCOPE_AGENT); }
__device__ __forceinline__ unsigned xb_xcc_id() { return (unsigned)__builtin_amdgcn_s_getreg((3 << 11) | 20) & 0xFu; }
#define XB_SPIN(cond, bar) do { unsigned _sp = 0; while (cond) { __builtin_amdgcn_s_sleep(1); \
    if ((++_sp & 255u) == 0u) { if (xb_ld(&(bar)[XB_TMO])) break; if (_sp > XB_SPIN_CAP) { atomicAdd(&(bar)[XB_TMO], 1u); break; } } } } while (0)

struct XcdBarrier {
    unsigned* bar; unsigned x;
    volatile LAS unsigned* st;
};

__device__ __forceinline__ XcdBarrier xcd_barrier_post(unsigned* bar, volatile LAS unsigned* st) {
    XcdBarrier b; b.bar = bar; b.x = xb_xcc_id(); b.st = st;
    if (threadIdx.x == 0) (void)xb_add(&bar[XB_XCNT(b.x)], 1u);
    return b;
}
__device__ __forceinline__ void xcd_barrier_complete(unsigned* bar, unsigned x, unsigned& nloc, unsigned& nx) {
    const unsigned G = gridDim.x * gridDim.y * gridDim.z;
    unsigned sum, cnt, mine, sp = 0u;
    for (;;) {
        sum = 0u; cnt = 0u; mine = 0u;
#pragma unroll
        for (unsigned j = 0; j < 16; ++j) { const unsigned c = xb_ld(&bar[XB_XCNT(j)]); sum += c; cnt += (c > 0u) ? 1u : 0u; mine = (j == x) ? c : mine; }
        if (sum == G) break;
        __builtin_amdgcn_s_sleep(1);
        if ((++sp & 255u) == 0u) { if (xb_ld(&bar[XB_TMO])) break; if (sp > XB_SPIN_CAP) { atomicAdd(&bar[XB_TMO], 1u); break; } }
    }
    nloc = mine > 0u ? mine : 1u; nx = cnt > 0u ? cnt : 1u;
}

__device__ __forceinline__ void xcd_barrier(const XcdBarrier& b) {
    asm volatile("s_waitcnt vmcnt(0)" ::: "memory");
    __syncthreads();
    if (threadIdx.x == 0) {
        unsigned* bar = b.bar;
        __builtin_amdgcn_s_waitcnt(0);
        unsigned nloc = b.st[0], nx = b.st[1];
        if (nloc == 0u) { xcd_barrier_complete(bar, b.x, nloc, nx); b.st[0] = nloc; b.st[1] = nx; }
        const unsigned old = xb_add(&bar[XB_XSUB(b.x)], 1u);
        const unsigned gen = old / nloc;
        if (old + 1u == (gen + 1u) * nloc) {
            __builtin_amdgcn_fence(__ATOMIC_RELEASE, "agent");
            asm volatile("s_waitcnt vmcnt(0)" ::: "memory");
            const unsigned og = xb_add(&bar[XB_TOP], 1u);
            const unsigned tg = og / nx;
            if (og + 1u == (tg + 1u) * nx) xb_add(&bar[XB_TOPGEN], 1u);
            else XB_SPIN(xb_ld(&bar[XB_TOPGEN]) == tg, bar);
            __builtin_amdgcn_fence(__ATOMIC_ACQUIRE, "agent");
            xb_add(&bar[XB_XGEN(b.x)], 1u);
            asm volatile("s_waitcnt vmcnt(0)" ::: "memory");
        } else {
            XB_SPIN(xb_ld(&bar[XB_XGEN(b.x)]) == gen, bar);
            __builtin_amdgcn_fence(__ATOMIC_ACQUIRE, "agent");
            asm volatile("s_waitcnt vmcnt(0)" ::: "memory");
        }
    }
    __syncthreads();
}

__global__ void __launch_bounds__(512, 2) yoco_fwd(Params Pk) {
    extern __shared__ __attribute__((aligned(16))) unsigned char lds_raw[];
    cg::grid_group grid = cg::this_grid();
    { LAS Params* LP = (LAS Params*)((LAS unsigned char*)lds_raw); if (threadIdx.x == 0) {
#pragma unroll
        for (int i = 0; i < 19; ++i) LP->in[i] = Pk.in[i];
        LP->out = Pk.out; LP->ws = Pk.ws; LP->ph_lo = Pk.ph_lo; LP->ph_hi = Pk.ph_hi; } }
    volatile LAS unsigned* xb_st = (volatile LAS unsigned*)((LAS unsigned char*)lds_raw + 192);
    if (threadIdx.x == 0) { xb_st[0] = 0u; xb_st[1] = 0u; }
    unsigned* const xb_words = (unsigned*)(Pk.ws + WS_BAR);
    if (blockIdx.x == 0) { for (int i = threadIdx.x; i < XCD_BAR_WORDS + 128; i += 512) __hip_atomic_store(xb_words + i, 0u, __ATOMIC_RELAXED, __HIP_MEMORY_SCOPE_AGENT); }
    asm volatile("s_waitcnt vmcnt(0)" ::: "memory");
    __syncthreads();
    const int ph_lo = Pk.ph_lo, ph_hi = Pk.ph_hi;
    grid.sync();
    (void)xcd_barrier_post(xb_words, xb_st);
    {
        int tid_ = threadIdx.x, g_ = gridDim.x, b_ = blockIdx.x; asm volatile("" : "+v"(tid_), "+s"(g_), "+s"(b_));
        Ctx X; X.lds = (LAS unsigned char*)lds_raw + 256; X.tid = tid_; X.lane = X.tid & 63; X.wave = __builtin_amdgcn_readfirstlane(X.tid >> 6); X.G = g_; X.bid = b_;
        p0_phase(X, (const LAS Params*)(X.lds - 256)); __syncthreads();
        XcdBarrier xbar; xbar.bar = xb_words; xbar.x = xb_xcc_id(); xbar.st = xb_st; xcd_barrier(xbar);
    }
    int dupflag_ = 0; (void)dupflag_;
    for (int ph = ph_lo < 1 ? 1 : ph_lo; ph < ph_hi; ++ph) {
        int cur_st_ = -1; (void)cur_st_;
        asm volatile("" ::: "memory");
        int tid_ = threadIdx.x, g_ = gridDim.x, b_ = blockIdx.x; asm volatile("" : "+v"(tid_), "+s"(g_), "+s"(b_));
        Ctx X; X.lds = (LAS unsigned char*)lds_raw + 256; X.tid = tid_; X.lane = X.tid & 63; X.wave = __builtin_amdgcn_readfirstlane(X.tid >> 6); X.G = g_; X.bid = b_;
        Params P;
        { const LAS Params* LP = (const LAS Params*)(X.lds - 256);
          P.in[I_X] = uptr(LP->in[I_X]); P.in[I_NORMG] = uptr(LP->in[I_NORMG]); P.in[I_ACONV] = uptr(LP->in[I_ACONV]); P.in[I_KVNG] = uptr(LP->in[I_KVNG]); P.in[I_CW2] = uptr(LP->in[I_CW2]);
          P.out = uptr(LP->out); P.ws = uptr(LP->ws); }
        unsigned char* ws = P.ws;
        bf16_t* const H = (bf16_t*)(ws + WS_H); bf16_t* const HID = (bf16_t*)(ws + WS_HID); bf16_t* const HID2 = (bf16_t*)(ws + WS_HID + 64 * MiB); bf16_t* const Y = (bf16_t*)(ws + WS_Y);
        float* const PART = (float*)(ws + WS_PART); float* const GATES = (float*)(ws + WS_GATES);
        const float* const MOD = (const float*)(ws + WS_MOD); const float* const KVMOD = (const float*)(ws + WS_KVMOD);
        const float* const NG = P.in[I_NORMG];
        if (ph == 1) {
            UpdArgs U{}; U.xin = P.in[I_X]; U.xout = nullptr; U.bstride = 9216; U.gpre = NG; U.shift = MOD; U.scale = MOD + 1024; U.h = H;

#ifndef SKIP_UPD
update_phase(X, U);
#endif

        } else {
            int p = ph - 2, l, st;
            if (p < 20) { l = p / 10; st = p % 10; } else if (p < 23) { l = 2; st = 10 + (p - 20); } else { p -= 23; l = 2 + p / 10; st = p % 10; }
            cur_st_ = st;
            const float* modl = MOD + (size_t)l * 8 * 9216; const float* ngl = NG + (size_t)l * 6 * 1024;
            if (st == 0 || st == 7) {
                const int s = st == 0 ? 0 : 1;
                pg8::Gemm g{H, (const bf16_t*)(ws + WS_FIN) + (size_t)(l * 2 + s) * 5632 * 1024, T, 5632, 1024, 1024}; pg8::StaticOrder S; S.init(T, 5632, X.G, X.bid);
                pg8::EpiSwiglu E{HID};

#ifndef REP_G1
#define REP_G1 1
#endif
for (int rep_ = 0; rep_ < REP_G1; ++rep_) pg8::gemm_phase<pg8::EpiSwiglu, pg8::StaticOrder, true, true>(X.lds, g, S, E, X.tid);

            } else if (st == 1 || st == 8 || st == 5) {
                pg8::Gemm g;
                if (st == 5) { g = pg8::Gemm{l < 2 ? H : HID2, l < 2 ? (const bf16_t*)(ws + WS_AOUT) + (size_t)l * 1024 * 1024 : (const bf16_t*)(ws + WS_BOUT) + (size_t)(l - 2) * 1024 * 1024, T, 1024, 1024, 1024}; }
                else { g = pg8::Gemm{HID, (const bf16_t*)(ws + WS_FOUT) + (size_t)(l * 2 + (st == 8 ? 1 : 0)) * 1024 * 2816, T, 1024, 2816, 2816}; }
                pg8::StaticOrder S; S.init(T, 1024, X.G, X.bid);
                pg8::EpiY E{Y, PART};

pg8::gemm_phase<pg8::EpiY, pg8::StaticOrder, true, true>(X.lds, g, S, E, X.tid);

            } else if (st == 2 || st == 6 || st == 9) {
                const int sub = st == 2 ? 0 : (st == 6 ? 1 : 2);
                UpdArgs U{}; U.xin = (l == 0 && sub == 0) ? P.in[I_X] : P.out; U.xout = P.out; U.y = Y; U.part = PART; U.gate = modl + (sub * 3 + 2) * 1024; U.gpost = ngl + (sub * 2 + 1) * 1024; U.w = sub == 1 ? 1.0f : 0.5f; U.bstride = 9216;
                if (sub < 2) { U.gpre = ngl + ((sub + 1) * 2) * 1024; U.shift = modl + ((sub + 1) * 3) * 1024; U.scale = modl + ((sub + 1) * 3 + 1) * 1024; U.h = H; }
                else if (l < 3) { U.gpre = ngl + 6 * 1024; U.shift = modl + 8 * 9216; U.scale = modl + 8 * 9216 + 1024; U.h = H;
                    if (l == 1) { U.gpre2 = P.in[I_KVNG]; U.shift2 = KVMOD; U.scale2 = KVMOD + 1024; U.h2 = HID; } }

#ifndef SKIP_UPD
update_phase(X, U);
#endif

            } else if (st == 3) {
                if (l < 2) {
                    pg8::Gemm g{H, (const bf16_t*)(ws + WS_AIN) + (size_t)l * 3072 * 1024, T, 3072, 1024, 1024}; pg8::StaticOrder S; S.init(T, 3072, X.G, X.bid);
                    pg8::EpiConvIn E{HID, HID2};

#ifndef SKIP_G3
pg8::gemm_phase<pg8::EpiConvIn, pg8::StaticOrder, true, true>(X.lds, g, S, E, X.tid);
#endif

                } else {
                    pg8::Gemm g{H, (const bf16_t*)(ws + WS_BIN) + (size_t)(l - 2) * 1280 * 1024, T, 1280, 1024, 1024}; pg8::StaticOrder S; S.init(T, 1280, X.G, X.bid);
                    pg8::EpiQG E{HID, GATES};

#ifndef SKIP_G3B
pg8::gemm_phase<pg8::EpiQG, pg8::StaticOrder, true, true>(X.lds, g, S, E, X.tid);
#endif

                }
            } else if (st == 4) {
                if (l < 2) {
#ifndef SKIP_CONV
conv_phase(X, HID, HID2, P.in[I_ACONV] + (size_t)l * 3 * 1024, H);
#endif
}
                else { AttnArgs A{HID, GATES, (const bf16_t*)(ws + WS_KCMP), (const bf16_t*)(ws + WS_VCMPT), (const bf16_t*)(ws + WS_KS), (const bf16_t*)(ws + WS_VST), (const bf16_t*)(ws + WS_KW), (const bf16_t*)(ws + WS_VWT), HID2};

#ifndef REP_ATTN
#define REP_ATTN 1
#endif
attn_phase(X, A);
#ifdef PROBE_ATTN_MODE
{ AttnArgs A2 = A; A2.O = Y; attn_phase(X, A2, PROBE_ATTN_MODE); }
#endif
 }
            } else if (st == 10) {
                pg8::Gemm g{HID, (const bf16_t*)(ws + WS_KVW), T, 1536, 1024, 1024}; pg8::StaticOrder S; S.init(T, 1536, X.G, X.bid);
                pg8::EpiKV E{(bf16_t*)(ws + WS_KC), (bf16_t*)(ws + WS_KS), (bf16_t*)(ws + WS_KW), (bf16_t*)(ws + WS_VST), (bf16_t*)(ws + WS_VWT)};

#ifndef SKIP_GK
pg8::gemm_phase<pg8::EpiKV, pg8::StaticOrder, true, true>(X.lds, g, S, E, X.tid);
#endif

            } else if (st == 11) {
                pg8::Gemm g{(const bf16_t*)(ws + WS_KC), (const bf16_t*)(ws + WS_CW1), 16384, 512, 2048, 1024}; pg8::DiagOrder S{X.G, X.bid};
                pg8::EpiCmp1 E{(bf16_t*)(ws + WS_HIDC), (const float*)(ws + WS_CBIAS)};

#ifndef SKIP_CM1
pg8::gemm_phase<pg8::EpiCmp1, pg8::DiagOrder, true, true>(X.lds, g, S, E, X.tid);
#endif

            } else if (st == 12) {

#ifndef SKIP_CM2
cmp2_phase(X, (const bf16_t*)(ws + WS_HIDC), P.in[I_CW2], (bf16_t*)(ws + WS_KCMP), (bf16_t*)(ws + WS_VCMPT));
#endif

            }
        }
        if (ph + 1 < ph_hi) { XcdBarrier xbar; xbar.bar = (unsigned*)(ws + WS_BAR); xbar.x = xb_xcc_id(); xbar.st = (volatile LAS unsigned*)((LAS unsigned char*)lds_raw + 192); xcd_barrier(xbar);
#ifdef PROBE_EXTRA_SYNC
            xcd_barrier(xbar);
#endif
        }
#ifdef PROBE_DUP_ST
        if (cur_st_ == PROBE_DUP_ST && !dupflag_) { dupflag_ = 1; --ph; } else dupflag_ = 0;
#endif
    }
}

extern "C" void kernel_launch(void* const* d_in, const int* in_sizes, int n_in, void* d_out, int out_size, void* d_ws, size_t ws_size, hipStream_t stream) {
    static int grid = 0;
    if (grid == 0) {
        if (n_in != 19 || out_size != T * D || ws_size < WS_END) { fprintf(stderr, "kernel_launch: unexpected shapes (n_in %d, out %d, ws %zu < %zu)\n", n_in, out_size, ws_size, (size_t)WS_END); grid = -1; return; }
        int dev = 0, cus = 0, per_cu = 0;
        (void)hipGetDevice(&dev); (void)hipDeviceGetAttribute(&cus, hipDeviceAttributeMultiprocessorCount, dev);
        if (hipFuncSetAttribute((const void*)yoco_fwd, hipFuncAttributeMaxDynamicSharedMemorySize, LDS_BYTES) != hipSuccess) { fprintf(stderr, "kernel_launch: hipFuncSetAttribute failed\n"); grid = -1; return; }
        if (hipOccupancyMaxActiveBlocksPerMultiprocessor(&per_cu, (const void*)yoco_fwd, 512, LDS_BYTES) != hipSuccess || per_cu < 1) { fprintf(stderr, "kernel_launch: occupancy query says %d\n", per_cu); per_cu = 1; }
        (void)hipGetLastError();
        grid = cus * per_cu;
    }
    if (grid < 0) return;
    Params p{};
    for (int i = 0; i < 19; ++i) p.in[i] = (const float*)d_in[i];
    p.out = (float*)d_out; p.ws = (unsigned char*)d_ws;
    p.ph_lo = 0; p.ph_hi = NPH;
    void* args[] = {&p};
    hipError_t e = hipLaunchCooperativeKernel((const void*)yoco_fwd, dim3(grid), dim3(512), args, LDS_BYTES, stream);
    if (e != hipSuccess) fprintf(stderr, "kernel_launch: cooperative launch failed: %s (grid %d)\n", hipGetErrorString(e), grid);
}
```
